# Optimizing an MI355X kernel written in HIP

```python
import math
import jax, jax.numpy as jnp
from jax import lax
import numpy as np

D_MODEL = 1024
BATCH = 4
SEQ = 8192
DEPTH = 1

HG_HEADS = 8
HG_DK = 128
HG_DV = D_MODEL // HG_HEADS
HG_CHUNK = 32

NSA_HEADS = 8
NSA_GROUPS = 2
NSA_REP = NSA_HEADS // NSA_GROUPS
NSA_DK = 128
NSA_DV = 128
CMP_BLOCK = 32
CMP_STRIDE = 16
CMP_HIDDEN = 128
SLC_BLOCK = 64
SLC_TOPK = 16
WINDOW = 512
Q_BLOCK = 64
FORCE_SCORE = 1e4

REL_BUCKETS = 32
REL_MAX_DIST = 128

N_GROUPS = 4
EXP_PER_GROUP = 8
N_EXPERTS = N_GROUPS * EXP_PER_GROUP
TOPK_IN_GROUP = 2
D_EXPERT = D_MODEL // 2
MOE_BLOCK = 128

ALPHA = (2 * DEPTH) ** 0.25
BETA = (8 * DEPTH) ** -0.25

SPLITS = (HG_HEADS * HG_DK, HG_HEADS * HG_DK, HG_HEADS * HG_DV, HG_HEADS * HG_DV,
          NSA_HEADS * NSA_DK,
          NSA_GROUPS * NSA_DK, NSA_GROUPS * NSA_DV,
          NSA_GROUPS * NSA_DK, NSA_GROUPS * NSA_DV,
          NSA_GROUPS * NSA_DK, NSA_GROUPS * NSA_DV,
          3 * NSA_HEADS, D_MODEL, D_MODEL)
D_IN = sum(SPLITS)

kernel_name = 'hybrid_hgrn2_nsa_hmoe_block'


def _layer_norm(x, eps=1e-5):
    xf = x.astype(jnp.float32)
    mu = jnp.mean(xf, axis=-1, keepdims=True)
    var = jnp.mean(jnp.square(xf - mu), axis=-1, keepdims=True)
    return ((xf - mu) * lax.rsqrt(var + eps)).astype(x.dtype)


def _rms_norm(x, eps=1e-6):
    xf = x.astype(jnp.float32)
    return (xf * lax.rsqrt(jnp.mean(jnp.square(xf), axis=-1, keepdims=True) + eps)).astype(x.dtype)


def _masked_softmax(logits, mask):
    lf = jnp.where(mask, logits.astype(jnp.float32), -1e30)
    p = jax.nn.softmax(lf, axis=-1)
    return jnp.where(mask, p, 0.0)


def _rel_bucket(dist):
    n = jnp.maximum(dist, 0)
    max_exact = REL_BUCKETS // 2
    nf = jnp.maximum(n, 1).astype(jnp.float32)
    large = max_exact + (jnp.log(nf / max_exact) / math.log(REL_MAX_DIST / max_exact)
                         * (REL_BUCKETS - max_exact)).astype(jnp.int32)
    large = jnp.minimum(large, REL_BUCKETS - 1)
    return jnp.where(n < max_exact, n, large)


def _hgrn2(q, f_raw, v, lb):
    B, T = q.shape[:2]
    N = T // HG_CHUNK
    lb = lb.reshape(HG_HEADS, HG_DK).astype(q.dtype)
    f = lb + (1 - lb) * jax.nn.sigmoid(f_raw)
    log_f = jnp.log(f)
    k = 1 - f

    def chunks(a):
        return a.reshape(B, N, HG_CHUNK, HG_HEADS, a.shape[-1]).transpose(1, 0, 3, 2, 4)

    qc, kc, vc, lfc = chunks(q), chunks(k), chunks(v), chunks(log_f)
    b = jnp.cumsum(lfc, axis=3)
    b_last = b[:, :, :, -1:, :]
    q_in = qc * jnp.exp(b)
    k_in = kc * jnp.exp(-b)
    k_end = kc * jnp.exp(b_last - b)
    causal = jnp.tril(jnp.ones((HG_CHUNK, HG_CHUNK), dtype=bool))
    att = jnp.einsum('nbhid,nbhjd->nbhij', q_in, k_in)
    att = jnp.where(causal, att, 0)
    o_intra = jnp.einsum('nbhij,nbhje->nbhie', att, vc)
    upd = jnp.einsum('nbhcd,nbhce->nbhde', k_end, vc)
    decay = jnp.exp(b_last[:, :, :, 0, :])

    def step(S, xs):
        q_n, dec_n, u_n = xs
        o_n = jnp.einsum('bhcd,bhde->bhce', q_n, S)
        S = dec_n[..., None] * S + u_n
        return S, o_n

    S0 = jnp.zeros((B, HG_HEADS, HG_DK, HG_DV), q.dtype)
    _, o_inter = lax.scan(step, S0, (q_in, decay, upd))
    o = o_intra + o_inter
    return o.transpose(1, 0, 3, 2, 4).reshape(B, T, HG_HEADS, HG_DV)


def _compress(kv, pos, w1, b1, w2):
    B, G, T, d = kv.shape
    r = CMP_BLOCK // CMP_STRIDE
    ns = T // CMP_STRIDE
    sub = kv.reshape(B, G, ns, CMP_STRIDE, d)
    blocks = jnp.concatenate([sub[:, :, j:ns - r + 1 + j] for j in range(r)], axis=3)
    blocks = (blocks + pos).reshape(B, G, ns - r + 1, CMP_BLOCK * d)
    return jax.nn.silu(blocks @ w1 + b1) @ w2


def _nsa(q, kc, vc, ks, vs, kw, vw, gate_raw, rel_bias,
         pos_k, w1_k, b1_k, w2_k, pos_v, w1_v, b1_v, w2_v):
    B, T = q.shape[:2]
    G, R = NSA_GROUPS, NSA_REP
    NQB = T // Q_BLOCK
    NSLC = T // SLC_BLOCK
    NSEL = min(SLC_TOPK, NSLC)
    scale = NSA_DK ** -0.5
    to_g = lambda a: a.transpose(0, 2, 1, 3)

    k_cmp = _compress(to_g(kc), pos_k, w1_k, b1_k, w2_k)
    v_cmp = _compress(to_g(vc), pos_v, w1_v, b1_v, w2_v)
    NC = k_cmp.shape[2]
    cmp_end = jnp.arange(NC) * CMP_STRIDE + CMP_BLOCK - 1
    cs = np.arange(NC) * CMP_STRIDE
    ss = np.arange(NSLC) * SLC_BLOCK
    overlap = jnp.asarray(((cs[:, None] < ss[None, :] + SLC_BLOCK)
                           & (cs[:, None] + CMP_BLOCK > ss[None, :])).astype(np.float32))

    k_slc = to_g(ks).reshape(B, G, NSLC, SLC_BLOCK, NSA_DK)
    v_slc = to_g(vs).reshape(B, G, NSLC, SLC_BLOCK, NSA_DV)
    pad = ((0, 0), (0, 0), (WINDOW, 0), (0, 0))
    k_win = jnp.pad(to_g(kw), pad)
    v_win = jnp.pad(to_g(vw), pad)
    table = rel_bias.reshape(G, R, REL_BUCKETS)
    g_ix = jnp.arange(G)[None, :, None, None, None]
    r_ix = jnp.arange(R)[None, None, :, None, None]
    blk_start = jnp.arange(NSLC) * SLC_BLOCK
    j_ix = jnp.arange(NSLC)

    q_blocks = q.reshape(B, NQB, Q_BLOCK, G, R, NSA_DK).transpose(1, 0, 3, 4, 2, 5)
    gate_blocks = jax.nn.sigmoid(gate_raw).reshape(B, NQB, Q_BLOCK, G, R, 3).transpose(1, 0, 3, 4, 2, 5)
    gather = jax.vmap(jax.vmap(lambda blk, ix: blk[ix]))

    def block_fn(args):
        qb, q_blk, g_blk = args
        t = qb * Q_BLOCK + jnp.arange(Q_BLOCK)
        dist_c = t[:, None] - cmp_end[None, :]
        s_c = jnp.einsum('bgrqd,bgnd->bgrqn', q_blk, k_cmp) * scale + table[:, :, _rel_bucket(dist_c)]
        p_c = _masked_softmax(s_c, dist_c >= 0)
        o_c = jnp.einsum('bgrqn,bgnd->bgrqd', p_c.astype(v_cmp.dtype), v_cmp)
        imp = jnp.einsum('bgqn,nj->bgqj', p_c.sum(axis=2), overlap)
        cur = t // SLC_BLOCK
        forced = (j_ix[None, :] == 0) | (j_ix[None, :] == cur[:, None]) | (j_ix[None, :] == cur[:, None] - 1)
        valid = blk_start[None, :] <= t[:, None]
        score = jnp.where(valid, jnp.where(forced, FORCE_SCORE, imp), -1.0)
        _, idx = lax.top_k(score, NSEL)
        k_sel = gather(k_slc, idx).reshape(B, G, Q_BLOCK, NSEL * SLC_BLOCK, NSA_DK)
        v_sel = gather(v_slc, idx).reshape(B, G, Q_BLOCK, NSEL * SLC_BLOCK, NSA_DV)
        s_pos = (idx[..., None] * SLC_BLOCK + jnp.arange(SLC_BLOCK)).reshape(B, G, Q_BLOCK, NSEL * SLC_BLOCK)
        dist_s = t[None, None, :, None] - s_pos
        s_s = (jnp.einsum('bgrqd,bgqkd->bgrqk', q_blk, k_sel) * scale
               + table[g_ix, r_ix, _rel_bucket(dist_s)[:, :, None]])
        p_s = _masked_softmax(s_s, (dist_s >= 0)[:, :, None])
        o_s = jnp.einsum('bgrqk,bgqkd->bgrqd', p_s.astype(v_sel.dtype), v_sel)
        k_w = lax.dynamic_slice_in_dim(k_win, qb * Q_BLOCK, WINDOW + Q_BLOCK, axis=2)
        v_w = lax.dynamic_slice_in_dim(v_win, qb * Q_BLOCK, WINDOW + Q_BLOCK, axis=2)
        pos_w = qb * Q_BLOCK - WINDOW + jnp.arange(WINDOW + Q_BLOCK)
        dist_w = t[:, None] - pos_w[None, :]
        mask_w = (dist_w >= 0) & (dist_w < WINDOW) & (pos_w[None, :] >= 0)
        s_w = jnp.einsum('bgrqd,bgkd->bgrqk', q_blk, k_w) * scale + table[:, :, _rel_bucket(dist_w)]
        p_w = _masked_softmax(s_w, mask_w)
        o_w = jnp.einsum('bgrqk,bgkd->bgrqd', p_w.astype(v_w.dtype), v_w)
        return g_blk[..., 0:1] * o_c + g_blk[..., 1:2] * o_s + g_blk[..., 2:3] * o_w

    o = lax.map(block_fn, (jnp.arange(NQB), q_blocks, gate_blocks))
    return o.transpose(1, 0, 4, 2, 3, 5).reshape(B, T, NSA_HEADS * NSA_DV)


def _hier_moe(h, w_grp, b_grp, w_exp, b_exp, w1, w3, w2):
    B, T, D = h.shape
    x = h.reshape(-1, D)
    NT = x.shape[0]
    grp_prob = jax.nn.softmax((x @ w_grp + b_grp).astype(jnp.float32), axis=-1)
    grp_p, grp_idx = lax.top_k(grp_prob, 1)
    exp_logits = (x @ w_exp + b_exp).astype(jnp.float32).reshape(NT, N_GROUPS, EXP_PER_GROUP)
    in_grp = exp_logits[jnp.arange(NT), grp_idx[:, 0]]
    top_l, top_i = lax.top_k(in_grp, TOPK_IN_GROUP)
    comb = grp_p * jax.nn.softmax(top_l, axis=-1)
    expert = grp_idx * EXP_PER_GROUP + top_i

    A = NT * TOPK_IN_GROUP
    e_flat = expert.reshape(-1)
    tok_flat = jnp.repeat(jnp.arange(NT), TOPK_IN_GROUP)
    order = jnp.argsort(e_flat)
    e_s, tok_s, w_s = e_flat[order], tok_flat[order], comb.reshape(-1)[order]
    counts = jnp.bincount(e_flat, length=N_EXPERTS)
    starts = jnp.cumsum(counts) - counts
    padded = (counts + MOE_BLOCK - 1) // MOE_BLOCK * MOE_BLOCK
    pend = jnp.cumsum(padded)
    pstarts = pend - padded
    dest = pstarts[e_s] + jnp.arange(A) - starts[e_s]
    n_blocks = -(-A // MOE_BLOCK) + N_EXPERTS
    x_pad = jnp.zeros((n_blocks * MOE_BLOCK, D), x.dtype).at[dest].set(x[tok_s])
    block_expert = jnp.minimum(jnp.searchsorted(pend, jnp.arange(n_blocks) * MOE_BLOCK, side='right'),
                               N_EXPERTS - 1)

    def expert_block(args):
        xb, e = args
        return (jax.nn.silu(xb @ w1[e]) * (xb @ w3[e])) @ w2[e]

    y_pad = lax.map(expert_block, (x_pad.reshape(n_blocks, MOE_BLOCK, D), block_expert)).reshape(-1, D)
    y = y_pad[dest] * w_s[:, None].astype(x.dtype)
    out = jnp.zeros_like(x).at[tok_s].add(y)
    return out.reshape(B, T, D)


def setup_inputs(seed: int = 0) -> dict:
    key = jax.random.key(seed)
    ks = iter(jax.random.split(key, 40))
    nrm = lambda shape, s: jax.random.normal(next(ks), shape, jnp.float32) * s
    L, D = DEPTH, D_MODEL
    return {
        'x': nrm((BATCH, SEQ, D), 1.0),
        'c': nrm((BATCH, D), 1.0),
        'ada_w': nrm((L, D, 6 * D), 0.1 * D ** -0.5),
        'ada_b': nrm((L, 6 * D), 0.02),
        'w_in': nrm((L, D, D_IN), D ** -0.5),
        'b_in': nrm((L, D_IN), 0.02),
        'hg_lb_logits': nrm((DEPTH + 1, HG_HEADS * HG_DK), 0.1),
        'hg_norm_w': 1.0 + nrm((L, HG_HEADS * HG_DV), 0.05),
        'cmp_pos_k': nrm((L, CMP_BLOCK, NSA_DK), 0.1),
        'cmp_w1_k': nrm((L, CMP_BLOCK * NSA_DK, CMP_HIDDEN), (CMP_BLOCK * NSA_DK) ** -0.5),
        'cmp_b1_k': nrm((L, CMP_HIDDEN), 0.02),
        'cmp_w2_k': nrm((L, CMP_HIDDEN, NSA_DK), CMP_HIDDEN ** -0.5),
        'cmp_pos_v': nrm((L, CMP_BLOCK, NSA_DV), 0.1),
        'cmp_w1_v': nrm((L, CMP_BLOCK * NSA_DV, CMP_HIDDEN), (CMP_BLOCK * NSA_DV) ** -0.5),
        'cmp_b1_v': nrm((L, CMP_HIDDEN), 0.02),
        'cmp_w2_v': nrm((L, CMP_HIDDEN, NSA_DV), CMP_HIDDEN ** -0.5),
        'rel_bias': nrm((NSA_HEADS, REL_BUCKETS), 0.5),
        'w_br_hg': nrm((L, HG_HEADS * HG_DV, D), BETA * (HG_HEADS * HG_DV) ** -0.5),
        'w_br_nsa': nrm((L, NSA_HEADS * NSA_DV, D), BETA * (NSA_HEADS * NSA_DV) ** -0.5),
        'w_out': nrm((L, D, D), BETA * D ** -0.5),
        'ln1_g': 1.0 + nrm((L, D), 0.05),
        'ln1_b': nrm((L, D), 0.02),
        'router_grp_w': nrm((L, D, N_GROUPS), D ** -0.5),
        'router_grp_b': nrm((L, N_GROUPS), 0.01),
        'router_exp_w': nrm((L, D, N_EXPERTS), D ** -0.5),
        'router_exp_b': nrm((L, N_EXPERTS), 0.01),
        'exp_w1': nrm((L, N_EXPERTS, D, D_EXPERT), D ** -0.5),
        'exp_w3': nrm((L, N_EXPERTS, D, D_EXPERT), D ** -0.5),
        'exp_w2': nrm((L, N_EXPERTS, D_EXPERT, D), BETA * D_EXPERT ** -0.5),
        'ln2_g': 1.0 + nrm((L, D), 0.05),
        'ln2_b': nrm((L, D), 0.02),
    }


def reference(x, c, ada_w, ada_b, w_in, b_in, hg_lb_logits, hg_norm_w,
              cmp_pos_k, cmp_w1_k, cmp_b1_k, cmp_w2_k, cmp_pos_v, cmp_w1_v, cmp_b1_v, cmp_w2_v,
              rel_bias, w_br_hg, w_br_nsa, w_out, ln1_g, ln1_b,
              router_grp_w, router_grp_b, router_exp_w, router_exp_b,
              exp_w1, exp_w3, exp_w2, ln2_g, ln2_b):
    B, T, D = x.shape
    split_idx = [int(v) for v in np.cumsum(SPLITS)[:-1]]
    lb_all = jnp.cumsum(jax.nn.softmax(hg_lb_logits.astype(jnp.float32), axis=0), axis=0)
    c_act = jax.nn.silu(c)
    for l in range(DEPTH):
        mod = c_act @ ada_w[l] + ada_b[l]
        sh1, sc1, g1, sh2, sc2, g2 = jnp.split(mod, 6, axis=-1)

        h = _layer_norm(x) * (1 + sc1[:, None]) + sh1[:, None]
        proj = h @ w_in[l] + b_in[l]
        (hq, hf, hi, hg, nq, kc, vc, ks, vs, kw, vw, ngate, mg_h, mg_n) = jnp.split(proj, split_idx, axis=-1)
        o_h = _hgrn2(hq.reshape(B, T, HG_HEADS, HG_DK), hf.reshape(B, T, HG_HEADS, HG_DK),
                     hi.reshape(B, T, HG_HEADS, HG_DV), lb_all[l])
        o_h = (_rms_norm(o_h) * hg_norm_w[l].reshape(HG_HEADS, HG_DV)
               * jax.nn.sigmoid(hg.reshape(B, T, HG_HEADS, HG_DV))).reshape(B, T, HG_HEADS * HG_DV)
        gsz = (B, T, NSA_GROUPS, NSA_DK)
        o_n = _nsa(nq.reshape(B, T, NSA_HEADS, NSA_DK),
                   kc.reshape(gsz), vc.reshape(gsz), ks.reshape(gsz), vs.reshape(gsz),
                   kw.reshape(gsz), vw.reshape(gsz),
                   ngate.reshape(B, T, NSA_HEADS, 3), rel_bias,
                   cmp_pos_k[l], cmp_w1_k[l], cmp_b1_k[l], cmp_w2_k[l],
                   cmp_pos_v[l], cmp_w1_v[l], cmp_b1_v[l], cmp_w2_v[l])
        merged = jax.nn.sigmoid(mg_h) * (o_h @ w_br_hg[l]) + jax.nn.sigmoid(mg_n) * (o_n @ w_br_nsa[l])
        y = (1 + g1[:, None]) * (merged @ w_out[l])
        x = _layer_norm(ALPHA * x + y) * ln1_g[l] + ln1_b[l]

        h = _layer_norm(x) * (1 + sc2[:, None]) + sh2[:, None]
        y = (1 + g2[:, None]) * _hier_moe(h, router_grp_w[l], router_grp_b[l], router_exp_w[l],
                                          router_exp_b[l], exp_w1[l], exp_w3[l], exp_w2[l])
        x = _layer_norm(ALPHA * x + y) * ln2_g[l] + ln2_b[l]
    return x
```

```cpp
#include <hip/hip_runtime.h>
#include <stdint.h>

typedef unsigned short bf16_t;

constexpr int B_ = 4, T_ = 8192, D_ = 1024, NT = B_ * T_;
constexpr int DIN = 8728;
constexpr int LDP = 6656;
constexpr int C_HQ = 0, C_HF = 1024, C_HI = 2048, C_HG = 3072, C_NQ = 4096, C_KC = 5120, C_VC = 5376, C_KS = 5632, C_VS = 5888, C_KW = 6144, C_VW = 6400;
constexpr int NC = 511;
constexpr float ALPHA = 1.189207115002721f;
constexpr int MAXROWS = 73728;

constexpr size_t KB = 1024, MB = 1024 * 1024;
constexpr size_t OFF_BAR = 0, OFF_MOD = 16 * KB, OFF_LB = 112 * KB, OFF_LUT = 116 * KB, OFF_CB = 120 * KB, OFF_CNT = 124 * KB, OFF_TOKI = 128 * KB;
constexpr size_t OFF_GATE = 1 * MB, OFF_KCMP = 4 * MB, OFF_VCMP = 5 * MB, OFF_HID = 6 * MB;
constexpr size_t OFF_DEC = 18 * MB;
constexpr size_t OFF_QCTR = 960 * KB;
constexpr size_t OFF_CMPW = 10 * MB;
constexpr size_t OFF_H = 31 * MB;
constexpr size_t OFF_PROJ = 95 * MB;
constexpr size_t OFF_Z = OFF_PROJ, OFF_XPAD = OFF_PROJ + 128 * MB;
constexpr size_t OFF_BIAS1 = 896 * KB, OFF_TILEE = 940 * KB;
constexpr size_t OFF_WINT = 12 * MB;
constexpr size_t OFF_WBRH = 12 * MB, OFF_WBRN = 14 * MB, OFF_WOUTT = 16 * MB;
constexpr size_t OFF_E13 = OFF_PROJ + 272 * MB, OFF_E2T = OFF_PROJ + 336 * MB;
constexpr int N1 = 8960;

struct Params {
    const float *x, *c, *ada_w, *ada_b, *w_in, *b_in, *lb_logits, *hg_norm_w, *pos_k, *w1_k, *b1_k, *w2_k, *pos_v, *w1_v, *b1_v, *w2_v, *rel_bias,
        *w_br_hg, *w_br_nsa, *w_out, *ln1_g, *ln1_b, *rg_w, *rg_b, *re_w, *re_b, *e_w1, *e_w3, *e_w2, *ln2_g, *ln2_b;
    float* out; unsigned char* ws;
};

__device__ __forceinline__ int tid_() { int t = threadIdx.x; asm volatile("" : "+v"(t)); return t; }
__device__ __forceinline__ float bf2f(bf16_t v) { return __uint_as_float(((unsigned)v) << 16); }
__device__ __forceinline__ bf16_t f2bf(float f) { unsigned u = __float_as_uint(f); u += 0x7FFFu + ((u >> 16) & 1u); return (bf16_t)(u >> 16); }
__device__ __forceinline__ float sigmoidf_(float v) { return 1.f / (1.f + __expf(-v)); }
__device__ __forceinline__ float siluf_(float v) { return v / (1.f + __expf(-v)); }
__device__ __forceinline__ float wsum(float v) { for (int o = 32; o > 0; o >>= 1) v += __shfl_xor(v, o); return v; }
__device__ __forceinline__ float rfl(float v) { return __int_as_float(__builtin_amdgcn_readfirstlane(__float_as_int(v))); }
__device__ __forceinline__ float wmax(float v) { for (int o = 32; o > 0; o >>= 1) v = fmaxf(v, __shfl_xor(v, o)); return v; }
__device__ __forceinline__ float4 ld_bf4(const bf16_t* p) { uint2 r = *(const uint2*)p; return make_float4(__uint_as_float(r.x << 16), __uint_as_float(r.x & 0xFFFF0000u), __uint_as_float(r.y << 16), __uint_as_float(r.y & 0xFFFF0000u)); }
__device__ __forceinline__ void st_bf4(bf16_t* p, float a, float b, float c, float d) { uint2 r; r.x = (unsigned)f2bf(a) | ((unsigned)f2bf(b) << 16); r.y = (unsigned)f2bf(c) | ((unsigned)f2bf(d) << 16); *(uint2*)p = r; }
__device__ __forceinline__ int rel_bucket(int n) {
    if (n < 16) return n < 0 ? 0 : n;
    int b = 16;
    b += (n >= 19) + (n >= 21) + (n >= 24) + (n >= 27) + (n >= 31) + (n >= 35) + (n >= 40) + (n >= 46) + (n >= 52) + (n >= 59) + (n >= 67) + (n >= 77) + (n >= 87) + (n >= 99) + (n >= 113);
    return b;
}

template <class AF, class BF, class EF>
__device__ __forceinline__ void gemm128(float* sm, int m0, int n0, int K, AF af, BF bf, EF ef) {
    float(*As)[132] = (float(*)[132])sm;
    float(*Bs)[132] = (float(*)[132])(sm + 16 * 132);
    const int tid = tid_(), tx = tid & 31, ty = tid >> 5;
    const int ar = tid >> 2, ak = (tid & 3) * 4, bk = tid >> 5, bn = (tid & 31) * 4;
    float acc[8][4];
#pragma unroll
    for (int i = 0; i < 8; ++i)
#pragma unroll
        for (int j = 0; j < 4; ++j) acc[i][j] = 0.f;
    for (int k0 = 0; k0 < K; k0 += 16) {
        const float4 a = af(m0 + ar, k0 + ak);
        const float4 b = bf(k0 + bk, n0 + bn);
        __syncthreads();
        As[ak + 0][ar] = a.x; As[ak + 1][ar] = a.y; As[ak + 2][ar] = a.z; As[ak + 3][ar] = a.w;
        *(float4*)&Bs[bk][bn] = b;
        __syncthreads();
#pragma unroll
        for (int k = 0; k < 16; ++k) {
            const float4 a0 = *(const float4*)&As[k][ty * 8], a1 = *(const float4*)&As[k][ty * 8 + 4], bb = *(const float4*)&Bs[k][tx * 4];
            const float av[8] = {a0.x, a0.y, a0.z, a0.w, a1.x, a1.y, a1.z, a1.w};
            const float bv[4] = {bb.x, bb.y, bb.z, bb.w};
#pragma unroll
            for (int i = 0; i < 8; ++i)
#pragma unroll
                for (int j = 0; j < 4; ++j) acc[i][j] = fmaf(av[i], bv[j], acc[i][j]);
        }
    }
#pragma unroll
    for (int i = 0; i < 8; ++i) ef(m0 + ty * 8 + i, n0 + tx * 4, make_float4(acc[i][0], acc[i][1], acc[i][2], acc[i][3]));
    __syncthreads();
}


#define XB_TMO      128
#define XB_XCNT(j)  (256  + 64 * (j))
#define XB_XSUB(j)  (1280 + 64 * (j))
#define XB_XGEN(j)  (2304 + 64 * (j))
#define XB_TOP      3328
#define XB_TOPGEN   3392
#define XCD_BAR_WORDS 3456
#define XB_SPIN_CAP (1u << 22)
#define LAS __attribute__((address_space(3)))
__device__ __forceinline__ unsigned xb_ld(unsigned* p)              { return __hip_atomic_load(p, __ATOMIC_RELAXED, __HIP_MEMORY_SCOPE_AGENT); }
__device__ __forceinline__ unsigned xb_add(unsigned* p, unsigned v) { return __hip_atomic_fetch_add(p, v, __ATOMIC_RELAXED, __HIP_MEMORY_SCOPE_AGENT); }
__device__ __forceinline__ unsigned xb_xcc_id() { return (unsigned)__builtin_amdgcn_s_getreg((3 << 11) | 20) & 0xFu; }
#define XB_SPIN(cond, bar) do { unsigned _sp = 0; while (cond) { __builtin_amdgcn_s_sleep(1); \
    if ((++_sp & 255u) == 0u) { if (xb_ld(&(bar)[XB_TMO])) break; if (_sp > XB_SPIN_CAP) { atomicAdd(&(bar)[XB_TMO], 1u); break; } } } } while (0)
struct XcdBarrier { unsigned* bar; unsigned x; volatile LAS unsigned* st; };
__device__ __forceinline__ XcdBarrier xcd_barrier_post(unsigned* bar, volatile LAS unsigned* st) {
    XcdBarrier b; b.bar = bar; b.x = xb_xcc_id(); b.st = st;
    if (threadIdx.x == 0) (void)xb_add(&bar[XB_XCNT(b.x)], 1u);
    return b;
}
__device__ __forceinline__ void xcd_barrier_complete(unsigned* bar, unsigned x, unsigned& nloc, unsigned& nx) {
    const unsigned G = gridDim.x * gridDim.y * gridDim.z;
    unsigned sum, cnt, mine, sp = 0u;
    for (;;) {
        sum = 0u; cnt = 0u; mine = 0u;
#pragma unroll
        for (unsigned j = 0; j < 16; ++j) { const unsigned c = xb_ld(&bar[XB_XCNT(j)]); sum += c; cnt += (c > 0u) ? 1u : 0u; mine = (j == x) ? c : mine; }
        if (sum == G) break;
        __builtin_amdgcn_s_sleep(1);
        if ((++sp & 255u) == 0u) { if (xb_ld(&bar[XB_TMO])) break; if (sp > XB_SPIN_CAP) { atomicAdd(&bar[XB_TMO], 1u); break; } }
    }
    nloc = mine > 0u ? mine : 1u; nx = cnt > 0u ? cnt : 1u;
}
__device__ __forceinline__ void xcd_barrier(const XcdBarrier& b) {
    asm volatile("s_waitcnt vmcnt(0)" ::: "memory");
    __syncthreads();
    if (threadIdx.x == 0) {
        unsigned* bar = b.bar;
        __builtin_amdgcn_s_waitcnt(0);
        unsigned nloc = b.st[0], nx = b.st[1];
        if (nloc == 0u) { xcd_barrier_complete(bar, b.x, nloc, nx); b.st[0] = nloc; b.st[1] = nx; }
        const unsigned old = xb_add(&bar[XB_XSUB(b.x)], 1u);
        const unsigned gen = old / nloc;
        if (old + 1u == (gen + 1u) * nloc) {
            __builtin_amdgcn_fence(__ATOMIC_RELEASE, "agent");
            asm volatile("s_waitcnt vmcnt(0)" ::: "memory");
            const unsigned og = xb_add(&bar[XB_TOP], 1u);
            const unsigned tg = og / nx;
            if (og + 1u == (tg + 1u) * nx) xb_add(&bar[XB_TOPGEN], 1u);
            else XB_SPIN(xb_ld(&bar[XB_TOPGEN]) == tg, bar);
            __builtin_amdgcn_fence(__ATOMIC_ACQUIRE, "agent");
            xb_add(&bar[XB_XGEN(b.x)], 1u);
            asm volatile("s_waitcnt vmcnt(0)" ::: "memory");
        } else {
            XB_SPIN(xb_ld(&bar[XB_XGEN(b.x)]) == gen, bar);
            __builtin_amdgcn_fence(__ATOMIC_ACQUIRE, "agent");
            asm volatile("s_waitcnt vmcnt(0)" ::: "memory");
        }
    }
    __syncthreads();
}


namespace pg8 {
#define PG8_LAS __attribute__((address_space(3)))
typedef short bf16x8 __attribute__((ext_vector_type(8)));
typedef float f32x4 __attribute__((ext_vector_type(4)));
typedef unsigned u32x4 __attribute__((ext_vector_type(4)));
constexpr int BM = 256, BK = 64, HALF = 128, HTB = HALF * BK * 2, STAGE_BYTES = 8 * HTB, NXCD = 8, WGM = 8;
__host__ __device__ __forceinline__ int lds_byte(int r, int c) { const int st = (r >> 4) * 2 + (c >> 5), rr = r & 15, cc = c & 31, ob = rr * 64 + cc * 2; return st * 1024 + (ob ^ (((ob >> 9) & 1) << 5)); }
__host__ __device__ __forceinline__ void stage_rc(int b, int& R, int& C) { const int st = b / 1024, sb = b % 1024, swz = sb ^ (((sb >> 9) & 1) << 5); R = (st >> 1) * 16 + swz / 64; C = (st & 1) * 32 + (swz % 64) / 2; }
__host__ __device__ __forceinline__ int perm32(int rho) { const int n = rho >> 4, i = rho & 15; return 8 * (i >> 2) + 4 * n + (i & 3); }
struct Unit { int pm, pn; long boff; long aoff; };
struct Gemm { const bf16_t* A; const bf16_t* Bt; int K, lda, ldb; int kmode = 0; int bdup = 0; };
struct StaticOrder {
    int nM, nN, nwg, G, c;
    __device__ void init(int M, int N, int G_, int c_) { nM = M / BM; nN = N / BM; nwg = nM * nN; G = G_; c = c_; }
    __device__ bool next(int i, Unit& u) const {
        const long L = (long)i * G + c; if (L >= nwg) return false;
        int wgid = (int)L; { const int q = nwg / NXCD, r = nwg % NXCD, xcd = wgid % NXCD, off = wgid / NXCD; wgid = (xcd < r ? xcd * (q + 1) : r * (q + 1) + (xcd - r) * q) + off; }
        const int nig = WGM * nN, gid = wgid / nig, fm = gid * WGM, gsz = (nM - fm) < WGM ? (nM - fm) : WGM;
        u.pm = fm + ((wgid % nig) % gsz); u.pn = (wgid % nig) / gsz; u.boff = 0; u.aoff = 0; return true;
    }
    __device__ __forceinline__ void a_ready(const Unit&) const {}
    __device__ __forceinline__ void done(const Unit&) const {}
};
struct MoeOrder {
    const int* tile_e; int nwg, G, c; long estride;
    __device__ bool next(int i, Unit& u) const {
        const long L = (long)i * G + c; if (L >= nwg) return false;
        u.pm = (int)(L >> 2); u.pn = (int)(L & 3); u.boff = (long)tile_e[u.pm] * estride; u.aoff = 0; return true;
    }
    __device__ __forceinline__ void a_ready(const Unit&) const {}
    __device__ __forceinline__ void done(const Unit&) const {}
};
struct CmpOrder {
    int G, c;
    __device__ bool next(int i, Unit& u) const {
        const int L = i * G + c; if (L >= 128) return false;
        const int kv = L >> 6, bg = (L >> 3) & 7, half = (L >> 2) & 1, kq = L & 3;
        u.pm = half; u.pn = (kv << 3) | bg;
        u.aoff = ((long)((bg >> 1) * T_ + 8 * kq) * LDP + (kv ? C_VC : C_KC) + (bg & 1) * 128) * 2;
        u.boff = ((long)kv * 128 * 4096 + kq * 1024) * 2;
        return true;
    }
    __device__ __forceinline__ void a_ready(const Unit&) const {}
    __device__ __forceinline__ void done(const Unit&) const {}
};
__device__ __forceinline__ unsigned cvt_pk_bf16(float lo, float hi) { unsigned r; asm volatile("v_cvt_pk_bf16_f32 %0, %1, %2" : "=v"(r) : "v"(lo), "v"(hi)); return r; }
__device__ __forceinline__ f32x4 unpk_lo(u32x4 w) { return (f32x4){__uint_as_float(w.x << 16), __uint_as_float(w.x & 0xFFFF0000u), __uint_as_float(w.y << 16), __uint_as_float(w.y & 0xFFFF0000u)}; }
__device__ __forceinline__ f32x4 unpk_hi(u32x4 w) { return (f32x4){__uint_as_float(w.z << 16), __uint_as_float(w.z & 0xFFFF0000u), __uint_as_float(w.w << 16), __uint_as_float(w.w & 0xFFFF0000u)}; }
__device__ __forceinline__ u32x4 pk8(f32x4 v0, f32x4 v1) { u32x4 w; w.x = cvt_pk_bf16(v0[0], v0[1]); w.y = cvt_pk_bf16(v0[2], v0[3]); w.z = cvt_pk_bf16(v1[0], v1[1]); w.w = cvt_pk_bf16(v1[2], v1[3]); return w; }
__device__ __forceinline__ f32x4 sig4(f32x4 v) { return (f32x4){sigmoidf_(v[0]), sigmoidf_(v[1]), sigmoidf_(v[2]), sigmoidf_(v[3])}; }
struct EpiProj {
    static constexpr bool PERM = true, AFTER_DRAIN = false, HAS_MID = false;
    bf16_t* proj; bf16_t* mg; float* gate; const float* bias;
    __device__ __forceinline__ void operator()(const f32x4 (&acc)[2][2][4][2], const Unit& u, int wr, int wc, int fr, int fq) const {
        const int row0 = u.pm * BM + wr * 64 + fr, c8 = u.pn * BM + wc * 32 + 8 * fq;
        f32x4 bv[2][2];
#pragma unroll
        for (int bj = 0; bj < 2; ++bj)
#pragma unroll
            for (int n = 0; n < 2; ++n) bv[bj][n] = *(const f32x4*)(bias + c8 + bj * HALF + 4 * n);
#pragma unroll
        for (int ai = 0; ai < 2; ++ai)
#pragma unroll
            for (int m = 0; m < 4; ++m) {
                const size_t row = (size_t)(row0 + ai * HALF + m * 16);
#pragma unroll
                for (int bj = 0; bj < 2; ++bj) {
                    const f32x4 v0 = acc[ai][bj][m][0] + bv[bj][0], v1 = acc[ai][bj][m][1] + bv[bj][1];
                    const int col = c8 + bj * HALF;
                    if (u.pn < 26) *(u32x4*)(proj + row * LDP + col) = pk8(v0, v1);
                    else if (u.pn < 34) *(u32x4*)(mg + row * 2048 + (col - 6656)) = pk8(sig4(v0), sig4(v1));
                    else if (col - 8704 < 24) { float* gp = gate + row * 24 + (col - 8704); *(f32x4*)gp = sig4(v0); *(f32x4*)(gp + 4) = sig4(v1); }
                }
            }
    }
};
struct EpiMrg {
    static constexpr bool PERM = true, AFTER_DRAIN = false, HAS_MID = true;
    const bf16_t* mg; bf16_t* mr;
    __device__ __forceinline__ void mid(f32x4 (&acc)[2][2][4][2], const Unit& u, int wr, int wc, int fr, int fq) const {
        const int row0 = u.pm * BM + wr * 64 + fr, c8 = u.pn * BM + wc * 32 + 8 * fq;
#pragma unroll
        for (int ai = 0; ai < 2; ++ai)
#pragma unroll
            for (int m = 0; m < 4; ++m) {
                const size_t row = (size_t)(row0 + ai * HALF + m * 16);
#pragma unroll
                for (int bj = 0; bj < 2; ++bj) {
                    const int col = c8 + bj * HALF;
                    const u32x4 hw = *(const u32x4*)(mg + row * 2048 + col), nw = *(const u32x4*)(mg + row * 2048 + 1024 + col);
                    const f32x4 h0 = unpk_lo(hw), h1 = unpk_hi(hw), n0 = unpk_lo(nw), n1 = unpk_hi(nw);
#pragma unroll
                    for (int j = 0; j < 4; ++j) { acc[ai][bj][m][0][j] *= h0[j] * __builtin_amdgcn_rcpf(fmaxf(n0[j], 8.673617e-19f)); acc[ai][bj][m][1][j] *= h1[j] * __builtin_amdgcn_rcpf(fmaxf(n1[j], 8.673617e-19f)); }
                    asm volatile("" ::: "memory");
                }
            }
    }
    __device__ __forceinline__ void operator()(const f32x4 (&acc)[2][2][4][2], const Unit& u, int wr, int wc, int fr, int fq) const {
        const int row0 = u.pm * BM + wr * 64 + fr, c8 = u.pn * BM + wc * 32 + 8 * fq;
#pragma unroll
        for (int ai = 0; ai < 2; ++ai)
#pragma unroll
            for (int m = 0; m < 4; ++m) {
                const size_t row = (size_t)(row0 + ai * HALF + m * 16);
#pragma unroll
                for (int bj = 0; bj < 2; ++bj) {
                    const int col = c8 + bj * HALF;
                    const u32x4 nw = *(const u32x4*)(mg + row * 2048 + 1024 + col);
                    f32x4 n0 = unpk_lo(nw), n1 = unpk_hi(nw);
#pragma unroll
                    for (int j = 0; j < 4; ++j) { n0[j] = fmaxf(n0[j], 8.673617e-19f); n1[j] = fmaxf(n1[j], 8.673617e-19f); }
                    *(u32x4*)(mr + row * 1024 + col) = pk8(n0 * acc[ai][bj][m][0], n1 * acc[ai][bj][m][1]);
                }
                asm volatile("" ::: "memory");
            }
    }
};
struct EpiWout {
    static constexpr bool PERM = false, AFTER_DRAIN = false, HAS_MID = false;
    const float* x; const float* mod; float* z;
    __device__ __forceinline__ void operator()(const f32x4 (&acc)[2][2][4][2], const Unit& u, int wr, int wc, int fr, int fq) const {
        const int row0 = u.pm * BM + wr * 64 + fr, col0 = u.pn * BM + wc * 32 + 4 * fq;
        const float* g1 = mod + ((u.pm * BM) / T_) * 6144 + 2048 + col0;
#pragma unroll
        for (int ai = 0; ai < 2; ++ai)
#pragma unroll
            for (int m = 0; m < 4; ++m) {
                const size_t ro = (size_t)(row0 + ai * HALF + m * 16) * 1024 + col0;
#pragma unroll
                for (int bj = 0; bj < 2; ++bj)
#pragma unroll
                    for (int n = 0; n < 2; ++n) { const f32x4 xv = *(const f32x4*)(x + ro + bj * HALF + n * 16), gv = *(const f32x4*)(g1 + bj * HALF + n * 16) + 1.0f;
                        *(f32x4*)(z + ro + bj * HALF + n * 16) = xv * ALPHA + gv * acc[ai][bj][m][n]; }
                if (m & 1) asm volatile("" ::: "memory");
            }
    }
};
struct EpiExp1 {
    static constexpr bool PERM = true, AFTER_DRAIN = false, HAS_MID = false;
    bf16_t* U;
    __device__ __forceinline__ void operator()(const f32x4 (&acc)[2][2][4][2], const Unit& u, int wr, int wc, int fr, int fq) const {
        const int row0 = u.pm * BM + wr * 64 + fr, c8 = u.pn * HALF + wc * 32 + 8 * fq;
#pragma unroll
        for (int ai = 0; ai < 2; ++ai)
#pragma unroll
            for (int m = 0; m < 4; ++m) {
                f32x4 r[2];
#pragma unroll
                for (int n = 0; n < 2; ++n)
#pragma unroll
                    for (int j = 0; j < 4; ++j) r[n][j] = siluf_(acc[ai][0][m][n][j]) * acc[ai][1][m][n][j];
                *(u32x4*)(U + (size_t)(row0 + ai * HALF + m * 16) * 512 + c8) = pk8(r[0], r[1]);
            }
    }
};
struct EpiCmpAcc {
    static constexpr bool PERM = false, AFTER_DRAIN = false, HAS_MID = false;
    float* hp;
    __device__ __forceinline__ void operator()(const f32x4 (&acc)[2][2][4][2], const Unit& u, int wr, int wc, int fr, int fq) const {
        const int row0 = u.pn * 512 + u.pm * BM + wr * 64 + fr, col0 = wc * 32 + 4 * fq;
#pragma unroll
        for (int ai = 0; ai < 2; ++ai)
#pragma unroll
            for (int m = 0; m < 4; ++m) { float* rp = hp + (size_t)(row0 + ai * HALF + m * 16) * 128 + col0;
#pragma unroll
                for (int n = 0; n < 2; ++n)
#pragma unroll
                    for (int j = 0; j < 4; ++j) atomicAdd(rp + n * 16 + j, acc[ai][0][m][n][j]); }
    }
};
struct EpiBf {
    static constexpr bool PERM = true, AFTER_DRAIN = false, HAS_MID = false;
    bf16_t* O; int ldo;
    __device__ __forceinline__ void operator()(const f32x4 (&acc)[2][2][4][2], const Unit& u, int wr, int wc, int fr, int fq) const {
        const int row0 = u.pm * BM + wr * 64 + fr, c8 = u.pn * BM + wc * 32 + 8 * fq;
#pragma unroll
        for (int ai = 0; ai < 2; ++ai)
#pragma unroll
            for (int m = 0; m < 4; ++m)
#pragma unroll
                for (int bj = 0; bj < 2; ++bj) *(u32x4*)(O + (size_t)(row0 + ai * HALF + m * 16) * ldo + c8 + bj * HALF) = pk8(acc[ai][bj][m][0], acc[ai][bj][m][1]);
    }
};
template <class Epi, class Sched>
__device__ __forceinline__ void gemm_phase(PG8_LAS unsigned char* lds, const Gemm g, const Sched& S, const Epi& E) {
    const int tid = tid_(), wid = __builtin_amdgcn_readfirstlane(tid >> 6), lane = tid & 63, wr = wid >> 2, wc = wid & 3, fr = lane & 15, fq = lane >> 4;
    const int K = g.K, nt = K / BK;
    unsigned voffA[2], voffB[2];
#pragma unroll
    for (int i = 0; i < 2; ++i) { int R, C; stage_rc(tid * 16 + i * 8192, R, C); const int Rb = Epi::PERM ? ((R & ~31) + perm32(R & 31)) : R;
        voffA[i] = (unsigned)(R * g.lda + C) * 2u; voffB[i] = (unsigned)(Rb * g.ldb + C) * 2u; }
    const size_t kstep = (size_t)(BK * 2);
#define PG8_KA(t) (g.kmode == 1 ? (size_t)((t) >> 1) * (LDP * 2) + (size_t)((t) & 1) * 128 : g.kmode == 2 ? (size_t)(t) * kstep + ((t) >= 16 ? (size_t)2048 : (size_t)0) : (size_t)(t) * kstep)
    const size_t hstepA = (size_t)HALF * g.lda * 2, hstepB = g.bdup ? (size_t)0 : (size_t)HALF * g.ldb * 2;
    const size_t tstepA = 2 * hstepA, tstepB = 2 * hstepB;
    const unsigned ldsw = (unsigned)wid * 1024u;
    const int aoff = lds_byte(wr * 64 + fr, fq * 8), boff = lds_byte(wc * 32 + fr, fq * 8);
#define PG8_SA(b, h) (((b) * 2 + (h)) * HTB)
#define PG8_SB(b, h) ((4 + (b) * 2 + (h)) * HTB)
#define PG8_STAGE(bufoff, gbase, voff) do { _Pragma("unroll") for (int _i = 0; _i < 2; ++_i) \
        __builtin_amdgcn_global_load_lds((const unsigned*)((const char*)(gbase) + (voff)[_i]), (PG8_LAS unsigned*)(lds + (bufoff) + ldsw + _i * 8192), 16, 0, 0); } while (0)
#define PG8_LDA(dst, b, h) do { _Pragma("unroll") for (int m = 0; m < 4; ++m) _Pragma("unroll") for (int k = 0; k < 2; ++k) dst[m][k] = *(const PG8_LAS bf16x8*)(lds + PG8_SA(b, h) + aoff + m * 2048 + k * 1024); } while (0)
#define PG8_LDB(dst, b, h) do { _Pragma("unroll") for (int n = 0; n < 2; ++n) _Pragma("unroll") for (int k = 0; k < 2; ++k) dst[n][k] = *(const PG8_LAS bf16x8*)(lds + PG8_SB(b, h) + boff + n * 2048 + k * 1024); } while (0)
#define PG8_MMA(ai, bj, At, Bt) do { __builtin_amdgcn_s_setprio(1); _Pragma("unroll") for (int m = 0; m < 4; ++m) _Pragma("unroll") for (int n = 0; n < 2; ++n) _Pragma("unroll") for (int k = 0; k < 2; ++k) \
        acc[ai][bj][m][n] = __builtin_amdgcn_mfma_f32_16x16x32_bf16(Bt[n][k], At[m][k], acc[ai][bj][m][n], 0, 0, 0); __builtin_amdgcn_s_setprio(0); } while (0)
#define PG8_WAIT_V(n) asm volatile("s_waitcnt vmcnt(" #n ")" ::: "memory")
#define PG8_WAIT_L(n) asm volatile("s_waitcnt lgkmcnt(" #n ")" ::: "memory")
#define PG8_BAR __builtin_amdgcn_s_barrier()
#define PG8_SCHED __builtin_amdgcn_sched_barrier(0)
    Unit cur, nxt; int ui = 0;
    if (!S.next(0, cur)) return;
    f32x4 acc[2][2][4][2];
#pragma unroll
    for (int a = 0; a < 2; ++a)
#pragma unroll
        for (int b = 0; b < 2; ++b)
#pragma unroll
            for (int m = 0; m < 4; ++m)
#pragma unroll
                for (int n = 0; n < 2; ++n) acc[a][b][m][n] = (f32x4){0.f, 0.f, 0.f, 0.f};
    bf16x8 At[4][2], B0[2][2], B1[2][2];
    const char* cA = (const char*)g.A + cur.aoff + (size_t)cur.pm * tstepA; const char* cB = (const char*)g.Bt + cur.boff + (size_t)cur.pn * tstepB;
    S.a_ready(cur);
    PG8_STAGE(PG8_SB(0, 0), cB, voffB); PG8_STAGE(PG8_SA(0, 0), cA, voffA); PG8_STAGE(PG8_SB(0, 1), cB + hstepB, voffB); PG8_STAGE(PG8_SA(0, 1), cA + hstepA, voffA);
    if (wr == 1) PG8_BAR;
    PG8_WAIT_V(4); PG8_BAR;
    PG8_STAGE(PG8_SB(1, 0), cB + kstep, voffB); PG8_STAGE(PG8_SA(1, 0), cA + PG8_KA(1), voffA); PG8_STAGE(PG8_SB(1, 1), cB + hstepB + kstep, voffB);
    PG8_WAIT_V(6); PG8_BAR;
    for (;;) {
        const bool has_next = S.next(ui + 1, nxt);
        const char* nA = has_next ? (const char*)g.A + nxt.aoff + (size_t)nxt.pm * tstepA : cA; const char* nB = has_next ? (const char*)g.Bt + nxt.boff + (size_t)nxt.pn * tstepB : cB;
        for (int t = 0; t < nt; t += 2) {
            const bool last = (t == nt - 2);
            const char* a1 = cA + PG8_KA(t + 1);
            const char* a2 = last ? nA : cA + PG8_KA(t + 2); const char* b2 = last ? nB : cB + (size_t)(t + 2) * kstep;
            const char* a3 = last ? nA + PG8_KA(1) : cA + PG8_KA(t + 3); const char* b3 = b2 + kstep;
            if (last && has_next) S.a_ready(nxt);
            if constexpr (Epi::HAS_MID) { if (t == 16) E.mid(acc, cur, wr, wc, fr, fq); }
            PG8_LDB(B0, 0, 0); PG8_SCHED; PG8_LDA(At, 0, 0); PG8_STAGE(PG8_SA(1, 1), a1 + hstepA, voffA);
            PG8_WAIT_L(8); PG8_BAR; PG8_WAIT_L(0); PG8_MMA(0, 0, At, B0); PG8_BAR; PG8_SCHED;
            PG8_LDB(B1, 0, 1); PG8_STAGE(PG8_SB(0, 0), b2, voffB);
            PG8_BAR; PG8_WAIT_L(0); PG8_MMA(0, 1, At, B1); PG8_BAR;
            PG8_LDA(At, 0, 1); PG8_STAGE(PG8_SA(0, 0), a2, voffA);
            PG8_BAR; PG8_WAIT_L(0); PG8_MMA(1, 0, At, B0); PG8_BAR; PG8_SCHED;
            PG8_STAGE(PG8_SB(0, 1), b2 + hstepB, voffB);
            PG8_WAIT_V(6); PG8_BAR; PG8_MMA(1, 1, At, B1); PG8_BAR;
            PG8_LDB(B0, 1, 0); PG8_SCHED; PG8_LDA(At, 1, 0); PG8_STAGE(PG8_SA(0, 1), a2 + hstepA, voffA);
            PG8_WAIT_L(8); PG8_BAR; PG8_WAIT_L(0); PG8_MMA(0, 0, At, B0); PG8_BAR; PG8_SCHED;
            PG8_LDB(B1, 1, 1); PG8_STAGE(PG8_SB(1, 0), b3, voffB);
            PG8_BAR; PG8_WAIT_L(0); PG8_MMA(0, 1, At, B1); PG8_BAR;
            PG8_LDA(At, 1, 1); PG8_STAGE(PG8_SA(1, 0), a3, voffA);
            PG8_BAR; PG8_WAIT_L(0); PG8_MMA(1, 0, At, B0); PG8_BAR; PG8_SCHED;
            PG8_STAGE(PG8_SB(1, 1), b3 + hstepB, voffB);
            PG8_WAIT_V(6); PG8_BAR; PG8_MMA(1, 1, At, B1); PG8_BAR;
        }
        if constexpr (!Epi::AFTER_DRAIN) { E(acc, cur, wr, wc, fr, fq); S.done(cur); }
        if (!has_next) break;
#pragma unroll
        for (int a = 0; a < 2; ++a)
#pragma unroll
            for (int b = 0; b < 2; ++b)
#pragma unroll
                for (int m = 0; m < 4; ++m)
#pragma unroll
                    for (int n = 0; n < 2; ++n) acc[a][b][m][n] = (f32x4){0.f, 0.f, 0.f, 0.f};
        cur = nxt; cA = nA; cB = nB; ++ui;
    }
    PG8_WAIT_V(0);
    if (wr == 0) PG8_BAR;
    PG8_BAR;
    if constexpr (Epi::AFTER_DRAIN) { E.fused(acc, cur, wr, wc, fr, fq, lds, wid, lane); S.done(cur); }
#undef PG8_SA
#undef PG8_SB
#undef PG8_STAGE
#undef PG8_LDA
#undef PG8_LDB
#undef PG8_MMA
#undef PG8_WAIT_V
#undef PG8_WAIT_L
#undef PG8_BAR
#undef PG8_SCHED
#undef PG8_KA
}
}

namespace nsa {
typedef short bf16x8 __attribute__((ext_vector_type(8)));
typedef short s16x4 __attribute__((ext_vector_type(4)));
typedef float f32x16 __attribute__((ext_vector_type(16)));
typedef float f32x4 __attribute__((ext_vector_type(4)));
typedef unsigned u32x4 __attribute__((ext_vector_type(4)));
constexpr int SHM_V = 16384, SHM_K = 16384;
constexpr int L_V = 0, L_K = 32768, L_WS = 65536, L_LUT = 67584, L_IMP = 69632, L_SEL = 102400, L_UNI = 103424, L_TL = 103488, L_END = 104064;
constexpr float LOG2E = 1.4426950408889634f, C2 = 0.08838834764831845f * LOG2E, THR2 = 11.5f;
#define KSWZ(row, colB) ((row) * 256 + ((colB) ^ (((row) & 7) << 4)))
#define SBAR() __builtin_amdgcn_sched_barrier(0)
__device__ __forceinline__ int v_st(int k, int c) { const int kk = (k & ~0xC) | ((k & 4) << 1) | ((k & 8) >> 1); return ((kk >> 3) * 4 + (c >> 5)) * 512 + ((kk & 7) * 32 + (c & 31)) * 2; }
__device__ __forceinline__ int v_rd_base(int lane) { return ((lane & 3) << 3) | (((lane >> 2) & 3) << 6) | (((lane >> 4) & 1) << 5) | (((lane >> 5) & 1) << 8); }
constexpr int v_rd_off(int d0, int ks, int half) { return d0 * 512 + ks * 4096 + half * 2048; }
__device__ __forceinline__ int crow(int r, int hi) { return (r & 3) + 8 * (r >> 2) + 4 * hi; }
__device__ __forceinline__ unsigned cvtpk(float lo, float hi) { unsigned r; asm volatile("v_cvt_pk_bf16_f32 %0, %1, %2" : "=v"(r) : "v"(lo), "v"(hi)); return r; }

template <int KB>
__device__ __forceinline__ void qkt(f32x16& p0, f32x16& p1, const char* K_lds, int r32, int hi, const bf16x8* qr) {
    p0 = f32x16{}; p1 = f32x16{};
    const char* kb[4];
#pragma unroll
    for (int dd = 0; dd < 4; ++dd) kb[dd] = K_lds + KB * SHM_K + KSWZ(r32, (dd * 16 + hi * 8) * 2);
#pragma unroll
    for (int d0 = 0; d0 < 8; ++d0) { const char* a = kb[d0 & 3] + (d0 >> 2) * 128;
        bf16x8 b0 = *reinterpret_cast<const bf16x8*>(a);
        bf16x8 b1 = *reinterpret_cast<const bf16x8*>(a + 32 * 256);
        p0 = __builtin_amdgcn_mfma_f32_32x32x16_bf16(b0, qr[d0], p0, 0, 0, 0);
        p1 = __builtin_amdgcn_mfma_f32_32x32x16_bf16(b1, qr[d0], p1, 0, 0, 0); }
}
template <int VB>
__device__ __forceinline__ void pv_tile(f32x16* o, int vb0, bf16x8 pa0, bf16x8 pa1, bf16x8 pa2, bf16x8 pa3) {
#define TRRD(dst, off) asm volatile("ds_read_b64_tr_b16 %0, %1 offset:%2" : "=&v"(dst) : "v"(vb0), "i"(off) : "memory")
#define PV_D0(d0) do { s16x4 l0, l1, l2, l3, h0, h1, h2, h3; constexpr int b_ = VB * SHM_V + v_rd_off(d0, 0, 0); \
        TRRD(l0, b_); TRRD(h0, b_ + 2048); TRRD(l1, b_ + 4096); TRRD(h1, b_ + 6144); TRRD(l2, b_ + 8192); TRRD(h2, b_ + 10240); TRRD(l3, b_ + 12288); TRRD(h3, b_ + 14336); \
        asm volatile("s_waitcnt lgkmcnt(0)" ::: "memory"); SBAR(); \
        o[d0] = __builtin_amdgcn_mfma_f32_32x32x16_bf16(pa0, (bf16x8){l0[0], l0[1], l0[2], l0[3], h0[0], h0[1], h0[2], h0[3]}, o[d0], 0, 0, 0); \
        o[d0] = __builtin_amdgcn_mfma_f32_32x32x16_bf16(pa1, (bf16x8){l1[0], l1[1], l1[2], l1[3], h1[0], h1[1], h1[2], h1[3]}, o[d0], 0, 0, 0); \
        o[d0] = __builtin_amdgcn_mfma_f32_32x32x16_bf16(pa2, (bf16x8){l2[0], l2[1], l2[2], l2[3], h2[0], h2[1], h2[2], h2[3]}, o[d0], 0, 0, 0); \
        o[d0] = __builtin_amdgcn_mfma_f32_32x32x16_bf16(pa3, (bf16x8){l3[0], l3[1], l3[2], l3[3], h3[0], h3[1], h3[2], h3[3]}, o[d0], 0, 0, 0); } while (0)
    PV_D0(0); PV_D0(1); PV_D0(2); PV_D0(3);
#undef PV_D0
#undef TRRD
}
__device__ __forceinline__ void mask_tile(f32x16& p0, f32x16& p1, int dq, unsigned W) {
    const float NEG = -__builtin_inff();
    asm volatile("" : "+v"(dq));
#pragma unroll
    for (int r = 0; r < 16; ++r) {
        const int c = (r & 3) + 8 * (r >> 2);
        if ((unsigned)(dq - c) >= W) p0[r] = NEG;
        if ((unsigned)(dq - c - 32) >= W) p1[r] = NEG;
    }
}
template <int STRIDE>
__device__ __forceinline__ void bias_near(f32x16& p0, f32x16& p1, int dbase, const float* lut) {
    asm volatile("" : "+v"(dbase));
#pragma unroll
    for (int r = 0; r < 16; ++r) {
        const int c = (r & 3) + 8 * (r >> 2);
        int d0 = dbase - STRIDE * c, d1 = dbase - STRIDE * (c + 32);
        d0 = d0 < 0 ? 0 : (d0 > 127 ? 127 : d0); d1 = d1 < 0 ? 0 : (d1 > 127 ? 127 : d1);
        p0[r] = fmaf(p0[r], C2, lut[d0]); p1[r] = fmaf(p1[r], C2, lut[d1]);
    }
}
__device__ __forceinline__ void bias_const(f32x16& p0, f32x16& p1, float cb) {
#pragma unroll
    for (int r = 0; r < 16; ++r) { p0[r] = fmaf(p0[r], C2, cb); p1[r] = fmaf(p1[r], C2, cb); }
}
__device__ __forceinline__ float half_max(float v) { auto rr = __builtin_amdgcn_permlane32_swap(__float_as_uint(v), __float_as_uint(v), false, false); return fmaxf(__uint_as_float(rr[0]), __uint_as_float(rr[1])); }
__device__ __forceinline__ float half_sum(float v) { auto rr = __builtin_amdgcn_permlane32_swap(__float_as_uint(v), __float_as_uint(v), false, false); return __uint_as_float(rr[0]) + __uint_as_float(rr[1]); }
__device__ __forceinline__ void softmax_online(f32x16& p0, f32x16& p1, float sc, float cb2, bool sel, float& m, float& l, float& alpha) {
    float pmax = p0[0];
#pragma unroll
    for (int r = 1; r < 16; ++r) pmax = fmaxf(pmax, p0[r]);
#pragma unroll
    for (int r = 0; r < 16; ++r) pmax = fmaxf(pmax, p1[r]);
    pmax = half_max(pmax);
    pmax = sel ? fmaf(pmax, sc, cb2) : -__builtin_inff();
    if (__all(pmax - m <= THR2)) alpha = 1.f;
    else { const float mn = fmaxf(m, pmax); alpha = __builtin_amdgcn_exp2f(m - mn); m = mn; }
    const float off = sel ? cb2 - m : -__builtin_inff();
#pragma unroll
    for (int r = 0; r < 16; ++r) { p0[r] = fmaf(p0[r], sc, off); p1[r] = fmaf(p1[r], sc, off); }
    SBAR();
#pragma unroll
    for (int r = 0; r < 16; ++r) { p0[r] = __builtin_amdgcn_exp2f(p0[r]); p1[r] = __builtin_amdgcn_exp2f(p1[r]); }
    SBAR();
    float ps = 0.f;
#pragma unroll
    for (int r = 0; r < 16; ++r) ps += p0[r] + p1[r];
    l = l * alpha + half_sum(ps);
}
__device__ __forceinline__ void pack_p(const f32x16& p0, const f32x16& p1, bf16x8& pa0, bf16x8& pa1, bf16x8& pa2, bf16x8& pa3) {
#define PK4(P, B_, OUT) do { unsigned a0 = cvtpk(P[B_+0], P[B_+1]), a1 = cvtpk(P[B_+2], P[B_+3]); \
        unsigned b0 = cvtpk(P[B_+4], P[B_+5]), b1 = cvtpk(P[B_+6], P[B_+7]); \
        auto r0 = __builtin_amdgcn_permlane32_swap(a0, b0, false, false); auto r1 = __builtin_amdgcn_permlane32_swap(a1, b1, false, false); \
        u32x4 w = {r0[0], r1[0], r0[1], r1[1]}; OUT = *reinterpret_cast<bf16x8*>(&w); } while (0)
    PK4(p0, 0, pa0); PK4(p0, 8, pa1); PK4(p1, 0, pa2); PK4(p1, 8, pa3);
#undef PK4
}
__device__ __forceinline__ void rescale_o(f32x16* o, float alpha, float* al_l, int r32, int hi) {
    if (__any(alpha < 1.f)) {
        if (hi == 0) al_l[r32] = alpha;
        asm volatile("s_waitcnt lgkmcnt(0)" ::: "memory");
#pragma unroll
        for (int r = 0; r < 16; ++r) { const float a = al_l[crow(r, hi)];
#pragma unroll
            for (int d = 0; d < 4; ++d) o[d][r] *= a; }
    }
}
__device__ __forceinline__ void flush_out(const f32x16* o, float lsum, int br, unsigned char* ws, char* lds, int b, int g, int qb, int wid, int lane_in, bool first) {
    int lane = lane_in; asm volatile("" : "+v"(lane));
    const int r32 = lane & 31, hi = lane >> 5, head = g * 4 + (wid >> 1);
    const size_t tok = (size_t)b * T_ + qb * 64 + (wid & 1) * 32;
    float* li_l = (float*)(lds + L_WS) + wid * 64;
    bf16_t* tb = (bf16_t*)(lds + wid * 8192);
    bf16_t* orow = (bf16_t*)(ws + OFF_PROJ) + tok * LDP + C_NQ + head * 128;
    const float gate = ((const float*)(ws + OFF_GATE))[(tok + r32) * 24 + head * 3 + br];
    const float f_lane = br == 0 ? gate : (lsum > 0.f ? gate / lsum : 0.f);
    if (hi == 0) li_l[r32] = f_lane;
    asm volatile("s_waitcnt lgkmcnt(0)" ::: "memory");
#pragma unroll
    for (int r = 0; r < 16; ++r) {
        const float f = li_l[crow(r, hi)];
#pragma unroll
        for (int d = 0; d < 4; ++d) tb[crow(r, hi) * 128 + d * 32 + r32] = f2bf(o[d][r] * f);
    }
    asm volatile("s_waitcnt lgkmcnt(0)" ::: "memory");
    uint4 gq[8];
    if (!first) {
#pragma unroll
        for (int i = 0; i < 8; ++i) { const int idx = i * 64 + lane, row = idx >> 4, ch = idx & 15; gq[i] = *(const uint4*)(orow + (size_t)row * LDP + ch * 8); }
    }
#pragma unroll
    for (int i = 0; i < 8; ++i) {
        const int idx = i * 64 + lane, row = idx >> 4, ch = idx & 15;
        uint4 w = *(const uint4*)(tb + row * 128 + ch * 8);
        uint4* gp = (uint4*)(orow + (size_t)row * LDP + ch * 8);
        if (!first) {
            const uint4 g = gq[i];
            w.x = cvtpk(__uint_as_float(w.x << 16) + __uint_as_float(g.x << 16), __uint_as_float(w.x & 0xFFFF0000u) + __uint_as_float(g.x & 0xFFFF0000u));
            w.y = cvtpk(__uint_as_float(w.y << 16) + __uint_as_float(g.y << 16), __uint_as_float(w.y & 0xFFFF0000u) + __uint_as_float(g.y & 0xFFFF0000u));
            w.z = cvtpk(__uint_as_float(w.z << 16) + __uint_as_float(g.z << 16), __uint_as_float(w.z & 0xFFFF0000u) + __uint_as_float(g.z & 0xFFFF0000u));
            w.w = cvtpk(__uint_as_float(w.w << 16) + __uint_as_float(g.w << 16), __uint_as_float(w.w & 0xFFFF0000u) + __uint_as_float(g.w & 0xFFFF0000u));
        }
        *gp = w;
    }
}

struct Src { const bf16_t* K; const bf16_t* V; int stride; };

template <int MODE>
__device__ __forceinline__ void branch(const Src s, char* lds, const bf16x8* qr, f32x16* o, float& m, float& l, int NTL, int jbase, int t, int qb, int wid, int lane, int tid,
                                       const unsigned (&selw)[4], float inv_l) {
    const int r32 = lane & 31, hi = lane >> 5, rh = wid >> 1, iq = (wid & 1) * 32 + r32;
    char* V_lds = lds + L_V; char* K_lds = lds + L_K;
    float* al_l = (float*)(lds + L_WS) + wid * 64 + 32;
    const float* lut = (const float*)(lds + L_LUT) + rh * 128;
    const int* tl = (const int*)(lds + L_TL);
    float* impL = (float*)(lds + L_IMP);
    const int vb0 = (int)(uintptr_t)V_lds + v_rd_base(lane);
    const float cb = lut[127];
    constexpr bool HASV = MODE != 0;
    LAS unsigned char* ldsl = (LAS unsigned char*)lds;
#define TILE_OF(n) (MODE == 2 ? tl[n] : jbase + (n))
#define DMA(j, bf) do { const bf16_t* kt_ = s.K + (size_t)(j) * 64 * s.stride; const bf16_t* vt_ = s.V + (size_t)(j) * 64 * s.stride; \
        int ln_ = lane; asm volatile("" : "+v"(ln_));        \
        _Pragma("unroll") for (int i_ = 0; i_ < 2; ++i_) { \
            const int row_ = i_ * 32 + wid * 4 + (ln_ >> 4), srcch_ = (ln_ & 15) ^ (row_ & 7); \
            __builtin_amdgcn_global_load_lds((const unsigned*)(kt_ + (row_ * s.stride + srcch_ * 8)), (LAS unsigned*)(ldsl + L_K + (bf) * SHM_K + i_ * 8192 + wid * 1024), 16, 0, 0); \
            if (HASV) { const int kk_ = (i_ * 4 + (wid >> 1)) * 8 + ((ln_ & 31) >> 2), k_ = (kk_ & ~0xC) | ((kk_ & 4) << 1) | ((kk_ & 8) >> 1), cc_ = ((wid & 1) * 2 + (ln_ >> 5)) * 32 + (ln_ & 3) * 8; \
                __builtin_amdgcn_global_load_lds((const unsigned*)(vt_ + (k_ * s.stride + cc_)), (LAS unsigned*)(ldsl + L_V + (bf) * SHM_V + i_ * 8192 + wid * 1024), 16, 0, 0); } } } while (0)
#define COMPUTE(n, BF) do { const int j_ = TILE_OF(n); \
        bool act_ = true; bool rowsel_ = true; \
        if (MODE == 2) { const unsigned w_ = j_ < 32 ? selw[0] : j_ < 64 ? selw[1] : j_ < 96 ? selw[2] : selw[3]; rowsel_ = (w_ >> (j_ & 31)) & 1u; act_ = __any(rowsel_); } \
        if (act_) { f32x16 p0, p1; \
            qkt<BF>(p0, p1, K_lds, r32, hi, qr); \
              \
            const bool plain_ = MODE >= 2 && (qb - j_ > 2) && !(MODE == 3 && j_ == qb - 8); \
            float sc_ = C2, cb_ = cb; bool sel_ = rowsel_; \
            if (!plain_) { sc_ = 1.f; cb_ = 0.f; sel_ = true; \
                if (MODE <= 1) { \
                    if (64 * j_ + 63 >= 4 * qb - 10) bias_near<16>(p0, p1, t - 31 - 16 * (64 * j_ + 4 * hi), lut); else bias_const(p0, p1, cb); \
                    if (64 * j_ + 63 > ((64 * qb - 31) >> 4)) mask_tile(p0, p1, ((t - 31) >> 4) - 64 * j_ - 4 * hi, 1u << 30); \
                } else { \
                    bias_near<1>(p0, p1, t - 64 * j_ - 4 * hi, lut); \
                    if (MODE == 2) { if (j_ == qb) mask_tile(p0, p1, t - 64 * j_ - 4 * hi, 1u << 30); \
                        if (!rowsel_) { const float NEG_ = -__builtin_inff(); _Pragma("unroll") for (int r = 0; r < 16; ++r) { p0[r] = NEG_; p1[r] = NEG_; } } } \
                    else { if (j_ == qb || j_ == qb - 8) mask_tile(p0, p1, t - 64 * j_ - 4 * hi, 512u); } \
                } \
            } \
            if (MODE == 1) { \
                _Pragma("unroll") for (int r = 0; r < 16; ++r) { p0[r] = __builtin_amdgcn_exp2f(p0[r] - m) * inv_l; p1[r] = __builtin_amdgcn_exp2f(p1[r] - m) * inv_l; } \
                _Pragma("unroll") for (int a = 0; a < 4; ++a) { \
                    const int jj0 = 16 * j_ + 2 * a + hi, jj1 = jj0 + 8; \
                    atomicAdd(&impL[iq * 128 + jj0], p0[4 * a] + p0[4 * a + 1] + p0[4 * a + 2] + p0[4 * a + 3]); \
                    atomicAdd(&impL[iq * 128 + jj1], p1[4 * a] + p1[4 * a + 1] + p1[4 * a + 2] + p1[4 * a + 3]); \
                    if (jj0 + 1 < 128) atomicAdd(&impL[iq * 128 + jj0 + 1], p0[4 * a + 3]); \
                    if (jj1 + 1 < 128) atomicAdd(&impL[iq * 128 + jj1 + 1], p1[4 * a + 3]); } \
            } else { float alpha_; softmax_online(p0, p1, sc_, cb_, sel_, m, l, alpha_); if (MODE != 0) rescale_o(o, alpha_, al_l, r32, hi); } \
            if (MODE != 0) { bf16x8 pa0, pa1, pa2, pa3; pack_p(p0, p1, pa0, pa1, pa2, pa3); pv_tile<BF>(o, vb0, pa0, pa1, pa2, pa3); } \
        } } while (0)
#define STEP(n, BF) do { \
        if ((n) + 1 < NTL) DMA(TILE_OF((n) + 1), 1 - (BF)); \
        SBAR(); COMPUTE(n, BF); SBAR(); \
        asm volatile("s_waitcnt vmcnt(0)" ::: "memory"); \
        __syncthreads(); } while (0)
    if (NTL > 0) {
        DMA(TILE_OF(0), 0); asm volatile("s_waitcnt vmcnt(0)" ::: "memory");
        __syncthreads();
        for (int n = 0; n < NTL; n += 2) { STEP(n, 0); if (n + 1 < NTL) STEP(n + 1, 1); }
    }
#undef TILE_OF
#undef DMA
#undef COMPUTE
#undef STEP
}

__device__ __forceinline__ void item(unsigned char* ws, int b, int g, int qb, char* lds) {
    const int tid = tid_(), wid = __builtin_amdgcn_readfirstlane(tid >> 6), lane = tid & 63, r32 = lane & 31, hi = lane >> 5, rh = wid >> 1, iq = (wid & 1) * 32 + r32;
    const int t = qb * 64 + iq, head = g * 4 + rh;
    bf16_t* proj = (bf16_t*)(ws + OFF_PROJ);
    const size_t tok0 = (size_t)b * T_;
    float* impL = (float*)(lds + L_IMP); unsigned* selL = (unsigned*)(lds + L_SEL); unsigned* uniL = (unsigned*)(lds + L_UNI); int* tl = (int*)(lds + L_TL);
    for (int i = tid; i < 64 * 128; i += 512) impL[i] = 0.f;
    if (tid < 4) uniL[tid] = 0u;
    { const float* lutg = (const float*)(ws + OFF_LUT) + (g * 4) * 128; ((float*)(lds + L_LUT))[tid] = lutg[tid] * LOG2E; }
    bf16x8 qr[8];
    { const bf16_t* qp = proj + (tok0 + t) * LDP + C_NQ + head * 128 + hi * 8;
#pragma unroll
      for (int d0 = 0; d0 < 8; ++d0) qr[d0] = *(const bf16x8*)(qp + d0 * 16); }
    unsigned selw[4] = {0u, 0u, 0u, 0u};
    f32x16 o[4];
    __syncthreads();
    {
        const Src s{(const bf16_t*)(ws + OFF_KCMP) + (size_t)(b * 2 + g) * 512 * 128, (const bf16_t*)(ws + OFF_VCMP) + (size_t)(b * 2 + g) * 512 * 128, 128};
        const int nct = ((4 * qb + 2) >> 6) + 1;
        float m = -1e30f, l = 0.f;
        branch<0>(s, lds, qr, o, m, l, nct, 0, t, qb, wid, lane, tid, selw, 0.f);
#pragma unroll
        for (int d = 0; d < 4; ++d) o[d] = f32x16{};
        const float inv_l = l > 0.f ? 1.f / l : 0.f;
        branch<1>(s, lds, qr, o, m, l, nct, 0, t, qb, wid, lane, tid, selw, inv_l);
        flush_out(o, 1.f, 0, ws, lds, b, g, qb, wid, lane, true);
    }
    __syncthreads();
    {
        const int q = wid * 8 + (lane >> 3), sub = lane & 7;
        unsigned m0 = 0u, m1 = 0u, m2 = 0u, m3 = 0u;
        if (qb <= 15) { m0 = qb == 31 ? 0xFFFFFFFFu : ((1u << (qb + 1)) - 1u); }
        else {
            unsigned key[16];
#pragma unroll
            for (int k = 0; k < 16; ++k) { const int j = sub * 16 + k; key[k] = (j >= 1 && j <= qb - 2) ? ((__float_as_uint(impL[q * 128 + j]) & ~0x7Fu) | (unsigned)(127 - j)) : 0u; }
            for (int it = 0; it < 13; ++it) {
                unsigned lm = key[0];
#pragma unroll
                for (int k = 1; k < 16; ++k) lm = lm > key[k] ? lm : key[k];
                unsigned gm = lm, x;
                x = (unsigned)__builtin_amdgcn_update_dpp(0, (int)gm, 0xB1, 0xF, 0xF, true); gm = gm > x ? gm : x;
                x = (unsigned)__builtin_amdgcn_update_dpp(0, (int)gm, 0x4E, 0xF, 0xF, true); gm = gm > x ? gm : x;
                x = (unsigned)__builtin_amdgcn_update_dpp(0, (int)gm, 0x141, 0xF, 0xF, true); gm = gm > x ? gm : x;
#pragma unroll
                for (int k = 0; k < 16; ++k) key[k] = key[k] == gm ? 0u : key[k];
                const int j = 127 - (int)(gm & 0x7Fu);
                const unsigned bit = 1u << (j & 31);
                m0 |= j < 32 ? bit : 0u; m1 |= (j >= 32 && j < 64) ? bit : 0u; m2 |= (j >= 64 && j < 96) ? bit : 0u; m3 |= j >= 96 ? bit : 0u;
            }
            m0 |= 1u;
            { const int j = qb; const unsigned bit = 1u << (j & 31); m0 |= j < 32 ? bit : 0u; m1 |= (j >= 32 && j < 64) ? bit : 0u; m2 |= (j >= 64 && j < 96) ? bit : 0u; m3 |= j >= 96 ? bit : 0u; }
            { const int j = qb - 1; const unsigned bit = 1u << (j & 31); m0 |= j < 32 ? bit : 0u; m1 |= (j >= 32 && j < 64) ? bit : 0u; m2 |= (j >= 64 && j < 96) ? bit : 0u; m3 |= j >= 96 ? bit : 0u; }
        }
        if (sub == 0) { selL[q * 4 + 0] = m0; selL[q * 4 + 1] = m1; selL[q * 4 + 2] = m2; selL[q * 4 + 3] = m3;
                        atomicOr(&uniL[0], m0); atomicOr(&uniL[1], m1); atomicOr(&uniL[2], m2); atomicOr(&uniL[3], m3); }
    }
    __syncthreads();
    int nsl = 0;
    {
        if (wid == 0) {
            const bool s0 = lane <= qb && ((uniL[lane >> 5] >> (lane & 31)) & 1u), s1 = lane + 64 <= qb && ((uniL[2 + (lane >> 5)] >> (lane & 31)) & 1u);
            const unsigned long long b0 = __ballot(s0), b1 = __ballot(s1), below = (1ull << lane) - 1ull;
            const int n0 = __popcll(b0);
            if (s0) tl[__popcll(b0 & below)] = lane;
            if (s1) tl[n0 + __popcll(b1 & below)] = lane + 64;
            if (lane == 0) tl[128] = n0 + __popcll(b1);
        }
        selw[0] = selL[iq * 4 + 0]; selw[1] = selL[iq * 4 + 1]; selw[2] = selL[iq * 4 + 2]; selw[3] = selL[iq * 4 + 3];
        __syncthreads();
        nsl = tl[128];
    }
    {
        const Src s{proj + tok0 * LDP + C_KS + g * 128, proj + tok0 * LDP + C_VS + g * 128, LDP};
        float m = -1e30f, l = 0.f;
#pragma unroll
        for (int d = 0; d < 4; ++d) o[d] = f32x16{};
        branch<2>(s, lds, qr, o, m, l, nsl, 0, t, qb, wid, lane, tid, selw, 0.f);
        flush_out(o, l, 1, ws, lds, b, g, qb, wid, lane, false);
    }
    __syncthreads();
    {
        const Src s{proj + tok0 * LDP + C_KW + g * 128, proj + tok0 * LDP + C_VW + g * 128, LDP};
        const int jlo = qb >= 8 ? qb - 8 : 0;
        float m = -1e30f, l = 0.f;
#pragma unroll
        for (int d = 0; d < 4; ++d) o[d] = f32x16{};
        branch<3>(s, lds, qr, o, m, l, qb - jlo + 1, jlo, t, qb, wid, lane, tid, selw, 0.f);
        flush_out(o, l, 2, ws, lds, b, g, qb, wid, lane, false);
    }
    __syncthreads();
}
#undef KSWZ
#undef SBAR
}

__device__ void ph_hpre(const Params& p, int u) {
    const int tid = tid_(), b = u >> 8, n = u & 255, c2 = tid * 2;
    char* proj = (char*)(p.ws + OFF_PROJ) + (size_t)(b * T_ + n * 32) * (LDP * 2);
    const unsigned vo = (unsigned)c2 * 2u;
    const float* lb = (const float*)(p.ws + OFF_LB);
    const float kb0 = 1.f - lb[c2], kb1 = 1.f - lb[c2 + 1];
    float b0[32], b1[32];
    unsigned wf[32], wq[32];
#pragma unroll
    for (int i = 0; i < 32; ++i) wf[i] = *(const unsigned*)(proj + ((size_t)i * (LDP * 2) + C_HF * 2) + vo);
#pragma unroll
    for (int i = 0; i < 32; ++i) wq[i] = *(const unsigned*)(proj + ((size_t)i * (LDP * 2) + C_HQ * 2) + vo);
    float s0 = 1.f, s1 = 1.f;
#pragma unroll
    for (int i = 0; i < 32; ++i) {
        const float r0 = __uint_as_float(wf[i] << 16), r1 = __uint_as_float(wf[i] & 0xFFFF0000u);
        const float k0 = kb0 * sigmoidf_(-r0), k1 = kb1 * sigmoidf_(-r1);
        s0 *= 1.f - k0; s1 *= 1.f - k1;
        b0[i] = s0; b1[i] = s1;
        wf[i] = pg8::cvt_pk_bf16(k0, k1);
    }
    const float il0 = __builtin_amdgcn_rcpf(fmaxf(s0, 1e-30f)), il1 = __builtin_amdgcn_rcpf(fmaxf(s1, 1e-30f));
#pragma unroll
    for (int i = 0; i < 32; ++i) {
        const float k0 = __uint_as_float(wf[i] << 16), k1 = __uint_as_float(wf[i] & 0xFFFF0000u);
        const float q0 = __uint_as_float(wq[i] << 16), q1 = __uint_as_float(wq[i] & 0xFFFF0000u);
        const float e0 = s0 * __builtin_amdgcn_rcpf(fmaxf(b0[i], 1e-30f)), e1 = s1 * __builtin_amdgcn_rcpf(fmaxf(b1[i], 1e-30f));
        unsigned long long ro = (unsigned long long)i * (LDP * 2); asm volatile("" : "+s"(ro));
        char* rp = proj + ro + vo;
        *(unsigned*)(rp + C_HQ * 2) = pg8::cvt_pk_bf16(q0 * (b0[i] * il0), q1 * (b1[i] * il1));
        *(unsigned*)(rp + C_HF * 2) = pg8::cvt_pk_bf16(k0 * e0, k1 * e1);
    }
    float* dec = (float*)(p.ws + OFF_DEC) + ((size_t)((b * 8 + (c2 >> 7)) * 256 + n)) * 256 + (c2 & 127);
    dec[0] = s0; dec[1] = s1;
}

namespace hg {
typedef short bf16x8 __attribute__((ext_vector_type(8)));
typedef short s16x4 __attribute__((ext_vector_type(4)));
typedef float f32x4 __attribute__((ext_vector_type(4)));
typedef unsigned u32x4 __attribute__((ext_vector_type(4)));
constexpr int BUF = 25600, L_QA = 0, L_KE = 8192, L_VV = 16384, L_DEC = 24576, L_OB = 51200, OBS = 132;
__device__ __forceinline__ unsigned off_b(unsigned row, unsigned ch) { return 256u * row + 16u * (ch ^ (((row & 3) << 2) | ((row >> 2) & 3))); }
__device__ __forceinline__ unsigned tr_addr16(unsigned lane, unsigned c, unsigned t) {
    const unsigned g = lane >> 4, q = (lane & 15) >> 2, pp = lane & 3;
    return off_b(8 * g + 4 * t + q, 2 * c + (pp >> 1)) + 8 * (pp & 1);
}
__device__ __forceinline__ unsigned cvtpk(float lo, float hi) { unsigned r; asm volatile("v_cvt_pk_bf16_f32 %0, %1, %2" : "=v"(r) : "v"(lo), "v"(hi)); return r; }
__device__ __forceinline__ bf16x8 pack8(f32x4 a, f32x4 b) { u32x4 w = {cvtpk(a[0], a[1]), cvtpk(a[2], a[3]), cvtpk(b[0], b[1]), cvtpk(b[2], b[3])}; return *reinterpret_cast<bf16x8*>(&w); }
__device__ __forceinline__ s16x4 tr_read(unsigned addr) { s16x4 r; asm volatile("ds_read_b64_tr_b16 %0, %1" : "=v"(r) : "v"(addr) : "memory"); return r; }

__device__ __forceinline__ void item(unsigned char* ws, const float* norm_w, int b, int h, char* lds) {
    const int tid = tid_(), wid = __builtin_amdgcn_readfirstlane(tid >> 6), lane = tid & 63, l15 = lane & 15, g = lane >> 4;
    bf16_t* proj = (bf16_t*)(ws + OFF_PROJ) + (size_t)b * T_ * LDP + h * 128;
    const float* decg = (const float*)(ws + OFF_DEC) + (size_t)(b * 8 + h) * 256 * 256;
    LAS unsigned char* ldsl = (LAS unsigned char*)lds;
    const unsigned ldsb = (unsigned)(uintptr_t)lds;
    const int drow = 4 * wid + (lane >> 4);
    const unsigned dsrc = (unsigned)(drow * LDP + (((lane & 15) ^ (((drow & 3) << 2) | ((drow >> 2) & 3))) * 8));
#define HDMA(n, bf) do { const bf16_t* cp_ = proj + (size_t)(n) * 32 * LDP + dsrc; \
        __builtin_amdgcn_global_load_lds((const unsigned*)(cp_ + C_HQ), (LAS unsigned*)(ldsl + (bf) * BUF + L_QA + wid * 1024), 16, 0, 0); \
        __builtin_amdgcn_global_load_lds((const unsigned*)(cp_ + C_HF), (LAS unsigned*)(ldsl + (bf) * BUF + L_KE + wid * 1024), 16, 0, 0); \
        __builtin_amdgcn_global_load_lds((const unsigned*)(cp_ + C_HI), (LAS unsigned*)(ldsl + (bf) * BUF + L_VV + wid * 1024), 16, 0, 0); \
        if (wid == 0) __builtin_amdgcn_global_load_lds((const unsigned*)(decg + (size_t)(n) * 256 + lane * 4), (LAS unsigned*)(ldsl + (bf) * BUF + L_DEC), 16, 0, 0); } while (0)
    unsigned a_ke[2], a_qa[2], a_qp[2], a_vt[2];
#pragma unroll
    for (int x = 0; x < 2; ++x) {
        a_ke[x] = off_b(8 * (l15 >> 2) + 4 * x + (l15 & 3), g);
        a_qa[x] = off_b(16 * x + l15, g);
        a_qp[x] = off_b(16 * x + l15, g >> 1) + 8 * (g & 1);
        a_vt[x] = tr_addr16(lane, wid, x);
    }
    const int ntok = tid >> 4, ndv = (tid & 15) * 8;
    f32x4 S[8];
#pragma unroll
    for (int i = 0; i < 8; ++i) S[i] = (f32x4){0.f, 0.f, 0.f, 0.f};
    float* obuf = (float*)(lds + L_OB);
    HDMA(0, 0); asm volatile("s_waitcnt vmcnt(0)" ::: "memory");
    __syncthreads();
    for (int n = 0; n < 256; ++n) {
        const int bf = n & 1;
        if (n + 1 < 256) HDMA(n + 1, bf ^ 1);
        const u32x4 hgw = *(const u32x4*)(proj + (size_t)(n * 32 + ntok) * LDP + C_HG + ndv);
        const unsigned B0 = ldsb + bf * BUF;
        f32x4 att[2][2];
#pragma unroll
        for (int x = 0; x < 2; ++x)
#pragma unroll
            for (int y = 0; y < 2; ++y) att[x][y] = (f32x4){0.f, 0.f, 0.f, 0.f};
#pragma unroll
        for (int ks = 0; ks < 4; ++ks) {
            bf16x8 ka[2], qb[2];
#pragma unroll
            for (int x = 0; x < 2; ++x) {
                const unsigned rj = 8 * (l15 >> 2) + 4 * x + (l15 & 3), ri = 16 * x + l15;
                ka[x] = *(const LAS bf16x8*)(uintptr_t)(B0 + L_KE + off_b(rj, 4 * ks + g));
                qb[x] = *(const LAS bf16x8*)(uintptr_t)(B0 + L_QA + off_b(ri, 4 * ks + g));
            }
#pragma unroll
            for (int x = 0; x < 2; ++x)
#pragma unroll
                for (int y = 0; y < 2; ++y) att[x][y] = __builtin_amdgcn_mfma_f32_16x16x32_bf16(ka[x], qb[y], att[x][y], 0, 0, 0);
        }
        bf16x8 attf[2];
#pragma unroll
        for (int y = 0; y < 2; ++y) {
            const int i = 16 * y + l15;
            f32x4 a0 = att[0][y], a1 = att[1][y];
#pragma unroll
            for (int r = 0; r < 4; ++r) { if (8 * g + r > i) a0[r] = 0.f; if (8 * g + 4 + r > i) a1[r] = 0.f; }
            attf[y] = pack8(a0, a1);
        }
        bf16x8 vf;
        { const s16x4 v0 = tr_read(B0 + L_VV + a_vt[0]), v1 = tr_read(B0 + L_VV + a_vt[1]);
          asm volatile("s_waitcnt lgkmcnt(0)" ::: "memory");
          vf = (bf16x8){v0[0], v0[1], v0[2], v0[3], v1[0], v1[1], v1[2], v1[3]}; }
        f32x4 o[2];
#pragma unroll
        for (int y = 0; y < 2; ++y) o[y] = __builtin_amdgcn_mfma_f32_16x16x32_bf16(vf, attf[y], (f32x4){0.f, 0.f, 0.f, 0.f}, 0, 0, 0);
#pragma unroll
        for (int dt = 0; dt < 8; ++dt) { const f32x4 d = *(const LAS f32x4*)(uintptr_t)(B0 + L_DEC + (16 * dt + 4 * g) * 4); S[dt] *= d; }
#pragma unroll
        for (int ks = 0; ks < 4; ++ks) {
            const bf16x8 sa = pack8(S[2 * ks], S[2 * ks + 1]);
#pragma unroll
            for (int y = 0; y < 2; ++y) {
                const unsigned ri = 16 * y + l15;
                const unsigned long long q0 = *(const LAS unsigned long long*)(uintptr_t)(B0 + L_QA + off_b(ri, 4 * ks + (g >> 1)) + 8 * (g & 1));
                const unsigned long long q1 = *(const LAS unsigned long long*)(uintptr_t)(B0 + L_QA + off_b(ri, 4 * ks + 2 + (g >> 1)) + 8 * (g & 1));
                u32x4 w = {(unsigned)q0, (unsigned)(q0 >> 32), (unsigned)q1, (unsigned)(q1 >> 32)};
                o[y] = __builtin_amdgcn_mfma_f32_16x16x32_bf16(sa, *reinterpret_cast<bf16x8*>(&w), o[y], 0, 0, 0);
            }
        }
#pragma unroll
        for (int dt = 0; dt < 8; ++dt) {
            const s16x4 k0 = tr_read(B0 + L_KE + tr_addr16(lane, dt, 0)), k1 = tr_read(B0 + L_KE + tr_addr16(lane, dt, 1));
            asm volatile("s_waitcnt lgkmcnt(0)" ::: "memory");
            const bf16x8 kf = (bf16x8){k0[0], k0[1], k0[2], k0[3], k1[0], k1[1], k1[2], k1[3]};
            S[dt] = __builtin_amdgcn_mfma_f32_16x16x32_bf16(kf, vf, S[dt], 0, 0, 0);
        }
#pragma unroll
        for (int y = 0; y < 2; ++y) *(f32x4*)(obuf + (16 * y + l15) * OBS + 16 * wid + 4 * g) = o[y];
        __syncthreads();
        {
            const f32x4 x0 = *(const f32x4*)(obuf + ntok * OBS + ndv), x1 = *(const f32x4*)(obuf + ntok * OBS + ndv + 4);
            float ss = x0[0] * x0[0] + x0[1] * x0[1] + x0[2] * x0[2] + x0[3] * x0[3] + x1[0] * x1[0] + x1[1] * x1[1] + x1[2] * x1[2] + x1[3] * x1[3];
            ss += __shfl_xor(ss, 1); ss += __shfl_xor(ss, 2); ss += __shfl_xor(ss, 4); ss += __shfl_xor(ss, 8);
            const float r = rsqrtf(ss * (1.f / 128.f) + 1e-6f);
            const float gv[8] = {__uint_as_float(hgw.x << 16), __uint_as_float(hgw.x & 0xFFFF0000u), __uint_as_float(hgw.y << 16), __uint_as_float(hgw.y & 0xFFFF0000u),
                                 __uint_as_float(hgw.z << 16), __uint_as_float(hgw.z & 0xFFFF0000u), __uint_as_float(hgw.w << 16), __uint_as_float(hgw.w & 0xFFFF0000u)};
            const float xv[8] = {x0[0], x0[1], x0[2], x0[3], x1[0], x1[1], x1[2], x1[3]};
            const f32x4 n0 = *(const f32x4*)(norm_w + h * 128 + ndv), n1 = *(const f32x4*)(norm_w + h * 128 + ndv + 4);
            const float nw[8] = {n0[0], n0[1], n0[2], n0[3], n1[0], n1[1], n1[2], n1[3]};
            float ov[8];
#pragma unroll
            for (int i = 0; i < 8; ++i) ov[i] = xv[i] * r * nw[i] * sigmoidf_(gv[i]);
            u32x4 w = {cvtpk(ov[0], ov[1]), cvtpk(ov[2], ov[3]), cvtpk(ov[4], ov[5]), cvtpk(ov[6], ov[7])};
            *(u32x4*)(proj + (size_t)(n * 32 + ntok) * LDP + C_HI + ndv) = w;
        }
        asm volatile("s_waitcnt vmcnt(0)" ::: "memory");
        __syncthreads();
    }
#undef HDMA
    (void)a_ke; (void)a_qa; (void)a_qp;
}
}

__device__ void cvt_tile(float* sm, const float* src, int ldsrc, int k0, int ns0, int nvalid, bf16_t* dst, int lddst, int nd0) {
    float(*t)[65] = (float(*)[65])sm;
    const int tid = tid_();
    float4 v[8];
#pragma unroll
    for (int r = 0; r < 8; ++r) {
        const int idx = tid + r * 512, k = idx >> 4, n4 = (idx & 15) * 4;
        v[r] = n4 < nvalid ? *(const float4*)(src + (size_t)(k0 + k) * ldsrc + ns0 + n4) : make_float4(0.f, 0.f, 0.f, 0.f);
    }
#pragma unroll
    for (int r = 0; r < 8; ++r) {
        const int idx = tid + r * 512, k = idx >> 4, n4 = (idx & 15) * 4;
        t[k][n4] = v[r].x; t[k][n4 + 1] = v[r].y; t[k][n4 + 2] = v[r].z; t[k][n4 + 3] = v[r].w;
    }
    __syncthreads();
#pragma unroll
    for (int r = 0; r < 4; ++r) {
        const int idx = tid + r * 512, kg = idx & 31, n = idx >> 5;
        uint4 w;
        w.x = (unsigned)f2bf(t[kg * 8 + 0][n]) | ((unsigned)f2bf(t[kg * 8 + 1][n]) << 16); w.y = (unsigned)f2bf(t[kg * 8 + 2][n]) | ((unsigned)f2bf(t[kg * 8 + 3][n]) << 16);
        w.z = (unsigned)f2bf(t[kg * 8 + 4][n]) | ((unsigned)f2bf(t[kg * 8 + 5][n]) << 16); w.w = (unsigned)f2bf(t[kg * 8 + 6][n]) | ((unsigned)f2bf(t[kg * 8 + 7][n]) << 16);
        *(uint4*)(dst + (size_t)(nd0 + n) * lddst + k0 + kg * 8) = w;
    }
    __syncthreads();
}
__device__ __forceinline__ int gemm1_src_col(int nd) { return nd < 6656 ? nd : nd < 8704 ? nd + 24 : nd < 8728 ? 6656 + (nd - 8704) : -1; }
__device__ void ph_cvt_win(const Params& p, int u, float* sm) {
    if (u < 560) {
        const int nt = u >> 2, kt = u & 3, nd0 = nt * 64;
        const int ns0 = nd0 < 6656 ? nd0 : nd0 < 8704 ? nd0 + 24 : 6656, nvalid = nd0 < 8704 ? 64 : nd0 == 8704 ? 24 : 0;
        cvt_tile(sm, p.w_in, DIN, kt * 256, ns0, nvalid, (bf16_t*)(p.ws + OFF_WINT), 1024, nd0);
    } else {
        float* b1 = (float*)(p.ws + OFF_BIAS1);
        for (int i = tid_(); i < N1; i += 512) { const int s = gemm1_src_col(i); b1[i] = s >= 0 ? p.b_in[s] : 0.f; }
    }
}
__device__ void ph_cvt_br(const Params& p, int u, float* sm) {
    const int w = u >> 6, t = u & 63, nt = t >> 2, kt = t & 3;
    if (w < 2) cvt_tile(sm, w == 0 ? p.w_br_hg : p.w_br_nsa, 1024, kt * 256, nt * 64, 64, (bf16_t*)(p.ws + OFF_WBRH) + w * 1024, 2048, nt * 64);
    else cvt_tile(sm, p.w_out, 1024, kt * 256, nt * 64, 64, (bf16_t*)(p.ws + OFF_WOUTT), 1024, nt * 64);
}
__device__ void ph_cvt_exp(const Params& p, int u, float* sm) {
    if (u < 2048) {
        const int e = u >> 6, t = u & 63, nt = t >> 2, kt = t & 3, nd0 = nt * 64, pn = nd0 >> 8, half = (nd0 >> 7) & 1, off = nd0 & 127;
        cvt_tile(sm, (half ? p.e_w3 : p.e_w1) + (size_t)e * 1024 * 512, 512, kt * 256, pn * 128 + off, 64, (bf16_t*)(p.ws + OFF_E13) + (size_t)e * 1024 * 1024, 1024, nd0);
    } else {
        const int v = u - 2048, e = v >> 5, t = v & 31, nt = t >> 1, kt = t & 1;
        cvt_tile(sm, p.e_w2 + (size_t)e * 512 * 1024, 1024, kt * 256, nt * 64, 64, (bf16_t*)(p.ws + OFF_E2T) + (size_t)e * 1024 * 512, 512, nt * 64);
    }
}
enum { PH_PRO = 0, PH_LN0, PH_CMP2, PH_FINAL };
__host__ __device__ constexpr int phase_units(int ph) { return ph == PH_PRO ? 99 : ph == PH_LN0 ? NT / 16 : ph == PH_CMP2 ? 64 : ph == PH_FINAL ? NT / 16 : 0; }

__device__ void ph_pro(const Params& p, int u, float* sm) {
    const int tid = tid_();
    float* mod = (float*)(p.ws + OFF_MOD);
    if (u < 96) {
        float* ca = sm;
        float* red = sm + 4096;
        for (int i = tid; i < 4096; i += 512) ca[i] = siluf_(p.c[i]);
        __syncthreads();
        const int col = u * 64 + (tid & 63), kg = tid >> 6;
        float a0 = 0.f, a1 = 0.f, a2 = 0.f, a3 = 0.f;
        for (int k = kg * 128; k < kg * 128 + 128; ++k) {
            const float w = p.ada_w[(size_t)k * 6144 + col];
            a0 = fmaf(ca[k], w, a0); a1 = fmaf(ca[1024 + k], w, a1); a2 = fmaf(ca[2048 + k], w, a2); a3 = fmaf(ca[3072 + k], w, a3);
        }
        red[(kg * 64 + (tid & 63)) * 4 + 0] = a0; red[(kg * 64 + (tid & 63)) * 4 + 1] = a1; red[(kg * 64 + (tid & 63)) * 4 + 2] = a2; red[(kg * 64 + (tid & 63)) * 4 + 3] = a3;
        __syncthreads();
        if (tid < 256) {
            const int cl = tid & 63, b = tid >> 6;
            float s = 0.f;
            for (int g = 0; g < 8; ++g) s += red[(g * 64 + cl) * 4 + b];
            mod[b * 6144 + u * 64 + cl] = s + p.ada_b[u * 64 + cl];
        }
        __syncthreads();
    } else if (u == 96) {
        float* lb = (float*)(p.ws + OFF_LB);
        float* lut = (float*)(p.ws + OFF_LUT);
        unsigned* cnt = (unsigned*)(p.ws + OFF_CNT);
        for (int i = tid; i < 1024; i += 512) {
            const float l0 = p.lb_logits[i], l1 = p.lb_logits[1024 + i];
            lb[i] = 1.f / (1.f + __expf(l1 - l0));
            const int h = i >> 7, d = i & 127;
            lut[i] = p.rel_bias[h * 32 + rel_bucket(d)];
        }
        if (tid < 64) cnt[tid] = 0u;
        if (tid < 8) ((unsigned*)(p.ws + OFF_QCTR))[tid * 64] = 0u;
        { bf16_t* kc = (bf16_t*)(p.ws + OFF_KCMP); bf16_t* vc = (bf16_t*)(p.ws + OFF_VCMP);
          for (int i = tid; i < 8 * 128; i += 512) { kc[(size_t)((i >> 7) * 512 + 511) * 128 + (i & 127)] = 0; vc[(size_t)((i >> 7) * 512 + 511) * 128 + (i & 127)] = 0; } }
    } else {
        const int kv = u - 97;
        float* cb = (float*)(p.ws + OFF_CB) + kv * 128;
        if (tid < 128) cb[tid] = (kv ? p.b1_v : p.b1_k)[tid];
    }
}
__device__ void ph_cmpconst(const Params& p, int u, float* sm) {
    const int tid = tid_(), kv = u >> 5, kc = u & 31;
    const float* pos = kv ? p.pos_v : p.pos_k; const float* w1 = kv ? p.w1_v : p.w1_k;
    const int n = tid & 127, kg = tid >> 7;
    float s = 0.f;
#pragma unroll 8
    for (int k = kc * 128 + kg * 32; k < kc * 128 + kg * 32 + 32; ++k) s = fmaf(pos[k], w1[(size_t)k * 128 + n], s);
    sm[kg * 128 + n] = s;
    __syncthreads();
    if (tid < 128) atomicAdd((float*)(p.ws + OFF_CB) + kv * 128 + tid, sm[tid] + sm[128 + tid] + sm[256 + tid] + sm[384 + tid]);
    __syncthreads();
}

__device__ void ph_ln0(const Params& p, int u) {
    const int tidx = tid_(), lane = tidx & 63;
    float4 v[2][4]; float s[2] = {0.f, 0.f}; int rowi[2];
#pragma unroll
    for (int k = 0; k < 2; ++k) {
        rowi[k] = (u + k * (NT / 16)) * 8 + (tidx >> 6);
        const float* xr = p.x + (size_t)rowi[k] * D_;
#pragma unroll
        for (int i = 0; i < 4; ++i) { v[k][i] = *(const float4*)(xr + (i * 64 + lane) * 4); s[k] += v[k][i].x + v[k][i].y + v[k][i].z + v[k][i].w; }
    }
#pragma unroll
    for (int k = 0; k < 2; ++k) {
        const float* mod = (const float*)(p.ws + OFF_MOD) + (rowi[k] / T_) * 6144;
        bf16_t* h = (bf16_t*)(p.ws + OFF_H) + (size_t)rowi[k] * D_;
        const float mu = wsum(s[k]) * (1.f / 1024.f);
        float q = 0.f;
#pragma unroll
        for (int i = 0; i < 4; ++i) { v[k][i].x -= mu; v[k][i].y -= mu; v[k][i].z -= mu; v[k][i].w -= mu; q += v[k][i].x * v[k][i].x + v[k][i].y * v[k][i].y + v[k][i].z * v[k][i].z + v[k][i].w * v[k][i].w; }
        const float rs = rsqrtf(wsum(q) * (1.f / 1024.f) + 1e-5f);
#pragma unroll
        for (int i = 0; i < 4; ++i) {
            const int c = (i * 64 + lane) * 4;
            const float4 sh = *(const float4*)(mod + c), sc = *(const float4*)(mod + 1024 + c);
            st_bf4(h + c, v[k][i].x * rs * (1.f + sc.x) + sh.x, v[k][i].y * rs * (1.f + sc.y) + sh.y, v[k][i].z * rs * (1.f + sc.z) + sh.z, v[k][i].w * rs * (1.f + sc.w) + sh.w);
        }
    }
}

__device__ void ph_cmp2(const Params& p, int u, float* sm) {
    const int tid = tid_(), kv = u >> 5, m0 = (u & 31) * 128;
    const float* w2 = kv ? p.w2_v : p.w2_k;
    const float* hid = (const float*)(p.ws + OFF_HID) + (size_t)kv * 4096 * 128;
    const float* cb = (const float*)(p.ws + OFF_CB) + kv * 128;
    bf16_t* dst = (bf16_t*)(p.ws + (kv ? OFF_VCMP : OFF_KCMP));
    float(*As)[132] = (float(*)[132])sm;
    float(*Bs)[132] = (float(*)[132])(sm + 128 * 132);
    float4 av[8], bv[8];
#pragma unroll
    for (int r = 0; r < 8; ++r) { const int idx = tid + r * 512, row = idx >> 5, k4 = (idx & 31) * 4; av[r] = *(const float4*)(hid + (size_t)(m0 + row) * 128 + k4); bv[r] = *(const float4*)(w2 + (size_t)row * 128 + k4); }
#pragma unroll
    for (int r = 0; r < 8; ++r) { const int idx = tid + r * 512, row = idx >> 5, k4 = (idx & 31) * 4;
        const float4 c4 = *(const float4*)(cb + k4);
        As[k4][row] = siluf_(av[r].x + c4.x); As[k4 + 1][row] = siluf_(av[r].y + c4.y); As[k4 + 2][row] = siluf_(av[r].z + c4.z); As[k4 + 3][row] = siluf_(av[r].w + c4.w);
        *(float4*)&Bs[row][k4] = bv[r]; }
    __syncthreads();
    const int tx = tid & 31, ty = tid >> 5;
    float acc[8][4];
#pragma unroll
    for (int i = 0; i < 8; ++i)
#pragma unroll
        for (int j = 0; j < 4; ++j) acc[i][j] = 0.f;
#pragma unroll 8
    for (int k = 0; k < 128; ++k) {
        const float4 a0 = *(const float4*)&As[k][ty * 8], a1 = *(const float4*)&As[k][ty * 8 + 4], bb = *(const float4*)&Bs[k][tx * 4];
        const float a_[8] = {a0.x, a0.y, a0.z, a0.w, a1.x, a1.y, a1.z, a1.w};
        const float b_[4] = {bb.x, bb.y, bb.z, bb.w};
#pragma unroll
        for (int i = 0; i < 8; ++i)
#pragma unroll
            for (int j = 0; j < 4; ++j) acc[i][j] = fmaf(a_[i], b_[j], acc[i][j]);
    }
#pragma unroll
    for (int i = 0; i < 8; ++i) {
        const int m = m0 + ty * 8 + i;
        const bool dead = (m & 511) == 511;
        st_bf4(dst + (size_t)m * 128 + tx * 4, dead ? 0.f : acc[i][0], dead ? 0.f : acc[i][1], dead ? 0.f : acc[i][2], dead ? 0.f : acc[i][3]);
    }
    __syncthreads();
}

struct Ln1rArgs { unsigned char* ws; const float *ln1_g, *ln1_b, *rg_b, *re_b; float* wl; };
__device__ __noinline__ void ph_ln1r_(const Ln1rArgs p, int u) {
    const int tidx = tid_(), lane = tidx & 63, row = u * 8 + (tidx >> 6), b = row / T_;
    float* zr = (float*)(p.ws + OFF_Z) + (size_t)row * D_;
    const float* mod = (const float*)(p.ws + OFF_MOD) + b * 6144;
    bf16_t* h2 = (bf16_t*)(p.ws + OFF_H) + (size_t)row * D_;
    float v[16]; float s = 0.f;
#pragma unroll
    for (int i = 0; i < 4; ++i) { const float4 a = *(const float4*)(zr + (i * 64 + lane) * 4); v[i * 4] = a.x; v[i * 4 + 1] = a.y; v[i * 4 + 2] = a.z; v[i * 4 + 3] = a.w; s += a.x + a.y + a.z + a.w; }
    float mu = wsum(s) * (1.f / 1024.f), q = 0.f;
#pragma unroll
    for (int i = 0; i < 16; ++i) { v[i] -= mu; q = fmaf(v[i], v[i], q); }
    float rs = rsqrtf(wsum(q) * (1.f / 1024.f) + 1e-5f);
    s = 0.f;
#pragma unroll
    for (int i = 0; i < 4; ++i) {
        const int c = (i * 64 + lane) * 4;
        const float4 gg = *(const float4*)(p.ln1_g + c), bb = *(const float4*)(p.ln1_b + c);
        v[i * 4] = v[i * 4] * rs * gg.x + bb.x; v[i * 4 + 1] = v[i * 4 + 1] * rs * gg.y + bb.y; v[i * 4 + 2] = v[i * 4 + 2] * rs * gg.z + bb.z; v[i * 4 + 3] = v[i * 4 + 3] * rs * gg.w + bb.w;
        *(float4*)(zr + c) = make_float4(v[i * 4], v[i * 4 + 1], v[i * 4 + 2], v[i * 4 + 3]);
        s += v[i * 4] + v[i * 4 + 1] + v[i * 4 + 2] + v[i * 4 + 3];
    }
    mu = wsum(s) * (1.f / 1024.f); q = 0.f;
#pragma unroll
    for (int i = 0; i < 16; ++i) { v[i] -= mu; q = fmaf(v[i], v[i], q); }
    rs = rsqrtf(wsum(q) * (1.f / 1024.f) + 1e-5f);
#pragma unroll
    for (int i = 0; i < 4; ++i) {
        const int c = (i * 64 + lane) * 4;
        const float4 sh = *(const float4*)(mod + 3072 + c), sc = *(const float4*)(mod + 4096 + c);
        v[i * 4] = v[i * 4] * rs * (1.f + sc.x) + sh.x; v[i * 4 + 1] = v[i * 4 + 1] * rs * (1.f + sc.y) + sh.y; v[i * 4 + 2] = v[i * 4 + 2] * rs * (1.f + sc.z) + sh.z; v[i * 4 + 3] = v[i * 4 + 3] * rs * (1.f + sc.w) + sh.w;
        st_bf4(h2 + c, v[i * 4], v[i * 4 + 1], v[i * 4 + 2], v[i * 4 + 3]);
    }
    float lg[36];
#pragma unroll
    for (int n = 0; n < 36; ++n) lg[n] = 0.f;
#pragma unroll
    for (int i = 0; i < 16; ++i) {
        const LAS float* wr = (const LAS float*)p.wl + (i * 64 + lane) * 4;
        pg8::f32x4 wa[9];
#pragma unroll
        for (int q = 0; q < 9; ++q) wa[q] = *(const LAS pg8::f32x4*)(wr + q * 4096);
        __builtin_amdgcn_sched_barrier(0);
#pragma unroll
        for (int q = 0; q < 9; ++q) { lg[q * 4] = fmaf(v[i], wa[q][0], lg[q * 4]); lg[q * 4 + 1] = fmaf(v[i], wa[q][1], lg[q * 4 + 1]); lg[q * 4 + 2] = fmaf(v[i], wa[q][2], lg[q * 4 + 2]); lg[q * 4 + 3] = fmaf(v[i], wa[q][3], lg[q * 4 + 3]); }
        __builtin_amdgcn_sched_barrier(0);
    }
    {
        const bool h5 = lane & 32, h4 = lane & 16, h3 = lane & 8, h2_ = lane & 4, h1 = lane & 2, h0 = lane & 1;
        float a18[18], a9[10], a5[6], a3[4], a2[2];
#pragma unroll
        for (int i = 0; i < 18; ++i) { const float keep = h5 ? lg[18 + i] : lg[i], send = h5 ? lg[i] : lg[18 + i]; a18[i] = keep + __shfl_xor(send, 32); }
#pragma unroll
        for (int i = 0; i < 9; ++i) { const float keep = h4 ? a18[9 + i] : a18[i], send = h4 ? a18[i] : a18[9 + i]; a9[i] = keep + __shfl_xor(send, 16); }
        a9[9] = 0.f;
#pragma unroll
        for (int i = 0; i < 5; ++i) { const float keep = h3 ? a9[5 + i] : a9[i], send = h3 ? a9[i] : a9[5 + i]; a5[i] = keep + __shfl_xor(send, 8); }
        a5[5] = 0.f;
#pragma unroll
        for (int i = 0; i < 3; ++i) { const float keep = h2_ ? a5[3 + i] : a5[i], send = h2_ ? a5[i] : a5[3 + i]; a3[i] = keep + __shfl_xor(send, 4); }
        a3[3] = 0.f;
#pragma unroll
        for (int i = 0; i < 2; ++i) { const float keep = h1 ? a3[2 + i] : a3[i], send = h1 ? a3[i] : a3[2 + i]; a2[i] = keep + __shfl_xor(send, 2); }
        const float tot = (h0 ? a2[1] : a2[0]) + __shfl_xor(h0 ? a2[0] : a2[1], 1);
        const int r2 = h0 ? 1 : 0, r3 = (h1 ? 2 : 0) + r2, r5 = (h2_ ? 3 : 0) + r3, r9 = (h3 ? 5 : 0) + r5, r18 = (h4 ? 9 : 0) + r9, r36 = (h5 ? 18 : 0) + r18;
        LAS float* slot = (LAS float*)p.wl + 1024 * 36 + (tidx >> 6) * 64;
        if (r3 < 3 && r5 < 5 && r9 < 9) slot[r36] = tot;
        asm volatile("s_waitcnt lgkmcnt(0)" ::: "memory");
#pragma unroll
        for (int q = 0; q < 9; ++q) { const pg8::f32x4 w4 = *(const LAS pg8::f32x4*)(slot + q * 4); const float4 w = make_float4(w4[0], w4[1], w4[2], w4[3]); lg[q * 4] = w.x; lg[q * 4 + 1] = w.y; lg[q * 4 + 2] = w.z; lg[q * 4 + 3] = w.w; }
    }
    float gl[4];
#pragma unroll
    for (int j = 0; j < 4; ++j) gl[j] = lg[j] + p.rg_b[j];
    int gi = 0; float gm = gl[0];
#pragma unroll
    for (int j = 1; j < 4; ++j) if (gl[j] > gm) { gm = gl[j]; gi = j; }
    float gs = 0.f;
#pragma unroll
    for (int j = 0; j < 4; ++j) gs += __expf(gl[j] - gm);
    const float gp = 1.f / gs;
    float el[8];
#pragma unroll
    for (int i = 0; i < 8; ++i) el[i] = (gi == 0 ? lg[4 + i] : gi == 1 ? lg[12 + i] : gi == 2 ? lg[20 + i] : lg[28 + i]) + p.re_b[gi * 8 + i];
    int i0 = 0; float l0 = el[0];
#pragma unroll
    for (int i = 1; i < 8; ++i) if (el[i] > l0) { l0 = el[i]; i0 = i; }
    int i1 = -1; float l1 = -3.0e38f;
#pragma unroll
    for (int i = 0; i < 8; ++i) if (i != i0 && el[i] > l1) { l1 = el[i]; i1 = i; }
    const float w0 = 1.f / (1.f + __expf(l1 - l0));
    if (lane == 0) {
        unsigned* cnt = (unsigned*)(p.ws + OFF_CNT);
        int* ti = (int*)(p.ws + OFF_TOKI) + (size_t)row * 6;
        const int e0 = gi * 8 + i0, e1 = gi * 8 + i1;
        ti[0] = e0; ti[1] = e1;
        (void)cnt;
        LAS unsigned* lc = (LAS unsigned*)((LAS float*)p.wl + 1024 * 36 + 512);
        ti[2] = (int)__hip_atomic_fetch_add(lc + e0, 1u, __ATOMIC_RELAXED, __HIP_MEMORY_SCOPE_WORKGROUP); ti[3] = (int)__hip_atomic_fetch_add(lc + e1, 1u, __ATOMIC_RELAXED, __HIP_MEMORY_SCOPE_WORKGROUP);
        ((float*)ti)[4] = gp * w0; ((float*)ti)[5] = gp * (1.f - w0);
    }
}

__device__ __forceinline__ int wave_offsets(const unsigned* cnt, int lane, int& pc_out, int& tot) {
    const int c = lane < 32 ? (int)cnt[lane] : 0;
    const int pc = ((c + 255) >> 8) << 8;
    int inc = pc;
    for (int o = 1; o < 64; o <<= 1) { const int t = __shfl_up(inc, o); if (lane >= o) inc += t; }
    tot = __shfl(inc, 63);
    pc_out = pc;
    return inc - pc;
}

__device__ void ph_final(const Params& p, int u) {
    const int tidx = tid_(), lane = tidx & 63;
    float v[2][16]; float s[2] = {0.f, 0.f};
    int rowi[2];
#pragma unroll
    for (int k = 0; k < 2; ++k) {
        const int row = (u + k * (NT / 16)) * 8 + (tidx >> 6), b = row / T_;
        rowi[k] = row;
        const float* x1 = (const float*)(p.ws + OFF_Z) + (size_t)row * D_;
        const float* mod = (const float*)(p.ws + OFF_MOD) + b * 6144 + 5120;
        const int* ti = (const int*)(p.ws + OFF_TOKI) + (size_t)row * 6;
        const int r0 = ti[2], r1 = ti[3]; const float w0 = ((const float*)ti)[4], w1 = ((const float*)ti)[5];
        const bf16_t* y0 = (const bf16_t*)(p.ws + OFF_XPAD) + (size_t)r0 * D_; const bf16_t* y1 = (const bf16_t*)(p.ws + OFF_XPAD) + (size_t)r1 * D_;
#pragma unroll
        for (int i = 0; i < 4; ++i) {
            const int c = (i * 64 + lane) * 4;
            const float4 xv = *(const float4*)(x1 + c), g2 = *(const float4*)(mod + c), a = ld_bf4(y0 + c), bb = ld_bf4(y1 + c);
            v[k][i * 4] = ALPHA * xv.x + (1.f + g2.x) * (w0 * a.x + w1 * bb.x); v[k][i * 4 + 1] = ALPHA * xv.y + (1.f + g2.y) * (w0 * a.y + w1 * bb.y);
            v[k][i * 4 + 2] = ALPHA * xv.z + (1.f + g2.z) * (w0 * a.z + w1 * bb.z); v[k][i * 4 + 3] = ALPHA * xv.w + (1.f + g2.w) * (w0 * a.w + w1 * bb.w);
            s[k] += v[k][i * 4] + v[k][i * 4 + 1] + v[k][i * 4 + 2] + v[k][i * 4 + 3];
        }
    }
#pragma unroll
    for (int k = 0; k < 2; ++k) {
        const float mu = wsum(s[k]) * (1.f / 1024.f); float q = 0.f;
#pragma unroll
        for (int i = 0; i < 16; ++i) { v[k][i] -= mu; q = fmaf(v[k][i], v[k][i], q); }
        const float rs = rsqrtf(wsum(q) * (1.f / 1024.f) + 1e-5f);
#pragma unroll
        for (int i = 0; i < 4; ++i) {
            const int c = (i * 64 + lane) * 4;
            const float4 gg = *(const float4*)(p.ln2_g + c), bb = *(const float4*)(p.ln2_b + c);
            *(float4*)(p.out + (size_t)rowi[k] * D_ + c) = make_float4(v[k][i * 4] * rs * gg.x + bb.x, v[k][i * 4 + 1] * rs * gg.y + bb.y, v[k][i * 4 + 2] * rs * gg.z + bb.z, v[k][i * 4 + 3] * rs * gg.w + bb.w);
        }
    }
}

template <int PH> __device__ __forceinline__ void run_unit(const Params& p, int u, float* sm) {
    if constexpr (PH == PH_PRO) ph_pro(p, u, sm);
    else if constexpr (PH == PH_LN0) ph_ln0(p, u);
    else if constexpr (PH == PH_CMP2) ph_cmp2(p, u, sm);
    else if constexpr (PH == PH_FINAL) ph_final(p, u);
}

constexpr int MEGA_LDS = 153600 + 16;
enum { Q_PRO = 0, Q_LN0, Q_GEMM1, Q_CMP1, Q_CMP2, Q_MIX, Q_MRG, Q_WOUT, Q_LN1R, Q_PAD, Q_EXP1, Q_EXP2, Q_FINAL };
template <int PH> __device__ __forceinline__ void unit_loop(const Params& p, float* sm) {
    for (int u = blockIdx.x; u < phase_units(PH); u += gridDim.x) run_unit<PH>(p, u, sm);
}
template <int Q> __device__ __forceinline__ void run_phase(const Params& p, float* sm) {
    PG8_LAS unsigned char* lds = (PG8_LAS unsigned char*)sm;
    const int G = gridDim.x, c = blockIdx.x;
    if constexpr (Q == Q_PRO) {
        unit_loop<PH_PRO>(p, sm); for (int u = c; u < 561; u += G) ph_cvt_win(p, u, sm);
        for (int u = c; u < 64; u += G) { const int kv = u >> 5, t = u & 31, nt = t >> 4, kt = t & 15;
            cvt_tile(sm, kv ? p.w1_v : p.w1_k, 128, kt * 256, nt * 64, 64, (bf16_t*)(p.ws + OFF_CMPW) + (size_t)kv * 128 * 4096, 4096, nt * 64); }
        { float4* hz = (float4*)(p.ws + OFF_HID); for (int i = c * 512 + threadIdx.x; i < 2 * 4096 * 128 / 4; i += G * 512) hz[i] = make_float4(0.f, 0.f, 0.f, 0.f); }
    }
    else if constexpr (Q == Q_LN0) { for (int u = c; u < 64; u += G) ph_cmpconst(p, u, sm); unit_loop<PH_LN0>(p, sm); }
    else if constexpr (Q == Q_GEMM1) {
        pg8::Gemm g{(const bf16_t*)(p.ws + OFF_H), (const bf16_t*)(p.ws + OFF_WINT), 1024, 1024, 1024};
        pg8::StaticOrder S; S.init(NT, N1, G, c);
        pg8::EpiProj E{(bf16_t*)(p.ws + OFF_PROJ), (bf16_t*)p.out, (float*)(p.ws + OFF_GATE), (const float*)(p.ws + OFF_BIAS1)};
        pg8::gemm_phase(lds, g, S, E);
    }
    else if constexpr (Q == Q_CMP1) {
        for (int u = c; u < 1024; u += G) ph_hpre(p, u);
        for (int u = c; u < 192; u += G) ph_cvt_br(p, u, sm);
        __syncthreads();
        pg8::Gemm g{(const bf16_t*)(p.ws + OFF_PROJ), (const bf16_t*)(p.ws + OFF_CMPW), 1024, 16 * LDP, 4096, 1, 1};
        pg8::CmpOrder S{G, c};
        pg8::EpiCmpAcc E{(float*)(p.ws + OFF_HID)};
        pg8::gemm_phase(lds, g, S, E);
    }
    else if constexpr (Q == Q_CMP2) unit_loop<PH_CMP2>(p, sm);
    else if constexpr (Q == Q_MIX) {
        unsigned* qc = (unsigned*)(p.ws + OFF_QCTR);
        volatile int* slot = (volatile int*)((char*)sm + 131072 - 64);
        for (int k = 0; k < 8; ++k) {
            const int q = (c + k) & 7;
            for (;;) {
                __syncthreads();
                if (threadIdx.x == 0) *slot = (int)__hip_atomic_fetch_add(qc + q * 64, 1u, __ATOMIC_RELAXED, __HIP_MEMORY_SCOPE_AGENT);
                __syncthreads();
                const int it = *slot;
                if (it >= 4 + 128) break;
                if (it < 4) hg::item(p.ws, p.hg_norm_w, q >> 1, (q & 1) * 4 + it, (char*)sm);
                else nsa::item(p.ws, q >> 1, q & 1, 127 - (it - 4), (char*)sm);
            }
        }
    }
    else if constexpr (Q == Q_MRG) {
        pg8::StaticOrder S; S.init(NT, 1024, G, c);
        pg8::Gemm g{(const bf16_t*)(p.ws + OFF_PROJ) + C_HI, (const bf16_t*)(p.ws + OFF_WBRH), 2048, LDP, 2048, 2, 0};
        pg8::EpiMrg E{(const bf16_t*)p.out, (bf16_t*)(p.ws + OFF_H)};
        pg8::gemm_phase(lds, g, S, E);
    }
    else if constexpr (Q == Q_WOUT) {
        for (int u = c; u < 3072; u += G) ph_cvt_exp(p, u, sm);
        pg8::Gemm g{(const bf16_t*)(p.ws + OFF_H), (const bf16_t*)(p.ws + OFF_WOUTT), 1024, 1024, 1024};
        pg8::StaticOrder S; S.init(NT, 1024, G, c);
        pg8::EpiWout E{p.x, (const float*)(p.ws + OFF_MOD), (float*)(p.ws + OFF_Z)};
        pg8::gemm_phase(lds, g, S, E);
    }
    else if constexpr (Q == Q_LN1R) {
        for (int i = threadIdx.x; i < 1024 * 4; i += 512) { const int cc = i >> 2, pos = ((cc >> 8) * 4 + (cc & 3)) * 64 + ((cc >> 2) & 63); sm[pos * 4 + (i & 3)] = p.rg_w[i]; }
        for (int i = threadIdx.x; i < 1024 * 32; i += 512) { const int cc = i >> 5, n = 4 + (i & 31), pos = ((cc >> 8) * 4 + (cc & 3)) * 64 + ((cc >> 2) & 63); sm[((n >> 2) * 1024 + pos) * 4 + (n & 3)] = p.re_w[i]; }
        unsigned* lc = (unsigned*)(sm + 1024 * 36 + 512);
        if (threadIdx.x < 64) lc[threadIdx.x] = 0u;
        __syncthreads();
        for (int u = c; u < NT / 8; u += G) ph_ln1r_(Ln1rArgs{p.ws, p.ln1_g, p.ln1_b, p.rg_b, p.re_b, sm}, u);
        __syncthreads();
        if (threadIdx.x < 32) lc[32 + threadIdx.x] = atomicAdd((unsigned*)(p.ws + OFF_CNT) + threadIdx.x, lc[threadIdx.x]);
        __syncthreads();
        for (int u = c; u < NT / 8; u += G) {
            if (threadIdx.x < 16) { int* ti = (int*)(p.ws + OFF_TOKI) + (size_t)(u * 8 + (threadIdx.x >> 1)) * 6; const int k = threadIdx.x & 1; ti[2 + k] += (int)lc[32 + ti[k]]; }
        }
        __syncthreads();
    }
    else if constexpr (Q == Q_PAD) {
        const int tidx = tid_(), lane = tidx & 63, w = tidx >> 6;
        const unsigned* cnt = (const unsigned*)(p.ws + OFF_CNT);
        bf16_t* xp = (bf16_t*)(p.ws + OFF_XPAD);
        int pc, tot; const int off = wave_offsets(cnt, lane, pc, tot);
#define PAD_LOAD(K_, ROW_) \
            const int rw##K_ = (ROW_) < NT ? (ROW_) : NT - 1; const int* tq##K_ = (const int*)(p.ws + OFF_TOKI) + (size_t)rw##K_ * 6; \
            const int ra##K_ = __shfl(off, tq##K_[0]) + tq##K_[2], rb##K_ = __shfl(off, tq##K_[1]) + tq##K_[3]; \
            const uint4* sp##K_ = (const uint4*)((const bf16_t*)(p.ws + OFF_H) + (size_t)rw##K_ * D_); const uint4 xa##K_ = sp##K_[lane], xb##K_ = sp##K_[64 + lane];
#define PAD_STORE(K_, ROW_) if ((ROW_) < NT) { uint4* d0 = (uint4*)(xp + (size_t)ra##K_ * D_); uint4* d1 = (uint4*)(xp + (size_t)rb##K_ * D_); \
            d0[lane] = xa##K_; d0[64 + lane] = xb##K_; d1[lane] = xa##K_; d1[64 + lane] = xb##K_; \
            if (lane == 0) { int* tw = (int*)(p.ws + OFF_TOKI) + (size_t)(ROW_) * 6; tw[2] = ra##K_; tw[3] = rb##K_; } }
        for (int base = c * 8 + w; base < NT; base += G * 16) {
            PAD_LOAD(0, base) PAD_LOAD(1, base + G * 8)
            PAD_STORE(0, base) PAD_STORE(1, base + G * 8)
        }
#undef PAD_LOAD
#undef PAD_STORE
        for (int e = c; e < 32; e += G) {
            const int oe = __shfl(off, e), ce = (int)cnt[e], pe = __shfl(pc, e);
            for (int r = oe + ce + w; r < oe + pe; r += 8) { uint4* d = (uint4*)(xp + (size_t)r * D_); d[lane] = make_uint4(0, 0, 0, 0); d[64 + lane] = make_uint4(0, 0, 0, 0); }
        }
        if (c == G - 1) {
            int* te = (int*)(p.ws + OFF_TILEE);
            if (tidx < 32) { for (int r = off; r < off + pc; r += 256) te[r >> 8] = tidx; }
            if (tidx == 0) te[511] = tot >> 8;
        }
    }
    else if constexpr (Q == Q_EXP1) {
        const int* te = (const int*)(p.ws + OFF_TILEE);
        pg8::Gemm g{(const bf16_t*)(p.ws + OFF_XPAD), (const bf16_t*)(p.ws + OFF_E13), 1024, 1024, 1024};
        pg8::MoeOrder S{te, te[511] * 4, G, c, (long)1024 * 1024 * 2};
        pg8::EpiExp1 E{(bf16_t*)p.out};
        pg8::gemm_phase(lds, g, S, E);
    }
    else if constexpr (Q == Q_EXP2) {
        const int* te = (const int*)(p.ws + OFF_TILEE);
        pg8::Gemm g{(const bf16_t*)p.out, (const bf16_t*)(p.ws + OFF_E2T), 512, 512, 512};
        pg8::MoeOrder S{te, te[511] * 4, G, c, (long)1024 * 512 * 2};
        pg8::EpiBf E{(bf16_t*)(p.ws + OFF_XPAD), 1024};
        pg8::gemm_phase(lds, g, S, E);
    }
    else if constexpr (Q == Q_FINAL) unit_loop<PH_FINAL>(p, sm);
}
__global__ void __launch_bounds__(512, 2) k_mega(Params p) {
    extern __shared__ __attribute__((aligned(16))) float smem[];
    volatile LAS unsigned* st = (volatile LAS unsigned*)(smem + 153600 / 4);
    if (threadIdx.x == 0) { st[0] = 0u; st[1] = 0u; st[2] = 0u; st[3] = 0u; }
    __syncthreads();
    XcdBarrier bar = xcd_barrier_post((unsigned*)(p.ws + OFF_BAR), st);
    run_phase<Q_PRO>(p, smem);   xcd_barrier(bar);
    run_phase<Q_LN0>(p, smem);   xcd_barrier(bar);
    run_phase<Q_GEMM1>(p, smem); xcd_barrier(bar);
    run_phase<Q_CMP1>(p, smem);  xcd_barrier(bar);
    run_phase<Q_CMP2>(p, smem);  xcd_barrier(bar);
    run_phase<Q_MIX>(p, smem);   xcd_barrier(bar);
    run_phase<Q_MRG>(p, smem);   xcd_barrier(bar);
    run_phase<Q_WOUT>(p, smem);  xcd_barrier(bar);
    run_phase<Q_LN1R>(p, smem);  xcd_barrier(bar);
    run_phase<Q_PAD>(p, smem);   xcd_barrier(bar);
    run_phase<Q_EXP1>(p, smem);  xcd_barrier(bar);
    run_phase<Q_EXP2>(p, smem);  xcd_barrier(bar);
    run_phase<Q_FINAL>(p, smem);
}

extern "C" void kernel_launch(void* const* d_in, const int* in_sizes, int n_in, void* d_out, int out_size, void* d_ws, size_t ws_size, hipStream_t stream) {
    Params p{};
    const float** fp = (const float**)&p;
    for (int i = 0; i < 31; ++i) fp[i] = (const float*)d_in[i];
    p.out = (float*)d_out; p.ws = (unsigned char*)d_ws;
    static int grid = 0;
    if (!grid) {
        int dev = 0, cus = 0, per_cu = 0;
        (void)hipGetDevice(&dev);
        (void)hipDeviceGetAttribute(&cus, hipDeviceAttributeMultiprocessorCount, dev);
        (void)hipFuncSetAttribute((const void*)k_mega, hipFuncAttributeMaxDynamicSharedMemorySize, MEGA_LDS);
        (void)hipOccupancyMaxActiveBlocksPerMultiprocessor(&per_cu, (const void*)k_mega, 512, MEGA_LDS);
        grid = cus * (per_cu < 1 ? per_cu : 1);
    }
    (void)hipMemsetAsync(p.ws + OFF_BAR, 0, XCD_BAR_WORDS * sizeof(unsigned), stream);
    hipLaunchKernelGGL(k_mega, dim3(grid), dim3(512), MEGA_LDS, stream, p);
}
```

```cpp
#include <hip/hip_runtime.h>
#include <stdint.h>

typedef unsigned short bf16_t;

constexpr int B_ = 4, T_ = 8192, D_ = 1024, NT = B_ * T_;
constexpr int DIN = 8728;
constexpr int LDP = 6656;
constexpr int C_HQ = 0, C_HF = 1024, C_HI = 2048, C_HG = 3072, C_NQ = 4096, C_KC = 5120, C_VC = 5376, C_KS = 5632, C_VS = 5888, C_KW = 6144, C_VW = 6400;
constexpr int NC = 511;
constexpr float ALPHA = 1.189207115002721f;
constexpr int MAXROWS = 73728;

constexpr size_t KB = 1024, MB = 1024 * 1024;
constexpr size_t OFF_BAR = 0, OFF_MOD = 16 * KB, OFF_LB = 112 * KB, OFF_LUT = 116 * KB, OFF_CB = 120 * KB, OFF_CNT = 124 * KB, OFF_TOKI = 128 * KB;
constexpr size_t OFF_GATE = 1 * MB, OFF_KCMP = 4 * MB, OFF_VCMP = 5 * MB, OFF_HID = 6 * MB;
constexpr size_t OFF_DEC = 18 * MB;
constexpr size_t OFF_QCTR = 960 * KB;
constexpr size_t OFF_CMPW = 10 * MB;
constexpr size_t OFF_H = 31 * MB;
constexpr size_t OFF_PROJ = 95 * MB;
constexpr size_t OFF_Z = OFF_PROJ, OFF_XPAD = OFF_PROJ + 128 * MB;
constexpr size_t OFF_BIAS1 = 896 * KB, OFF_TILEE = 940 * KB;
constexpr size_t OFF_WINT = 12 * MB;
constexpr size_t OFF_WBRH = 12 * MB, OFF_WBRN = 14 * MB, OFF_WOUTT = 16 * MB;
constexpr size_t OFF_E13 = OFF_PROJ + 272 * MB, OFF_E2T = OFF_PROJ + 336 * MB;
constexpr int N1 = 8960;

struct Params {
    const float *x, *c, *ada_w, *ada_b, *w_in, *b_in, *lb_logits, *hg_norm_w, *pos_k, *w1_k, *b1_k, *w2_k, *pos_v, *w1_v, *b1_v, *w2_v, *rel_bias,
        *w_br_hg, *w_br_nsa, *w_out, *ln1_g, *ln1_b, *rg_w, *rg_b, *re_w, *re_b, *e_w1, *e_w3, *e_w2, *ln2_g, *ln2_b;
    float* out; unsigned char* ws;
};

__device__ __forceinline__ int tid_() { int t = threadIdx.x; asm volatile("" : "+v"(t)); return t; }
__device__ __forceinline__ float bf2f(bf16_t v) { return __uint_as_float(((unsigned)v) << 16); }
__device__ __forceinline__ bf16_t f2bf(float f) { unsigned u = __float_as_uint(f); u += 0x7FFFu + ((u >> 16) & 1u); return (bf16_t)(u >> 16); }
__device__ __forceinline__ float sigmoidf_(float v) { return __builtin_amdgcn_rcpf(1.f + __expf(-v)); }
__device__ __forceinline__ float siluf_(float v) { return v * __builtin_amdgcn_rcpf(1.f + __expf(-v)); }
__device__ __forceinline__ float wsum(float v) { for (int o = 32; o > 0; o >>= 1) v += __shfl_xor(v, o); return v; }
__device__ __forceinline__ float rfl(float v) { return __int_as_float(__builtin_amdgcn_readfirstlane(__float_as_int(v))); }
__device__ __forceinline__ float wmax(float v) { for (int o = 32; o > 0; o >>= 1) v = fmaxf(v, __shfl_xor(v, o)); return v; }
__device__ __forceinline__ float4 ld_bf4(const bf16_t* p) { uint2 r = *(const uint2*)p; return make_float4(__uint_as_float(r.x << 16), __uint_as_float(r.x & 0xFFFF0000u), __uint_as_float(r.y << 16), __uint_as_float(r.y & 0xFFFF0000u)); }
__device__ __forceinline__ void st_bf4(bf16_t* p, float a, float b, float c, float d) { uint2 r; r.x = (unsigned)f2bf(a) | ((unsigned)f2bf(b) << 16); r.y = (unsigned)f2bf(c) | ((unsigned)f2bf(d) << 16); *(uint2*)p = r; }
__device__ __forceinline__ int rel_bucket(int n) {
    if (n < 16) return n < 0 ? 0 : n;
    int b = 16;
    b += (n >= 19) + (n >= 21) + (n >= 24) + (n >= 27) + (n >= 31) + (n >= 35) + (n >= 40) + (n >= 46) + (n >= 52) + (n >= 59) + (n >= 67) + (n >= 77) + (n >= 87) + (n >= 99) + (n >= 113);
    return b;
}

template <class AF, class BF, class EF>
__device__ __forceinline__ void gemm128(float* sm, int m0, int n0, int K, AF af, BF bf, EF ef) {
    float(*As)[132] = (float(*)[132])sm;
    float(*Bs)[132] = (float(*)[132])(sm + 16 * 132);
    const int tid = tid_(), tx = tid & 31, ty = tid >> 5;
    const int ar = tid >> 2, ak = (tid & 3) * 4, bk = tid >> 5, bn = (tid & 31) * 4;
    float acc[8][4];
#pragma unroll
    for (int i = 0; i < 8; ++i)
#pragma unroll
        for (int j = 0; j < 4; ++j) acc[i][j] = 0.f;
    for (int k0 = 0; k0 < K; k0 += 16) {
        const float4 a = af(m0 + ar, k0 + ak);
        const float4 b = bf(k0 + bk, n0 + bn);
        __syncthreads();
        As[ak + 0][ar] = a.x; As[ak + 1][ar] = a.y; As[ak + 2][ar] = a.z; As[ak + 3][ar] = a.w;
        *(float4*)&Bs[bk][bn] = b;
        __syncthreads();
#pragma unroll
        for (int k = 0; k < 16; ++k) {
            const float4 a0 = *(const float4*)&As[k][ty * 8], a1 = *(const float4*)&As[k][ty * 8 + 4], bb = *(const float4*)&Bs[k][tx * 4];
            const float av[8] = {a0.x, a0.y, a0.z, a0.w, a1.x, a1.y, a1.z, a1.w};
            const float bv[4] = {bb.x, bb.y, bb.z, bb.w};
#pragma unroll
            for (int i = 0; i < 8; ++i)
#pragma unroll
                for (int j = 0; j < 4; ++j) acc[i][j] = fmaf(av[i], bv[j], acc[i][j]);
        }
    }
#pragma unroll
    for (int i = 0; i < 8; ++i) ef(m0 + ty * 8 + i, n0 + tx * 4, make_float4(acc[i][0], acc[i][1], acc[i][2], acc[i][3]));
    __syncthreads();
}


#define XB_TMO      128
#define XB_XCNT(j)  (256  + 64 * (j))
#define XB_XSUB(j)  (1280 + 64 * (j))
#define XB_XGEN(j)  (2304 + 64 * (j))
#define XB_TOP      3328
#define XB_TOPGEN   3392
#define XCD_BAR_WORDS 3456
#define XB_SPIN_CAP (1u << 22)
#define LAS __attribute__((address_space(3)))
__device__ __forceinline__ unsigned xb_ld(unsigned* p)              { return __hip_atomic_load(p, __ATOMIC_RELAXED, __HIP_MEMORY_SCOPE_AGENT); }
__device__ __forceinline__ unsigned xb_add(unsigned* p, unsigned v) { return __hip_atomic_fetch_add(p, v, __ATOMIC_RELAXED, __HIP_MEMORY_SCOPE_AGENT); }
__device__ __forceinline__ unsigned xb_xcc_id() { return (unsigned)__builtin_amdgcn_s_getreg((3 << 11) | 20) & 0xFu; }
#define XB_SPIN(cond, bar) do { unsigned _sp = 0; while (cond) { __builtin_amdgcn_s_sleep(1); \
    if ((++_sp & 255u) == 0u) { if (xb_ld(&(bar)[XB_TMO])) break; if (_sp > XB_SPIN_CAP) { atomicAdd(&(bar)[XB_TMO], 1u); break; } } } } while (0)
struct XcdBarrier { unsigned* bar; unsigned x; volatile LAS unsigned* st; };
__device__ __forceinline__ XcdBarrier xcd_barrier_post(unsigned* bar, volatile LAS unsigned* st) {
    XcdBarrier b; b.bar = bar; b.x = xb_xcc_id(); b.st = st;
    if (threadIdx.x == 0) (void)xb_add(&bar[XB_XCNT(b.x)], 1u);
    return b;
}
__device__ __forceinline__ void xcd_barrier_complete(unsigned* bar, unsigned x, unsigned& nloc, unsigned& nx) {
    const unsigned G = gridDim.x * gridDim.y * gridDim.z;
    unsigned sum, cnt, mine, sp = 0u;
    for (;;) {
        sum = 0u; cnt = 0u; mine = 0u;
#pragma unroll
        for (unsigned j = 0; j < 16; ++j) { const unsigned c = xb_ld(&bar[XB_XCNT(j)]); sum += c; cnt += (c > 0u) ? 1u : 0u; mine = (j == x) ? c : mine; }
        if (sum == G) break;
        __builtin_amdgcn_s_sleep(1);
        if ((++sp & 255u) == 0u) { if (xb_ld(&bar[XB_TMO])) break; if (sp > XB_SPIN_CAP) { atomicAdd(&bar[XB_TMO], 1u); break; } }
    }
    nloc = mine > 0u ? mine : 1u; nx = cnt > 0u ? cnt : 1u;
}
__device__ __forceinline__ void xcd_barrier(const XcdBarrier& b) {
    asm volatile("s_waitcnt vmcnt(0)" ::: "memory");
    __syncthreads();
    if (threadIdx.x == 0) {
        unsigned* bar = b.bar;
        __builtin_amdgcn_s_waitcnt(0);
        unsigned nloc = b.st[0], nx = b.st[1];
        if (nloc == 0u) { xcd_barrier_complete(bar, b.x, nloc, nx); b.st[0] = nloc; b.st[1] = nx; }
        const unsigned old = xb_add(&bar[XB_XSUB(b.x)], 1u);
        const unsigned gen = old / nloc;
        if (old + 1u == (gen + 1u) * nloc) {
            __builtin_amdgcn_fence(__ATOMIC_RELEASE, "agent");
            asm volatile("s_waitcnt vmcnt(0)" ::: "memory");
            const unsigned og = xb_add(&bar[XB_TOP], 1u);
            const unsigned tg = og / nx;
            if (og + 1u == (tg + 1u) * nx) xb_add(&bar[XB_TOPGEN], 1u);
            else XB_SPIN(xb_ld(&bar[XB_TOPGEN]) == tg, bar);
            __builtin_amdgcn_fence(__ATOMIC_ACQUIRE, "agent");
            xb_add(&bar[XB_XGEN(b.x)], 1u);
            asm volatile("s_waitcnt vmcnt(0)" ::: "memory");
        } else {
            XB_SPIN(xb_ld(&bar[XB_XGEN(b.x)]) == gen, bar);
            __builtin_amdgcn_fence(__ATOMIC_ACQUIRE, "agent");
            asm volatile("s_waitcnt vmcnt(0)" ::: "memory");
        }
    }
    __syncthreads();
}


namespace pg8 {
#define PG8_LAS __attribute__((address_space(3)))
typedef short bf16x8 __attribute__((ext_vector_type(8)));
typedef float f32x4 __attribute__((ext_vector_type(4)));
typedef unsigned u32x4 __attribute__((ext_vector_type(4)));
constexpr int BM = 256, BK = 64, HALF = 128, HTB = HALF * BK * 2, STAGE_BYTES = 8 * HTB, NXCD = 8, WGM = 8;
__host__ __device__ __forceinline__ int lds_byte(int r, int c) { const int st = (r >> 4) * 2 + (c >> 5), rr = r & 15, cc = c & 31, ob = rr * 64 + cc * 2; return st * 1024 + (ob ^ (((ob >> 9) & 1) << 5)); }
__host__ __device__ __forceinline__ void stage_rc(int b, int& R, int& C) { const int st = b / 1024, sb = b % 1024, swz = sb ^ (((sb >> 9) & 1) << 5); R = (st >> 1) * 16 + swz / 64; C = (st & 1) * 32 + (swz % 64) / 2; }
__host__ __device__ __forceinline__ int perm32(int rho) { const int n = rho >> 4, i = rho & 15; return 8 * (i >> 2) + 4 * n + (i & 3); }
struct Unit { int pm, pn; long boff; long aoff; };
struct Gemm { const bf16_t* A; const bf16_t* Bt; int K, lda, ldb; int kmode = 0; int bdup = 0; };
struct StaticOrder {
    int nM, nN, nwg, G, c;
    __device__ void init(int M, int N, int G_, int c_) { nM = M / BM; nN = N / BM; nwg = nM * nN; G = G_; c = c_; }
    __device__ bool next(int i, Unit& u) const {
        const long L = (long)i * G + c; if (L >= nwg) return false;
        int wgid = (int)L; { const int q = nwg / NXCD, r = nwg % NXCD, xcd = wgid % NXCD, off = wgid / NXCD; wgid = (xcd < r ? xcd * (q + 1) : r * (q + 1) + (xcd - r) * q) + off; }
        const int nig = WGM * nN, gid = wgid / nig, fm = gid * WGM, gsz = (nM - fm) < WGM ? (nM - fm) : WGM;
        u.pm = fm + ((wgid % nig) % gsz); u.pn = (wgid % nig) / gsz; u.boff = 0; u.aoff = 0; return true;
    }
    __device__ __forceinline__ void a_ready(const Unit&) const {}
    __device__ __forceinline__ void done(const Unit&) const {}
};
struct MoeOrder {
    const int* tile_e; int nwg, G, c; long estride;
    __device__ bool next(int i, Unit& u) const {
        const long L = (long)i * G + c; if (L >= nwg) return false;
        u.pm = (int)(L >> 2); u.pn = (int)(L & 3); u.boff = (long)tile_e[u.pm] * estride; u.aoff = 0; return true;
    }
    __device__ __forceinline__ void a_ready(const Unit&) const {}
    __device__ __forceinline__ void done(const Unit&) const {}
};
struct CmpOrder {
    int G, c;
    __device__ bool next(int i, Unit& u) const {
        const int L = i * G + c; if (L >= 128) return false;
        const int kv = L >> 6, bg = (L >> 3) & 7, half = (L >> 2) & 1, kq = L & 3;
        u.pm = half; u.pn = (kv << 3) | bg;
        u.aoff = ((long)((bg >> 1) * T_ + 8 * kq) * LDP + (kv ? C_VC : C_KC) + (bg & 1) * 128) * 2;
        u.boff = ((long)kv * 128 * 4096 + kq * 1024) * 2;
        return true;
    }
    __device__ __forceinline__ void a_ready(const Unit&) const {}
    __device__ __forceinline__ void done(const Unit&) const {}
};
typedef __bf16 bf16x2n __attribute__((ext_vector_type(2)));
typedef float f32x2n __attribute__((ext_vector_type(2)));
__device__ __forceinline__ unsigned cvt_pk_bf16(float lo, float hi) { const f32x2n v = {lo, hi}; const bf16x2n r = __builtin_convertvector(v, bf16x2n); return __builtin_bit_cast(unsigned, r); }
__device__ __forceinline__ f32x4 unpk_lo(u32x4 w) { return (f32x4){__uint_as_float(w.x << 16), __uint_as_float(w.x & 0xFFFF0000u), __uint_as_float(w.y << 16), __uint_as_float(w.y & 0xFFFF0000u)}; }
__device__ __forceinline__ f32x4 unpk_hi(u32x4 w) { return (f32x4){__uint_as_float(w.z << 16), __uint_as_float(w.z & 0xFFFF0000u), __uint_as_float(w.w << 16), __uint_as_float(w.w & 0xFFFF0000u)}; }
__device__ __forceinline__ u32x4 pk8(f32x4 v0, f32x4 v1) { u32x4 w; w.x = cvt_pk_bf16(v0[0], v0[1]); w.y = cvt_pk_bf16(v0[2], v0[3]); w.z = cvt_pk_bf16(v1[0], v1[1]); w.w = cvt_pk_bf16(v1[2], v1[3]); return w; }
__device__ __forceinline__ f32x4 sig4(f32x4 v) { return (f32x4){sigmoidf_(v[0]), sigmoidf_(v[1]), sigmoidf_(v[2]), sigmoidf_(v[3])}; }
struct EpiProj {
    static constexpr bool PERM = true, AFTER_DRAIN = false, HAS_MID = false;
    bf16_t* proj; bf16_t* mg; float* gate; const float* bias;
    __device__ __forceinline__ void operator()(const f32x4 (&acc)[2][2][4][2], const Unit& u, int wr, int wc, int fr, int fq) const {
        const int row0 = u.pm * BM + wr * 64 + fr, c8 = u.pn * BM + wc * 32 + 8 * fq;
        f32x4 bv[2][2];
#pragma unroll
        for (int bj = 0; bj < 2; ++bj)
#pragma unroll
            for (int n = 0; n < 2; ++n) bv[bj][n] = *(const f32x4*)(bias + c8 + bj * HALF + 4 * n);
#pragma unroll
        for (int ai = 0; ai < 2; ++ai)
#pragma unroll
            for (int m = 0; m < 4; ++m) {
                const size_t row = (size_t)(row0 + ai * HALF + m * 16);
#pragma unroll
                for (int bj = 0; bj < 2; ++bj) {
                    const f32x4 v0 = acc[ai][bj][m][0] + bv[bj][0], v1 = acc[ai][bj][m][1] + bv[bj][1];
                    const int col = c8 + bj * HALF;
                    if (u.pn < 26) *(u32x4*)(proj + row * LDP + col) = pk8(v0, v1);
                    else if (u.pn < 34) *(u32x4*)(mg + row * 2048 + (col - 6656)) = pk8(sig4(v0), sig4(v1));
                    else if (col - 8704 < 24) { float* gp = gate + row * 24 + (col - 8704); *(f32x4*)gp = sig4(v0); *(f32x4*)(gp + 4) = sig4(v1); }
                }
            }
    }
};
struct EpiMrg {
    static constexpr bool PERM = true, AFTER_DRAIN = false, HAS_MID = true;
    const bf16_t* mg; bf16_t* mr;
    __device__ __forceinline__ void mid(f32x4 (&acc)[2][2][4][2], const Unit& u, int wr, int wc, int fr, int fq) const {
        const int row0 = u.pm * BM + wr * 64 + fr, c8 = u.pn * BM + wc * 32 + 8 * fq;
#pragma unroll
        for (int ai = 0; ai < 2; ++ai)
#pragma unroll
            for (int m = 0; m < 4; ++m) {
                const size_t row = (size_t)(row0 + ai * HALF + m * 16);
#pragma unroll
                for (int bj = 0; bj < 2; ++bj) {
                    const int col = c8 + bj * HALF;
                    const u32x4 hw = *(const u32x4*)(mg + row * 2048 + col), nw = *(const u32x4*)(mg + row * 2048 + 1024 + col);
                    const f32x4 h0 = unpk_lo(hw), h1 = unpk_hi(hw), n0 = unpk_lo(nw), n1 = unpk_hi(nw);
#pragma unroll
                    for (int j = 0; j < 4; ++j) { acc[ai][bj][m][0][j] *= h0[j] * __builtin_amdgcn_rcpf(fmaxf(n0[j], 8.673617e-19f)); acc[ai][bj][m][1][j] *= h1[j] * __builtin_amdgcn_rcpf(fmaxf(n1[j], 8.673617e-19f)); }
                    asm volatile("" ::: "memory");
                }
            }
    }
    __device__ __forceinline__ void operator()(const f32x4 (&acc)[2][2][4][2], const Unit& u, int wr, int wc, int fr, int fq) const {
        const int row0 = u.pm * BM + wr * 64 + fr, c8 = u.pn * BM + wc * 32 + 8 * fq;
#pragma unroll
        for (int ai = 0; ai < 2; ++ai)
#pragma unroll
            for (int m = 0; m < 4; ++m) {
                const size_t row = (size_t)(row0 + ai * HALF + m * 16);
#pragma unroll
                for (int bj = 0; bj < 2; ++bj) {
                    const int col = c8 + bj * HALF;
                    const u32x4 nw = *(const u32x4*)(mg + row * 2048 + 1024 + col);
                    f32x4 n0 = unpk_lo(nw), n1 = unpk_hi(nw);
#pragma unroll
                    for (int j = 0; j < 4; ++j) { n0[j] = fmaxf(n0[j], 8.673617e-19f); n1[j] = fmaxf(n1[j], 8.673617e-19f); }
                    *(u32x4*)(mr + row * 1024 + col) = pk8(n0 * acc[ai][bj][m][0], n1 * acc[ai][bj][m][1]);
                }
                asm volatile("" ::: "memory");
            }
    }
};
struct EpiWout {
    static constexpr bool PERM = false, AFTER_DRAIN = false, HAS_MID = false;
    const float* x; const float* mod; float* z;
    __device__ __forceinline__ void operator()(const f32x4 (&acc)[2][2][4][2], const Unit& u, int wr, int wc, int fr, int fq) const {
        const int row0 = u.pm * BM + wr * 64 + fr, col0 = u.pn * BM + wc * 32 + 4 * fq;
        const float* g1 = mod + ((u.pm * BM) / T_) * 6144 + 2048 + col0;
#pragma unroll
        for (int ai = 0; ai < 2; ++ai)
#pragma unroll
            for (int m = 0; m < 4; ++m) {
                const size_t ro = (size_t)(row0 + ai * HALF + m * 16) * 1024 + col0;
#pragma unroll
                for (int bj = 0; bj < 2; ++bj)
#pragma unroll
                    for (int n = 0; n < 2; ++n) { const f32x4 xv = *(const f32x4*)(x + ro + bj * HALF + n * 16), gv = *(const f32x4*)(g1 + bj * HALF + n * 16) + 1.0f;
                        *(f32x4*)(z + ro + bj * HALF + n * 16) = xv * ALPHA + gv * acc[ai][bj][m][n]; }
                if (m & 1) asm volatile("" ::: "memory");
            }
    }
};
struct EpiExp1 {
    static constexpr bool PERM = true, AFTER_DRAIN = false, HAS_MID = false;
    bf16_t* U;
    __device__ __forceinline__ void operator()(const f32x4 (&acc)[2][2][4][2], const Unit& u, int wr, int wc, int fr, int fq) const {
        const int row0 = u.pm * BM + wr * 64 + fr, c8 = u.pn * HALF + wc * 32 + 8 * fq;
#pragma unroll
        for (int ai = 0; ai < 2; ++ai)
#pragma unroll
            for (int m = 0; m < 4; ++m) {
                f32x4 r[2];
#pragma unroll
                for (int n = 0; n < 2; ++n)
#pragma unroll
                    for (int j = 0; j < 4; ++j) r[n][j] = siluf_(acc[ai][0][m][n][j]) * acc[ai][1][m][n][j];
                *(u32x4*)(U + (size_t)(row0 + ai * HALF + m * 16) * 512 + c8) = pk8(r[0], r[1]);
            }
    }
};
struct EpiCmpAcc {
    static constexpr bool PERM = false, AFTER_DRAIN = false, HAS_MID = false;
    float* hp;
    __device__ __forceinline__ void operator()(const f32x4 (&acc)[2][2][4][2], const Unit& u, int wr, int wc, int fr, int fq) const {
        const int row0 = u.pn * 512 + u.pm * BM + wr * 64 + fr, col0 = wc * 32 + 4 * fq;
#pragma unroll
        for (int ai = 0; ai < 2; ++ai)
#pragma unroll
            for (int m = 0; m < 4; ++m) { float* rp = hp + (size_t)(row0 + ai * HALF + m * 16) * 128 + col0;
#pragma unroll
                for (int n = 0; n < 2; ++n)
#pragma unroll
                    for (int j = 0; j < 4; ++j) atomicAdd(rp + n * 16 + j, acc[ai][0][m][n][j]); }
    }
};
struct EpiBf {
    static constexpr bool PERM = true, AFTER_DRAIN = false, HAS_MID = false;
    bf16_t* O; int ldo;
    __device__ __forceinline__ void operator()(const f32x4 (&acc)[2][2][4][2], const Unit& u, int wr, int wc, int fr, int fq) const {
        const int row0 = u.pm * BM + wr * 64 + fr, c8 = u.pn * BM + wc * 32 + 8 * fq;
#pragma unroll
        for (int ai = 0; ai < 2; ++ai)
#pragma unroll
            for (int m = 0; m < 4; ++m)
#pragma unroll
                for (int bj = 0; bj < 2; ++bj) *(u32x4*)(O + (size_t)(row0 + ai * HALF + m * 16) * ldo + c8 + bj * HALF) = pk8(acc[ai][bj][m][0], acc[ai][bj][m][1]);
    }
};
template <class Epi, class Sched>
__device__ __forceinline__ void gemm_phase(PG8_LAS unsigned char* lds, const Gemm g, const Sched& S, const Epi& E) {
    const int tid = tid_(), wid = __builtin_amdgcn_readfirstlane(tid >> 6), lane = tid & 63, wr = wid >> 2, wc = wid & 3, fr = lane & 15, fq = lane >> 4;
    const int K = g.K, nt = K / BK;
    unsigned voffA[2], voffB[2];
#pragma unroll
    for (int i = 0; i < 2; ++i) { int R, C; stage_rc(tid * 16 + i * 8192, R, C); const int Rb = Epi::PERM ? ((R & ~31) + perm32(R & 31)) : R;
        voffA[i] = (unsigned)(R * g.lda + C) * 2u; voffB[i] = (unsigned)(Rb * g.ldb + C) * 2u; }
    const size_t kstep = (size_t)(BK * 2);
#define PG8_KA(t) (g.kmode == 1 ? (size_t)((t) >> 1) * (LDP * 2) + (size_t)((t) & 1) * 128 : g.kmode == 2 ? (size_t)(t) * kstep + ((t) >= 16 ? (size_t)2048 : (size_t)0) : (size_t)(t) * kstep)
    const size_t hstepA = (size_t)HALF * g.lda * 2, hstepB = g.bdup ? (size_t)0 : (size_t)HALF * g.ldb * 2;
    const size_t tstepA = 2 * hstepA, tstepB = 2 * hstepB;
    const unsigned ldsw = (unsigned)wid * 1024u;
    const int aoff = lds_byte(wr * 64 + fr, fq * 8), boff = lds_byte(wc * 32 + fr, fq * 8);
#define PG8_SA(b, h) (((b) * 2 + (h)) * HTB)
#define PG8_SB(b, h) ((4 + (b) * 2 + (h)) * HTB)
#define PG8_STAGE(bufoff, gbase, voff) do { _Pragma("unroll") for (int _i = 0; _i < 2; ++_i) \
        __builtin_amdgcn_global_load_lds((const unsigned*)((const char*)(gbase) + (voff)[_i]), (PG8_LAS unsigned*)(lds + (bufoff) + ldsw + _i * 8192), 16, 0, 0); } while (0)
#define PG8_LDA(dst, b, h) do { _Pragma("unroll") for (int m = 0; m < 4; ++m) _Pragma("unroll") for (int k = 0; k < 2; ++k) dst[m][k] = *(const PG8_LAS bf16x8*)(lds + PG8_SA(b, h) + aoff + m * 2048 + k * 1024); } while (0)
#define PG8_LDB(dst, b, h) do { _Pragma("unroll") for (int n = 0; n < 2; ++n) _Pragma("unroll") for (int k = 0; k < 2; ++k) dst[n][k] = *(const PG8_LAS bf16x8*)(lds + PG8_SB(b, h) + boff + n * 2048 + k * 1024); } while (0)
#define PG8_MMA(ai, bj, At, Bt) do { __builtin_amdgcn_s_setprio(1); _Pragma("unroll") for (int m = 0; m < 4; ++m) _Pragma("unroll") for (int n = 0; n < 2; ++n) _Pragma("unroll") for (int k = 0; k < 2; ++k) \
        acc[ai][bj][m][n] = __builtin_amdgcn_mfma_f32_16x16x32_bf16(Bt[n][k], At[m][k], acc[ai][bj][m][n], 0, 0, 0); __builtin_amdgcn_s_setprio(0); } while (0)
#define PG8_WAIT_V(n) asm volatile("s_waitcnt vmcnt(" #n ")" ::: "memory")
#define PG8_WAIT_L(n) asm volatile("s_waitcnt lgkmcnt(" #n ")" ::: "memory")
#define PG8_BAR __builtin_amdgcn_s_barrier()
#define PG8_SCHED __builtin_amdgcn_sched_barrier(0)
    Unit cur, nxt; int ui = 0;
    if (!S.next(0, cur)) return;
    f32x4 acc[2][2][4][2];
#pragma unroll
    for (int a = 0; a < 2; ++a)
#pragma unroll
        for (int b = 0; b < 2; ++b)
#pragma unroll
            for (int m = 0; m < 4; ++m)
#pragma unroll
                for (int n = 0; n < 2; ++n) acc[a][b][m][n] = (f32x4){0.f, 0.f, 0.f, 0.f};
    bf16x8 At[4][2], B0[2][2], B1[2][2];
    const char* cA = (const char*)g.A + cur.aoff + (size_t)cur.pm * tstepA; const char* cB = (const char*)g.Bt + cur.boff + (size_t)cur.pn * tstepB;
    S.a_ready(cur);
    PG8_STAGE(PG8_SB(0, 0), cB, voffB); PG8_STAGE(PG8_SA(0, 0), cA, voffA); PG8_STAGE(PG8_SB(0, 1), cB + hstepB, voffB); PG8_STAGE(PG8_SA(0, 1), cA + hstepA, voffA);
    if (wr == 1) PG8_BAR;
    PG8_WAIT_V(4); PG8_BAR;
    PG8_STAGE(PG8_SB(1, 0), cB + kstep, voffB); PG8_STAGE(PG8_SA(1, 0), cA + PG8_KA(1), voffA); PG8_STAGE(PG8_SB(1, 1), cB + hstepB + kstep, voffB);
    PG8_WAIT_V(6); PG8_BAR;
    for (;;) {
        const bool has_next = S.next(ui + 1, nxt);
        const char* nA = has_next ? (const char*)g.A + nxt.aoff + (size_t)nxt.pm * tstepA : cA; const char* nB = has_next ? (const char*)g.Bt + nxt.boff + (size_t)nxt.pn * tstepB : cB;
        for (int t = 0; t < nt; t += 2) {
            const bool last = (t == nt - 2);
            const char* a1 = cA + PG8_KA(t + 1);
            const char* a2 = last ? nA : cA + PG8_KA(t + 2); const char* b2 = last ? nB : cB + (size_t)(t + 2) * kstep;
            const char* a3 = last ? nA + PG8_KA(1) : cA + PG8_KA(t + 3); const char* b3 = b2 + kstep;
            if (last && has_next) S.a_ready(nxt);
            if constexpr (Epi::HAS_MID) { if (t == 16) E.mid(acc, cur, wr, wc, fr, fq); }
            PG8_LDB(B0, 0, 0); PG8_SCHED; PG8_LDA(At, 0, 0); PG8_STAGE(PG8_SA(1, 1), a1 + hstepA, voffA);
            PG8_WAIT_L(8); PG8_BAR; PG8_WAIT_L(0); PG8_MMA(0, 0, At, B0); PG8_BAR; PG8_SCHED;
            PG8_LDB(B1, 0, 1); PG8_STAGE(PG8_SB(0, 0), b2, voffB);
            PG8_BAR; PG8_WAIT_L(0); PG8_MMA(0, 1, At, B1); PG8_BAR;
            PG8_LDA(At, 0, 1); PG8_STAGE(PG8_SA(0, 0), a2, voffA);
            PG8_BAR; PG8_WAIT_L(0); PG8_MMA(1, 0, At, B0); PG8_BAR; PG8_SCHED;
            PG8_STAGE(PG8_SB(0, 1), b2 + hstepB, voffB);
            PG8_WAIT_V(6); PG8_BAR; PG8_MMA(1, 1, At, B1); PG8_BAR;
            PG8_LDB(B0, 1, 0); PG8_SCHED; PG8_LDA(At, 1, 0); PG8_STAGE(PG8_SA(0, 1), a2 + hstepA, voffA);
            PG8_WAIT_L(8); PG8_BAR; PG8_WAIT_L(0); PG8_MMA(0, 0, At, B0); PG8_BAR; PG8_SCHED;
            PG8_LDB(B1, 1, 1); PG8_STAGE(PG8_SB(1, 0), b3, voffB);
            PG8_BAR; PG8_WAIT_L(0); PG8_MMA(0, 1, At, B1); PG8_BAR;
            PG8_LDA(At, 1, 1); PG8_STAGE(PG8_SA(1, 0), a3, voffA);
            PG8_BAR; PG8_WAIT_L(0); PG8_MMA(1, 0, At, B0); PG8_BAR; PG8_SCHED;
            PG8_STAGE(PG8_SB(1, 1), b3 + hstepB, voffB);
            PG8_WAIT_V(6); PG8_BAR; PG8_MMA(1, 1, At, B1); PG8_BAR;
        }
        if constexpr (!Epi::AFTER_DRAIN) { E(acc, cur, wr, wc, fr, fq); S.done(cur); }
        if (!has_next) break;
#pragma unroll
        for (int a = 0; a < 2; ++a)
#pragma unroll
            for (int b = 0; b < 2; ++b)
#pragma unroll
                for (int m = 0; m < 4; ++m)
#pragma unroll
                    for (int n = 0; n < 2; ++n) acc[a][b][m][n] = (f32x4){0.f, 0.f, 0.f, 0.f};
        cur = nxt; cA = nA; cB = nB; ++ui;
    }
    PG8_WAIT_V(0);
    if (wr == 0) PG8_BAR;
    PG8_BAR;
    if constexpr (Epi::AFTER_DRAIN) { E.fused(acc, cur, wr, wc, fr, fq, lds, wid, lane); S.done(cur); }
#undef PG8_SA
#undef PG8_SB
#undef PG8_STAGE
#undef PG8_LDA
#undef PG8_LDB
#undef PG8_MMA
#undef PG8_WAIT_V
#undef PG8_WAIT_L
#undef PG8_BAR
#undef PG8_SCHED
#undef PG8_KA
}
}

namespace nsa {
typedef short bf16x8 __attribute__((ext_vector_type(8)));
typedef short s16x4 __attribute__((ext_vector_type(4)));
typedef float f32x16 __attribute__((ext_vector_type(16)));
typedef float f32x4 __attribute__((ext_vector_type(4)));
typedef unsigned u32x4 __attribute__((ext_vector_type(4)));
constexpr int SHM_V = 16384, SHM_K = 16384;
constexpr int L_V = 0, L_K = 32768, L_WS = 65536, L_LUT = 67584, L_IMP = 69632, L_SEL = 102400, L_UNI = 103424, L_TL = 103488, L_END = 104064;
constexpr float LOG2E = 1.4426950408889634f, C2 = 0.08838834764831845f * LOG2E, THR2 = 11.5f;
#define KSWZ(row, colB) ((row) * 256 + ((colB) ^ (((row) & 7) << 4)))
#define SBAR() __builtin_amdgcn_sched_barrier(0)
__device__ __forceinline__ int v_st(int k, int c) { const int kk = (k & ~0xC) | ((k & 4) << 1) | ((k & 8) >> 1); return ((kk >> 3) * 4 + (c >> 5)) * 512 + ((kk & 7) * 32 + (c & 31)) * 2; }
__device__ __forceinline__ int v_rd_base(int lane) { return ((lane & 3) << 3) | (((lane >> 2) & 3) << 6) | (((lane >> 4) & 1) << 5) | (((lane >> 5) & 1) << 8); }
constexpr int v_rd_off(int d0, int ks, int half) { return d0 * 512 + ks * 4096 + half * 2048; }
__device__ __forceinline__ int crow(int r, int hi) { return (r & 3) + 8 * (r >> 2) + 4 * hi; }
__device__ __forceinline__ unsigned cvtpk(float lo, float hi) { unsigned r; asm volatile("v_cvt_pk_bf16_f32 %0, %1, %2" : "=v"(r) : "v"(lo), "v"(hi)); return r; }

template <int KB>
__device__ __forceinline__ void qkt(f32x16& p0, f32x16& p1, const char* K_lds, int r32, int hi, const bf16x8* qr) {
    p0 = f32x16{}; p1 = f32x16{};
    const char* kb[4];
#pragma unroll
    for (int dd = 0; dd < 4; ++dd) kb[dd] = K_lds + KB * SHM_K + KSWZ(r32, (dd * 16 + hi * 8) * 2);
#pragma unroll
    for (int d0 = 0; d0 < 8; ++d0) { const char* a = kb[d0 & 3] + (d0 >> 2) * 128;
        bf16x8 b0 = *reinterpret_cast<const bf16x8*>(a);
        bf16x8 b1 = *reinterpret_cast<const bf16x8*>(a + 32 * 256);
        p0 = __builtin_amdgcn_mfma_f32_32x32x16_bf16(b0, qr[d0], p0, 0, 0, 0);
        p1 = __builtin_amdgcn_mfma_f32_32x32x16_bf16(b1, qr[d0], p1, 0, 0, 0); }
}
template <int VB>
__device__ __forceinline__ void pv_tile(f32x16* o, int vb0, bf16x8 pa0, bf16x8 pa1, bf16x8 pa2, bf16x8 pa3) {
#define TRRD(dst, off) asm volatile("ds_read_b64_tr_b16 %0, %1 offset:%2" : "=&v"(dst) : "v"(vb0), "i"(off) : "memory")
#define PV_D0(d0) do { s16x4 l0, l1, l2, l3, h0, h1, h2, h3; constexpr int b_ = VB * SHM_V + v_rd_off(d0, 0, 0); \
        TRRD(l0, b_); TRRD(h0, b_ + 2048); TRRD(l1, b_ + 4096); TRRD(h1, b_ + 6144); TRRD(l2, b_ + 8192); TRRD(h2, b_ + 10240); TRRD(l3, b_ + 12288); TRRD(h3, b_ + 14336); \
        asm volatile("s_waitcnt lgkmcnt(0)" ::: "memory"); SBAR(); \
        o[d0] = __builtin_amdgcn_mfma_f32_32x32x16_bf16(pa0, (bf16x8){l0[0], l0[1], l0[2], l0[3], h0[0], h0[1], h0[2], h0[3]}, o[d0], 0, 0, 0); \
        o[d0] = __builtin_amdgcn_mfma_f32_32x32x16_bf16(pa1, (bf16x8){l1[0], l1[1], l1[2], l1[3], h1[0], h1[1], h1[2], h1[3]}, o[d0], 0, 0, 0); \
        o[d0] = __builtin_amdgcn_mfma_f32_32x32x16_bf16(pa2, (bf16x8){l2[0], l2[1], l2[2], l2[3], h2[0], h2[1], h2[2], h2[3]}, o[d0], 0, 0, 0); \
        o[d0] = __builtin_amdgcn_mfma_f32_32x32x16_bf16(pa3, (bf16x8){l3[0], l3[1], l3[2], l3[3], h3[0], h3[1], h3[2], h3[3]}, o[d0], 0, 0, 0); } while (0)
    PV_D0(0); PV_D0(1); PV_D0(2); PV_D0(3);
#undef PV_D0
#undef TRRD
}
__device__ __forceinline__ void mask_tile(f32x16& p0, f32x16& p1, int dq, unsigned W) {
    const float NEG = -__builtin_inff();
    asm volatile("" : "+v"(dq));
#pragma unroll
    for (int r = 0; r < 16; ++r) {
        const int c = (r & 3) + 8 * (r >> 2);
        if ((unsigned)(dq - c) >= W) p0[r] = NEG;
        if ((unsigned)(dq - c - 32) >= W) p1[r] = NEG;
    }
}
template <int STRIDE>
__device__ __forceinline__ void bias_near(f32x16& p0, f32x16& p1, int dbase, const float* lut) {
    asm volatile("" : "+v"(dbase));
#pragma unroll
    for (int r = 0; r < 16; ++r) {
        const int c = (r & 3) + 8 * (r >> 2);
        int d0 = dbase - STRIDE * c, d1 = dbase - STRIDE * (c + 32);
        d0 = d0 < 0 ? 0 : (d0 > 127 ? 127 : d0); d1 = d1 < 0 ? 0 : (d1 > 127 ? 127 : d1);
        p0[r] = fmaf(p0[r], C2, lut[d0]); p1[r] = fmaf(p1[r], C2, lut[d1]);
    }
}
__device__ __forceinline__ void bias_const(f32x16& p0, f32x16& p1, float cb) {
#pragma unroll
    for (int r = 0; r < 16; ++r) { p0[r] = fmaf(p0[r], C2, cb); p1[r] = fmaf(p1[r], C2, cb); }
}
__device__ __forceinline__ float half_max(float v) { auto rr = __builtin_amdgcn_permlane32_swap(__float_as_uint(v), __float_as_uint(v), false, false); return fmaxf(__uint_as_float(rr[0]), __uint_as_float(rr[1])); }
__device__ __forceinline__ float half_sum(float v) { auto rr = __builtin_amdgcn_permlane32_swap(__float_as_uint(v), __float_as_uint(v), false, false); return __uint_as_float(rr[0]) + __uint_as_float(rr[1]); }
__device__ __forceinline__ void softmax_online(f32x16& p0, f32x16& p1, float sc, float cb2, bool sel, float& m, float& l, float& alpha) {
    float pmax = p0[0];
#pragma unroll
    for (int r = 1; r < 16; ++r) pmax = fmaxf(pmax, p0[r]);
#pragma unroll
    for (int r = 0; r < 16; ++r) pmax = fmaxf(pmax, p1[r]);
    pmax = half_max(pmax);
    pmax = sel ? fmaf(pmax, sc, cb2) : -__builtin_inff();
    if (__all(pmax - m <= THR2)) alpha = 1.f;
    else { const float mn = fmaxf(m, pmax); alpha = __builtin_amdgcn_exp2f(m - mn); m = mn; }
    const float off = sel ? cb2 - m : -__builtin_inff();
#pragma unroll
    for (int r = 0; r < 16; ++r) { p0[r] = fmaf(p0[r], sc, off); p1[r] = fmaf(p1[r], sc, off); }
    SBAR();
#pragma unroll
    for (int r = 0; r < 16; ++r) { p0[r] = __builtin_amdgcn_exp2f(p0[r]); p1[r] = __builtin_amdgcn_exp2f(p1[r]); }
    SBAR();
    float ps = 0.f;
#pragma unroll
    for (int r = 0; r < 16; ++r) ps += p0[r] + p1[r];
    l = l * alpha + half_sum(ps);
}
__device__ __forceinline__ void pack_p(const f32x16& p0, const f32x16& p1, bf16x8& pa0, bf16x8& pa1, bf16x8& pa2, bf16x8& pa3) {
#define PK4(P, B_, OUT) do { unsigned a0 = cvtpk(P[B_+0], P[B_+1]), a1 = cvtpk(P[B_+2], P[B_+3]); \
        unsigned b0 = cvtpk(P[B_+4], P[B_+5]), b1 = cvtpk(P[B_+6], P[B_+7]); \
        auto r0 = __builtin_amdgcn_permlane32_swap(a0, b0, false, false); auto r1 = __builtin_amdgcn_permlane32_swap(a1, b1, false, false); \
        u32x4 w = {r0[0], r1[0], r0[1], r1[1]}; OUT = *reinterpret_cast<bf16x8*>(&w); } while (0)
    PK4(p0, 0, pa0); PK4(p0, 8, pa1); PK4(p1, 0, pa2); PK4(p1, 8, pa3);
#undef PK4
}
__device__ __forceinline__ void rescale_o(f32x16* o, float alpha, float* al_l, int r32, int hi) {
    if (__any(alpha < 1.f)) {
        if (hi == 0) al_l[r32] = alpha;
        asm volatile("s_waitcnt lgkmcnt(0)" ::: "memory");
#pragma unroll
        for (int r = 0; r < 16; ++r) { const float a = al_l[crow(r, hi)];
#pragma unroll
            for (int d = 0; d < 4; ++d) o[d][r] *= a; }
    }
}
__device__ __forceinline__ void flush_out(const f32x16* o, float lsum, int br, unsigned char* ws, char* lds, int b, int g, int qb, int wid, int lane_in, bool first) {
    int lane = lane_in; asm volatile("" : "+v"(lane));
    const int r32 = lane & 31, hi = lane >> 5, head = g * 4 + (wid >> 1);
    const size_t tok = (size_t)b * T_ + qb * 64 + (wid & 1) * 32;
    float* li_l = (float*)(lds + L_WS) + wid * 64;
    bf16_t* tb = (bf16_t*)(lds + wid * 8192);
    bf16_t* orow = (bf16_t*)(ws + OFF_PROJ) + tok * LDP + C_NQ + head * 128;
    const float gate = ((const float*)(ws + OFF_GATE))[(tok + r32) * 24 + head * 3 + br];
    const float f_lane = br == 0 ? gate : (lsum > 0.f ? gate / lsum : 0.f);
    if (hi == 0) li_l[r32] = f_lane;
    asm volatile("s_waitcnt lgkmcnt(0)" ::: "memory");
#pragma unroll
    for (int r = 0; r < 16; ++r) {
        const float f = li_l[crow(r, hi)];
#pragma unroll
        for (int d = 0; d < 4; ++d) tb[crow(r, hi) * 128 + d * 32 + r32] = f2bf(o[d][r] * f);
    }
    asm volatile("s_waitcnt lgkmcnt(0)" ::: "memory");
    uint4 gq[8];
    if (!first) {
#pragma unroll
        for (int i = 0; i < 8; ++i) { const int idx = i * 64 + lane, row = idx >> 4, ch = idx & 15; gq[i] = *(const uint4*)(orow + (size_t)row * LDP + ch * 8); }
    }
#pragma unroll
    for (int i = 0; i < 8; ++i) {
        const int idx = i * 64 + lane, row = idx >> 4, ch = idx & 15;
        uint4 w = *(const uint4*)(tb + row * 128 + ch * 8);
        uint4* gp = (uint4*)(orow + (size_t)row * LDP + ch * 8);
        if (!first) {
            const uint4 g = gq[i];
            w.x = cvtpk(__uint_as_float(w.x << 16) + __uint_as_float(g.x << 16), __uint_as_float(w.x & 0xFFFF0000u) + __uint_as_float(g.x & 0xFFFF0000u));
            w.y = cvtpk(__uint_as_float(w.y << 16) + __uint_as_float(g.y << 16), __uint_as_float(w.y & 0xFFFF0000u) + __uint_as_float(g.y & 0xFFFF0000u));
            w.z = cvtpk(__uint_as_float(w.z << 16) + __uint_as_float(g.z << 16), __uint_as_float(w.z & 0xFFFF0000u) + __uint_as_float(g.z & 0xFFFF0000u));
            w.w = cvtpk(__uint_as_float(w.w << 16) + __uint_as_float(g.w << 16), __uint_as_float(w.w & 0xFFFF0000u) + __uint_as_float(g.w & 0xFFFF0000u));
        }
        *gp = w;
    }
}

struct Src { const bf16_t* K; const bf16_t* V; int stride; };

template <int MODE>
__device__ __forceinline__ void branch(const Src s, char* lds, const bf16x8* qr, f32x16* o, float& m, float& l, int NTL, int jbase, int t, int qb, int wid, int lane, int tid,
                                       const unsigned (&selw)[4], float inv_l) {
    const int r32 = lane & 31, hi = lane >> 5, rh = wid >> 1, iq = (wid & 1) * 32 + r32;
    char* V_lds = lds + L_V; char* K_lds = lds + L_K;
    float* al_l = (float*)(lds + L_WS) + wid * 64 + 32;
    const float* lut = (const float*)(lds + L_LUT) + rh * 128;
    const int* tl = (const int*)(lds + L_TL);
    float* impL = (float*)(lds + L_IMP);
    const int vb0 = (int)(uintptr_t)V_lds + v_rd_base(lane);
    const float cb = lut[127];
    constexpr bool HASV = MODE != 0;
    LAS unsigned char* ldsl = (LAS unsigned char*)lds;
#define TILE_OF(n) (MODE == 2 ? tl[n] : jbase + (n))
#define DMA(j, bf) do { const bf16_t* kt_ = s.K + (size_t)(j) * 64 * s.stride; const bf16_t* vt_ = s.V + (size_t)(j) * 64 * s.stride; \
        int ln_ = lane; asm volatile("" : "+v"(ln_));        \
        _Pragma("unroll") for (int i_ = 0; i_ < 2; ++i_) { \
            const int row_ = i_ * 32 + wid * 4 + (ln_ >> 4), srcch_ = (ln_ & 15) ^ (row_ & 7); \
            __builtin_amdgcn_global_load_lds((const unsigned*)(kt_ + (row_ * s.stride + srcch_ * 8)), (LAS unsigned*)(ldsl + L_K + (bf) * SHM_K + i_ * 8192 + wid * 1024), 16, 0, 0); \
            if (HASV) { const int kk_ = (i_ * 4 + (wid >> 1)) * 8 + ((ln_ & 31) >> 2), k_ = (kk_ & ~0xC) | ((kk_ & 4) << 1) | ((kk_ & 8) >> 1), cc_ = ((wid & 1) * 2 + (ln_ >> 5)) * 32 + (ln_ & 3) * 8; \
                __builtin_amdgcn_global_load_lds((const unsigned*)(vt_ + (k_ * s.stride + cc_)), (LAS unsigned*)(ldsl + L_V + (bf) * SHM_V + i_ * 8192 + wid * 1024), 16, 0, 0); } } } while (0)
#define COMPUTE(n, BF) do { const int j_ = TILE_OF(n); \
        bool act_ = true; bool rowsel_ = true; \
        if (MODE == 2) { const unsigned w_ = j_ < 32 ? selw[0] : j_ < 64 ? selw[1] : j_ < 96 ? selw[2] : selw[3]; rowsel_ = (w_ >> (j_ & 31)) & 1u; act_ = __any(rowsel_); } \
        if (act_) { f32x16 p0, p1; \
            qkt<BF>(p0, p1, K_lds, r32, hi, qr); \
              \
            const bool plain_ = MODE >= 2 && (qb - j_ > 2) && !(MODE == 3 && j_ == qb - 8); \
            float sc_ = C2, cb_ = cb; bool sel_ = rowsel_; \
            if (!plain_) { sc_ = 1.f; cb_ = 0.f; sel_ = true; \
                if (MODE <= 1) { \
                    if (64 * j_ + 63 >= 4 * qb - 10) bias_near<16>(p0, p1, t - 31 - 16 * (64 * j_ + 4 * hi), lut); else bias_const(p0, p1, cb); \
                    if (64 * j_ + 63 > ((64 * qb - 31) >> 4)) mask_tile(p0, p1, ((t - 31) >> 4) - 64 * j_ - 4 * hi, 1u << 30); \
                } else { \
                    bias_near<1>(p0, p1, t - 64 * j_ - 4 * hi, lut); \
                    if (MODE == 2) { if (j_ == qb) mask_tile(p0, p1, t - 64 * j_ - 4 * hi, 1u << 30); \
                        if (!rowsel_) { const float NEG_ = -__builtin_inff(); _Pragma("unroll") for (int r = 0; r < 16; ++r) { p0[r] = NEG_; p1[r] = NEG_; } } } \
                    else { if (j_ == qb || j_ == qb - 8) mask_tile(p0, p1, t - 64 * j_ - 4 * hi, 512u); } \
                } \
            } \
            if (MODE == 1) { \
                _Pragma("unroll") for (int r = 0; r < 16; ++r) { p0[r] = __builtin_amdgcn_exp2f(p0[r] - m) * inv_l; p1[r] = __builtin_amdgcn_exp2f(p1[r] - m) * inv_l; } \
                _Pragma("unroll") for (int a = 0; a < 4; ++a) { \
                    const int jj0 = 16 * j_ + 2 * a + hi, jj1 = jj0 + 8; \
                    atomicAdd(&impL[iq * 128 + jj0], p0[4 * a] + p0[4 * a + 1] + p0[4 * a + 2] + p0[4 * a + 3]); \
                    atomicAdd(&impL[iq * 128 + jj1], p1[4 * a] + p1[4 * a + 1] + p1[4 * a + 2] + p1[4 * a + 3]); \
                    if (jj0 + 1 < 128) atomicAdd(&impL[iq * 128 + jj0 + 1], p0[4 * a + 3]); \
                    if (jj1 + 1 < 128) atomicAdd(&impL[iq * 128 + jj1 + 1], p1[4 * a + 3]); } \
            } else { float alpha_; softmax_online(p0, p1, sc_, cb_, sel_, m, l, alpha_); if (MODE != 0) rescale_o(o, alpha_, al_l, r32, hi); } \
            if (MODE != 0) { bf16x8 pa0, pa1, pa2, pa3; pack_p(p0, p1, pa0, pa1, pa2, pa3); pv_tile<BF>(o, vb0, pa0, pa1, pa2, pa3); } \
        } } while (0)
#define STEP(n, BF) do { \
        if ((n) + 1 < NTL) DMA(TILE_OF((n) + 1), 1 - (BF)); \
        SBAR(); COMPUTE(n, BF); SBAR(); \
        asm volatile("s_waitcnt vmcnt(0)" ::: "memory"); \
        __syncthreads(); } while (0)
    if (NTL > 0) {
        DMA(TILE_OF(0), 0); asm volatile("s_waitcnt vmcnt(0)" ::: "memory");
        __syncthreads();
        for (int n = 0; n < NTL; n += 2) { STEP(n, 0); if (n + 1 < NTL) STEP(n + 1, 1); }
    }
#undef TILE_OF
#undef DMA
#undef COMPUTE
#undef STEP
}

__device__ __forceinline__ void item(unsigned char* ws, int b, int g, int qb, char* lds) {
    const int tid = tid_(), wid = __builtin_amdgcn_readfirstlane(tid >> 6), lane = tid & 63, r32 = lane & 31, hi = lane >> 5, rh = wid >> 1, iq = (wid & 1) * 32 + r32;
    const int t = qb * 64 + iq, head = g * 4 + rh;
    bf16_t* proj = (bf16_t*)(ws + OFF_PROJ);
    const size_t tok0 = (size_t)b * T_;
    float* impL = (float*)(lds + L_IMP); unsigned* selL = (unsigned*)(lds + L_SEL); unsigned* uniL = (unsigned*)(lds + L_UNI); int* tl = (int*)(lds + L_TL);
    for (int i = tid; i < 64 * 128; i += 512) impL[i] = 0.f;
    if (tid < 4) uniL[tid] = 0u;
    { const float* lutg = (const float*)(ws + OFF_LUT) + (g * 4) * 128; ((float*)(lds + L_LUT))[tid] = lutg[tid] * LOG2E; }
    bf16x8 qr[8];
    { const bf16_t* qp = proj + (tok0 + t) * LDP + C_NQ + head * 128 + hi * 8;
#pragma unroll
      for (int d0 = 0; d0 < 8; ++d0) qr[d0] = *(const bf16x8*)(qp + d0 * 16); }
    unsigned selw[4] = {0u, 0u, 0u, 0u};
    f32x16 o[4];
    __syncthreads();
    {
        const Src s{(const bf16_t*)(ws + OFF_KCMP) + (size_t)(b * 2 + g) * 512 * 128, (const bf16_t*)(ws + OFF_VCMP) + (size_t)(b * 2 + g) * 512 * 128, 128};
        const int nct = ((4 * qb + 2) >> 6) + 1;
        float m = -1e30f, l = 0.f;
        branch<0>(s, lds, qr, o, m, l, nct, 0, t, qb, wid, lane, tid, selw, 0.f);
#pragma unroll
        for (int d = 0; d < 4; ++d) o[d] = f32x16{};
        const float inv_l = l > 0.f ? 1.f / l : 0.f;
        branch<1>(s, lds, qr, o, m, l, nct, 0, t, qb, wid, lane, tid, selw, inv_l);
        flush_out(o, 1.f, 0, ws, lds, b, g, qb, wid, lane, true);
    }
    __syncthreads();
    {
        const int q = wid * 8 + (lane >> 3), sub = lane & 7;
        unsigned m0 = 0u, m1 = 0u, m2 = 0u, m3 = 0u;
        if (qb <= 15) { m0 = qb == 31 ? 0xFFFFFFFFu : ((1u << (qb + 1)) - 1u); }
        else {
            unsigned key[16];
#pragma unroll
            for (int k = 0; k < 16; ++k) { const int j = sub * 16 + k; key[k] = (j >= 1 && j <= qb - 2) ? ((__float_as_uint(impL[q * 128 + j]) & ~0x7Fu) | (unsigned)(127 - j)) : 0u; }
            for (int it = 0; it < 13; ++it) {
                unsigned lm = key[0];
#pragma unroll
                for (int k = 1; k < 16; ++k) lm = lm > key[k] ? lm : key[k];
                unsigned gm = lm, x;
                x = (unsigned)__builtin_amdgcn_update_dpp(0, (int)gm, 0xB1, 0xF, 0xF, true); gm = gm > x ? gm : x;
                x = (unsigned)__builtin_amdgcn_update_dpp(0, (int)gm, 0x4E, 0xF, 0xF, true); gm = gm > x ? gm : x;
                x = (unsigned)__builtin_amdgcn_update_dpp(0, (int)gm, 0x141, 0xF, 0xF, true); gm = gm > x ? gm : x;
#pragma unroll
                for (int k = 0; k < 16; ++k) key[k] = key[k] == gm ? 0u : key[k];
                const int j = 127 - (int)(gm & 0x7Fu);
                const unsigned bit = 1u << (j & 31);
                m0 |= j < 32 ? bit : 0u; m1 |= (j >= 32 && j < 64) ? bit : 0u; m2 |= (j >= 64 && j < 96) ? bit : 0u; m3 |= j >= 96 ? bit : 0u;
            }
            m0 |= 1u;
            { const int j = qb; const unsigned bit = 1u << (j & 31); m0 |= j < 32 ? bit : 0u; m1 |= (j >= 32 && j < 64) ? bit : 0u; m2 |= (j >= 64 && j < 96) ? bit : 0u; m3 |= j >= 96 ? bit : 0u; }
            { const int j = qb - 1; const unsigned bit = 1u << (j & 31); m0 |= j < 32 ? bit : 0u; m1 |= (j >= 32 && j < 64) ? bit : 0u; m2 |= (j >= 64 && j < 96) ? bit : 0u; m3 |= j >= 96 ? bit : 0u; }
        }
        if (sub == 0) { selL[q * 4 + 0] = m0; selL[q * 4 + 1] = m1; selL[q * 4 + 2] = m2; selL[q * 4 + 3] = m3;
                        atomicOr(&uniL[0], m0); atomicOr(&uniL[1], m1); atomicOr(&uniL[2], m2); atomicOr(&uniL[3], m3); }
    }
    __syncthreads();
    int nsl = 0;
    {
        if (wid == 0) {
            const bool s0 = lane <= qb && ((uniL[lane >> 5] >> (lane & 31)) & 1u), s1 = lane + 64 <= qb && ((uniL[2 + (lane >> 5)] >> (lane & 31)) & 1u);
            const unsigned long long b0 = __ballot(s0), b1 = __ballot(s1), below = (1ull << lane) - 1ull;
            const int n0 = __popcll(b0);
            if (s0) tl[__popcll(b0 & below)] = lane;
            if (s1) tl[n0 + __popcll(b1 & below)] = lane + 64;
            if (lane == 0) tl[128] = n0 + __popcll(b1);
        }
        selw[0] = selL[iq * 4 + 0]; selw[1] = selL[iq * 4 + 1]; selw[2] = selL[iq * 4 + 2]; selw[3] = selL[iq * 4 + 3];
        __syncthreads();
        nsl = tl[128];
    }
    {
        const Src s{proj + tok0 * LDP + C_KS + g * 128, proj + tok0 * LDP + C_VS + g * 128, LDP};
        float m = -1e30f, l = 0.f;
#pragma unroll
        for (int d = 0; d < 4; ++d) o[d] = f32x16{};
        branch<2>(s, lds, qr, o, m, l, nsl, 0, t, qb, wid, lane, tid, selw, 0.f);
        flush_out(o, l, 1, ws, lds, b, g, qb, wid, lane, false);
    }
    __syncthreads();
    {
        const Src s{proj + tok0 * LDP + C_KW + g * 128, proj + tok0 * LDP + C_VW + g * 128, LDP};
        const int jlo = qb >= 8 ? qb - 8 : 0;
        float m = -1e30f, l = 0.f;
#pragma unroll
        for (int d = 0; d < 4; ++d) o[d] = f32x16{};
        branch<3>(s, lds, qr, o, m, l, qb - jlo + 1, jlo, t, qb, wid, lane, tid, selw, 0.f);
        flush_out(o, l, 2, ws, lds, b, g, qb, wid, lane, false);
    }
    __syncthreads();
}
#undef KSWZ
#undef SBAR
}

__device__ void ph_hpre(const Params& p, int u) {
    const int tid = tid_(), b = u >> 8, n = u & 255, c2 = tid * 2;
    char* proj = (char*)(p.ws + OFF_PROJ) + (size_t)(b * T_ + n * 32) * (LDP * 2);
    const unsigned vo = (unsigned)c2 * 2u;
    const float* lb = (const float*)(p.ws + OFF_LB);
    const float kb0 = 1.f - lb[c2], kb1 = 1.f - lb[c2 + 1];
    float b0[32], b1[32];
    unsigned wf[32], wq[32];
#pragma unroll
    for (int i = 0; i < 32; ++i) wf[i] = *(const unsigned*)(proj + ((size_t)i * (LDP * 2) + C_HF * 2) + vo);
#pragma unroll
    for (int i = 0; i < 32; ++i) wq[i] = *(const unsigned*)(proj + ((size_t)i * (LDP * 2) + C_HQ * 2) + vo);
    float s0 = 1.f, s1 = 1.f;
#pragma unroll
    for (int i = 0; i < 32; ++i) {
        const float r0 = __uint_as_float(wf[i] << 16), r1 = __uint_as_float(wf[i] & 0xFFFF0000u);
        const float k0 = kb0 * sigmoidf_(-r0), k1 = kb1 * sigmoidf_(-r1);
        s0 *= 1.f - k0; s1 *= 1.f - k1;
        b0[i] = s0; b1[i] = s1;
        wf[i] = pg8::cvt_pk_bf16(k0, k1);
    }
    const float il0 = __builtin_amdgcn_rcpf(fmaxf(s0, 1e-30f)), il1 = __builtin_amdgcn_rcpf(fmaxf(s1, 1e-30f));
#pragma unroll
    for (int i = 0; i < 32; ++i) {
        const float k0 = __uint_as_float(wf[i] << 16), k1 = __uint_as_float(wf[i] & 0xFFFF0000u);
        const float q0 = __uint_as_float(wq[i] << 16), q1 = __uint_as_float(wq[i] & 0xFFFF0000u);
        const float e0 = s0 * __builtin_amdgcn_rcpf(fmaxf(b0[i], 1e-30f)), e1 = s1 * __builtin_amdgcn_rcpf(fmaxf(b1[i], 1e-30f));
        unsigned long long ro = (unsigned long long)i * (LDP * 2); asm volatile("" : "+s"(ro));
        char* rp = proj + ro + vo;
        *(unsigned*)(rp + C_HQ * 2) = pg8::cvt_pk_bf16(q0 * (b0[i] * il0), q1 * (b1[i] * il1));
        *(unsigned*)(rp + C_HF * 2) = pg8::cvt_pk_bf16(k0 * e0, k1 * e1);
    }
    float* dec = (float*)(p.ws + OFF_DEC) + ((size_t)((b * 8 + (c2 >> 7)) * 256 + n)) * 256 + (c2 & 127);
    dec[0] = s0; dec[1] = s1;
}

namespace hg {
typedef short bf16x8 __attribute__((ext_vector_type(8)));
typedef short s16x4 __attribute__((ext_vector_type(4)));
typedef float f32x4 __attribute__((ext_vector_type(4)));
typedef unsigned u32x4 __attribute__((ext_vector_type(4)));
constexpr int BUF = 25600, L_QA = 0, L_KE = 8192, L_VV = 16384, L_DEC = 24576, L_OB = 51200, OBS = 132;
__device__ __forceinline__ unsigned off_b(unsigned row, unsigned ch) { return 256u * row + 16u * (ch ^ (((row & 3) << 2) | ((row >> 2) & 3))); }
__device__ __forceinline__ unsigned tr_addr16(unsigned lane, unsigned c, unsigned t) {
    const unsigned g = lane >> 4, q = (lane & 15) >> 2, pp = lane & 3;
    return off_b(8 * g + 4 * t + q, 2 * c + (pp >> 1)) + 8 * (pp & 1);
}
__device__ __forceinline__ unsigned cvtpk(float lo, float hi) { unsigned r; asm volatile("v_cvt_pk_bf16_f32 %0, %1, %2" : "=v"(r) : "v"(lo), "v"(hi)); return r; }
__device__ __forceinline__ bf16x8 pack8(f32x4 a, f32x4 b) { u32x4 w = {cvtpk(a[0], a[1]), cvtpk(a[2], a[3]), cvtpk(b[0], b[1]), cvtpk(b[2], b[3])}; return *reinterpret_cast<bf16x8*>(&w); }
__device__ __forceinline__ s16x4 tr_read(unsigned addr) { s16x4 r; asm volatile("ds_read_b64_tr_b16 %0, %1" : "=v"(r) : "v"(addr) : "memory"); return r; }

__device__ __forceinline__ void item(unsigned char* ws, const float* norm_w, int b, int h, char* lds) {
    const int tid = tid_(), wid = __builtin_amdgcn_readfirstlane(tid >> 6), lane = tid & 63, l15 = lane & 15, g = lane >> 4;
    bf16_t* proj = (bf16_t*)(ws + OFF_PROJ) + (size_t)b * T_ * LDP + h * 128;
    const float* decg = (const float*)(ws + OFF_DEC) + (size_t)(b * 8 + h) * 256 * 256;
    LAS unsigned char* ldsl = (LAS unsigned char*)lds;
    const unsigned ldsb = (unsigned)(uintptr_t)lds;
    const int drow = 4 * wid + (lane >> 4);
    const unsigned dsrc = (unsigned)(drow * LDP + (((lane & 15) ^ (((drow & 3) << 2) | ((drow >> 2) & 3))) * 8));
#define HDMA(n, bf) do { const bf16_t* cp_ = proj + (size_t)(n) * 32 * LDP + dsrc; \
        __builtin_amdgcn_global_load_lds((const unsigned*)(cp_ + C_HQ), (LAS unsigned*)(ldsl + (bf) * BUF + L_QA + wid * 1024), 16, 0, 0); \
        __builtin_amdgcn_global_load_lds((const unsigned*)(cp_ + C_HF), (LAS unsigned*)(ldsl + (bf) * BUF + L_KE + wid * 1024), 16, 0, 0); \
        __builtin_amdgcn_global_load_lds((const unsigned*)(cp_ + C_HI), (LAS unsigned*)(ldsl + (bf) * BUF + L_VV + wid * 1024), 16, 0, 0); \
        if (wid == 0) __builtin_amdgcn_global_load_lds((const unsigned*)(decg + (size_t)(n) * 256 + lane * 4), (LAS unsigned*)(ldsl + (bf) * BUF + L_DEC), 16, 0, 0); } while (0)
    unsigned a_ke[2], a_qa[2], a_qp[2], a_vt[2];
#pragma unroll
    for (int x = 0; x < 2; ++x) {
        a_ke[x] = off_b(8 * (l15 >> 2) + 4 * x + (l15 & 3), g);
        a_qa[x] = off_b(16 * x + l15, g);
        a_qp[x] = off_b(16 * x + l15, g >> 1) + 8 * (g & 1);
        a_vt[x] = tr_addr16(lane, wid, x);
    }
    const int ntok = tid >> 4, ndv = (tid & 15) * 8;
    f32x4 S[8];
#pragma unroll
    for (int i = 0; i < 8; ++i) S[i] = (f32x4){0.f, 0.f, 0.f, 0.f};
    float* obuf = (float*)(lds + L_OB);
    HDMA(0, 0); asm volatile("s_waitcnt vmcnt(0)" ::: "memory");
    __syncthreads();
    for (int n = 0; n < 256; ++n) {
        const int bf = n & 1;
        if (n + 1 < 256) HDMA(n + 1, bf ^ 1);
        const u32x4 hgw = *(const u32x4*)(proj + (size_t)(n * 32 + ntok) * LDP + C_HG + ndv);
        const unsigned B0 = ldsb + bf * BUF;
        f32x4 att[2][2];
#pragma unroll
        for (int x = 0; x < 2; ++x)
#pragma unroll
            for (int y = 0; y < 2; ++y) att[x][y] = (f32x4){0.f, 0.f, 0.f, 0.f};
#pragma unroll
        for (int ks = 0; ks < 4; ++ks) {
            bf16x8 ka[2], qb[2];
#pragma unroll
            for (int x = 0; x < 2; ++x) {
                const unsigned rj = 8 * (l15 >> 2) + 4 * x + (l15 & 3), ri = 16 * x + l15;
                ka[x] = *(const LAS bf16x8*)(uintptr_t)(B0 + L_KE + off_b(rj, 4 * ks + g));
                qb[x] = *(const LAS bf16x8*)(uintptr_t)(B0 + L_QA + off_b(ri, 4 * ks + g));
            }
#pragma unroll
            for (int x = 0; x < 2; ++x)
#pragma unroll
                for (int y = 0; y < 2; ++y) att[x][y] = __builtin_amdgcn_mfma_f32_16x16x32_bf16(ka[x], qb[y], att[x][y], 0, 0, 0);
        }
        bf16x8 attf[2];
#pragma unroll
        for (int y = 0; y < 2; ++y) {
            const int i = 16 * y + l15;
            f32x4 a0 = att[0][y], a1 = att[1][y];
#pragma unroll
            for (int r = 0; r < 4; ++r) { if (8 * g + r > i) a0[r] = 0.f; if (8 * g + 4 + r > i) a1[r] = 0.f; }
            attf[y] = pack8(a0, a1);
        }
        bf16x8 vf;
        { const s16x4 v0 = tr_read(B0 + L_VV + a_vt[0]), v1 = tr_read(B0 + L_VV + a_vt[1]);
          asm volatile("s_waitcnt lgkmcnt(0)" ::: "memory");
          vf = (bf16x8){v0[0], v0[1], v0[2], v0[3], v1[0], v1[1], v1[2], v1[3]}; }
        f32x4 o[2];
#pragma unroll
        for (int y = 0; y < 2; ++y) o[y] = __builtin_amdgcn_mfma_f32_16x16x32_bf16(vf, attf[y], (f32x4){0.f, 0.f, 0.f, 0.f}, 0, 0, 0);
#pragma unroll
        for (int dt = 0; dt < 8; ++dt) { const f32x4 d = *(const LAS f32x4*)(uintptr_t)(B0 + L_DEC + (16 * dt + 4 * g) * 4); S[dt] *= d; }
#pragma unroll
        for (int ks = 0; ks < 4; ++ks) {
            const bf16x8 sa = pack8(S[2 * ks], S[2 * ks + 1]);
#pragma unroll
            for (int y = 0; y < 2; ++y) {
                const unsigned ri = 16 * y + l15;
                const unsigned long long q0 = *(const LAS unsigned long long*)(uintptr_t)(B0 + L_QA + off_b(ri, 4 * ks + (g >> 1)) + 8 * (g & 1));
                const unsigned long long q1 = *(const LAS unsigned long long*)(uintptr_t)(B0 + L_QA + off_b(ri, 4 * ks + 2 + (g >> 1)) + 8 * (g & 1));
                u32x4 w = {(unsigned)q0, (unsigned)(q0 >> 32), (unsigned)q1, (unsigned)(q1 >> 32)};
                o[y] = __builtin_amdgcn_mfma_f32_16x16x32_bf16(sa, *reinterpret_cast<bf16x8*>(&w), o[y], 0, 0, 0);
            }
        }
#pragma unroll
        for (int dt = 0; dt < 8; ++dt) {
            const s16x4 k0 = tr_read(B0 + L_KE + tr_addr16(lane, dt, 0)), k1 = tr_read(B0 + L_KE + tr_addr16(lane, dt, 1));
            asm volatile("s_waitcnt lgkmcnt(0)" ::: "memory");
            const bf16x8 kf = (bf16x8){k0[0], k0[1], k0[2], k0[3], k1[0], k1[1], k1[2], k1[3]};
            S[dt] = __builtin_amdgcn_mfma_f32_16x16x32_bf16(kf, vf, S[dt], 0, 0, 0);
        }
#pragma unroll
        for (int y = 0; y < 2; ++y) *(f32x4*)(obuf + (16 * y + l15) * OBS + 16 * wid + 4 * g) = o[y];
        __syncthreads();
        {
            const f32x4 x0 = *(const f32x4*)(obuf + ntok * OBS + ndv), x1 = *(const f32x4*)(obuf + ntok * OBS + ndv + 4);
            float ss = x0[0] * x0[0] + x0[1] * x0[1] + x0[2] * x0[2] + x0[3] * x0[3] + x1[0] * x1[0] + x1[1] * x1[1] + x1[2] * x1[2] + x1[3] * x1[3];
            ss += __shfl_xor(ss, 1); ss += __shfl_xor(ss, 2); ss += __shfl_xor(ss, 4); ss += __shfl_xor(ss, 8);
            const float r = rsqrtf(ss * (1.f / 128.f) + 1e-6f);
            const float gv[8] = {__uint_as_float(hgw.x << 16), __uint_as_float(hgw.x & 0xFFFF0000u), __uint_as_float(hgw.y << 16), __uint_as_float(hgw.y & 0xFFFF0000u),
                                 __uint_as_float(hgw.z << 16), __uint_as_float(hgw.z & 0xFFFF0000u), __uint_as_float(hgw.w << 16), __uint_as_float(hgw.w & 0xFFFF0000u)};
            const float xv[8] = {x0[0], x0[1], x0[2], x0[3], x1[0], x1[1], x1[2], x1[3]};
            const f32x4 n0 = *(const f32x4*)(norm_w + h * 128 + ndv), n1 = *(const f32x4*)(norm_w + h * 128 + ndv + 4);
            const float nw[8] = {n0[0], n0[1], n0[2], n0[3], n1[0], n1[1], n1[2], n1[3]};
            float ov[8];
#pragma unroll
            for (int i = 0; i < 8; ++i) ov[i] = xv[i] * r * nw[i] * sigmoidf_(gv[i]);
            u32x4 w = {cvtpk(ov[0], ov[1]), cvtpk(ov[2], ov[3]), cvtpk(ov[4], ov[5]), cvtpk(ov[6], ov[7])};
            *(u32x4*)(proj + (size_t)(n * 32 + ntok) * LDP + C_HI + ndv) = w;
        }
        asm volatile("s_waitcnt vmcnt(0)" ::: "memory");
        __syncthreads();
    }
#undef HDMA
    (void)a_ke; (void)a_qa; (void)a_qp;
}
}

__device__ void cvt_tile(float* sm, const float* src, int ldsrc, int k0, int ns0, int nvalid, bf16_t* dst, int lddst, int nd0) {
    float(*t)[65] = (float(*)[65])sm;
    const int tid = tid_();
    float4 v[8];
#pragma unroll
    for (int r = 0; r < 8; ++r) {
        const int idx = tid + r * 512, k = idx >> 4, n4 = (idx & 15) * 4;
        v[r] = n4 < nvalid ? *(const float4*)(src + (size_t)(k0 + k) * ldsrc + ns0 + n4) : make_float4(0.f, 0.f, 0.f, 0.f);
    }
#pragma unroll
    for (int r = 0; r < 8; ++r) {
        const int idx = tid + r * 512, k = idx >> 4, n4 = (idx & 15) * 4;
        t[k][n4] = v[r].x; t[k][n4 + 1] = v[r].y; t[k][n4 + 2] = v[r].z; t[k][n4 + 3] = v[r].w;
    }
    __syncthreads();
#pragma unroll
    for (int r = 0; r < 4; ++r) {
        const int idx = tid + r * 512, kg = idx & 31, n = idx >> 5;
        uint4 w;
        w.x = (unsigned)f2bf(t[kg * 8 + 0][n]) | ((unsigned)f2bf(t[kg * 8 + 1][n]) << 16); w.y = (unsigned)f2bf(t[kg * 8 + 2][n]) | ((unsigned)f2bf(t[kg * 8 + 3][n]) << 16);
        w.z = (unsigned)f2bf(t[kg * 8 + 4][n]) | ((unsigned)f2bf(t[kg * 8 + 5][n]) << 16); w.w = (unsigned)f2bf(t[kg * 8 + 6][n]) | ((unsigned)f2bf(t[kg * 8 + 7][n]) << 16);
        *(uint4*)(dst + (size_t)(nd0 + n) * lddst + k0 + kg * 8) = w;
    }
    __syncthreads();
}
__device__ __forceinline__ int gemm1_src_col(int nd) { return nd < 6656 ? nd : nd < 8704 ? nd + 24 : nd < 8728 ? 6656 + (nd - 8704) : -1; }
__device__ void ph_cvt_win(const Params& p, int u, float* sm) {
    if (u < 560) {
        const int nt = u >> 2, kt = u & 3, nd0 = nt * 64;
        const int ns0 = nd0 < 6656 ? nd0 : nd0 < 8704 ? nd0 + 24 : 6656, nvalid = nd0 < 8704 ? 64 : nd0 == 8704 ? 24 : 0;
        cvt_tile(sm, p.w_in, DIN, kt * 256, ns0, nvalid, (bf16_t*)(p.ws + OFF_WINT), 1024, nd0);
    } else {
        float* b1 = (float*)(p.ws + OFF_BIAS1);
        for (int i = tid_(); i < N1; i += 512) { const int s = gemm1_src_col(i); b1[i] = s >= 0 ? p.b_in[s] : 0.f; }
    }
}
__device__ void ph_cvt_br(const Params& p, int u, float* sm) {
    const int w = u >> 6, t = u & 63, nt = t >> 2, kt = t & 3;
    if (w < 2) cvt_tile(sm, w == 0 ? p.w_br_hg : p.w_br_nsa, 1024, kt * 256, nt * 64, 64, (bf16_t*)(p.ws + OFF_WBRH) + w * 1024, 2048, nt * 64);
    else cvt_tile(sm, p.w_out, 1024, kt * 256, nt * 64, 64, (bf16_t*)(p.ws + OFF_WOUTT), 1024, nt * 64);
}
__device__ void ph_cvt_exp(const Params& p, int u, float* sm) {
    if (u < 2048) {
        const int e = u >> 6, t = u & 63, nt = t >> 2, kt = t & 3, nd0 = nt * 64, pn = nd0 >> 8, half = (nd0 >> 7) & 1, off = nd0 & 127;
        cvt_tile(sm, (half ? p.e_w3 : p.e_w1) + (size_t)e * 1024 * 512, 512, kt * 256, pn * 128 + off, 64, (bf16_t*)(p.ws + OFF_E13) + (size_t)e * 1024 * 1024, 1024, nd0);
    } else {
        const int v = u - 2048, e = v >> 5, t = v & 31, nt = t >> 1, kt = t & 1;
        cvt_tile(sm, p.e_w2 + (size_t)e * 512 * 1024, 1024, kt * 256, nt * 64, 64, (bf16_t*)(p.ws + OFF_E2T) + (size_t)e * 1024 * 512, 512, nt * 64);
    }
}
enum { PH_PRO = 0, PH_LN0, PH_CMP2, PH_FINAL };
__host__ __device__ constexpr int phase_units(int ph) { return ph == PH_PRO ? 99 : ph == PH_LN0 ? NT / 16 : ph == PH_CMP2 ? 64 : ph == PH_FINAL ? NT / 16 : 0; }

__device__ void ph_pro(const Params& p, int u, float* sm) {
    const int tid = tid_();
    float* mod = (float*)(p.ws + OFF_MOD);
    if (u < 96) {
        float* ca = sm;
        float* red = sm + 4096;
        for (int i = tid; i < 4096; i += 512) ca[i] = siluf_(p.c[i]);
        __syncthreads();
        const int col = u * 64 + (tid & 63), kg = tid >> 6;
        float a0 = 0.f, a1 = 0.f, a2 = 0.f, a3 = 0.f;
        for (int k = kg * 128; k < kg * 128 + 128; ++k) {
            const float w = p.ada_w[(size_t)k * 6144 + col];
            a0 = fmaf(ca[k], w, a0); a1 = fmaf(ca[1024 + k], w, a1); a2 = fmaf(ca[2048 + k], w, a2); a3 = fmaf(ca[3072 + k], w, a3);
        }
        red[(kg * 64 + (tid & 63)) * 4 + 0] = a0; red[(kg * 64 + (tid & 63)) * 4 + 1] = a1; red[(kg * 64 + (tid & 63)) * 4 + 2] = a2; red[(kg * 64 + (tid & 63)) * 4 + 3] = a3;
        __syncthreads();
        if (tid < 256) {
            const int cl = tid & 63, b = tid >> 6;
            float s = 0.f;
            for (int g = 0; g < 8; ++g) s += red[(g * 64 + cl) * 4 + b];
            mod[b * 6144 + u * 64 + cl] = s + p.ada_b[u * 64 + cl];
        }
        __syncthreads();
    } else if (u == 96) {
        float* lb = (float*)(p.ws + OFF_LB);
        float* lut = (float*)(p.ws + OFF_LUT);
        unsigned* cnt = (unsigned*)(p.ws + OFF_CNT);
        for (int i = tid; i < 1024; i += 512) {
            const float l0 = p.lb_logits[i], l1 = p.lb_logits[1024 + i];
            lb[i] = 1.f / (1.f + __expf(l1 - l0));
            const int h = i >> 7, d = i & 127;
            lut[i] = p.rel_bias[h * 32 + rel_bucket(d)];
        }
        if (tid < 64) cnt[tid] = 0u;
        if (tid < 8) ((unsigned*)(p.ws + OFF_QCTR))[tid * 64] = 0u;
        { bf16_t* kc = (bf16_t*)(p.ws + OFF_KCMP); bf16_t* vc = (bf16_t*)(p.ws + OFF_VCMP);
          for (int i = tid; i < 8 * 128; i += 512) { kc[(size_t)((i >> 7) * 512 + 511) * 128 + (i & 127)] = 0; vc[(size_t)((i >> 7) * 512 + 511) * 128 + (i & 127)] = 0; } }
    } else {
        const int kv = u - 97;
        float* cb = (float*)(p.ws + OFF_CB) + kv * 128;
        if (tid < 128) cb[tid] = (kv ? p.b1_v : p.b1_k)[tid];
    }
}
__device__ void ph_cmpconst(const Params& p, int u, float* sm) {
    const int tid = tid_(), kv = u >> 5, kc = u & 31;
    const float* pos = kv ? p.pos_v : p.pos_k; const float* w1 = kv ? p.w1_v : p.w1_k;
    const int n = tid & 127, kg = tid >> 7;
    float s = 0.f;
#pragma unroll 8
    for (int k = kc * 128 + kg * 32; k < kc * 128 + kg * 32 + 32; ++k) s = fmaf(pos[k], w1[(size_t)k * 128 + n], s);
    sm[kg * 128 + n] = s;
    __syncthreads();
    if (tid < 128) atomicAdd((float*)(p.ws + OFF_CB) + kv * 128 + tid, sm[tid] + sm[128 + tid] + sm[256 + tid] + sm[384 + tid]);
    __syncthreads();
}

__device__ void ph_ln0(const Params& p, int u) {
    const int tidx = tid_(), lane = tidx & 63;
    float4 v[2][4]; float s[2] = {0.f, 0.f}; int rowi[2];
#pragma unroll
    for (int k = 0; k < 2; ++k) {
        rowi[k] = (u + k * (NT / 16)) * 8 + (tidx >> 6);
        const float* xr = p.x + (size_t)rowi[k] * D_;
#pragma unroll
        for (int i = 0; i < 4; ++i) { v[k][i] = *(const float4*)(xr + (i * 64 + lane) * 4); s[k] += v[k][i].x + v[k][i].y + v[k][i].z + v[k][i].w; }
    }
#pragma unroll
    for (int k = 0; k < 2; ++k) {
        const float* mod = (const float*)(p.ws + OFF_MOD) + (rowi[k] / T_) * 6144;
        bf16_t* h = (bf16_t*)(p.ws + OFF_H) + (size_t)rowi[k] * D_;
        const float mu = wsum(s[k]) * (1.f / 1024.f);
        float q = 0.f;
#pragma unroll
        for (int i = 0; i < 4; ++i) { v[k][i].x -= mu; v[k][i].y -= mu; v[k][i].z -= mu; v[k][i].w -= mu; q += v[k][i].x * v[k][i].x + v[k][i].y * v[k][i].y + v[k][i].z * v[k][i].z + v[k][i].w * v[k][i].w; }
        const float rs = rsqrtf(wsum(q) * (1.f / 1024.f) + 1e-5f);
#pragma unroll
        for (int i = 0; i < 4; ++i) {
            const int c = (i * 64 + lane) * 4;
            const float4 sh = *(const float4*)(mod + c), sc = *(const float4*)(mod + 1024 + c);
            st_bf4(h + c, v[k][i].x * rs * (1.f + sc.x) + sh.x, v[k][i].y * rs * (1.f + sc.y) + sh.y, v[k][i].z * rs * (1.f + sc.z) + sh.z, v[k][i].w * rs * (1.f + sc.w) + sh.w);
        }
    }
}

__device__ void ph_cmp2(const Params& p, int u, float* sm) {
    const int tid = tid_(), kv = u >> 5, m0 = (u & 31) * 128;
    const float* w2 = kv ? p.w2_v : p.w2_k;
    const float* hid = (const float*)(p.ws + OFF_HID) + (size_t)kv * 4096 * 128;
    const float* cb = (const float*)(p.ws + OFF_CB) + kv * 128;
    bf16_t* dst = (bf16_t*)(p.ws + (kv ? OFF_VCMP : OFF_KCMP));
    float(*As)[132] = (float(*)[132])sm;
    float(*Bs)[132] = (float(*)[132])(sm + 128 * 132);
    float4 av[8], bv[8];
#pragma unroll
    for (int r = 0; r < 8; ++r) { const int idx = tid + r * 512, row = idx >> 5, k4 = (idx & 31) * 4; av[r] = *(const float4*)(hid + (size_t)(m0 + row) * 128 + k4); bv[r] = *(const float4*)(w2 + (size_t)row * 128 + k4); }
#pragma unroll
    for (int r = 0; r < 8; ++r) { const int idx = tid + r * 512, row = idx >> 5, k4 = (idx & 31) * 4;
        const float4 c4 = *(const float4*)(cb + k4);
        As[k4][row] = siluf_(av[r].x + c4.x); As[k4 + 1][row] = siluf_(av[r].y + c4.y); As[k4 + 2][row] = siluf_(av[r].z + c4.z); As[k4 + 3][row] = siluf_(av[r].w + c4.w);
        *(float4*)&Bs[row][k4] = bv[r]; }
    __syncthreads();
    const int tx = tid & 31, ty = tid >> 5;
    float acc[8][4];
#pragma unroll
    for (int i = 0; i < 8; ++i)
#pragma unroll
        for (int j = 0; j < 4; ++j) acc[i][j] = 0.f;
#pragma unroll 8
    for (int k = 0; k < 128; ++k) {
        const float4 a0 = *(const float4*)&As[k][ty * 8], a1 = *(const float4*)&As[k][ty * 8 + 4], bb = *(const float4*)&Bs[k][tx * 4];
        const float a_[8] = {a0.x, a0.y, a0.z, a0.w, a1.x, a1.y, a1.z, a1.w};
        const float b_[4] = {bb.x, bb.y, bb.z, bb.w};
#pragma unroll
        for (int i = 0; i < 8; ++i)
#pragma unroll
            for (int j = 0; j < 4; ++j) acc[i][j] = fmaf(a_[i], b_[j], acc[i][j]);
    }
#pragma unroll
    for (int i = 0; i < 8; ++i) {
        const int m = m0 + ty * 8 + i;
        const bool dead = (m & 511) == 511;
        st_bf4(dst + (size_t)m * 128 + tx * 4, dead ? 0.f : acc[i][0], dead ? 0.f : acc[i][1], dead ? 0.f : acc[i][2], dead ? 0.f : acc[i][3]);
    }
    __syncthreads();
}

struct Ln1rArgs { unsigned char* ws; const float *ln1_g, *ln1_b, *rg_b, *re_b; float* wl; };
__device__ __noinline__ void ph_ln1r_(const Ln1rArgs p, int u) {
    const int tidx = tid_(), lane = tidx & 63, row = u * 8 + (tidx >> 6), b = row / T_;
    float* zr = (float*)(p.ws + OFF_Z) + (size_t)row * D_;
    const float* mod = (const float*)(p.ws + OFF_MOD) + b * 6144;
    bf16_t* h2 = (bf16_t*)(p.ws + OFF_H) + (size_t)row * D_;
    float v[16]; float s = 0.f;
#pragma unroll
    for (int i = 0; i < 4; ++i) { const float4 a = *(const float4*)(zr + (i * 64 + lane) * 4); v[i * 4] = a.x; v[i * 4 + 1] = a.y; v[i * 4 + 2] = a.z; v[i * 4 + 3] = a.w; s += a.x + a.y + a.z + a.w; }
    float mu = wsum(s) * (1.f / 1024.f), q = 0.f;
#pragma unroll
    for (int i = 0; i < 16; ++i) { v[i] -= mu; q = fmaf(v[i], v[i], q); }
    float rs = rsqrtf(wsum(q) * (1.f / 1024.f) + 1e-5f);
    s = 0.f;
#pragma unroll
    for (int i = 0; i < 4; ++i) {
        const int c = (i * 64 + lane) * 4;
        const float4 gg = *(const float4*)(p.ln1_g + c), bb = *(const float4*)(p.ln1_b + c);
        v[i * 4] = v[i * 4] * rs * gg.x + bb.x; v[i * 4 + 1] = v[i * 4 + 1] * rs * gg.y + bb.y; v[i * 4 + 2] = v[i * 4 + 2] * rs * gg.z + bb.z; v[i * 4 + 3] = v[i * 4 + 3] * rs * gg.w + bb.w;
        *(float4*)(zr + c) = make_float4(v[i * 4], v[i * 4 + 1], v[i * 4 + 2], v[i * 4 + 3]);
        s += v[i * 4] + v[i * 4 + 1] + v[i * 4 + 2] + v[i * 4 + 3];
    }
    mu = wsum(s) * (1.f / 1024.f); q = 0.f;
#pragma unroll
    for (int i = 0; i < 16; ++i) { v[i] -= mu; q = fmaf(v[i], v[i], q); }
    rs = rsqrtf(wsum(q) * (1.f / 1024.f) + 1e-5f);
#pragma unroll
    for (int i = 0; i < 4; ++i) {
        const int c = (i * 64 + lane) * 4;
        const float4 sh = *(const float4*)(mod + 3072 + c), sc = *(const float4*)(mod + 4096 + c);
        v[i * 4] = v[i * 4] * rs * (1.f + sc.x) + sh.x; v[i * 4 + 1] = v[i * 4 + 1] * rs * (1.f + sc.y) + sh.y; v[i * 4 + 2] = v[i * 4 + 2] * rs * (1.f + sc.z) + sh.z; v[i * 4 + 3] = v[i * 4 + 3] * rs * (1.f + sc.w) + sh.w;
        st_bf4(h2 + c, v[i * 4], v[i * 4 + 1], v[i * 4 + 2], v[i * 4 + 3]);
    }
    float lg[36];
#pragma unroll
    for (int n = 0; n < 36; ++n) lg[n] = 0.f;
#pragma unroll
    for (int i = 0; i < 16; ++i) {
        const LAS float* wr = (const LAS float*)p.wl + (i * 64 + lane) * 4;
        pg8::f32x4 wa[9];
#pragma unroll
        for (int q = 0; q < 9; ++q) wa[q] = *(const LAS pg8::f32x4*)(wr + q * 4096);
        __builtin_amdgcn_sched_barrier(0);
#pragma unroll
        for (int q = 0; q < 9; ++q) { lg[q * 4] = fmaf(v[i], wa[q][0], lg[q * 4]); lg[q * 4 + 1] = fmaf(v[i], wa[q][1], lg[q * 4 + 1]); lg[q * 4 + 2] = fmaf(v[i], wa[q][2], lg[q * 4 + 2]); lg[q * 4 + 3] = fmaf(v[i], wa[q][3], lg[q * 4 + 3]); }
        __builtin_amdgcn_sched_barrier(0);
    }
    {
        const bool h5 = lane & 32, h4 = lane & 16, h3 = lane & 8, h2_ = lane & 4, h1 = lane & 2, h0 = lane & 1;
        float a18[18], a9[10], a5[6], a3[4], a2[2];
#pragma unroll
        for (int i = 0; i < 18; ++i) { const float keep = h5 ? lg[18 + i] : lg[i], send = h5 ? lg[i] : lg[18 + i]; a18[i] = keep + __shfl_xor(send, 32); }
#pragma unroll
        for (int i = 0; i < 9; ++i) { const float keep = h4 ? a18[9 + i] : a18[i], send = h4 ? a18[i] : a18[9 + i]; a9[i] = keep + __shfl_xor(send, 16); }
        a9[9] = 0.f;
#pragma unroll
        for (int i = 0; i < 5; ++i) { const float keep = h3 ? a9[5 + i] : a9[i], send = h3 ? a9[i] : a9[5 + i]; a5[i] = keep + __shfl_xor(send, 8); }
        a5[5] = 0.f;
#pragma unroll
        for (int i = 0; i < 3; ++i) { const float keep = h2_ ? a5[3 + i] : a5[i], send = h2_ ? a5[i] : a5[3 + i]; a3[i] = keep + __shfl_xor(send, 4); }
        a3[3] = 0.f;
#pragma unroll
        for (int i = 0; i < 2; ++i) { const float keep = h1 ? a3[2 + i] : a3[i], send = h1 ? a3[i] : a3[2 + i]; a2[i] = keep + __shfl_xor(send, 2); }
        const float tot = (h0 ? a2[1] : a2[0]) + __shfl_xor(h0 ? a2[0] : a2[1], 1);
        const int r2 = h0 ? 1 : 0, r3 = (h1 ? 2 : 0) + r2, r5 = (h2_ ? 3 : 0) + r3, r9 = (h3 ? 5 : 0) + r5, r18 = (h4 ? 9 : 0) + r9, r36 = (h5 ? 18 : 0) + r18;
        LAS float* slot = (LAS float*)p.wl + 1024 * 36 + (tidx >> 6) * 64;
        if (r3 < 3 && r5 < 5 && r9 < 9) slot[r36] = tot;
        asm volatile("s_waitcnt lgkmcnt(0)" ::: "memory");
#pragma unroll
        for (int q = 0; q < 9; ++q) { const pg8::f32x4 w4 = *(const LAS pg8::f32x4*)(slot + q * 4); const float4 w = make_float4(w4[0], w4[1], w4[2], w4[3]); lg[q * 4] = w.x; lg[q * 4 + 1] = w.y; lg[q * 4 + 2] = w.z; lg[q * 4 + 3] = w.w; }
    }
    float gl[4];
#pragma unroll
    for (int j = 0; j < 4; ++j) gl[j] = lg[j] + p.rg_b[j];
    int gi = 0; float gm = gl[0];
#pragma unroll
    for (int j = 1; j < 4; ++j) if (gl[j] > gm) { gm = gl[j]; gi = j; }
    float gs = 0.f;
#pragma unroll
    for (int j = 0; j < 4; ++j) gs += __expf(gl[j] - gm);
    const float gp = 1.f / gs;
    float el[8];
#pragma unroll
    for (int i = 0; i < 8; ++i) el[i] = (gi == 0 ? lg[4 + i] : gi == 1 ? lg[12 + i] : gi == 2 ? lg[20 + i] : lg[28 + i]) + p.re_b[gi * 8 + i];
    int i0 = 0; float l0 = el[0];
#pragma unroll
    for (int i = 1; i < 8; ++i) if (el[i] > l0) { l0 = el[i]; i0 = i; }
    int i1 = -1; float l1 = -3.0e38f;
#pragma unroll
    for (int i = 0; i < 8; ++i) if (i != i0 && el[i] > l1) { l1 = el[i]; i1 = i; }
    const float w0 = 1.f / (1.f + __expf(l1 - l0));
    if (lane == 0) {
        unsigned* cnt = (unsigned*)(p.ws + OFF_CNT);
        int* ti = (int*)(p.ws + OFF_TOKI) + (size_t)row * 6;
        const int e0 = gi * 8 + i0, e1 = gi * 8 + i1;
        ti[0] = e0; ti[1] = e1;
        (void)cnt;
        LAS unsigned* lc = (LAS unsigned*)((LAS float*)p.wl + 1024 * 36 + 512);
        ti[2] = (int)__hip_atomic_fetch_add(lc + e0, 1u, __ATOMIC_RELAXED, __HIP_MEMORY_SCOPE_WORKGROUP); ti[3] = (int)__hip_atomic_fetch_add(lc + e1, 1u, __ATOMIC_RELAXED, __HIP_MEMORY_SCOPE_WORKGROUP);
        ((float*)ti)[4] = gp * w0; ((float*)ti)[5] = gp * (1.f - w0);
    }
}

__device__ __forceinline__ int wave_offsets(const unsigned* cnt, int lane, int& pc_out, int& tot) {
    const int c = lane < 32 ? (int)cnt[lane] : 0;
    const int pc = ((c + 255) >> 8) << 8;
    int inc = pc;
    for (int o = 1; o < 64; o <<= 1) { const int t = __shfl_up(inc, o); if (lane >= o) inc += t; }
    tot = __shfl(inc, 63);
    pc_out = pc;
    return inc - pc;
}

__device__ void ph_final(const Params& p, int u) {
    const int tidx = tid_(), lane = tidx & 63;
    float v[2][16]; float s[2] = {0.f, 0.f};
    int rowi[2];
#pragma unroll
    for (int k = 0; k < 2; ++k) {
        const int row = (u + k * (NT / 16)) * 8 + (tidx >> 6), b = row / T_;
        rowi[k] = row;
        const float* x1 = (const float*)(p.ws + OFF_Z) + (size_t)row * D_;
        const float* mod = (const float*)(p.ws + OFF_MOD) + b * 6144 + 5120;
        const int* ti = (const int*)(p.ws + OFF_TOKI) + (size_t)row * 6;
        const int r0 = ti[2], r1 = ti[3]; const float w0 = ((const float*)ti)[4], w1 = ((const float*)ti)[5];
        const bf16_t* y0 = (const bf16_t*)(p.ws + OFF_XPAD) + (size_t)r0 * D_; const bf16_t* y1 = (const bf16_t*)(p.ws + OFF_XPAD) + (size_t)r1 * D_;
#pragma unroll
        for (int i = 0; i < 4; ++i) {
            const int c = (i * 64 + lane) * 4;
            const float4 xv = *(const float4*)(x1 + c), g2 = *(const float4*)(mod + c), a = ld_bf4(y0 + c), bb = ld_bf4(y1 + c);
            v[k][i * 4] = ALPHA * xv.x + (1.f + g2.x) * (w0 * a.x + w1 * bb.x); v[k][i * 4 + 1] = ALPHA * xv.y + (1.f + g2.y) * (w0 * a.y + w1 * bb.y);
            v[k][i * 4 + 2] = ALPHA * xv.z + (1.f + g2.z) * (w0 * a.z + w1 * bb.z); v[k][i * 4 + 3] = ALPHA * xv.w + (1.f + g2.w) * (w0 * a.w + w1 * bb.w);
            s[k] += v[k][i * 4] + v[k][i * 4 + 1] + v[k][i * 4 + 2] + v[k][i * 4 + 3];
        }
    }
#pragma unroll
    for (int k = 0; k < 2; ++k) {
        const float mu = wsum(s[k]) * (1.f / 1024.f); float q = 0.f;
#pragma unroll
        for (int i = 0; i < 16; ++i) { v[k][i] -= mu; q = fmaf(v[k][i], v[k][i], q); }
        const float rs = rsqrtf(wsum(q) * (1.f / 1024.f) + 1e-5f);
#pragma unroll
        for (int i = 0; i < 4; ++i) {
            const int c = (i * 64 + lane) * 4;
            const float4 gg = *(const float4*)(p.ln2_g + c), bb = *(const float4*)(p.ln2_b + c);
            *(float4*)(p.out + (size_t)rowi[k] * D_ + c) = make_float4(v[k][i * 4] * rs * gg.x + bb.x, v[k][i * 4 + 1] * rs * gg.y + bb.y, v[k][i * 4 + 2] * rs * gg.z + bb.z, v[k][i * 4 + 3] * rs * gg.w + bb.w);
        }
    }
}

template <int PH> __device__ __forceinline__ void run_unit(const Params& p, int u, float* sm) {
    if constexpr (PH == PH_PRO) ph_pro(p, u, sm);
    else if constexpr (PH == PH_LN0) ph_ln0(p, u);
    else if constexpr (PH == PH_CMP2) ph_cmp2(p, u, sm);
    else if constexpr (PH == PH_FINAL) ph_final(p, u);
}

constexpr int MEGA_LDS = 153600 + 16;
enum { Q_PRO = 0, Q_LN0, Q_GEMM1, Q_CMP1, Q_CMP2, Q_MIX, Q_MRG, Q_WOUT, Q_LN1R, Q_PAD, Q_EXP1, Q_EXP2, Q_FINAL };
template <int PH> __device__ __forceinline__ void unit_loop(const Params& p, float* sm) {
    for (int u = blockIdx.x; u < phase_units(PH); u += gridDim.x) run_unit<PH>(p, u, sm);
}
template <int Q> __device__ __forceinline__ void run_phase(const Params& p, float* sm) {
    PG8_LAS unsigned char* lds = (PG8_LAS unsigned char*)sm;
    const int G = gridDim.x, c = blockIdx.x;
    if constexpr (Q == Q_PRO) {
        unit_loop<PH_PRO>(p, sm); for (int u = c; u < 561; u += G) ph_cvt_win(p, u, sm);
        for (int u = c; u < 64; u += G) { const int kv = u >> 5, t = u & 31, nt = t >> 4, kt = t & 15;
            cvt_tile(sm, kv ? p.w1_v : p.w1_k, 128, kt * 256, nt * 64, 64, (bf16_t*)(p.ws + OFF_CMPW) + (size_t)kv * 128 * 4096, 4096, nt * 64); }
        { float4* hz = (float4*)(p.ws + OFF_HID); for (int i = c * 512 + threadIdx.x; i < 2 * 4096 * 128 / 4; i += G * 512) hz[i] = make_float4(0.f, 0.f, 0.f, 0.f); }
    }
    else if constexpr (Q == Q_LN0) { for (int u = c; u < 64; u += G) ph_cmpconst(p, u, sm); unit_loop<PH_LN0>(p, sm); }
    else if constexpr (Q == Q_GEMM1) {
        pg8::Gemm g{(const bf16_t*)(p.ws + OFF_H), (const bf16_t*)(p.ws + OFF_WINT), 1024, 1024, 1024};
        pg8::StaticOrder S; S.init(NT, N1, G, c);
        pg8::EpiProj E{(bf16_t*)(p.ws + OFF_PROJ), (bf16_t*)p.out, (float*)(p.ws + OFF_GATE), (const float*)(p.ws + OFF_BIAS1)};
        pg8::gemm_phase(lds, g, S, E);
    }
    else if constexpr (Q == Q_CMP1) {
        for (int u = c; u < 1024; u += G) ph_hpre(p, u);
        for (int u = c; u < 192; u += G) ph_cvt_br(p, u, sm);
        __syncthreads();
        pg8::Gemm g{(const bf16_t*)(p.ws + OFF_PROJ), (const bf16_t*)(p.ws + OFF_CMPW), 1024, 16 * LDP, 4096, 1, 1};
        pg8::CmpOrder S{G, c};
        pg8::EpiCmpAcc E{(float*)(p.ws + OFF_HID)};
        pg8::gemm_phase(lds, g, S, E);
    }
    else if constexpr (Q == Q_CMP2) unit_loop<PH_CMP2>(p, sm);
    else if constexpr (Q == Q_MIX) {
        unsigned* qc = (unsigned*)(p.ws + OFF_QCTR);
        volatile int* slot = (volatile int*)((char*)sm + 131072 - 64);
        for (int k = 0; k < 8; ++k) {
            const int q = (c + k) & 7;
            for (;;) {
                __syncthreads();
                if (threadIdx.x == 0) *slot = (int)__hip_atomic_fetch_add(qc + q * 64, 1u, __ATOMIC_RELAXED, __HIP_MEMORY_SCOPE_AGENT);
                __syncthreads();
                const int it = *slot;
                if (it >= 4 + 128) break;
                if (it < 4) hg::item(p.ws, p.hg_norm_w, q >> 1, (q & 1) * 4 + it, (char*)sm);
                else nsa::item(p.ws, q >> 1, q & 1, 127 - (it - 4), (char*)sm);
            }
        }
    }
    else if constexpr (Q == Q_MRG) {
        pg8::StaticOrder S; S.init(NT, 1024, G, c);
        pg8::Gemm g{(const bf16_t*)(p.ws + OFF_PROJ) + C_HI, (const bf16_t*)(p.ws + OFF_WBRH), 2048, LDP, 2048, 2, 0};
        pg8::EpiMrg E{(const bf16_t*)p.out, (bf16_t*)(p.ws + OFF_H)};
        pg8::gemm_phase(lds, g, S, E);
    }
    else if constexpr (Q == Q_WOUT) {
        for (int u = c; u < 3072; u += G) ph_cvt_exp(p, u, sm);
        pg8::Gemm g{(const bf16_t*)(p.ws + OFF_H), (const bf16_t*)(p.ws + OFF_WOUTT), 1024, 1024, 1024};
        pg8::StaticOrder S; S.init(NT, 1024, G, c);
        pg8::EpiWout E{p.x, (const float*)(p.ws + OFF_MOD), (float*)(p.ws + OFF_Z)};
        pg8::gemm_phase(lds, g, S, E);
    }
    else if constexpr (Q == Q_LN1R) {
        for (int i = threadIdx.x; i < 1024 * 4; i += 512) { const int cc = i >> 2, pos = ((cc >> 8) * 4 + (cc & 3)) * 64 + ((cc >> 2) & 63); sm[pos * 4 + (i & 3)] = p.rg_w[i]; }
        for (int i = threadIdx.x; i < 1024 * 32; i += 512) { const int cc = i >> 5, n = 4 + (i & 31), pos = ((cc >> 8) * 4 + (cc & 3)) * 64 + ((cc >> 2) & 63); sm[((n >> 2) * 1024 + pos) * 4 + (n & 3)] = p.re_w[i]; }
        unsigned* lc = (unsigned*)(sm + 1024 * 36 + 512);
        if (threadIdx.x < 64) lc[threadIdx.x] = 0u;
        __syncthreads();
        for (int u = c; u < NT / 8; u += G) ph_ln1r_(Ln1rArgs{p.ws, p.ln1_g, p.ln1_b, p.rg_b, p.re_b, sm}, u);
        __syncthreads();
        if (threadIdx.x < 32) lc[32 + threadIdx.x] = atomicAdd((unsigned*)(p.ws + OFF_CNT) + threadIdx.x, lc[threadIdx.x]);
        __syncthreads();
        for (int u = c; u < NT / 8; u += G) {
            if (threadIdx.x < 16) { int* ti = (int*)(p.ws + OFF_TOKI) + (size_t)(u * 8 + (threadIdx.x >> 1)) * 6; const int k = threadIdx.x & 1; ti[2 + k] += (int)lc[32 + ti[k]]; }
        }
        __syncthreads();
    }
    else if constexpr (Q == Q_PAD) {
        const int tidx = tid_(), lane = tidx & 63, w = tidx >> 6;
        const unsigned* cnt = (const unsigned*)(p.ws + OFF_CNT);
        bf16_t* xp = (bf16_t*)(p.ws + OFF_XPAD);
        int pc, tot; const int off = wave_offsets(cnt, lane, pc, tot);
#define PAD_LOAD(K_, ROW_) \
            const int rw##K_ = (ROW_) < NT ? (ROW_) : NT - 1; const int* tq##K_ = (const int*)(p.ws + OFF_TOKI) + (size_t)rw##K_ * 6; \
            const int ra##K_ = __shfl(off, tq##K_[0]) + tq##K_[2], rb##K_ = __shfl(off, tq##K_[1]) + tq##K_[3]; \
            const uint4* sp##K_ = (const uint4*)((const bf16_t*)(p.ws + OFF_H) + (size_t)rw##K_ * D_); const uint4 xa##K_ = sp##K_[lane], xb##K_ = sp##K_[64 + lane];
#define PAD_STORE(K_, ROW_) if ((ROW_) < NT) { uint4* d0 = (uint4*)(xp + (size_t)ra##K_ * D_); uint4* d1 = (uint4*)(xp + (size_t)rb##K_ * D_); \
            d0[lane] = xa##K_; d0[64 + lane] = xb##K_; d1[lane] = xa##K_; d1[64 + lane] = xb##K_; \
            if (lane == 0) { int* tw = (int*)(p.ws + OFF_TOKI) + (size_t)(ROW_) * 6; tw[2] = ra##K_; tw[3] = rb##K_; } }
        for (int base = c * 8 + w; base < NT; base += G * 16) {
            PAD_LOAD(0, base) PAD_LOAD(1, base + G * 8)
            PAD_STORE(0, base) PAD_STORE(1, base + G * 8)
        }
#undef PAD_LOAD
#undef PAD_STORE
        for (int e = c; e < 32; e += G) {
            const int oe = __shfl(off, e), ce = (int)cnt[e], pe = __shfl(pc, e);
            for (int r = oe + ce + w; r < oe + pe; r += 8) { uint4* d = (uint4*)(xp + (size_t)r * D_); d[lane] = make_uint4(0, 0, 0, 0); d[64 + lane] = make_uint4(0, 0, 0, 0); }
        }
        if (c == G - 1) {
            int* te = (int*)(p.ws + OFF_TILEE);
            if (tidx < 32) { for (int r = off; r < off + pc; r += 256) te[r >> 8] = tidx; }
            if (tidx == 0) te[511] = tot >> 8;
        }
    }
    else if constexpr (Q == Q_EXP1) {
        const int* te = (const int*)(p.ws + OFF_TILEE);
        pg8::Gemm g{(const bf16_t*)(p.ws + OFF_XPAD), (const bf16_t*)(p.ws + OFF_E13), 1024, 1024, 1024};
        pg8::MoeOrder S{te, te[511] * 4, G, c, (long)1024 * 1024 * 2};
        pg8::EpiExp1 E{(bf16_t*)p.out};
        pg8::gemm_phase(lds, g, S, E);
    }
    else if constexpr (Q == Q_EXP2) {
        const int* te = (const int*)(p.ws + OFF_TILEE);
        pg8::Gemm g{(const bf16_t*)p.out, (const bf16_t*)(p.ws + OFF_E2T), 512, 512, 512};
        pg8::MoeOrder S{te, te[511] * 4, G, c, (long)1024 * 512 * 2};
        pg8::EpiBf E{(bf16_t*)(p.ws + OFF_XPAD), 1024};
        pg8::gemm_phase(lds, g, S, E);
    }
    else if constexpr (Q == Q_FINAL) unit_loop<PH_FINAL>(p, sm);
}
__global__ void __launch_bounds__(512, 2) k_mega(Params p) {
    extern __shared__ __attribute__((aligned(16))) float smem[];
    volatile LAS unsigned* st = (volatile LAS unsigned*)(smem + 153600 / 4);
    if (threadIdx.x == 0) { st[0] = 0u; st[1] = 0u; st[2] = 0u; st[3] = 0u; }
    __syncthreads();
    XcdBarrier bar = xcd_barrier_post((unsigned*)(p.ws + OFF_BAR), st);
    run_phase<Q_PRO>(p, smem);   xcd_barrier(bar);
    run_phase<Q_LN0>(p, smem);   xcd_barrier(bar);
    run_phase<Q_GEMM1>(p, smem); xcd_barrier(bar);
    run_phase<Q_CMP1>(p, smem);  xcd_barrier(bar);
    run_phase<Q_CMP2>(p, smem);  xcd_barrier(bar);
    run_phase<Q_MIX>(p, smem);   xcd_barrier(bar);
    run_phase<Q_MRG>(p, smem);   xcd_barrier(bar);
    run_phase<Q_WOUT>(p, smem);  xcd_barrier(bar);
    run_phase<Q_LN1R>(p, smem);  xcd_barrier(bar);
    run_phase<Q_PAD>(p, smem);   xcd_barrier(bar);
    run_phase<Q_EXP1>(p, smem);  xcd_barrier(bar);
    run_phase<Q_EXP2>(p, smem);  xcd_barrier(bar);
    run_phase<Q_FINAL>(p, smem);
}

extern "C" void kernel_launch(void* const* d_in, const int* in_sizes, int n_in, void* d_out, int out_size, void* d_ws, size_t ws_size, hipStream_t stream) {
    Params p{};
    const float** fp = (const float**)&p;
    for (int i = 0; i < 31; ++i) fp[i] = (const float*)d_in[i];
    p.out = (float*)d_out; p.ws = (unsigned char*)d_ws;
    static int grid = 0;
    if (!grid) {
        int dev = 0, cus = 0, per_cu = 0;
        (void)hipGetDevice(&dev);
        (void)hipDeviceGetAttribute(&cus, hipDeviceAttributeMultiprocessorCount, dev);
        (void)hipFuncSetAttribute((const void*)k_mega, hipFuncAttributeMaxDynamicSharedMemorySize, MEGA_LDS);
        (void)hipOccupancyMaxActiveBlocksPerMultiprocessor(&per_cu, (const void*)k_mega, 512, MEGA_LDS);
        grid = cus * (per_cu < 1 ? per_cu : 1);
    }
    (void)hipMemsetAsync(p.ws + OFF_BAR, 0, XCD_BAR_WORDS * sizeof(unsigned), stream);
    hipLaunchKernelGGL(k_mega, dim3(grid), dim3(512), MEGA_LDS, stream, p);
}
```

```cpp
#include <hip/hip_runtime.h>
#include <stdint.h>

typedef unsigned short bf16_t;

constexpr int B_ = 4, T_ = 8192, D_ = 1024, NT = B_ * T_;
constexpr int DIN = 8728;
constexpr int LDP = 6656;
constexpr int C_HQ = 0, C_HF = 1024, C_HI = 2048, C_HG = 3072, C_NQ = 4096, C_KC = 5120, C_VC = 5376, C_KS = 5632, C_VS = 5888, C_KW = 6144, C_VW = 6400;
constexpr int NC = 511;
constexpr float ALPHA = 1.189207115002721f;
constexpr int MAXROWS = 73728;

constexpr size_t KB = 1024, MB = 1024 * 1024;
constexpr size_t OFF_BAR = 0, OFF_MOD = 16 * KB, OFF_LB = 112 * KB, OFF_LUT = 116 * KB, OFF_CB = 120 * KB, OFF_CNT = 124 * KB, OFF_TOKI = 128 * KB;
constexpr size_t OFF_GATE = 1 * MB, OFF_KCMP = 4 * MB, OFF_VCMP = 5 * MB, OFF_HID = 6 * MB;
constexpr size_t OFF_DEC = 18 * MB;
constexpr size_t OFF_QCTR = 960 * KB;
constexpr size_t OFF_CMPW = 10 * MB;
constexpr size_t OFF_H = 31 * MB;
constexpr size_t OFF_PROJ = 95 * MB;
constexpr size_t OFF_Z = OFF_PROJ, OFF_XPAD = OFF_PROJ + 128 * MB;
constexpr size_t OFF_BIAS1 = 896 * KB, OFF_TILEE = 940 * KB;
constexpr size_t OFF_WINT = 12 * MB;
constexpr size_t OFF_WBRH = 12 * MB, OFF_WBRN = 14 * MB, OFF_WOUTT = 16 * MB;
constexpr size_t OFF_E13 = OFF_PROJ + 272 * MB, OFF_E2T = OFF_PROJ + 336 * MB;
constexpr int N1 = 8960;

struct Params {
    const float *x, *c, *ada_w, *ada_b, *w_in, *b_in, *lb_logits, *hg_norm_w, *pos_k, *w1_k, *b1_k, *w2_k, *pos_v, *w1_v, *b1_v, *w2_v, *rel_bias,
        *w_br_hg, *w_br_nsa, *w_out, *ln1_g, *ln1_b, *rg_w, *rg_b, *re_w, *re_b, *e_w1, *e_w3, *e_w2, *ln2_g, *ln2_b;
    float* out; unsigned char* ws;
};

__device__ __forceinline__ int tid_() { int t = threadIdx.x; asm volatile("" : "+v"(t)); return t; }
__device__ __forceinline__ float bf2f(bf16_t v) { return __uint_as_float(((unsigned)v) << 16); }
__device__ __forceinline__ bf16_t f2bf(float f) { unsigned u = __float_as_uint(f); u += 0x7FFFu + ((u >> 16) & 1u); return (bf16_t)(u >> 16); }
__device__ __forceinline__ float sigmoidf_(float v) { return __builtin_amdgcn_rcpf(1.f + __expf(-v)); }
__device__ __forceinline__ float siluf_(float v) { return v * __builtin_amdgcn_rcpf(1.f + __expf(-v)); }
__device__ __forceinline__ float wsum(float v) { for (int o = 32; o > 0; o >>= 1) v += __shfl_xor(v, o); return v; }
__device__ __forceinline__ float rfl(float v) { return __int_as_float(__builtin_amdgcn_readfirstlane(__float_as_int(v))); }
__device__ __forceinline__ float wmax(float v) { for (int o = 32; o > 0; o >>= 1) v = fmaxf(v, __shfl_xor(v, o)); return v; }
__device__ __forceinline__ float4 ld_bf4(const bf16_t* p) { uint2 r = *(const uint2*)p; return make_float4(__uint_as_float(r.x << 16), __uint_as_float(r.x & 0xFFFF0000u), __uint_as_float(r.y << 16), __uint_as_float(r.y & 0xFFFF0000u)); }
typedef __bf16 bf16x2n __attribute__((ext_vector_type(2)));
typedef float f32x2n __attribute__((ext_vector_type(2)));
__device__ __forceinline__ unsigned pk_bf16(float lo, float hi) { const f32x2n v = {lo, hi}; const bf16x2n r = __builtin_convertvector(v, bf16x2n); return __builtin_bit_cast(unsigned, r); }
__device__ __forceinline__ void st_bf4(bf16_t* p, float a, float b, float c, float d) { uint2 r; r.x = pk_bf16(a, b); r.y = pk_bf16(c, d); *(uint2*)p = r; }
__device__ __forceinline__ int rel_bucket(int n) {
    if (n < 16) return n < 0 ? 0 : n;
    int b = 16;
    b += (n >= 19) + (n >= 21) + (n >= 24) + (n >= 27) + (n >= 31) + (n >= 35) + (n >= 40) + (n >= 46) + (n >= 52) + (n >= 59) + (n >= 67) + (n >= 77) + (n >= 87) + (n >= 99) + (n >= 113);
    return b;
}

template <class AF, class BF, class EF>
__device__ __forceinline__ void gemm128(float* sm, int m0, int n0, int K, AF af, BF bf, EF ef) {
    float(*As)[132] = (float(*)[132])sm;
    float(*Bs)[132] = (float(*)[132])(sm + 16 * 132);
    const int tid = tid_(), tx = tid & 31, ty = tid >> 5;
    const int ar = tid >> 2, ak = (tid & 3) * 4, bk = tid >> 5, bn = (tid & 31) * 4;
    float acc[8][4];
#pragma unroll
    for (int i = 0; i < 8; ++i)
#pragma unroll
        for (int j = 0; j < 4; ++j) acc[i][j] = 0.f;
    for (int k0 = 0; k0 < K; k0 += 16) {
        const float4 a = af(m0 + ar, k0 + ak);
        const float4 b = bf(k0 + bk, n0 + bn);
        __syncthreads();
        As[ak + 0][ar] = a.x; As[ak + 1][ar] = a.y; As[ak + 2][ar] = a.z; As[ak + 3][ar] = a.w;
        *(float4*)&Bs[bk][bn] = b;
        __syncthreads();
#pragma unroll
        for (int k = 0; k < 16; ++k) {
            const float4 a0 = *(const float4*)&As[k][ty * 8], a1 = *(const float4*)&As[k][ty * 8 + 4], bb = *(const float4*)&Bs[k][tx * 4];
            const float av[8] = {a0.x, a0.y, a0.z, a0.w, a1.x, a1.y, a1.z, a1.w};
            const float bv[4] = {bb.x, bb.y, bb.z, bb.w};
#pragma unroll
            for (int i = 0; i < 8; ++i)
#pragma unroll
                for (int j = 0; j < 4; ++j) acc[i][j] = fmaf(av[i], bv[j], acc[i][j]);
        }
    }
#pragma unroll
    for (int i = 0; i < 8; ++i) ef(m0 + ty * 8 + i, n0 + tx * 4, make_float4(acc[i][0], acc[i][1], acc[i][2], acc[i][3]));
    __syncthreads();
}


#define XB_TMO      128
#define XB_XCNT(j)  (256  + 64 * (j))
#define XB_XSUB(j)  (1280 + 64 * (j))
#define XB_XGEN(j)  (2304 + 64 * (j))
#define XB_TOP      3328
#define XB_TOPGEN   3392
#define XCD_BAR_WORDS 3456
#define XB_SPIN_CAP (1u << 22)
#define LAS __attribute__((address_space(3)))
__device__ __forceinline__ unsigned xb_ld(unsigned* p)              { return __hip_atomic_load(p, __ATOMIC_RELAXED, __HIP_MEMORY_SCOPE_AGENT); }
__device__ __forceinline__ unsigned xb_add(unsigned* p, unsigned v) { return __hip_atomic_fetch_add(p, v, __ATOMIC_RELAXED, __HIP_MEMORY_SCOPE_AGENT); }
__device__ __forceinline__ unsigned xb_xcc_id() { return (unsigned)__builtin_amdgcn_s_getreg((3 << 11) | 20) & 0xFu; }
#define XB_SPIN(cond, bar) do { unsigned _sp = 0; while (cond) { __builtin_amdgcn_s_sleep(1); \
    if ((++_sp & 255u) == 0u) { if (xb_ld(&(bar)[XB_TMO])) break; if (_sp > XB_SPIN_CAP) { atomicAdd(&(bar)[XB_TMO], 1u); break; } } } } while (0)
struct XcdBarrier { unsigned* bar; unsigned x; volatile LAS unsigned* st; };
__device__ __forceinline__ XcdBarrier xcd_barrier_post(unsigned* bar, volatile LAS unsigned* st) {
    XcdBarrier b; b.bar = bar; b.x = xb_xcc_id(); b.st = st;
    if (threadIdx.x == 0) (void)xb_add(&bar[XB_XCNT(b.x)], 1u);
    return b;
}
__device__ __forceinline__ void xcd_barrier_complete(unsigned* bar, unsigned x, unsigned& nloc, unsigned& nx) {
    const unsigned G = gridDim.x * gridDim.y * gridDim.z;
    unsigned sum, cnt, mine, sp = 0u;
    for (;;) {
        sum = 0u; cnt = 0u; mine = 0u;
#pragma unroll
        for (unsigned j = 0; j < 16; ++j) { const unsigned c = xb_ld(&bar[XB_XCNT(j)]); sum += c; cnt += (c > 0u) ? 1u : 0u; mine = (j == x) ? c : mine; }
        if (sum == G) break;
        __builtin_amdgcn_s_sleep(1);
        if ((++sp & 255u) == 0u) { if (xb_ld(&bar[XB_TMO])) break; if (sp > XB_SPIN_CAP) { atomicAdd(&bar[XB_TMO], 1u); break; } }
    }
    nloc = mine > 0u ? mine : 1u; nx = cnt > 0u ? cnt : 1u;
}
__device__ __forceinline__ void xcd_barrier(const XcdBarrier& b) {
    asm volatile("s_waitcnt vmcnt(0)" ::: "memory");
    __syncthreads();
    if (threadIdx.x == 0) {
        unsigned* bar = b.bar;
        __builtin_amdgcn_s_waitcnt(0);
        unsigned nloc = b.st[0], nx = b.st[1];
        if (nloc == 0u) { xcd_barrier_complete(bar, b.x, nloc, nx); b.st[0] = nloc; b.st[1] = nx; }
        const unsigned old = xb_add(&bar[XB_XSUB(b.x)], 1u);
        const unsigned gen = old / nloc;
        if (old + 1u == (gen + 1u) * nloc) {
            __builtin_amdgcn_fence(__ATOMIC_RELEASE, "agent");
            asm volatile("s_waitcnt vmcnt(0)" ::: "memory");
            const unsigned og = xb_add(&bar[XB_TOP], 1u);
            const unsigned tg = og / nx;
            if (og + 1u == (tg + 1u) * nx) xb_add(&bar[XB_TOPGEN], 1u);
            else XB_SPIN(xb_ld(&bar[XB_TOPGEN]) == tg, bar);
            __builtin_amdgcn_fence(__ATOMIC_ACQUIRE, "agent");
            xb_add(&bar[XB_XGEN(b.x)], 1u);
            asm volatile("s_waitcnt vmcnt(0)" ::: "memory");
        } else {
            XB_SPIN(xb_ld(&bar[XB_XGEN(b.x)]) == gen, bar);
            __builtin_amdgcn_fence(__ATOMIC_ACQUIRE, "agent");
            asm volatile("s_waitcnt vmcnt(0)" ::: "memory");
        }
    }
    __syncthreads();
}


namespace pg8 {
#define PG8_LAS __attribute__((address_space(3)))
typedef short bf16x8 __attribute__((ext_vector_type(8)));
typedef float f32x4 __attribute__((ext_vector_type(4)));
typedef unsigned u32x4 __attribute__((ext_vector_type(4)));
typedef unsigned u32x2 __attribute__((ext_vector_type(2)));
constexpr int BM = 256, BK = 64, HALF = 128, HTB = HALF * BK * 2, STAGE_BYTES = 8 * HTB, NXCD = 8, WGM = 8;
__host__ __device__ __forceinline__ int lds_byte(int r, int c) { const int st = (r >> 4) * 2 + (c >> 5), rr = r & 15, cc = c & 31, ob = rr * 64 + cc * 2; return st * 1024 + (ob ^ (((ob >> 9) & 1) << 5)); }
__host__ __device__ __forceinline__ void stage_rc(int b, int& R, int& C) { const int st = b / 1024, sb = b % 1024, swz = sb ^ (((sb >> 9) & 1) << 5); R = (st >> 1) * 16 + swz / 64; C = (st & 1) * 32 + (swz % 64) / 2; }
__host__ __device__ __forceinline__ int perm32(int rho) { const int n = rho >> 4, i = rho & 15; return 8 * (i >> 2) + 4 * n + (i & 3); }
struct Unit { int pm, pn; long boff; long aoff; };
struct Gemm { const bf16_t* A; const bf16_t* Bt; int K, lda, ldb; int kmode = 0; int bdup = 0; };
struct StaticOrder {
    int nM, nN, nwg, G, c;
    __device__ void init(int M, int N, int G_, int c_) { nM = M / BM; nN = N / BM; nwg = nM * nN; G = G_; c = c_; }
    __device__ bool next(int i, Unit& u) const {
        const long L = (long)i * G + c; if (L >= nwg) return false;
        int wgid = (int)L; { const int q = nwg / NXCD, r = nwg % NXCD, xcd = wgid % NXCD, off = wgid / NXCD; wgid = (xcd < r ? xcd * (q + 1) : r * (q + 1) + (xcd - r) * q) + off; }
        const int nig = WGM * nN, gid = wgid / nig, fm = gid * WGM, gsz = (nM - fm) < WGM ? (nM - fm) : WGM;
        u.pm = fm + ((wgid % nig) % gsz); u.pn = (wgid % nig) / gsz; u.boff = 0; u.aoff = 0; return true;
    }
    __device__ __forceinline__ void a_ready(const Unit&) const {}
    __device__ __forceinline__ void done(const Unit&) const {}
};
struct MoeOrder {
    const int* tile_e; int nwg, G, c; long estride;
    __device__ bool next(int i, Unit& u) const {
        const long L = (long)i * G + c; if (L >= nwg) return false;
        u.pm = (int)(L >> 2); u.pn = (int)(L & 3); u.boff = (long)tile_e[u.pm] * estride; u.aoff = 0; return true;
    }
    __device__ __forceinline__ void a_ready(const Unit&) const {}
    __device__ __forceinline__ void done(const Unit&) const {}
};
struct CmpOrder {
    int G, c;
    __device__ bool next(int i, Unit& u) const {
        const int L = i * G + c; if (L >= 128) return false;
        const int kv = L >> 6, bg = (L >> 3) & 7, half = (L >> 2) & 1, kq = L & 3;
        u.pm = half; u.pn = (kv << 3) | bg;
        u.aoff = ((long)((bg >> 1) * T_ + 8 * kq) * LDP + (kv ? C_VC : C_KC) + (bg & 1) * 128) * 2;
        u.boff = ((long)kv * 128 * 4096 + kq * 1024) * 2;
        return true;
    }
    __device__ __forceinline__ void a_ready(const Unit&) const {}
    __device__ __forceinline__ void done(const Unit&) const {}
};
__device__ __forceinline__ unsigned cvt_pk_bf16(float lo, float hi) { return pk_bf16(lo, hi); }
__device__ __forceinline__ f32x4 unpk_lo(u32x4 w) { return (f32x4){__uint_as_float(w.x << 16), __uint_as_float(w.x & 0xFFFF0000u), __uint_as_float(w.y << 16), __uint_as_float(w.y & 0xFFFF0000u)}; }
__device__ __forceinline__ f32x4 unpk_hi(u32x4 w) { return (f32x4){__uint_as_float(w.z << 16), __uint_as_float(w.z & 0xFFFF0000u), __uint_as_float(w.w << 16), __uint_as_float(w.w & 0xFFFF0000u)}; }
__device__ __forceinline__ u32x4 pk8(f32x4 v0, f32x4 v1) { u32x4 w; w.x = cvt_pk_bf16(v0[0], v0[1]); w.y = cvt_pk_bf16(v0[2], v0[3]); w.z = cvt_pk_bf16(v1[0], v1[1]); w.w = cvt_pk_bf16(v1[2], v1[3]); return w; }
__device__ __forceinline__ f32x4 sig4(f32x4 v) { return (f32x4){sigmoidf_(v[0]), sigmoidf_(v[1]), sigmoidf_(v[2]), sigmoidf_(v[3])}; }
struct EpiProj {
    static constexpr bool PERM = true, AFTER_DRAIN = false, HAS_MID = false;
    bf16_t* proj; bf16_t* mg; float* gate; const float* bias;
    __device__ __forceinline__ void operator()(const f32x4 (&acc)[2][2][4][2], const Unit& u, int wr, int wc, int fr, int fq) const {
        const int row0 = u.pm * BM + wr * 64 + fr, c8 = u.pn * BM + wc * 32 + 8 * fq;
        f32x4 bv[2][2];
#pragma unroll
        for (int bj = 0; bj < 2; ++bj)
#pragma unroll
            for (int n = 0; n < 2; ++n) bv[bj][n] = *(const f32x4*)(bias + c8 + bj * HALF + 4 * n);
#pragma unroll
        for (int ai = 0; ai < 2; ++ai)
#pragma unroll
            for (int m = 0; m < 4; ++m) {
                const size_t row = (size_t)(row0 + ai * HALF + m * 16);
#pragma unroll
                for (int bj = 0; bj < 2; ++bj) {
                    const f32x4 v0 = acc[ai][bj][m][0] + bv[bj][0], v1 = acc[ai][bj][m][1] + bv[bj][1];
                    const int col = c8 + bj * HALF;
                    if (u.pn < 26) *(u32x4*)(proj + row * LDP + col) = pk8(v0, v1);
                    else if (u.pn < 34) *(u32x4*)(mg + row * 2048 + (col - 6656)) = pk8(sig4(v0), sig4(v1));
                    else if (col - 8704 < 24) { float* gp = gate + row * 24 + (col - 8704); *(f32x4*)gp = sig4(v0); *(f32x4*)(gp + 4) = sig4(v1); }
                }
            }
    }
};
struct EpiMrg {
    static constexpr bool PERM = true, AFTER_DRAIN = false, HAS_MID = true;
    const bf16_t* mg; bf16_t* mr;
    __device__ __forceinline__ void mid(f32x4 (&acc)[2][2][4][2], const Unit& u, int wr, int wc, int fr, int fq) const {
        const int row0 = u.pm * BM + wr * 64 + fr, c8 = u.pn * BM + wc * 32 + 8 * fq;
#pragma unroll
        for (int ai = 0; ai < 2; ++ai)
#pragma unroll
            for (int m = 0; m < 4; ++m) {
                const size_t row = (size_t)(row0 + ai * HALF + m * 16);
#pragma unroll
                for (int bj = 0; bj < 2; ++bj) {
                    const int col = c8 + bj * HALF;
                    const u32x4 hw = *(const u32x4*)(mg + row * 2048 + col), nw = *(const u32x4*)(mg + row * 2048 + 1024 + col);
                    const f32x4 h0 = unpk_lo(hw), h1 = unpk_hi(hw), n0 = unpk_lo(nw), n1 = unpk_hi(nw);
#pragma unroll
                    for (int j = 0; j < 4; ++j) { acc[ai][bj][m][0][j] *= h0[j] * __builtin_amdgcn_rcpf(fmaxf(n0[j], 8.673617e-19f)); acc[ai][bj][m][1][j] *= h1[j] * __builtin_amdgcn_rcpf(fmaxf(n1[j], 8.673617e-19f)); }
                    asm volatile("" ::: "memory");
                }
            }
    }
    __device__ __forceinline__ void operator()(const f32x4 (&acc)[2][2][4][2], const Unit& u, int wr, int wc, int fr, int fq) const {
        const int row0 = u.pm * BM + wr * 64 + fr, c8 = u.pn * BM + wc * 32 + 8 * fq;
#pragma unroll
        for (int ai = 0; ai < 2; ++ai)
#pragma unroll
            for (int m = 0; m < 4; ++m) {
                const size_t row = (size_t)(row0 + ai * HALF + m * 16);
#pragma unroll
                for (int bj = 0; bj < 2; ++bj) {
                    const int col = c8 + bj * HALF;
                    const u32x4 nw = *(const u32x4*)(mg + row * 2048 + 1024 + col);
                    f32x4 n0 = unpk_lo(nw), n1 = unpk_hi(nw);
#pragma unroll
                    for (int j = 0; j < 4; ++j) { n0[j] = fmaxf(n0[j], 8.673617e-19f); n1[j] = fmaxf(n1[j], 8.673617e-19f); }
                    *(u32x4*)(mr + row * 1024 + col) = pk8(n0 * acc[ai][bj][m][0], n1 * acc[ai][bj][m][1]);
                }
                asm volatile("" ::: "memory");
            }
    }
};
struct EpiWout {
    static constexpr bool PERM = false, AFTER_DRAIN = false, HAS_MID = false;
    const float* x; const float* mod; float* z;
    __device__ __forceinline__ void operator()(const f32x4 (&acc)[2][2][4][2], const Unit& u, int wr, int wc, int fr, int fq) const {
        const int row0 = u.pm * BM + wr * 64 + fr, col0 = u.pn * BM + wc * 32 + 4 * fq;
        const float* g1 = mod + ((u.pm * BM) / T_) * 6144 + 2048 + col0;
#pragma unroll
        for (int ai = 0; ai < 2; ++ai)
#pragma unroll
            for (int m = 0; m < 4; ++m) {
                const size_t ro = (size_t)(row0 + ai * HALF + m * 16) * 1024 + col0;
#pragma unroll
                for (int bj = 0; bj < 2; ++bj)
#pragma unroll
                    for (int n = 0; n < 2; ++n) { const f32x4 xv = *(const f32x4*)(x + ro + bj * HALF + n * 16), gv = *(const f32x4*)(g1 + bj * HALF + n * 16) + 1.0f;
                        *(f32x4*)(z + ro + bj * HALF + n * 16) = xv * ALPHA + gv * acc[ai][bj][m][n]; }
                if (m & 1) asm volatile("" ::: "memory");
            }
    }
};
struct EpiExp1 {
    static constexpr bool PERM = true, AFTER_DRAIN = false, HAS_MID = false;
    bf16_t* U;
    __device__ __forceinline__ void operator()(const f32x4 (&acc)[2][2][4][2], const Unit& u, int wr, int wc, int fr, int fq) const {
        const int row0 = u.pm * BM + wr * 64 + fr, c8 = u.pn * HALF + wc * 32 + 8 * fq;
#pragma unroll
        for (int ai = 0; ai < 2; ++ai)
#pragma unroll
            for (int m = 0; m < 4; ++m) {
                f32x4 r[2];
#pragma unroll
                for (int n = 0; n < 2; ++n)
#pragma unroll
                    for (int j = 0; j < 4; ++j) r[n][j] = siluf_(acc[ai][0][m][n][j]) * acc[ai][1][m][n][j];
                *(u32x4*)(U + (size_t)(row0 + ai * HALF + m * 16) * 512 + c8) = pk8(r[0], r[1]);
            }
    }
};
struct EpiCmpAcc {
    static constexpr bool PERM = false, AFTER_DRAIN = false, HAS_MID = false;
    float* hp;
    __device__ __forceinline__ void operator()(const f32x4 (&acc)[2][2][4][2], const Unit& u, int wr, int wc, int fr, int fq) const {
        const int row0 = u.pn * 512 + u.pm * BM + wr * 64 + fr, col0 = wc * 32 + 4 * fq;
#pragma unroll
        for (int ai = 0; ai < 2; ++ai)
#pragma unroll
            for (int m = 0; m < 4; ++m) { float* rp = hp + (size_t)(row0 + ai * HALF + m * 16) * 128 + col0;
#pragma unroll
                for (int n = 0; n < 2; ++n)
#pragma unroll
                    for (int j = 0; j < 4; ++j) atomicAdd(rp + n * 16 + j, acc[ai][0][m][n][j]); }
    }
};
struct EpiBf {
    static constexpr bool PERM = true, AFTER_DRAIN = false, HAS_MID = false;
    bf16_t* O; int ldo;
    __device__ __forceinline__ void operator()(const f32x4 (&acc)[2][2][4][2], const Unit& u, int wr, int wc, int fr, int fq) const {
        const int row0 = u.pm * BM + wr * 64 + fr, c8 = u.pn * BM + wc * 32 + 8 * fq;
#pragma unroll
        for (int ai = 0; ai < 2; ++ai)
#pragma unroll
            for (int m = 0; m < 4; ++m)
#pragma unroll
                for (int bj = 0; bj < 2; ++bj) *(u32x4*)(O + (size_t)(row0 + ai * HALF + m * 16) * ldo + c8 + bj * HALF) = pk8(acc[ai][bj][m][0], acc[ai][bj][m][1]);
    }
};
template <class Epi, class Sched>
__device__ __forceinline__ void gemm_phase(PG8_LAS unsigned char* lds, const Gemm g, const Sched& S, const Epi& E) {
    const int tid = tid_(), wid = __builtin_amdgcn_readfirstlane(tid >> 6), lane = tid & 63, wr = wid >> 2, wc = wid & 3, fr = lane & 15, fq = lane >> 4;
    const int K = g.K, nt = K / BK;
    unsigned voffA[2], voffB[2];
#pragma unroll
    for (int i = 0; i < 2; ++i) { int R, C; stage_rc(tid * 16 + i * 8192, R, C); const int Rb = Epi::PERM ? ((R & ~31) + perm32(R & 31)) : R;
        voffA[i] = (unsigned)(R * g.lda + C) * 2u; voffB[i] = (unsigned)(Rb * g.ldb + C) * 2u; }
    const size_t kstep = (size_t)(BK * 2);
#define PG8_KA(t) (g.kmode == 1 ? (size_t)((t) >> 1) * (LDP * 2) + (size_t)((t) & 1) * 128 : g.kmode == 2 ? (size_t)(t) * kstep + ((t) >= 16 ? (size_t)2048 : (size_t)0) : (size_t)(t) * kstep)
    const size_t hstepA = (size_t)HALF * g.lda * 2, hstepB = g.bdup ? (size_t)0 : (size_t)HALF * g.ldb * 2;
    const size_t tstepA = 2 * hstepA, tstepB = 2 * hstepB;
    const unsigned ldsw = (unsigned)wid * 1024u;
    const int aoff = lds_byte(wr * 64 + fr, fq * 8), boff = lds_byte(wc * 32 + fr, fq * 8);
#define PG8_SA(b, h) (((b) * 2 + (h)) * HTB)
#define PG8_SB(b, h) ((4 + (b) * 2 + (h)) * HTB)
#define PG8_STAGE(bufoff, gbase, voff) do { _Pragma("unroll") for (int _i = 0; _i < 2; ++_i) \
        __builtin_amdgcn_global_load_lds((const unsigned*)((const char*)(gbase) + (voff)[_i]), (PG8_LAS unsigned*)(lds + (bufoff) + ldsw + _i * 8192), 16, 0, 0); } while (0)
#define PG8_LDA(dst, b, h) do { _Pragma("unroll") for (int m = 0; m < 4; ++m) _Pragma("unroll") for (int k = 0; k < 2; ++k) dst[m][k] = *(const PG8_LAS bf16x8*)(lds + PG8_SA(b, h) + aoff + m * 2048 + k * 1024); } while (0)
#define PG8_LDB(dst, b, h) do { _Pragma("unroll") for (int n = 0; n < 2; ++n) _Pragma("unroll") for (int k = 0; k < 2; ++k) dst[n][k] = *(const PG8_LAS bf16x8*)(lds + PG8_SB(b, h) + boff + n * 2048 + k * 1024); } while (0)
#define PG8_MMA(ai, bj, At, Bt) do { __builtin_amdgcn_s_setprio(1); _Pragma("unroll") for (int m = 0; m < 4; ++m) _Pragma("unroll") for (int n = 0; n < 2; ++n) _Pragma("unroll") for (int k = 0; k < 2; ++k) \
        acc[ai][bj][m][n] = __builtin_amdgcn_mfma_f32_16x16x32_bf16(Bt[n][k], At[m][k], acc[ai][bj][m][n], 0, 0, 0); __builtin_amdgcn_s_setprio(0); } while (0)
#define PG8_WAIT_V(n) asm volatile("s_waitcnt vmcnt(" #n ")" ::: "memory")
#define PG8_WAIT_L(n) asm volatile("s_waitcnt lgkmcnt(" #n ")" ::: "memory")
#define PG8_BAR __builtin_amdgcn_s_barrier()
#define PG8_SCHED __builtin_amdgcn_sched_barrier(0)
    Unit cur, nxt; int ui = 0;
    if (!S.next(0, cur)) return;
    f32x4 acc[2][2][4][2];
#pragma unroll
    for (int a = 0; a < 2; ++a)
#pragma unroll
        for (int b = 0; b < 2; ++b)
#pragma unroll
            for (int m = 0; m < 4; ++m)
#pragma unroll
                for (int n = 0; n < 2; ++n) acc[a][b][m][n] = (f32x4){0.f, 0.f, 0.f, 0.f};
    bf16x8 At[4][2], B0[2][2], B1[2][2];
    const char* cA = (const char*)g.A + cur.aoff + (size_t)cur.pm * tstepA; const char* cB = (const char*)g.Bt + cur.boff + (size_t)cur.pn * tstepB;
    S.a_ready(cur);
    PG8_STAGE(PG8_SB(0, 0), cB, voffB); PG8_STAGE(PG8_SA(0, 0), cA, voffA); PG8_STAGE(PG8_SB(0, 1), cB + hstepB, voffB); PG8_STAGE(PG8_SA(0, 1), cA + hstepA, voffA);
    if (wr == 1) PG8_BAR;
    PG8_WAIT_V(4); PG8_BAR;
    PG8_STAGE(PG8_SB(1, 0), cB + kstep, voffB); PG8_STAGE(PG8_SA(1, 0), cA + PG8_KA(1), voffA); PG8_STAGE(PG8_SB(1, 1), cB + hstepB + kstep, voffB);
    PG8_WAIT_V(6); PG8_BAR;
    for (;;) {
        const bool has_next = S.next(ui + 1, nxt);
        const char* nA = has_next ? (const char*)g.A + nxt.aoff + (size_t)nxt.pm * tstepA : cA; const char* nB = has_next ? (const char*)g.Bt + nxt.boff + (size_t)nxt.pn * tstepB : cB;
        for (int t = 0; t < nt; t += 2) {
            const bool last = (t == nt - 2);
            const char* a1 = cA + PG8_KA(t + 1);
            const char* a2 = last ? nA : cA + PG8_KA(t + 2); const char* b2 = last ? nB : cB + (size_t)(t + 2) * kstep;
            const char* a3 = last ? nA + PG8_KA(1) : cA + PG8_KA(t + 3); const char* b3 = b2 + kstep;
            if (last && has_next) S.a_ready(nxt);
            if constexpr (Epi::HAS_MID) { if (t == 16) E.mid(acc, cur, wr, wc, fr, fq); }
            PG8_LDB(B0, 0, 0); PG8_SCHED; PG8_LDA(At, 0, 0); PG8_STAGE(PG8_SA(1, 1), a1 + hstepA, voffA);
            PG8_WAIT_L(8); PG8_BAR; PG8_WAIT_L(0); PG8_MMA(0, 0, At, B0); PG8_BAR; PG8_SCHED;
            PG8_LDB(B1, 0, 1); PG8_STAGE(PG8_SB(0, 0), b2, voffB);
            PG8_BAR; PG8_WAIT_L(0); PG8_MMA(0, 1, At, B1); PG8_BAR;
            PG8_LDA(At, 0, 1); PG8_STAGE(PG8_SA(0, 0), a2, voffA);
            PG8_BAR; PG8_WAIT_L(0); PG8_MMA(1, 0, At, B0); PG8_BAR; PG8_SCHED;
            PG8_STAGE(PG8_SB(0, 1), b2 + hstepB, voffB);
            PG8_WAIT_V(6); PG8_BAR; PG8_MMA(1, 1, At, B1); PG8_BAR;
            PG8_LDB(B0, 1, 0); PG8_SCHED; PG8_LDA(At, 1, 0); PG8_STAGE(PG8_SA(0, 1), a2 + hstepA, voffA);
            PG8_WAIT_L(8); PG8_BAR; PG8_WAIT_L(0); PG8_MMA(0, 0, At, B0); PG8_BAR; PG8_SCHED;
            PG8_LDB(B1, 1, 1); PG8_STAGE(PG8_SB(1, 0), b3, voffB);
            PG8_BAR; PG8_WAIT_L(0); PG8_MMA(0, 1, At, B1); PG8_BAR;
            PG8_LDA(At, 1, 1); PG8_STAGE(PG8_SA(1, 0), a3, voffA);
            PG8_BAR; PG8_WAIT_L(0); PG8_MMA(1, 0, At, B0); PG8_BAR; PG8_SCHED;
            PG8_STAGE(PG8_SB(1, 1), b3 + hstepB, voffB);
            PG8_WAIT_V(6); PG8_BAR; PG8_MMA(1, 1, At, B1); PG8_BAR;
        }
        if constexpr (!Epi::AFTER_DRAIN) { E(acc, cur, wr, wc, fr, fq); S.done(cur); }
        if (!has_next) break;
#pragma unroll
        for (int a = 0; a < 2; ++a)
#pragma unroll
            for (int b = 0; b < 2; ++b)
#pragma unroll
                for (int m = 0; m < 4; ++m)
#pragma unroll
                    for (int n = 0; n < 2; ++n) acc[a][b][m][n] = (f32x4){0.f, 0.f, 0.f, 0.f};
        cur = nxt; cA = nA; cB = nB; ++ui;
    }
    PG8_WAIT_V(0);
    if (wr == 0) PG8_BAR;
    PG8_BAR;
    if constexpr (Epi::AFTER_DRAIN) { E.fused(acc, cur, wr, wc, fr, fq, lds, wid, lane); S.done(cur); }
#undef PG8_SA
#undef PG8_SB
#undef PG8_STAGE
#undef PG8_LDA
#undef PG8_LDB
#undef PG8_MMA
#undef PG8_WAIT_V
#undef PG8_WAIT_L
#undef PG8_BAR
#undef PG8_SCHED
#undef PG8_KA
}
}

namespace nsa {
typedef short bf16x8 __attribute__((ext_vector_type(8)));
typedef short s16x4 __attribute__((ext_vector_type(4)));
typedef float f32x16 __attribute__((ext_vector_type(16)));
typedef float f32x4 __attribute__((ext_vector_type(4)));
typedef unsigned u32x4 __attribute__((ext_vector_type(4)));
constexpr int SHM_V = 16384, SHM_K = 16384;
constexpr int L_V = 0, L_K = 32768, L_WS = 65536, L_LUT = 67584, L_IMP = 69632, L_SEL = 102400, L_UNI = 103424, L_TL = 103488, L_END = 104064;
constexpr float LOG2E = 1.4426950408889634f, C2 = 0.08838834764831845f * LOG2E, THR2 = 11.5f;
#define KSWZ(row, colB) ((row) * 256 + ((colB) ^ (((row) & 7) << 4)))
#define SBAR() __builtin_amdgcn_sched_barrier(0)
__device__ __forceinline__ int v_st(int k, int c) { const int kk = (k & ~0xC) | ((k & 4) << 1) | ((k & 8) >> 1); return ((kk >> 3) * 4 + (c >> 5)) * 512 + ((kk & 7) * 32 + (c & 31)) * 2; }
__device__ __forceinline__ int v_rd_base(int lane) { return ((lane & 3) << 3) | (((lane >> 2) & 3) << 6) | (((lane >> 4) & 1) << 5) | (((lane >> 5) & 1) << 8); }
constexpr int v_rd_off(int d0, int ks, int half) { return d0 * 512 + ks * 4096 + half * 2048; }
__device__ __forceinline__ int crow(int r, int hi) { return (r & 3) + 8 * (r >> 2) + 4 * hi; }
__device__ __forceinline__ unsigned cvtpk(float lo, float hi) { unsigned r; asm volatile("v_cvt_pk_bf16_f32 %0, %1, %2" : "=v"(r) : "v"(lo), "v"(hi)); return r; }

template <int KB>
__device__ __forceinline__ void qkt(f32x16& p0, f32x16& p1, const char* K_lds, int r32, int hi, const bf16x8* qr) {
    p0 = f32x16{}; p1 = f32x16{};
    const char* kb[4];
#pragma unroll
    for (int dd = 0; dd < 4; ++dd) kb[dd] = K_lds + KB * SHM_K + KSWZ(r32, (dd * 16 + hi * 8) * 2);
#pragma unroll
    for (int d0 = 0; d0 < 8; ++d0) { const char* a = kb[d0 & 3] + (d0 >> 2) * 128;
        bf16x8 b0 = *reinterpret_cast<const bf16x8*>(a);
        bf16x8 b1 = *reinterpret_cast<const bf16x8*>(a + 32 * 256);
        p0 = __builtin_amdgcn_mfma_f32_32x32x16_bf16(b0, qr[d0], p0, 0, 0, 0);
        p1 = __builtin_amdgcn_mfma_f32_32x32x16_bf16(b1, qr[d0], p1, 0, 0, 0); }
}
template <int VB>
__device__ __forceinline__ void pv_tile(f32x16* o, int vb0, bf16x8 pa0, bf16x8 pa1, bf16x8 pa2, bf16x8 pa3) {
#define TRRD(dst, off) asm volatile("ds_read_b64_tr_b16 %0, %1 offset:%2" : "=&v"(dst) : "v"(vb0), "i"(off) : "memory")
#define PV_D0(d0) do { s16x4 l0, l1, l2, l3, h0, h1, h2, h3; constexpr int b_ = VB * SHM_V + v_rd_off(d0, 0, 0); \
        TRRD(l0, b_); TRRD(h0, b_ + 2048); TRRD(l1, b_ + 4096); TRRD(h1, b_ + 6144); TRRD(l2, b_ + 8192); TRRD(h2, b_ + 10240); TRRD(l3, b_ + 12288); TRRD(h3, b_ + 14336); \
        asm volatile("s_waitcnt lgkmcnt(0)" ::: "memory"); SBAR(); \
        o[d0] = __builtin_amdgcn_mfma_f32_32x32x16_bf16(pa0, (bf16x8){l0[0], l0[1], l0[2], l0[3], h0[0], h0[1], h0[2], h0[3]}, o[d0], 0, 0, 0); \
        o[d0] = __builtin_amdgcn_mfma_f32_32x32x16_bf16(pa1, (bf16x8){l1[0], l1[1], l1[2], l1[3], h1[0], h1[1], h1[2], h1[3]}, o[d0], 0, 0, 0); \
        o[d0] = __builtin_amdgcn_mfma_f32_32x32x16_bf16(pa2, (bf16x8){l2[0], l2[1], l2[2], l2[3], h2[0], h2[1], h2[2], h2[3]}, o[d0], 0, 0, 0); \
        o[d0] = __builtin_amdgcn_mfma_f32_32x32x16_bf16(pa3, (bf16x8){l3[0], l3[1], l3[2], l3[3], h3[0], h3[1], h3[2], h3[3]}, o[d0], 0, 0, 0); } while (0)
    PV_D0(0); PV_D0(1); PV_D0(2); PV_D0(3);
#undef PV_D0
#undef TRRD
}
__device__ __forceinline__ void mask_tile(f32x16& p0, f32x16& p1, int dq, unsigned W) {
    const float NEG = -__builtin_inff();
    asm volatile("" : "+v"(dq));
#pragma unroll
    for (int r = 0; r < 16; ++r) {
        const int c = (r & 3) + 8 * (r >> 2);
        if ((unsigned)(dq - c) >= W) p0[r] = NEG;
        if ((unsigned)(dq - c - 32) >= W) p1[r] = NEG;
    }
}
template <int STRIDE>
__device__ __forceinline__ void bias_near(f32x16& p0, f32x16& p1, int dbase, const float* lut) {
    asm volatile("" : "+v"(dbase));
#pragma unroll
    for (int r = 0; r < 16; ++r) {
        const int c = (r & 3) + 8 * (r >> 2);
        int d0 = dbase - STRIDE * c, d1 = dbase - STRIDE * (c + 32);
        d0 = d0 < 0 ? 0 : (d0 > 127 ? 127 : d0); d1 = d1 < 0 ? 0 : (d1 > 127 ? 127 : d1);
        p0[r] = fmaf(p0[r], C2, lut[d0]); p1[r] = fmaf(p1[r], C2, lut[d1]);
    }
}
__device__ __forceinline__ void bias_const(f32x16& p0, f32x16& p1, float cb) {
#pragma unroll
    for (int r = 0; r < 16; ++r) { p0[r] = fmaf(p0[r], C2, cb); p1[r] = fmaf(p1[r], C2, cb); }
}
__device__ __forceinline__ float half_max(float v) { auto rr = __builtin_amdgcn_permlane32_swap(__float_as_uint(v), __float_as_uint(v), false, false); return fmaxf(__uint_as_float(rr[0]), __uint_as_float(rr[1])); }
__device__ __forceinline__ float half_sum(float v) { auto rr = __builtin_amdgcn_permlane32_swap(__float_as_uint(v), __float_as_uint(v), false, false); return __uint_as_float(rr[0]) + __uint_as_float(rr[1]); }
__device__ __forceinline__ void softmax_online(f32x16& p0, f32x16& p1, float sc, float cb2, bool sel, float& m, float& l, float& alpha) {
    float pmax = p0[0];
#pragma unroll
    for (int r = 1; r < 16; ++r) pmax = fmaxf(pmax, p0[r]);
#pragma unroll
    for (int r = 0; r < 16; ++r) pmax = fmaxf(pmax, p1[r]);
    pmax = half_max(pmax);
    pmax = sel ? fmaf(pmax, sc, cb2) : -__builtin_inff();
    if (__all(pmax - m <= THR2)) alpha = 1.f;
    else { const float mn = fmaxf(m, pmax); alpha = __builtin_amdgcn_exp2f(m - mn); m = mn; }
    const float off = sel ? cb2 - m : -__builtin_inff();
#pragma unroll
    for (int r = 0; r < 16; ++r) { p0[r] = fmaf(p0[r], sc, off); p1[r] = fmaf(p1[r], sc, off); }
    SBAR();
#pragma unroll
    for (int r = 0; r < 16; ++r) { p0[r] = __builtin_amdgcn_exp2f(p0[r]); p1[r] = __builtin_amdgcn_exp2f(p1[r]); }
    SBAR();
    float ps = 0.f;
#pragma unroll
    for (int r = 0; r < 16; ++r) ps += p0[r] + p1[r];
    l = l * alpha + half_sum(ps);
}
__device__ __forceinline__ void pack_p(const f32x16& p0, const f32x16& p1, bf16x8& pa0, bf16x8& pa1, bf16x8& pa2, bf16x8& pa3) {
#define PK4(P, B_, OUT) do { unsigned a0 = cvtpk(P[B_+0], P[B_+1]), a1 = cvtpk(P[B_+2], P[B_+3]); \
        unsigned b0 = cvtpk(P[B_+4], P[B_+5]), b1 = cvtpk(P[B_+6], P[B_+7]); \
        auto r0 = __builtin_amdgcn_permlane32_swap(a0, b0, false, false); auto r1 = __builtin_amdgcn_permlane32_swap(a1, b1, false, false); \
        u32x4 w = {r0[0], r1[0], r0[1], r1[1]}; OUT = *reinterpret_cast<bf16x8*>(&w); } while (0)
    PK4(p0, 0, pa0); PK4(p0, 8, pa1); PK4(p1, 0, pa2); PK4(p1, 8, pa3);
#undef PK4
}
__device__ __forceinline__ void rescale_o(f32x16* o, float alpha, float* al_l, int r32, int hi) {
    if (__any(alpha < 1.f)) {
        if (hi == 0) al_l[r32] = alpha;
        asm volatile("s_waitcnt lgkmcnt(0)" ::: "memory");
#pragma unroll
        for (int r = 0; r < 16; ++r) { const float a = al_l[crow(r, hi)];
#pragma unroll
            for (int d = 0; d < 4; ++d) o[d][r] *= a; }
    }
}
__device__ __forceinline__ void flush_out(const f32x16* o, float lsum, int br, unsigned char* ws, char* lds, int b, int g, int qb, int wid, int lane_in, bool first) {
    int lane = lane_in; asm volatile("" : "+v"(lane));
    const int r32 = lane & 31, hi = lane >> 5, head = g * 4 + (wid >> 1);
    const size_t tok = (size_t)b * T_ + qb * 64 + (wid & 1) * 32;
    float* li_l = (float*)(lds + L_WS) + wid * 64;
    bf16_t* tb = (bf16_t*)(lds + wid * 8192);
    bf16_t* orow = (bf16_t*)(ws + OFF_PROJ) + tok * LDP + C_NQ + head * 128;
    const float gate = ((const float*)(ws + OFF_GATE))[(tok + r32) * 24 + head * 3 + br];
    const float f_lane = br == 0 ? gate : (lsum > 0.f ? gate / lsum : 0.f);
    if (hi == 0) li_l[r32] = f_lane;
    asm volatile("s_waitcnt lgkmcnt(0)" ::: "memory");
#pragma unroll
    for (int r = 0; r < 16; ++r) {
        const float f = li_l[crow(r, hi)];
#pragma unroll
        for (int d = 0; d < 4; ++d) tb[crow(r, hi) * 128 + d * 32 + r32] = f2bf(o[d][r] * f);
    }
    asm volatile("s_waitcnt lgkmcnt(0)" ::: "memory");
    uint4 gq[8];
    if (!first) {
#pragma unroll
        for (int i = 0; i < 8; ++i) { const int idx = i * 64 + lane, row = idx >> 4, ch = idx & 15; gq[i] = *(const uint4*)(orow + (size_t)row * LDP + ch * 8); }
    }
#pragma unroll
    for (int i = 0; i < 8; ++i) {
        const int idx = i * 64 + lane, row = idx >> 4, ch = idx & 15;
        uint4 w = *(const uint4*)(tb + row * 128 + ch * 8);
        uint4* gp = (uint4*)(orow + (size_t)row * LDP + ch * 8);
        if (!first) {
            const uint4 g = gq[i];
            w.x = cvtpk(__uint_as_float(w.x << 16) + __uint_as_float(g.x << 16), __uint_as_float(w.x & 0xFFFF0000u) + __uint_as_float(g.x & 0xFFFF0000u));
            w.y = cvtpk(__uint_as_float(w.y << 16) + __uint_as_float(g.y << 16), __uint_as_float(w.y & 0xFFFF0000u) + __uint_as_float(g.y & 0xFFFF0000u));
            w.z = cvtpk(__uint_as_float(w.z << 16) + __uint_as_float(g.z << 16), __uint_as_float(w.z & 0xFFFF0000u) + __uint_as_float(g.z & 0xFFFF0000u));
            w.w = cvtpk(__uint_as_float(w.w << 16) + __uint_as_float(g.w << 16), __uint_as_float(w.w & 0xFFFF0000u) + __uint_as_float(g.w & 0xFFFF0000u));
        }
        *gp = w;
    }
}

struct Src { const bf16_t* K; const bf16_t* V; int stride; };

template <int MODE>
__device__ __forceinline__ void branch(const Src s, char* lds, const bf16x8* qr, f32x16* o, float& m, float& l, int NTL, int jbase, int t, int qb, int wid, int lane, int tid,
                                       const unsigned (&selw)[4], float inv_l) {
    const int r32 = lane & 31, hi = lane >> 5, rh = wid >> 1, iq = (wid & 1) * 32 + r32;
    char* V_lds = lds + L_V; char* K_lds = lds + L_K;
    float* al_l = (float*)(lds + L_WS) + wid * 64 + 32;
    const float* lut = (const float*)(lds + L_LUT) + rh * 128;
    const int* tl = (const int*)(lds + L_TL);
    float* impL = (float*)(lds + L_IMP);
    const int vb0 = (int)(uintptr_t)V_lds + v_rd_base(lane);
    const float cb = lut[127];
    constexpr bool HASV = MODE != 0;
    LAS unsigned char* ldsl = (LAS unsigned char*)lds;
#define TILE_OF(n) (MODE == 2 ? tl[n] : jbase + (n))
#define DMA(j, bf) do { const bf16_t* kt_ = s.K + (size_t)(j) * 64 * s.stride; const bf16_t* vt_ = s.V + (size_t)(j) * 64 * s.stride; \
        int ln_ = lane; asm volatile("" : "+v"(ln_));        \
        _Pragma("unroll") for (int i_ = 0; i_ < 2; ++i_) { \
            const int row_ = i_ * 32 + wid * 4 + (ln_ >> 4), srcch_ = (ln_ & 15) ^ (row_ & 7); \
            __builtin_amdgcn_global_load_lds((const unsigned*)(kt_ + (row_ * s.stride + srcch_ * 8)), (LAS unsigned*)(ldsl + L_K + (bf) * SHM_K + i_ * 8192 + wid * 1024), 16, 0, 0); \
            if (HASV) { const int kk_ = (i_ * 4 + (wid >> 1)) * 8 + ((ln_ & 31) >> 2), k_ = (kk_ & ~0xC) | ((kk_ & 4) << 1) | ((kk_ & 8) >> 1), cc_ = ((wid & 1) * 2 + (ln_ >> 5)) * 32 + (ln_ & 3) * 8; \
                __builtin_amdgcn_global_load_lds((const unsigned*)(vt_ + (k_ * s.stride + cc_)), (LAS unsigned*)(ldsl + L_V + (bf) * SHM_V + i_ * 8192 + wid * 1024), 16, 0, 0); } } } while (0)
#define COMPUTE(n, BF) do { const int j_ = TILE_OF(n); \
        bool act_ = true; bool rowsel_ = true; \
        if (MODE == 2) { const unsigned w_ = j_ < 32 ? selw[0] : j_ < 64 ? selw[1] : j_ < 96 ? selw[2] : selw[3]; rowsel_ = (w_ >> (j_ & 31)) & 1u; act_ = __any(rowsel_); } \
        if (act_) { f32x16 p0, p1; \
            qkt<BF>(p0, p1, K_lds, r32, hi, qr); \
              \
            const bool plain_ = MODE >= 2 && (qb - j_ > 2) && !(MODE == 3 && j_ == qb - 8); \
            float sc_ = C2, cb_ = cb; bool sel_ = rowsel_; \
            if (!plain_) { sc_ = 1.f; cb_ = 0.f; sel_ = true; \
                if (MODE <= 1) { \
                    if (64 * j_ + 63 >= 4 * qb - 10) bias_near<16>(p0, p1, t - 31 - 16 * (64 * j_ + 4 * hi), lut); else bias_const(p0, p1, cb); \
                    if (64 * j_ + 63 > ((64 * qb - 31) >> 4)) mask_tile(p0, p1, ((t - 31) >> 4) - 64 * j_ - 4 * hi, 1u << 30); \
                } else { \
                    bias_near<1>(p0, p1, t - 64 * j_ - 4 * hi, lut); \
                    if (MODE == 2) { if (j_ == qb) mask_tile(p0, p1, t - 64 * j_ - 4 * hi, 1u << 30); \
                        if (!rowsel_) { const float NEG_ = -__builtin_inff(); _Pragma("unroll") for (int r = 0; r < 16; ++r) { p0[r] = NEG_; p1[r] = NEG_; } } } \
                    else { if (j_ == qb || j_ == qb - 8) mask_tile(p0, p1, t - 64 * j_ - 4 * hi, 512u); } \
                } \
            } \
            if (MODE == 1) { \
                _Pragma("unroll") for (int r = 0; r < 16; ++r) { p0[r] = __builtin_amdgcn_exp2f(p0[r] - m) * inv_l; p1[r] = __builtin_amdgcn_exp2f(p1[r] - m) * inv_l; } \
                _Pragma("unroll") for (int a = 0; a < 4; ++a) { \
                    const int jj0 = 16 * j_ + 2 * a + hi, jj1 = jj0 + 8; \
                    atomicAdd(&impL[iq * 128 + jj0], p0[4 * a] + p0[4 * a + 1] + p0[4 * a + 2] + p0[4 * a + 3]); \
                    atomicAdd(&impL[iq * 128 + jj1], p1[4 * a] + p1[4 * a + 1] + p1[4 * a + 2] + p1[4 * a + 3]); \
                    if (jj0 + 1 < 128) atomicAdd(&impL[iq * 128 + jj0 + 1], p0[4 * a + 3]); \
                    if (jj1 + 1 < 128) atomicAdd(&impL[iq * 128 + jj1 + 1], p1[4 * a + 3]); } \
            } else { float alpha_; softmax_online(p0, p1, sc_, cb_, sel_, m, l, alpha_); if (MODE != 0) rescale_o(o, alpha_, al_l, r32, hi); } \
            if (MODE != 0) { bf16x8 pa0, pa1, pa2, pa3; pack_p(p0, p1, pa0, pa1, pa2, pa3); pv_tile<BF>(o, vb0, pa0, pa1, pa2, pa3); } \
        } } while (0)
#define STEP(n, BF) do { \
        if ((n) + 1 < NTL) DMA(TILE_OF((n) + 1), 1 - (BF)); \
        SBAR(); COMPUTE(n, BF); SBAR(); \
        asm volatile("s_waitcnt vmcnt(0)" ::: "memory"); \
        __syncthreads(); } while (0)
    if (NTL > 0) {
        DMA(TILE_OF(0), 0); asm volatile("s_waitcnt vmcnt(0)" ::: "memory");
        __syncthreads();
        for (int n = 0; n < NTL; n += 2) { STEP(n, 0); if (n + 1 < NTL) STEP(n + 1, 1); }
    }
#undef TILE_OF
#undef DMA
#undef COMPUTE
#undef STEP
}

__device__ __forceinline__ void item(unsigned char* ws, int b, int g, int qb, char* lds) {
    const int tid = tid_(), wid = __builtin_amdgcn_readfirstlane(tid >> 6), lane = tid & 63, r32 = lane & 31, hi = lane >> 5, rh = wid >> 1, iq = (wid & 1) * 32 + r32;
    const int t = qb * 64 + iq, head = g * 4 + rh;
    bf16_t* proj = (bf16_t*)(ws + OFF_PROJ);
    const size_t tok0 = (size_t)b * T_;
    float* impL = (float*)(lds + L_IMP); unsigned* selL = (unsigned*)(lds + L_SEL); unsigned* uniL = (unsigned*)(lds + L_UNI); int* tl = (int*)(lds + L_TL);
    for (int i = tid; i < 64 * 128; i += 512) impL[i] = 0.f;
    if (tid < 4) uniL[tid] = 0u;
    { const float* lutg = (const float*)(ws + OFF_LUT) + (g * 4) * 128; ((float*)(lds + L_LUT))[tid] = lutg[tid] * LOG2E; }
    bf16x8 qr[8];
    { const bf16_t* qp = proj + (tok0 + t) * LDP + C_NQ + head * 128 + hi * 8;
#pragma unroll
      for (int d0 = 0; d0 < 8; ++d0) qr[d0] = *(const bf16x8*)(qp + d0 * 16); }
    unsigned selw[4] = {0u, 0u, 0u, 0u};
    f32x16 o[4];
    __syncthreads();
    {
        const Src s{(const bf16_t*)(ws + OFF_KCMP) + (size_t)(b * 2 + g) * 512 * 128, (const bf16_t*)(ws + OFF_VCMP) + (size_t)(b * 2 + g) * 512 * 128, 128};
        const int nct = ((4 * qb + 2) >> 6) + 1;
        float m = -1e30f, l = 0.f;
        branch<0>(s, lds, qr, o, m, l, nct, 0, t, qb, wid, lane, tid, selw, 0.f);
#pragma unroll
        for (int d = 0; d < 4; ++d) o[d] = f32x16{};
        const float inv_l = l > 0.f ? 1.f / l : 0.f;
        branch<1>(s, lds, qr, o, m, l, nct, 0, t, qb, wid, lane, tid, selw, inv_l);
        flush_out(o, 1.f, 0, ws, lds, b, g, qb, wid, lane, true);
    }
    __syncthreads();
    {
        const int q = wid * 8 + (lane >> 3), sub = lane & 7;
        unsigned m0 = 0u, m1 = 0u, m2 = 0u, m3 = 0u;
        if (qb <= 15) { m0 = qb == 31 ? 0xFFFFFFFFu : ((1u << (qb + 1)) - 1u); }
        else {
            unsigned key[16];
#pragma unroll
            for (int k = 0; k < 16; ++k) { const int j = sub * 16 + k; key[k] = (j >= 1 && j <= qb - 2) ? ((__float_as_uint(impL[q * 128 + j]) & ~0x7Fu) | (unsigned)(127 - j)) : 0u; }
            for (int it = 0; it < 13; ++it) {
                unsigned lm = key[0];
#pragma unroll
                for (int k = 1; k < 16; ++k) lm = lm > key[k] ? lm : key[k];
                unsigned gm = lm, x;
                x = (unsigned)__builtin_amdgcn_update_dpp(0, (int)gm, 0xB1, 0xF, 0xF, true); gm = gm > x ? gm : x;
                x = (unsigned)__builtin_amdgcn_update_dpp(0, (int)gm, 0x4E, 0xF, 0xF, true); gm = gm > x ? gm : x;
                x = (unsigned)__builtin_amdgcn_update_dpp(0, (int)gm, 0x141, 0xF, 0xF, true); gm = gm > x ? gm : x;
#pragma unroll
                for (int k = 0; k < 16; ++k) key[k] = key[k] == gm ? 0u : key[k];
                const int j = 127 - (int)(gm & 0x7Fu);
                const unsigned bit = 1u << (j & 31);
                m0 |= j < 32 ? bit : 0u; m1 |= (j >= 32 && j < 64) ? bit : 0u; m2 |= (j >= 64 && j < 96) ? bit : 0u; m3 |= j >= 96 ? bit : 0u;
            }
            m0 |= 1u;
            { const int j = qb; const unsigned bit = 1u << (j & 31); m0 |= j < 32 ? bit : 0u; m1 |= (j >= 32 && j < 64) ? bit : 0u; m2 |= (j >= 64 && j < 96) ? bit : 0u; m3 |= j >= 96 ? bit : 0u; }
            { const int j = qb - 1; const unsigned bit = 1u << (j & 31); m0 |= j < 32 ? bit : 0u; m1 |= (j >= 32 && j < 64) ? bit : 0u; m2 |= (j >= 64 && j < 96) ? bit : 0u; m3 |= j >= 96 ? bit : 0u; }
        }
        if (sub == 0) { selL[q * 4 + 0] = m0; selL[q * 4 + 1] = m1; selL[q * 4 + 2] = m2; selL[q * 4 + 3] = m3;
                        atomicOr(&uniL[0], m0); atomicOr(&uniL[1], m1); atomicOr(&uniL[2], m2); atomicOr(&uniL[3], m3); }
    }
    __syncthreads();
    int nsl = 0;
    {
        if (wid == 0) {
            const bool s0 = lane <= qb && ((uniL[lane >> 5] >> (lane & 31)) & 1u), s1 = lane + 64 <= qb && ((uniL[2 + (lane >> 5)] >> (lane & 31)) & 1u);
            const unsigned long long b0 = __ballot(s0), b1 = __ballot(s1), below = (1ull << lane) - 1ull;
            const int n0 = __popcll(b0);
            if (s0) tl[__popcll(b0 & below)] = lane;
            if (s1) tl[n0 + __popcll(b1 & below)] = lane + 64;
            if (lane == 0) tl[128] = n0 + __popcll(b1);
        }
        selw[0] = selL[iq * 4 + 0]; selw[1] = selL[iq * 4 + 1]; selw[2] = selL[iq * 4 + 2]; selw[3] = selL[iq * 4 + 3];
        __syncthreads();
        nsl = tl[128];
    }
    {
        const Src s{proj + tok0 * LDP + C_KS + g * 128, proj + tok0 * LDP + C_VS + g * 128, LDP};
        float m = -1e30f, l = 0.f;
#pragma unroll
        for (int d = 0; d < 4; ++d) o[d] = f32x16{};
        branch<2>(s, lds, qr, o, m, l, nsl, 0, t, qb, wid, lane, tid, selw, 0.f);
        flush_out(o, l, 1, ws, lds, b, g, qb, wid, lane, false);
    }
    __syncthreads();
    {
        const Src s{proj + tok0 * LDP + C_KW + g * 128, proj + tok0 * LDP + C_VW + g * 128, LDP};
        const int jlo = qb >= 8 ? qb - 8 : 0;
        float m = -1e30f, l = 0.f;
#pragma unroll
        for (int d = 0; d < 4; ++d) o[d] = f32x16{};
        branch<3>(s, lds, qr, o, m, l, qb - jlo + 1, jlo, t, qb, wid, lane, tid, selw, 0.f);
        flush_out(o, l, 2, ws, lds, b, g, qb, wid, lane, false);
    }
    __syncthreads();
}
#undef KSWZ
#undef SBAR
}

__device__ void ph_hpre(const Params& p, int u) {
    const int tid = tid_(), b = u >> 8, n = u & 255, c2 = tid * 2;
    char* proj = (char*)(p.ws + OFF_PROJ) + (size_t)(b * T_ + n * 32) * (LDP * 2);
    const unsigned vo = (unsigned)c2 * 2u;
    const float* lb = (const float*)(p.ws + OFF_LB);
    const float kb0 = 1.f - lb[c2], kb1 = 1.f - lb[c2 + 1];
    float b0[32], b1[32];
    unsigned wf[32], wq[32];
#pragma unroll
    for (int i = 0; i < 32; ++i) wf[i] = *(const unsigned*)(proj + ((size_t)i * (LDP * 2) + C_HF * 2) + vo);
#pragma unroll
    for (int i = 0; i < 32; ++i) wq[i] = *(const unsigned*)(proj + ((size_t)i * (LDP * 2) + C_HQ * 2) + vo);
    float s0 = 1.f, s1 = 1.f;
#pragma unroll
    for (int i = 0; i < 32; ++i) {
        const float r0 = __uint_as_float(wf[i] << 16), r1 = __uint_as_float(wf[i] & 0xFFFF0000u);
        const float k0 = kb0 * sigmoidf_(-r0), k1 = kb1 * sigmoidf_(-r1);
        s0 *= 1.f - k0; s1 *= 1.f - k1;
        b0[i] = s0; b1[i] = s1;
        wf[i] = pg8::cvt_pk_bf16(k0, k1);
    }
    const float il0 = __builtin_amdgcn_rcpf(fmaxf(s0, 1e-30f)), il1 = __builtin_amdgcn_rcpf(fmaxf(s1, 1e-30f));
#pragma unroll
    for (int i = 0; i < 32; ++i) {
        const float k0 = __uint_as_float(wf[i] << 16), k1 = __uint_as_float(wf[i] & 0xFFFF0000u);
        const float q0 = __uint_as_float(wq[i] << 16), q1 = __uint_as_float(wq[i] & 0xFFFF0000u);
        const float e0 = s0 * __builtin_amdgcn_rcpf(fmaxf(b0[i], 1e-30f)), e1 = s1 * __builtin_amdgcn_rcpf(fmaxf(b1[i], 1e-30f));
        unsigned long long ro = (unsigned long long)i * (LDP * 2); asm volatile("" : "+s"(ro));
        char* rp = proj + ro + vo;
        *(unsigned*)(rp + C_HQ * 2) = pg8::cvt_pk_bf16(q0 * (b0[i] * il0), q1 * (b1[i] * il1));
        *(unsigned*)(rp + C_HF * 2) = pg8::cvt_pk_bf16(k0 * e0, k1 * e1);
    }
    float* dec = (float*)(p.ws + OFF_DEC) + ((size_t)((b * 8 + (c2 >> 7)) * 256 + n)) * 256 + (c2 & 127);
    dec[0] = s0; dec[1] = s1;
}

namespace hg {
typedef short bf16x8 __attribute__((ext_vector_type(8)));
typedef short s16x4 __attribute__((ext_vector_type(4)));
typedef float f32x4 __attribute__((ext_vector_type(4)));
typedef unsigned u32x4 __attribute__((ext_vector_type(4)));
constexpr int BUF = 25600, L_QA = 0, L_KE = 8192, L_VV = 16384, L_DEC = 24576, L_OB = 51200, OBS = 132;
__device__ __forceinline__ unsigned off_b(unsigned row, unsigned ch) { return 256u * row + 16u * (ch ^ (((row & 3) << 2) | ((row >> 2) & 3))); }
__device__ __forceinline__ unsigned tr_addr16(unsigned lane, unsigned c, unsigned t) {
    const unsigned g = lane >> 4, q = (lane & 15) >> 2, pp = lane & 3;
    return off_b(8 * g + 4 * t + q, 2 * c + (pp >> 1)) + 8 * (pp & 1);
}
__device__ __forceinline__ unsigned cvtpk(float lo, float hi) { unsigned r; asm volatile("v_cvt_pk_bf16_f32 %0, %1, %2" : "=v"(r) : "v"(lo), "v"(hi)); return r; }
__device__ __forceinline__ bf16x8 pack8(f32x4 a, f32x4 b) { u32x4 w = {cvtpk(a[0], a[1]), cvtpk(a[2], a[3]), cvtpk(b[0], b[1]), cvtpk(b[2], b[3])}; return *reinterpret_cast<bf16x8*>(&w); }
__device__ __forceinline__ s16x4 tr_read(unsigned addr) { s16x4 r; asm volatile("ds_read_b64_tr_b16 %0, %1" : "=v"(r) : "v"(addr) : "memory"); return r; }

__device__ __forceinline__ void item(unsigned char* ws, const float* norm_w, int b, int h, char* lds) {
    const int tid = tid_(), wid = __builtin_amdgcn_readfirstlane(tid >> 6), lane = tid & 63, l15 = lane & 15, g = lane >> 4;
    bf16_t* proj = (bf16_t*)(ws + OFF_PROJ) + (size_t)b * T_ * LDP + h * 128;
    const float* decg = (const float*)(ws + OFF_DEC) + (size_t)(b * 8 + h) * 256 * 256;
    LAS unsigned char* ldsl = (LAS unsigned char*)lds;
    const unsigned ldsb = (unsigned)(uintptr_t)lds;
    const int drow = 4 * wid + (lane >> 4);
    const unsigned dsrc = (unsigned)(drow * LDP + (((lane & 15) ^ (((drow & 3) << 2) | ((drow >> 2) & 3))) * 8));
#define HDMA(n, bf) do { const bf16_t* cp_ = proj + (size_t)(n) * 32 * LDP + dsrc; \
        __builtin_amdgcn_global_load_lds((const unsigned*)(cp_ + C_HQ), (LAS unsigned*)(ldsl + (bf) * BUF + L_QA + wid * 1024), 16, 0, 0); \
        __builtin_amdgcn_global_load_lds((const unsigned*)(cp_ + C_HF), (LAS unsigned*)(ldsl + (bf) * BUF + L_KE + wid * 1024), 16, 0, 0); \
        __builtin_amdgcn_global_load_lds((const unsigned*)(cp_ + C_HI), (LAS unsigned*)(ldsl + (bf) * BUF + L_VV + wid * 1024), 16, 0, 0); \
        if (wid == 0) __builtin_amdgcn_global_load_lds((const unsigned*)(decg + (size_t)(n) * 256 + lane * 4), (LAS unsigned*)(ldsl + (bf) * BUF + L_DEC), 16, 0, 0); } while (0)
    unsigned a_ke[2], a_qa[2], a_qp[2], a_vt[2];
#pragma unroll
    for (int x = 0; x < 2; ++x) {
        a_ke[x] = off_b(8 * (l15 >> 2) + 4 * x + (l15 & 3), g);
        a_qa[x] = off_b(16 * x + l15, g);
        a_qp[x] = off_b(16 * x + l15, g >> 1) + 8 * (g & 1);
        a_vt[x] = tr_addr16(lane, wid, x);
    }
    const int ntok = tid >> 4, ndv = (tid & 15) * 8;
    f32x4 S[8];
#pragma unroll
    for (int i = 0; i < 8; ++i) S[i] = (f32x4){0.f, 0.f, 0.f, 0.f};
    float* obuf = (float*)(lds + L_OB);
    HDMA(0, 0); asm volatile("s_waitcnt vmcnt(0)" ::: "memory");
    __syncthreads();
    for (int n = 0; n < 256; ++n) {
        const int bf = n & 1;
        if (n + 1 < 256) HDMA(n + 1, bf ^ 1);
        const u32x4 hgw = *(const u32x4*)(proj + (size_t)(n * 32 + ntok) * LDP + C_HG + ndv);
        const unsigned B0 = ldsb + bf * BUF;
        f32x4 att[2][2];
#pragma unroll
        for (int x = 0; x < 2; ++x)
#pragma unroll
            for (int y = 0; y < 2; ++y) att[x][y] = (f32x4){0.f, 0.f, 0.f, 0.f};
#pragma unroll
        for (int ks = 0; ks < 4; ++ks) {
            bf16x8 ka[2], qb[2];
#pragma unroll
            for (int x = 0; x < 2; ++x) {
                const unsigned rj = 8 * (l15 >> 2) + 4 * x + (l15 & 3), ri = 16 * x + l15;
                ka[x] = *(const LAS bf16x8*)(uintptr_t)(B0 + L_KE + off_b(rj, 4 * ks + g));
                qb[x] = *(const LAS bf16x8*)(uintptr_t)(B0 + L_QA + off_b(ri, 4 * ks + g));
            }
#pragma unroll
            for (int x = 0; x < 2; ++x)
#pragma unroll
                for (int y = 0; y < 2; ++y) att[x][y] = __builtin_amdgcn_mfma_f32_16x16x32_bf16(ka[x], qb[y], att[x][y], 0, 0, 0);
        }
        bf16x8 attf[2];
#pragma unroll
        for (int y = 0; y < 2; ++y) {
            const int i = 16 * y + l15;
            f32x4 a0 = att[0][y], a1 = att[1][y];
#pragma unroll
            for (int r = 0; r < 4; ++r) { if (8 * g + r > i) a0[r] = 0.f; if (8 * g + 4 + r > i) a1[r] = 0.f; }
            attf[y] = pack8(a0, a1);
        }
        bf16x8 vf;
        { const s16x4 v0 = tr_read(B0 + L_VV + a_vt[0]), v1 = tr_read(B0 + L_VV + a_vt[1]);
          asm volatile("s_waitcnt lgkmcnt(0)" ::: "memory");
          vf = (bf16x8){v0[0], v0[1], v0[2], v0[3], v1[0], v1[1], v1[2], v1[3]}; }
        f32x4 o[2];
#pragma unroll
        for (int y = 0; y < 2; ++y) o[y] = __builtin_amdgcn_mfma_f32_16x16x32_bf16(vf, attf[y], (f32x4){0.f, 0.f, 0.f, 0.f}, 0, 0, 0);
#pragma unroll
        for (int dt = 0; dt < 8; ++dt) { const f32x4 d = *(const LAS f32x4*)(uintptr_t)(B0 + L_DEC + (16 * dt + 4 * g) * 4); S[dt] *= d; }
#pragma unroll
        for (int ks = 0; ks < 4; ++ks) {
            const bf16x8 sa = pack8(S[2 * ks], S[2 * ks + 1]);
#pragma unroll
            for (int y = 0; y < 2; ++y) {
                const unsigned ri = 16 * y + l15;
                const unsigned long long q0 = *(const LAS unsigned long long*)(uintptr_t)(B0 + L_QA + off_b(ri, 4 * ks + (g >> 1)) + 8 * (g & 1));
                const unsigned long long q1 = *(const LAS unsigned long long*)(uintptr_t)(B0 + L_QA + off_b(ri, 4 * ks + 2 + (g >> 1)) + 8 * (g & 1));
                u32x4 w = {(unsigned)q0, (unsigned)(q0 >> 32), (unsigned)q1, (unsigned)(q1 >> 32)};
                o[y] = __builtin_amdgcn_mfma_f32_16x16x32_bf16(sa, *reinterpret_cast<bf16x8*>(&w), o[y], 0, 0, 0);
            }
        }
#pragma unroll
        for (int dt = 0; dt < 8; ++dt) {
            const s16x4 k0 = tr_read(B0 + L_KE + tr_addr16(lane, dt, 0)), k1 = tr_read(B0 + L_KE + tr_addr16(lane, dt, 1));
            asm volatile("s_waitcnt lgkmcnt(0)" ::: "memory");
            const bf16x8 kf = (bf16x8){k0[0], k0[1], k0[2], k0[3], k1[0], k1[1], k1[2], k1[3]};
            S[dt] = __builtin_amdgcn_mfma_f32_16x16x32_bf16(kf, vf, S[dt], 0, 0, 0);
        }
#pragma unroll
        for (int y = 0; y < 2; ++y) *(f32x4*)(obuf + (16 * y + l15) * OBS + 16 * wid + 4 * g) = o[y];
        __syncthreads();
        {
            const f32x4 x0 = *(const f32x4*)(obuf + ntok * OBS + ndv), x1 = *(const f32x4*)(obuf + ntok * OBS + ndv + 4);
            float ss = x0[0] * x0[0] + x0[1] * x0[1] + x0[2] * x0[2] + x0[3] * x0[3] + x1[0] * x1[0] + x1[1] * x1[1] + x1[2] * x1[2] + x1[3] * x1[3];
            ss += __shfl_xor(ss, 1); ss += __shfl_xor(ss, 2); ss += __shfl_xor(ss, 4); ss += __shfl_xor(ss, 8);
            const float r = rsqrtf(ss * (1.f / 128.f) + 1e-6f);
            const float gv[8] = {__uint_as_float(hgw.x << 16), __uint_as_float(hgw.x & 0xFFFF0000u), __uint_as_float(hgw.y << 16), __uint_as_float(hgw.y & 0xFFFF0000u),
                                 __uint_as_float(hgw.z << 16), __uint_as_float(hgw.z & 0xFFFF0000u), __uint_as_float(hgw.w << 16), __uint_as_float(hgw.w & 0xFFFF0000u)};
            const float xv[8] = {x0[0], x0[1], x0[2], x0[3], x1[0], x1[1], x1[2], x1[3]};
            const f32x4 n0 = *(const f32x4*)(norm_w + h * 128 + ndv), n1 = *(const f32x4*)(norm_w + h * 128 + ndv + 4);
            const float nw[8] = {n0[0], n0[1], n0[2], n0[3], n1[0], n1[1], n1[2], n1[3]};
            float ov[8];
#pragma unroll
            for (int i = 0; i < 8; ++i) ov[i] = xv[i] * r * nw[i] * sigmoidf_(gv[i]);
            u32x4 w = {cvtpk(ov[0], ov[1]), cvtpk(ov[2], ov[3]), cvtpk(ov[4], ov[5]), cvtpk(ov[6], ov[7])};
            *(u32x4*)(proj + (size_t)(n * 32 + ntok) * LDP + C_HI + ndv) = w;
        }
        asm volatile("s_waitcnt vmcnt(0)" ::: "memory");
        __syncthreads();
    }
#undef HDMA
    (void)a_ke; (void)a_qa; (void)a_qp;
}
}

__device__ void cvt_tile(float* sm, const float* src, int ldsrc, int k0, int ns0, int nvalid, bf16_t* dst, int lddst, int nd0) {
    float(*t)[65] = (float(*)[65])sm;
    const int tid = tid_();
    float4 v[8];
#pragma unroll
    for (int r = 0; r < 8; ++r) {
        const int idx = tid + r * 512, k = idx >> 4, n4 = (idx & 15) * 4;
        v[r] = n4 < nvalid ? *(const float4*)(src + (size_t)(k0 + k) * ldsrc + ns0 + n4) : make_float4(0.f, 0.f, 0.f, 0.f);
    }
#pragma unroll
    for (int r = 0; r < 8; ++r) {
        const int idx = tid + r * 512, k = idx >> 4, n4 = (idx & 15) * 4;
        t[k][n4] = v[r].x; t[k][n4 + 1] = v[r].y; t[k][n4 + 2] = v[r].z; t[k][n4 + 3] = v[r].w;
    }
    __syncthreads();
#pragma unroll
    for (int r = 0; r < 4; ++r) {
        const int idx = tid + r * 512, kg = idx & 31, n = idx >> 5;
        uint4 w;
        w.x = (unsigned)f2bf(t[kg * 8 + 0][n]) | ((unsigned)f2bf(t[kg * 8 + 1][n]) << 16); w.y = (unsigned)f2bf(t[kg * 8 + 2][n]) | ((unsigned)f2bf(t[kg * 8 + 3][n]) << 16);
        w.z = (unsigned)f2bf(t[kg * 8 + 4][n]) | ((unsigned)f2bf(t[kg * 8 + 5][n]) << 16); w.w = (unsigned)f2bf(t[kg * 8 + 6][n]) | ((unsigned)f2bf(t[kg * 8 + 7][n]) << 16);
        *(uint4*)(dst + (size_t)(nd0 + n) * lddst + k0 + kg * 8) = w;
    }
    __syncthreads();
}
__device__ __forceinline__ int gemm1_src_col(int nd) { return nd < 6656 ? nd : nd < 8704 ? nd + 24 : nd < 8728 ? 6656 + (nd - 8704) : -1; }
__device__ void ph_cvt_win(const Params& p, int u, float* sm) {
    if (u < 560) {
        const int nt = u >> 2, kt = u & 3, nd0 = nt * 64;
        const int ns0 = nd0 < 6656 ? nd0 : nd0 < 8704 ? nd0 + 24 : 6656, nvalid = nd0 < 8704 ? 64 : nd0 == 8704 ? 24 : 0;
        cvt_tile(sm, p.w_in, DIN, kt * 256, ns0, nvalid, (bf16_t*)(p.ws + OFF_WINT), 1024, nd0);
    } else {
        float* b1 = (float*)(p.ws + OFF_BIAS1);
        for (int i = tid_(); i < N1; i += 512) { const int s = gemm1_src_col(i); b1[i] = s >= 0 ? p.b_in[s] : 0.f; }
    }
}
__device__ void ph_cvt_br(const Params& p, int u, float* sm) {
    const int w = u >> 6, t = u & 63, nt = t >> 2, kt = t & 3;
    if (w < 2) cvt_tile(sm, w == 0 ? p.w_br_hg : p.w_br_nsa, 1024, kt * 256, nt * 64, 64, (bf16_t*)(p.ws + OFF_WBRH) + w * 1024, 2048, nt * 64);
    else cvt_tile(sm, p.w_out, 1024, kt * 256, nt * 64, 64, (bf16_t*)(p.ws + OFF_WOUTT), 1024, nt * 64);
}
__device__ void ph_cvt_exp(const Params& p, int u, float* sm) {
    if (u < 2048) {
        const int e = u >> 6, t = u & 63, nt = t >> 2, kt = t & 3, nd0 = nt * 64, pn = nd0 >> 8, half = (nd0 >> 7) & 1, off = nd0 & 127;
        cvt_tile(sm, (half ? p.e_w3 : p.e_w1) + (size_t)e * 1024 * 512, 512, kt * 256, pn * 128 + off, 64, (bf16_t*)(p.ws + OFF_E13) + (size_t)e * 1024 * 1024, 1024, nd0);
    } else {
        const int v = u - 2048, e = v >> 5, t = v & 31, nt = t >> 1, kt = t & 1;
        cvt_tile(sm, p.e_w2 + (size_t)e * 512 * 1024, 1024, kt * 256, nt * 64, 64, (bf16_t*)(p.ws + OFF_E2T) + (size_t)e * 1024 * 512, 512, nt * 64);
    }
}
enum { PH_PRO = 0, PH_LN0, PH_CMP2, PH_FINAL };
__host__ __device__ constexpr int phase_units(int ph) { return ph == PH_PRO ? 99 : ph == PH_LN0 ? NT / 16 : ph == PH_CMP2 ? 64 : ph == PH_FINAL ? NT / 16 : 0; }

__device__ void ph_pro(const Params& p, int u, float* sm) {
    const int tid = tid_();
    float* mod = (float*)(p.ws + OFF_MOD);
    if (u < 96) {
        float* ca = sm;
        float* red = sm + 4096;
        for (int i = tid; i < 4096; i += 512) ca[i] = siluf_(p.c[i]);
        __syncthreads();
        const int col = u * 64 + (tid & 63), kg = tid >> 6;
        float a0 = 0.f, a1 = 0.f, a2 = 0.f, a3 = 0.f;
        for (int k = kg * 128; k < kg * 128 + 128; ++k) {
            const float w = p.ada_w[(size_t)k * 6144 + col];
            a0 = fmaf(ca[k], w, a0); a1 = fmaf(ca[1024 + k], w, a1); a2 = fmaf(ca[2048 + k], w, a2); a3 = fmaf(ca[3072 + k], w, a3);
        }
        red[(kg * 64 + (tid & 63)) * 4 + 0] = a0; red[(kg * 64 + (tid & 63)) * 4 + 1] = a1; red[(kg * 64 + (tid & 63)) * 4 + 2] = a2; red[(kg * 64 + (tid & 63)) * 4 + 3] = a3;
        __syncthreads();
        if (tid < 256) {
            const int cl = tid & 63, b = tid >> 6;
            float s = 0.f;
            for (int g = 0; g < 8; ++g) s += red[(g * 64 + cl) * 4 + b];
            mod[b * 6144 + u * 64 + cl] = s + p.ada_b[u * 64 + cl];
        }
        __syncthreads();
    } else if (u == 96) {
        float* lb = (float*)(p.ws + OFF_LB);
        float* lut = (float*)(p.ws + OFF_LUT);
        unsigned* cnt = (unsigned*)(p.ws + OFF_CNT);
        for (int i = tid; i < 1024; i += 512) {
            const float l0 = p.lb_logits[i], l1 = p.lb_logits[1024 + i];
            lb[i] = 1.f / (1.f + __expf(l1 - l0));
            const int h = i >> 7, d = i & 127;
            lut[i] = p.rel_bias[h * 32 + rel_bucket(d)];
        }
        if (tid < 64) cnt[tid] = 0u;
        if (tid < 8) ((unsigned*)(p.ws + OFF_QCTR))[tid * 64] = 0u;
        { bf16_t* kc = (bf16_t*)(p.ws + OFF_KCMP); bf16_t* vc = (bf16_t*)(p.ws + OFF_VCMP);
          for (int i = tid; i < 8 * 128; i += 512) { kc[(size_t)((i >> 7) * 512 + 511) * 128 + (i & 127)] = 0; vc[(size_t)((i >> 7) * 512 + 511) * 128 + (i & 127)] = 0; } }
    } else {
        const int kv = u - 97;
        float* cb = (float*)(p.ws + OFF_CB) + kv * 128;
        if (tid < 128) cb[tid] = (kv ? p.b1_v : p.b1_k)[tid];
    }
}
__device__ void ph_cmpconst(const Params& p, int u, float* sm) {
    const int tid = tid_(), kv = u >> 5, kc = u & 31;
    const float* pos = kv ? p.pos_v : p.pos_k; const float* w1 = kv ? p.w1_v : p.w1_k;
    const int n = tid & 127, kg = tid >> 7;
    float s = 0.f;
#pragma unroll 8
    for (int k = kc * 128 + kg * 32; k < kc * 128 + kg * 32 + 32; ++k) s = fmaf(pos[k], w1[(size_t)k * 128 + n], s);
    sm[kg * 128 + n] = s;
    __syncthreads();
    if (tid < 128) atomicAdd((float*)(p.ws + OFF_CB) + kv * 128 + tid, sm[tid] + sm[128 + tid] + sm[256 + tid] + sm[384 + tid]);
    __syncthreads();
}

__device__ void ph_ln0(const Params& p, int u) {
    const int tidx = tid_(), lane = tidx & 63;
    float4 v[2][4]; float s[2] = {0.f, 0.f}; int rowi[2];
#pragma unroll
    for (int k = 0; k < 2; ++k) {
        rowi[k] = (u + k * (NT / 16)) * 8 + (tidx >> 6);
        const float* xr = p.x + (size_t)rowi[k] * D_;
#pragma unroll
        for (int i = 0; i < 4; ++i) { v[k][i] = *(const float4*)(xr + (i * 64 + lane) * 4); s[k] += v[k][i].x + v[k][i].y + v[k][i].z + v[k][i].w; }
    }
#pragma unroll
    for (int k = 0; k < 2; ++k) {
        const float* mod = (const float*)(p.ws + OFF_MOD) + (rowi[k] / T_) * 6144;
        bf16_t* h = (bf16_t*)(p.ws + OFF_H) + (size_t)rowi[k] * D_;
        const float mu = wsum(s[k]) * (1.f / 1024.f);
        float q = 0.f;
#pragma unroll
        for (int i = 0; i < 4; ++i) { v[k][i].x -= mu; v[k][i].y -= mu; v[k][i].z -= mu; v[k][i].w -= mu; q += v[k][i].x * v[k][i].x + v[k][i].y * v[k][i].y + v[k][i].z * v[k][i].z + v[k][i].w * v[k][i].w; }
        const float rs = rsqrtf(wsum(q) * (1.f / 1024.f) + 1e-5f);
#pragma unroll
        for (int i = 0; i < 4; ++i) {
            const int c = (i * 64 + lane) * 4;
            const float4 sh = *(const float4*)(mod + c), sc = *(const float4*)(mod + 1024 + c);
            st_bf4(h + c, v[k][i].x * rs * (1.f + sc.x) + sh.x, v[k][i].y * rs * (1.f + sc.y) + sh.y, v[k][i].z * rs * (1.f + sc.z) + sh.z, v[k][i].w * rs * (1.f + sc.w) + sh.w);
        }
    }
}

__device__ void ph_cmp2(const Params& p, int u, float* sm) {
    const int tid = tid_(), kv = u >> 5, m0 = (u & 31) * 128;
    const float* w2 = kv ? p.w2_v : p.w2_k;
    const float* hid = (const float*)(p.ws + OFF_HID) + (size_t)kv * 4096 * 128;
    const float* cb = (const float*)(p.ws + OFF_CB) + kv * 128;
    bf16_t* dst = (bf16_t*)(p.ws + (kv ? OFF_VCMP : OFF_KCMP));
    float(*As)[132] = (float(*)[132])sm;
    float(*Bs)[132] = (float(*)[132])(sm + 128 * 132);
    float4 av[8], bv[8];
#pragma unroll
    for (int r = 0; r < 8; ++r) { const int idx = tid + r * 512, row = idx >> 5, k4 = (idx & 31) * 4; av[r] = *(const float4*)(hid + (size_t)(m0 + row) * 128 + k4); bv[r] = *(const float4*)(w2 + (size_t)row * 128 + k4); }
#pragma unroll
    for (int r = 0; r < 8; ++r) { const int idx = tid + r * 512, row = idx >> 5, k4 = (idx & 31) * 4;
        const float4 c4 = *(const float4*)(cb + k4);
        As[k4][row] = siluf_(av[r].x + c4.x); As[k4 + 1][row] = siluf_(av[r].y + c4.y); As[k4 + 2][row] = siluf_(av[r].z + c4.z); As[k4 + 3][row] = siluf_(av[r].w + c4.w);
        *(float4*)&Bs[row][k4] = bv[r]; }
    __syncthreads();
    const int tx = tid & 31, ty = tid >> 5;
    float acc[8][4];
#pragma unroll
    for (int i = 0; i < 8; ++i)
#pragma unroll
        for (int j = 0; j < 4; ++j) acc[i][j] = 0.f;
#pragma unroll 8
    for (int k = 0; k < 128; ++k) {
        const float4 a0 = *(const float4*)&As[k][ty * 8], a1 = *(const float4*)&As[k][ty * 8 + 4], bb = *(const float4*)&Bs[k][tx * 4];
        const float a_[8] = {a0.x, a0.y, a0.z, a0.w, a1.x, a1.y, a1.z, a1.w};
        const float b_[4] = {bb.x, bb.y, bb.z, bb.w};
#pragma unroll
        for (int i = 0; i < 8; ++i)
#pragma unroll
            for (int j = 0; j < 4; ++j) acc[i][j] = fmaf(a_[i], b_[j], acc[i][j]);
    }
#pragma unroll
    for (int i = 0; i < 8; ++i) {
        const int m = m0 + ty * 8 + i;
        const bool dead = (m & 511) == 511;
        st_bf4(dst + (size_t)m * 128 + tx * 4, dead ? 0.f : acc[i][0], dead ? 0.f : acc[i][1], dead ? 0.f : acc[i][2], dead ? 0.f : acc[i][3]);
    }
    __syncthreads();
}

constexpr int LR_A = 0, LR_AS = 1028, LR_P = 16 * LR_AS, LR_SLOT = LR_P + 8 * 16 * 48, LR_LC = LR_SLOT + 8 * 64;
struct Ln1rArgs { unsigned char* ws; const float *ln1_g, *ln1_b, *rg_b, *re_b; float* sm; };
struct Ln1rW { const float *rg_w, *re_w; };
#define GAS __attribute__((address_space(1)))
template <class T> __device__ __forceinline__ GAS T* gptr(T* q) { unsigned long long v = (unsigned long long)q; const unsigned lo = __builtin_amdgcn_readfirstlane((unsigned)v), hi = __builtin_amdgcn_readfirstlane((unsigned)(v >> 32)); return (GAS T*)(((unsigned long long)hi << 32) | lo); }
__device__ __forceinline__ void ph_ln1r_(const Ln1rArgs pa, const Ln1rW pw) {
    const int tidx = tid_(), lane = tidx & 63, w = tidx >> 6, n16 = lane & 15, kq = lane >> 4;
    GAS unsigned char* ws = gptr(pa.ws);
    const GAS float *ln1_g = gptr(pa.ln1_g), *ln1_b = gptr(pa.ln1_b), *rg_b = gptr(pa.rg_b), *re_b = gptr(pa.re_b), *rg_w = gptr(pw.rg_w), *re_w = gptr(pw.re_w);
    const int c = blockIdx.x, G = gridDim.x;
    LAS float* SM = (LAS float*)pa.sm;
    float bw[3][32];
#pragma unroll
    for (int sj = 0; sj < 32; ++sj) {
        const int k = 128 * w + 16 * (sj >> 2) + 4 * kq + (sj & 3);
        bw[0][sj] = re_w[k * 32 + n16]; bw[1][sj] = re_w[k * 32 + 16 + n16]; bw[2][sj] = rg_w[k * 4 + (n16 & 3)];
    }
#pragma unroll
    for (int sj = 0; sj < 32; ++sj) bw[2][sj] = n16 < 4 ? bw[2][sj] : 0.f;
    for (int u = c; u < NT / 16; u += G) {
        const int row0 = u * 16 + 2 * w, b = row0 / T_;
        const GAS float* mod = (const GAS float*)(ws + OFF_MOD) + b * 6144;
        float v[2][16]; float s[2] = {0.f, 0.f};
#pragma unroll
        for (int k = 0; k < 2; ++k) {
            const GAS float* zr = (const GAS float*)(ws + OFF_Z) + (size_t)(row0 + k) * D_;
#pragma unroll
            for (int i = 0; i < 4; ++i) { const pg8::f32x4 a = *(const GAS pg8::f32x4*)(zr + (i * 64 + lane) * 4); v[k][i * 4] = a[0]; v[k][i * 4 + 1] = a[1]; v[k][i * 4 + 2] = a[2]; v[k][i * 4 + 3] = a[3]; s[k] += a[0] + a[1] + a[2] + a[3]; }
        }
#pragma unroll
        for (int k = 0; k < 2; ++k) {
            asm volatile("" ::: "memory");
            GAS float* zr = (GAS float*)(ws + OFF_Z) + (size_t)(row0 + k) * D_;
            GAS bf16_t* h2 = (GAS bf16_t*)(ws + OFF_H) + (size_t)(row0 + k) * D_;
            float mu = wsum(s[k]) * (1.f / 1024.f), q = 0.f;
#pragma unroll
            for (int i = 0; i < 16; ++i) { v[k][i] -= mu; q = fmaf(v[k][i], v[k][i], q); }
            float rs = rsqrtf(wsum(q) * (1.f / 1024.f) + 1e-5f);
            float s2 = 0.f;
#pragma unroll
            for (int i = 0; i < 4; ++i) {
                const int cc = (i * 64 + lane) * 4;
                const pg8::f32x4 gg = *(const GAS pg8::f32x4*)(ln1_g + cc), bb = *(const GAS pg8::f32x4*)(ln1_b + cc);
                v[k][i * 4] = v[k][i * 4] * rs * gg[0] + bb[0]; v[k][i * 4 + 1] = v[k][i * 4 + 1] * rs * gg[1] + bb[1]; v[k][i * 4 + 2] = v[k][i * 4 + 2] * rs * gg[2] + bb[2]; v[k][i * 4 + 3] = v[k][i * 4 + 3] * rs * gg[3] + bb[3];
                *(GAS pg8::f32x4*)(zr + cc) = (pg8::f32x4){v[k][i * 4], v[k][i * 4 + 1], v[k][i * 4 + 2], v[k][i * 4 + 3]};
                s2 += v[k][i * 4] + v[k][i * 4 + 1] + v[k][i * 4 + 2] + v[k][i * 4 + 3];
            }
            mu = wsum(s2) * (1.f / 1024.f); q = 0.f;
#pragma unroll
            for (int i = 0; i < 16; ++i) { v[k][i] -= mu; q = fmaf(v[k][i], v[k][i], q); }
            rs = rsqrtf(wsum(q) * (1.f / 1024.f) + 1e-5f);
#pragma unroll
            for (int i = 0; i < 4; ++i) {
                const int cc = (i * 64 + lane) * 4;
                const pg8::f32x4 sh = *(const GAS pg8::f32x4*)(mod + 3072 + cc), sc = *(const GAS pg8::f32x4*)(mod + 4096 + cc);
                const pg8::f32x4 o = {v[k][i * 4] * rs * (1.f + sc[0]) + sh[0], v[k][i * 4 + 1] * rs * (1.f + sc[1]) + sh[1], v[k][i * 4 + 2] * rs * (1.f + sc[2]) + sh[2], v[k][i * 4 + 3] * rs * (1.f + sc[3]) + sh[3]};
                { pg8::u32x2 pk = {pk_bf16(o[0], o[1]), pk_bf16(o[2], o[3])}; *(GAS pg8::u32x2*)(h2 + cc) = pk; }
                *(LAS pg8::f32x4*)(SM + LR_A + (2 * w + k) * LR_AS + cc) = o;
            }
        }
        __syncthreads();
        {
            pg8::f32x4 acc[3] = {{0.f, 0.f, 0.f, 0.f}, {0.f, 0.f, 0.f, 0.f}, {0.f, 0.f, 0.f, 0.f}};
            const LAS float* ar = SM + LR_A + n16 * LR_AS + 128 * w + 4 * kq;
            pg8::f32x4 a4[8];
#pragma unroll
            for (int sI = 0; sI < 8; ++sI) a4[sI] = *(const LAS pg8::f32x4*)(ar + 16 * sI);
#pragma unroll
            for (int sI = 0; sI < 8; ++sI)
#pragma unroll
                for (int j = 0; j < 4; ++j)
#pragma unroll
                    for (int t = 0; t < 3; ++t) acc[t] = __builtin_amdgcn_mfma_f32_16x16x4f32(a4[sI][j], bw[t][sI * 4 + j], acc[t], 0, 0, 0);
            LAS float* pp = SM + LR_P + (w * 16 + 4 * kq) * 48 + n16;
#pragma unroll
            for (int t = 0; t < 3; ++t)
#pragma unroll
                for (int e = 0; e < 4; ++e) pp[e * 48 + 16 * t] = acc[t][e];
        }
        __syncthreads();
#pragma unroll 1
        for (int k = 0; k < 2; ++k) {
            const int row = row0 + k;
            LAS float* slot = SM + LR_SLOT + w * 64;
            {
                const int col = lane < 4 ? 32 + lane : lane - 4;
                const LAS float* pr = SM + LR_P + (2 * w + k) * 48 + (lane < 36 ? col : 0);
                float tot = 0.f;
#pragma unroll
                for (int ww = 0; ww < 8; ++ww) tot += pr[ww * 16 * 48];
                slot[lane] = tot;
            }
            asm volatile("s_waitcnt lgkmcnt(0)" ::: "memory");
            float lg[36];
#pragma unroll
            for (int q = 0; q < 9; ++q) { const pg8::f32x4 w4 = *(const LAS pg8::f32x4*)(slot + q * 4); lg[q * 4] = w4[0]; lg[q * 4 + 1] = w4[1]; lg[q * 4 + 2] = w4[2]; lg[q * 4 + 3] = w4[3]; }
            float gl[4];
#pragma unroll
            for (int j = 0; j < 4; ++j) gl[j] = lg[j] + rg_b[j];
            int gi = 0; float gm = gl[0];
#pragma unroll
            for (int j = 1; j < 4; ++j) if (gl[j] > gm) { gm = gl[j]; gi = j; }
            float gs = 0.f;
#pragma unroll
            for (int j = 0; j < 4; ++j) gs += __expf(gl[j] - gm);
            const float gp = 1.f / gs;
            float el[8];
#pragma unroll
            for (int i = 0; i < 8; ++i) el[i] = (gi == 0 ? lg[4 + i] : gi == 1 ? lg[12 + i] : gi == 2 ? lg[20 + i] : lg[28 + i]) + re_b[gi * 8 + i];
            int i0 = 0; float l0 = el[0];
#pragma unroll
            for (int i = 1; i < 8; ++i) if (el[i] > l0) { l0 = el[i]; i0 = i; }
            int i1 = -1; float l1 = -3.0e38f;
#pragma unroll
            for (int i = 0; i < 8; ++i) if (i != i0 && el[i] > l1) { l1 = el[i]; i1 = i; }
            const float w0 = 1.f / (1.f + __expf(l1 - l0));
            if (lane == 0) {
                GAS int* ti = (GAS int*)(ws + OFF_TOKI) + (size_t)row * 6;
                const int e0 = gi * 8 + i0, e1 = gi * 8 + i1;
                ti[0] = e0; ti[1] = e1;
                LAS unsigned* lc = (LAS unsigned*)(SM + LR_LC);
                ti[2] = (int)__hip_atomic_fetch_add(lc + e0, 1u, __ATOMIC_RELAXED, __HIP_MEMORY_SCOPE_WORKGROUP); ti[3] = (int)__hip_atomic_fetch_add(lc + e1, 1u, __ATOMIC_RELAXED, __HIP_MEMORY_SCOPE_WORKGROUP);
                ((GAS float*)ti)[4] = gp * w0; ((GAS float*)ti)[5] = gp * (1.f - w0);
            }
        }
    }
}

__device__ __forceinline__ int wave_offsets(const unsigned* cnt, int lane, int& pc_out, int& tot) {
    const int c = lane < 32 ? (int)cnt[lane] : 0;
    const int pc = ((c + 255) >> 8) << 8;
    int inc = pc;
    for (int o = 1; o < 64; o <<= 1) { const int t = __shfl_up(inc, o); if (lane >= o) inc += t; }
    tot = __shfl(inc, 63);
    pc_out = pc;
    return inc - pc;
}

__device__ void ph_final(const Params& p, int u) {
    const int tidx = tid_(), lane = tidx & 63;
    float v[2][16]; float s[2] = {0.f, 0.f};
    int rowi[2];
#pragma unroll
    for (int k = 0; k < 2; ++k) {
        const int row = (u + k * (NT / 16)) * 8 + (tidx >> 6), b = row / T_;
        rowi[k] = row;
        const float* x1 = (const float*)(p.ws + OFF_Z) + (size_t)row * D_;
        const float* mod = (const float*)(p.ws + OFF_MOD) + b * 6144 + 5120;
        const int* ti = (const int*)(p.ws + OFF_TOKI) + (size_t)row * 6;
        const int r0 = ti[2], r1 = ti[3]; const float w0 = ((const float*)ti)[4], w1 = ((const float*)ti)[5];
        const bf16_t* y0 = (const bf16_t*)(p.ws + OFF_XPAD) + (size_t)r0 * D_; const bf16_t* y1 = (const bf16_t*)(p.ws + OFF_XPAD) + (size_t)r1 * D_;
#pragma unroll
        for (int i = 0; i < 4; ++i) {
            const int c = (i * 64 + lane) * 4;
            const float4 xv = *(const float4*)(x1 + c), g2 = *(const float4*)(mod + c), a = ld_bf4(y0 + c), bb = ld_bf4(y1 + c);
            v[k][i * 4] = ALPHA * xv.x + (1.f + g2.x) * (w0 * a.x + w1 * bb.x); v[k][i * 4 + 1] = ALPHA * xv.y + (1.f + g2.y) * (w0 * a.y + w1 * bb.y);
            v[k][i * 4 + 2] = ALPHA * xv.z + (1.f + g2.z) * (w0 * a.z + w1 * bb.z); v[k][i * 4 + 3] = ALPHA * xv.w + (1.f + g2.w) * (w0 * a.w + w1 * bb.w);
            s[k] += v[k][i * 4] + v[k][i * 4 + 1] + v[k][i * 4 + 2] + v[k][i * 4 + 3];
        }
    }
#pragma unroll
    for (int k = 0; k < 2; ++k) {
        const float mu = wsum(s[k]) * (1.f / 1024.f); float q = 0.f;
#pragma unroll
        for (int i = 0; i < 16; ++i) { v[k][i] -= mu; q = fmaf(v[k][i], v[k][i], q); }
        const float rs = rsqrtf(wsum(q) * (1.f / 1024.f) + 1e-5f);
#pragma unroll
        for (int i = 0; i < 4; ++i) {
            const int c = (i * 64 + lane) * 4;
            const float4 gg = *(const float4*)(p.ln2_g + c), bb = *(const float4*)(p.ln2_b + c);
            *(float4*)(p.out + (size_t)rowi[k] * D_ + c) = make_float4(v[k][i * 4] * rs * gg.x + bb.x, v[k][i * 4 + 1] * rs * gg.y + bb.y, v[k][i * 4 + 2] * rs * gg.z + bb.z, v[k][i * 4 + 3] * rs * gg.w + bb.w);
        }
    }
}

template <int PH> __device__ __forceinline__ void run_unit(const Params& p, int u, float* sm) {
    if constexpr (PH == PH_PRO) ph_pro(p, u, sm);
    else if constexpr (PH == PH_LN0) ph_ln0(p, u);
    else if constexpr (PH == PH_CMP2) ph_cmp2(p, u, sm);
    else if constexpr (PH == PH_FINAL) ph_final(p, u);
}

constexpr int MEGA_LDS = 153600 + 16;
enum { Q_PRO = 0, Q_LN0, Q_GEMM1, Q_CMP1, Q_CMP2, Q_MIX, Q_MRG, Q_WOUT, Q_LN1R, Q_PAD, Q_EXP1, Q_EXP2, Q_FINAL };
template <int PH> __device__ __forceinline__ void unit_loop(const Params& p, float* sm) {
    for (int u = blockIdx.x; u < phase_units(PH); u += gridDim.x) run_unit<PH>(p, u, sm);
}
template <int Q> __device__ __forceinline__ void run_phase(const Params& p, float* sm) {
    PG8_LAS unsigned char* lds = (PG8_LAS unsigned char*)sm;
    const int G = gridDim.x, c = blockIdx.x;
    if constexpr (Q == Q_PRO) {
        unit_loop<PH_PRO>(p, sm); for (int u = c; u < 561; u += G) ph_cvt_win(p, u, sm);
        for (int u = c; u < 64; u += G) { const int kv = u >> 5, t = u & 31, nt = t >> 4, kt = t & 15;
            cvt_tile(sm, kv ? p.w1_v : p.w1_k, 128, kt * 256, nt * 64, 64, (bf16_t*)(p.ws + OFF_CMPW) + (size_t)kv * 128 * 4096, 4096, nt * 64); }
        { float4* hz = (float4*)(p.ws + OFF_HID); for (int i = c * 512 + threadIdx.x; i < 2 * 4096 * 128 / 4; i += G * 512) hz[i] = make_float4(0.f, 0.f, 0.f, 0.f); }
    }
    else if constexpr (Q == Q_LN0) { for (int u = c; u < 64; u += G) ph_cmpconst(p, u, sm); unit_loop<PH_LN0>(p, sm); }
    else if constexpr (Q == Q_GEMM1) {
        pg8::Gemm g{(const bf16_t*)(p.ws + OFF_H), (const bf16_t*)(p.ws + OFF_WINT), 1024, 1024, 1024};
        pg8::StaticOrder S; S.init(NT, N1, G, c);
        pg8::EpiProj E{(bf16_t*)(p.ws + OFF_PROJ), (bf16_t*)p.out, (float*)(p.ws + OFF_GATE), (const float*)(p.ws + OFF_BIAS1)};
        pg8::gemm_phase(lds, g, S, E);
    }
    else if constexpr (Q == Q_CMP1) {
        for (int u = c; u < 1024; u += G) ph_hpre(p, u);
        for (int u = c; u < 192; u += G) ph_cvt_br(p, u, sm);
        __syncthreads();
        pg8::Gemm g{(const bf16_t*)(p.ws + OFF_PROJ), (const bf16_t*)(p.ws + OFF_CMPW), 1024, 16 * LDP, 4096, 1, 1};
        pg8::CmpOrder S{G, c};
        pg8::EpiCmpAcc E{(float*)(p.ws + OFF_HID)};
        pg8::gemm_phase(lds, g, S, E);
    }
    else if constexpr (Q == Q_CMP2) unit_loop<PH_CMP2>(p, sm);
    else if constexpr (Q == Q_MIX) {
        unsigned* qc = (unsigned*)(p.ws + OFF_QCTR);
        volatile int* slot = (volatile int*)((char*)sm + 131072 - 64);
        for (int k = 0; k < 8; ++k) {
            const int q = (c + k) & 7;
            for (;;) {
                __syncthreads();
                if (threadIdx.x == 0) *slot = (int)__hip_atomic_fetch_add(qc + q * 64, 1u, __ATOMIC_RELAXED, __HIP_MEMORY_SCOPE_AGENT);
                __syncthreads();
                const int it = *slot;
                if (it >= 4 + 128) break;
                if (it < 4) hg::item(p.ws, p.hg_norm_w, q >> 1, (q & 1) * 4 + it, (char*)sm);
                else nsa::item(p.ws, q >> 1, q & 1, 127 - (it - 4), (char*)sm);
            }
        }
    }
    else if constexpr (Q == Q_MRG) {
        pg8::StaticOrder S; S.init(NT, 1024, G, c);
        pg8::Gemm g{(const bf16_t*)(p.ws + OFF_PROJ) + C_HI, (const bf16_t*)(p.ws + OFF_WBRH), 2048, LDP, 2048, 2, 0};
        pg8::EpiMrg E{(const bf16_t*)p.out, (bf16_t*)(p.ws + OFF_H)};
        pg8::gemm_phase(lds, g, S, E);
    }
    else if constexpr (Q == Q_WOUT) {
        for (int u = c; u < 3072; u += G) ph_cvt_exp(p, u, sm);
        pg8::Gemm g{(const bf16_t*)(p.ws + OFF_H), (const bf16_t*)(p.ws + OFF_WOUTT), 1024, 1024, 1024};
        pg8::StaticOrder S; S.init(NT, 1024, G, c);
        pg8::EpiWout E{p.x, (const float*)(p.ws + OFF_MOD), (float*)(p.ws + OFF_Z)};
        pg8::gemm_phase(lds, g, S, E);
    }
    else if constexpr (Q == Q_LN1R) {
        unsigned* lc = (unsigned*)(sm + LR_LC);
        if (threadIdx.x < 64) lc[threadIdx.x] = 0u;
        __syncthreads();
        ph_ln1r_(Ln1rArgs{p.ws, p.ln1_g, p.ln1_b, p.rg_b, p.re_b, sm}, Ln1rW{p.rg_w, p.re_w});
        __syncthreads();
        if (threadIdx.x < 32) lc[32 + threadIdx.x] = atomicAdd((unsigned*)(p.ws + OFF_CNT) + threadIdx.x, lc[threadIdx.x]);
        __syncthreads();
        for (int u = c; u < NT / 16; u += G) {
            if (threadIdx.x < 32) { int* ti = (int*)(p.ws + OFF_TOKI) + (size_t)(u * 16 + (threadIdx.x >> 1)) * 6; const int k = threadIdx.x & 1; ti[2 + k] += (int)lc[32 + ti[k]]; }
        }
        __syncthreads();
    }
    else if constexpr (Q == Q_PAD) {
        const int tidx = tid_(), lane = tidx & 63, w = tidx >> 6;
        const unsigned* cnt = (const unsigned*)(p.ws + OFF_CNT);
        bf16_t* xp = (bf16_t*)(p.ws + OFF_XPAD);
        int pc, tot; const int off = wave_offsets(cnt, lane, pc, tot);
#define PAD_LOAD(K_, ROW_) \
            const int rw##K_ = (ROW_) < NT ? (ROW_) : NT - 1; const int* tq##K_ = (const int*)(p.ws + OFF_TOKI) + (size_t)rw##K_ * 6; \
            const int ra##K_ = __shfl(off, tq##K_[0]) + tq##K_[2], rb##K_ = __shfl(off, tq##K_[1]) + tq##K_[3]; \
            const uint4* sp##K_ = (const uint4*)((const bf16_t*)(p.ws + OFF_H) + (size_t)rw##K_ * D_); const uint4 xa##K_ = sp##K_[lane], xb##K_ = sp##K_[64 + lane];
#define PAD_STORE(K_, ROW_) if ((ROW_) < NT) { uint4* d0 = (uint4*)(xp + (size_t)ra##K_ * D_); uint4* d1 = (uint4*)(xp + (size_t)rb##K_ * D_); \
            d0[lane] = xa##K_; d0[64 + lane] = xb##K_; d1[lane] = xa##K_; d1[64 + lane] = xb##K_; \
            if (lane == 0) { int* tw = (int*)(p.ws + OFF_TOKI) + (size_t)(ROW_) * 6; tw[2] = ra##K_; tw[3] = rb##K_; } }
        for (int base = c * 8 + w; base < NT; base += G * 16) {
            PAD_LOAD(0, base) PAD_LOAD(1, base + G * 8)
            PAD_STORE(0, base) PAD_STORE(1, base + G * 8)
        }
#undef PAD_LOAD
#undef PAD_STORE
        for (int e = c; e < 32; e += G) {
            const int oe = __shfl(off, e), ce = (int)cnt[e], pe = __shfl(pc, e);
            for (int r = oe + ce + w; r < oe + pe; r += 8) { uint4* d = (uint4*)(xp + (size_t)r * D_); d[lane] = make_uint4(0, 0, 0, 0); d[64 + lane] = make_uint4(0, 0, 0, 0); }
        }
        if (c == G - 1) {
            int* te = (int*)(p.ws + OFF_TILEE);
            if (tidx < 32) { for (int r = off; r < off + pc; r += 256) te[r >> 8] = tidx; }
            if (tidx == 0) te[511] = tot >> 8;
        }
    }
    else if constexpr (Q == Q_EXP1) {
        const int* te = (const int*)(p.ws + OFF_TILEE);
        pg8::Gemm g{(const bf16_t*)(p.ws + OFF_XPAD), (const bf16_t*)(p.ws + OFF_E13), 1024, 1024, 1024};
        pg8::MoeOrder S{te, te[511] * 4, G, c, (long)1024 * 1024 * 2};
        pg8::EpiExp1 E{(bf16_t*)p.out};
        pg8::gemm_phase(lds, g, S, E);
    }
    else if constexpr (Q == Q_EXP2) {
        const int* te = (const int*)(p.ws + OFF_TILEE);
        pg8::Gemm g{(const bf16_t*)p.out, (const bf16_t*)(p.ws + OFF_E2T), 512, 512, 512};
        pg8::MoeOrder S{te, te[511] * 4, G, c, (long)1024 * 512 * 2};
        pg8::EpiBf E{(bf16_t*)(p.ws + OFF_XPAD), 1024};
        pg8::gemm_phase(lds, g, S, E);
    }
    else if constexpr (Q == Q_FINAL) unit_loop<PH_FINAL>(p, sm);
}
__global__ void __launch_bounds__(512, 2) k_mega(Params p) {
    extern __shared__ __attribute__((aligned(16))) float smem[];
    volatile LAS unsigned* st = (volatile LAS unsigned*)(smem + 153600 / 4);
    if (threadIdx.x == 0) { st[0] = 0u; st[1] = 0u; st[2] = 0u; st[3] = 0u; }
    __syncthreads();
    XcdBarrier bar = xcd_barrier_post((unsigned*)(p.ws + OFF_BAR), st);
    run_phase<Q_PRO>(p, smem);   xcd_barrier(bar);
    run_phase<Q_LN0>(p, smem);   xcd_barrier(bar);
    run_phase<Q_GEMM1>(p, smem); xcd_barrier(bar);
    run_phase<Q_CMP1>(p, smem);  xcd_barrier(bar);
    run_phase<Q_CMP2>(p, smem);  xcd_barrier(bar);
    run_phase<Q_MIX>(p, smem);   xcd_barrier(bar);
    run_phase<Q_MRG>(p, smem);   xcd_barrier(bar);
    run_phase<Q_WOUT>(p, smem);  xcd_barrier(bar);
    run_phase<Q_LN1R>(p, smem);  xcd_barrier(bar);
    run_phase<Q_PAD>(p, smem);   xcd_barrier(bar);
    run_phase<Q_EXP1>(p, smem);  xcd_barrier(bar);
    run_phase<Q_EXP2>(p, smem);  xcd_barrier(bar);
    run_phase<Q_FINAL>(p, smem);
}

extern "C" void kernel_launch(void* const* d_in, const int* in_sizes, int n_in, void* d_out, int out_size, void* d_ws, size_t ws_size, hipStream_t stream) {
    Params p{};
    const float** fp = (const float**)&p;
    for (int i = 0; i < 31; ++i) fp[i] = (const float*)d_in[i];
    p.out = (float*)d_out; p.ws = (unsigned char*)d_ws;
    static int grid = 0;
    if (!grid) {
        int dev = 0, cus = 0, per_cu = 0;
        (void)hipGetDevice(&dev);
        (void)hipDeviceGetAttribute(&cus, hipDeviceAttributeMultiprocessorCount, dev);
        (void)hipFuncSetAttribute((const void*)k_mega, hipFuncAttributeMaxDynamicSharedMemorySize, MEGA_LDS);
        (void)hipOccupancyMaxActiveBlocksPerMultiprocessor(&per_cu, (const void*)k_mega, 512, MEGA_LDS);
        grid = cus * (per_cu < 1 ? per_cu : 1);
    }
    (void)hipMemsetAsync(p.ws + OFF_BAR, 0, XCD_BAR_WORDS * sizeof(unsigned), stream);
    hipLaunchKernelGGL(k_mega, dim3(grid), dim3(512), MEGA_LDS, stream, p);
}
```

```cpp
#include <hip/hip_runtime.h>
#include <stdint.h>

typedef unsigned short bf16_t;

constexpr int B_ = 4, T_ = 8192, D_ = 1024, NT = B_ * T_;
constexpr int DIN = 8728;
constexpr int LDP = 6656;
constexpr int C_HQ = 0, C_HF = 1024, C_HI = 2048, C_HG = 3072, C_NQ = 4096, C_KC = 5120, C_VC = 5376, C_KS = 5632, C_VS = 5888, C_KW = 6144, C_VW = 6400;
constexpr int NC = 511;
constexpr float ALPHA = 1.189207115002721f;
constexpr int MAXROWS = 73728;

constexpr size_t KB = 1024, MB = 1024 * 1024;
constexpr size_t OFF_BAR = 0, OFF_MOD = 16 * KB, OFF_LB = 112 * KB, OFF_LUT = 116 * KB, OFF_CB = 120 * KB, OFF_CNT = 124 * KB, OFF_TOKI = 128 * KB;
constexpr size_t OFF_GATE = 1 * MB, OFF_KCMP = 4 * MB, OFF_VCMP = 5 * MB, OFF_HID = 6 * MB;
constexpr size_t OFF_DEC = 18 * MB;
constexpr size_t OFF_QCTR = 960 * KB;
constexpr size_t OFF_CMPW = 10 * MB;
constexpr size_t OFF_H = 31 * MB;
constexpr size_t OFF_PROJ = 95 * MB;
constexpr size_t OFF_Z = OFF_PROJ, OFF_XPAD = OFF_PROJ + 128 * MB;
constexpr size_t OFF_BIAS1 = 896 * KB, OFF_TILEE = 940 * KB;
constexpr size_t OFF_WINT = 12 * MB;
constexpr size_t OFF_WBRH = 12 * MB, OFF_WBRN = 14 * MB, OFF_WOUTT = 16 * MB;
constexpr size_t OFF_E13 = OFF_PROJ + 272 * MB, OFF_E2T = OFF_PROJ + 336 * MB;
constexpr int N1 = 8960;

struct Params {
    const float *x, *c, *ada_w, *ada_b, *w_in, *b_in, *lb_logits, *hg_norm_w, *pos_k, *w1_k, *b1_k, *w2_k, *pos_v, *w1_v, *b1_v, *w2_v, *rel_bias,
        *w_br_hg, *w_br_nsa, *w_out, *ln1_g, *ln1_b, *rg_w, *rg_b, *re_w, *re_b, *e_w1, *e_w3, *e_w2, *ln2_g, *ln2_b;
    float* out; unsigned char* ws;
};

__device__ __forceinline__ int tid_() { int t = threadIdx.x; asm volatile("" : "+v"(t)); return t; }
__device__ __forceinline__ float bf2f(bf16_t v) { return __uint_as_float(((unsigned)v) << 16); }
__device__ __forceinline__ bf16_t f2bf(float f) { unsigned u = __float_as_uint(f); u += 0x7FFFu + ((u >> 16) & 1u); return (bf16_t)(u >> 16); }
__device__ __forceinline__ float sigmoidf_(float v) { return __builtin_amdgcn_rcpf(1.f + __expf(-v)); }
__device__ __forceinline__ float siluf_(float v) { return v * __builtin_amdgcn_rcpf(1.f + __expf(-v)); }
template <int CTRL> __device__ __forceinline__ float dpp_(float v) { return __int_as_float(__builtin_amdgcn_update_dpp(0, __float_as_int(v), CTRL, 0xF, 0xF, true)); }
__device__ __forceinline__ float rlane(float v, int l) { return __int_as_float(__builtin_amdgcn_readlane(__float_as_int(v), l)); }
__device__ __forceinline__ float wsum(float v) {
    v += dpp_<0xB1>(v); v += dpp_<0x4E>(v); v += dpp_<0x141>(v); v += dpp_<0x140>(v);
    return (rlane(v, 15) + rlane(v, 31)) + (rlane(v, 47) + rlane(v, 63));
}
__device__ __forceinline__ float rfl(float v) { return __int_as_float(__builtin_amdgcn_readfirstlane(__float_as_int(v))); }
__device__ __forceinline__ float wmax(float v) { for (int o = 32; o > 0; o >>= 1) v = fmaxf(v, __shfl_xor(v, o)); return v; }
__device__ __forceinline__ float4 ld_bf4(const bf16_t* p) { uint2 r = *(const uint2*)p; return make_float4(__uint_as_float(r.x << 16), __uint_as_float(r.x & 0xFFFF0000u), __uint_as_float(r.y << 16), __uint_as_float(r.y & 0xFFFF0000u)); }
typedef __bf16 bf16x2n __attribute__((ext_vector_type(2)));
typedef float f32x2n __attribute__((ext_vector_type(2)));
__device__ __forceinline__ unsigned pk_bf16(float lo, float hi) { const f32x2n v = {lo, hi}; const bf16x2n r = __builtin_convertvector(v, bf16x2n); return __builtin_bit_cast(unsigned, r); }
__device__ __forceinline__ void st_bf4(bf16_t* p, float a, float b, float c, float d) { uint2 r; r.x = pk_bf16(a, b); r.y = pk_bf16(c, d); *(uint2*)p = r; }
__device__ __forceinline__ int rel_bucket(int n) {
    if (n < 16) return n < 0 ? 0 : n;
    int b = 16;
    b += (n >= 19) + (n >= 21) + (n >= 24) + (n >= 27) + (n >= 31) + (n >= 35) + (n >= 40) + (n >= 46) + (n >= 52) + (n >= 59) + (n >= 67) + (n >= 77) + (n >= 87) + (n >= 99) + (n >= 113);
    return b;
}

template <class AF, class BF, class EF>
__device__ __forceinline__ void gemm128(float* sm, int m0, int n0, int K, AF af, BF bf, EF ef) {
    float(*As)[132] = (float(*)[132])sm;
    float(*Bs)[132] = (float(*)[132])(sm + 16 * 132);
    const int tid = tid_(), tx = tid & 31, ty = tid >> 5;
    const int ar = tid >> 2, ak = (tid & 3) * 4, bk = tid >> 5, bn = (tid & 31) * 4;
    float acc[8][4];
#pragma unroll
    for (int i = 0; i < 8; ++i)
#pragma unroll
        for (int j = 0; j < 4; ++j) acc[i][j] = 0.f;
    for (int k0 = 0; k0 < K; k0 += 16) {
        const float4 a = af(m0 + ar, k0 + ak);
        const float4 b = bf(k0 + bk, n0 + bn);
        __syncthreads();
        As[ak + 0][ar] = a.x; As[ak + 1][ar] = a.y; As[ak + 2][ar] = a.z; As[ak + 3][ar] = a.w;
        *(float4*)&Bs[bk][bn] = b;
        __syncthreads();
#pragma unroll
        for (int k = 0; k < 16; ++k) {
            const float4 a0 = *(const float4*)&As[k][ty * 8], a1 = *(const float4*)&As[k][ty * 8 + 4], bb = *(const float4*)&Bs[k][tx * 4];
            const float av[8] = {a0.x, a0.y, a0.z, a0.w, a1.x, a1.y, a1.z, a1.w};
            const float bv[4] = {bb.x, bb.y, bb.z, bb.w};
#pragma unroll
            for (int i = 0; i < 8; ++i)
#pragma unroll
                for (int j = 0; j < 4; ++j) acc[i][j] = fmaf(av[i], bv[j], acc[i][j]);
        }
    }
#pragma unroll
    for (int i = 0; i < 8; ++i) ef(m0 + ty * 8 + i, n0 + tx * 4, make_float4(acc[i][0], acc[i][1], acc[i][2], acc[i][3]));
    __syncthreads();
}


#define XB_TMO      128
#define XB_XCNT(j)  (256  + 64 * (j))
#define XB_XSUB(j)  (1280 + 64 * (j))
#define XB_XGEN(j)  (2304 + 64 * (j))
#define XB_TOP      3328
#define XB_TOPGEN   3392
#define XCD_BAR_WORDS 3456
#define XB_SPIN_CAP (1u << 22)
#define LAS __attribute__((address_space(3)))
__device__ __forceinline__ unsigned xb_ld(unsigned* p)              { return __hip_atomic_load(p, __ATOMIC_RELAXED, __HIP_MEMORY_SCOPE_AGENT); }
__device__ __forceinline__ unsigned xb_add(unsigned* p, unsigned v) { return __hip_atomic_fetch_add(p, v, __ATOMIC_RELAXED, __HIP_MEMORY_SCOPE_AGENT); }
__device__ __forceinline__ unsigned xb_xcc_id() { return (unsigned)__builtin_amdgcn_s_getreg((3 << 11) | 20) & 0xFu; }
#define XB_SPIN(cond, bar) do { unsigned _sp = 0; while (cond) { __builtin_amdgcn_s_sleep(1); \
    if ((++_sp & 255u) == 0u) { if (xb_ld(&(bar)[XB_TMO])) break; if (_sp > XB_SPIN_CAP) { atomicAdd(&(bar)[XB_TMO], 1u); break; } } } } while (0)
struct XcdBarrier { unsigned* bar; unsigned x; volatile LAS unsigned* st; };
__device__ __forceinline__ XcdBarrier xcd_barrier_post(unsigned* bar, volatile LAS unsigned* st) {
    XcdBarrier b; b.bar = bar; b.x = xb_xcc_id(); b.st = st;
    if (threadIdx.x == 0) (void)xb_add(&bar[XB_XCNT(b.x)], 1u);
    return b;
}
__device__ __forceinline__ void xcd_barrier_complete(unsigned* bar, unsigned x, unsigned& nloc, unsigned& nx) {
    const unsigned G = gridDim.x * gridDim.y * gridDim.z;
    unsigned sum, cnt, mine, sp = 0u;
    for (;;) {
        sum = 0u; cnt = 0u; mine = 0u;
#pragma unroll
        for (unsigned j = 0; j < 16; ++j) { const unsigned c = xb_ld(&bar[XB_XCNT(j)]); sum += c; cnt += (c > 0u) ? 1u : 0u; mine = (j == x) ? c : mine; }
        if (sum == G) break;
        __builtin_amdgcn_s_sleep(1);
        if ((++sp & 255u) == 0u) { if (xb_ld(&bar[XB_TMO])) break; if (sp > XB_SPIN_CAP) { atomicAdd(&bar[XB_TMO], 1u); break; } }
    }
    nloc = mine > 0u ? mine : 1u; nx = cnt > 0u ? cnt : 1u;
}
__device__ __forceinline__ void xcd_barrier(const XcdBarrier& b) {
    asm volatile("s_waitcnt vmcnt(0)" ::: "memory");
    __syncthreads();
    if (threadIdx.x == 0) {
        unsigned* bar = b.bar;
        __builtin_amdgcn_s_waitcnt(0);
        unsigned nloc = b.st[0], nx = b.st[1];
        if (nloc == 0u) { xcd_barrier_complete(bar, b.x, nloc, nx); b.st[0] = nloc; b.st[1] = nx; }
        const unsigned old = xb_add(&bar[XB_XSUB(b.x)], 1u);
        const unsigned gen = old / nloc;
        if (old + 1u == (gen + 1u) * nloc) {
            __builtin_amdgcn_fence(__ATOMIC_RELEASE, "agent");
            asm volatile("s_waitcnt vmcnt(0)" ::: "memory");
            const unsigned og = xb_add(&bar[XB_TOP], 1u);
            const unsigned tg = og / nx;
            if (og + 1u == (tg + 1u) * nx) xb_add(&bar[XB_TOPGEN], 1u);
            else XB_SPIN(xb_ld(&bar[XB_TOPGEN]) == tg, bar);
            __builtin_amdgcn_fence(__ATOMIC_ACQUIRE, "agent");
            xb_add(&bar[XB_XGEN(b.x)], 1u);
            asm volatile("s_waitcnt vmcnt(0)" ::: "memory");
        } else {
            XB_SPIN(xb_ld(&bar[XB_XGEN(b.x)]) == gen, bar);
            __builtin_amdgcn_fence(__ATOMIC_ACQUIRE, "agent");
            asm volatile("s_waitcnt vmcnt(0)" ::: "memory");
        }
    }
    __syncthreads();
}


namespace pg8 {
#define PG8_LAS __attribute__((address_space(3)))
typedef short bf16x8 __attribute__((ext_vector_type(8)));
typedef float f32x4 __attribute__((ext_vector_type(4)));
typedef unsigned u32x4 __attribute__((ext_vector_type(4)));
typedef unsigned u32x2 __attribute__((ext_vector_type(2)));
constexpr int BM = 256, BK = 64, HALF = 128, HTB = HALF * BK * 2, STAGE_BYTES = 8 * HTB, NXCD = 8, WGM = 8;
__host__ __device__ __forceinline__ int lds_byte(int r, int c) { const int st = (r >> 4) * 2 + (c >> 5), rr = r & 15, cc = c & 31, ob = rr * 64 + cc * 2; return st * 1024 + (ob ^ (((ob >> 9) & 1) << 5)); }
__host__ __device__ __forceinline__ void stage_rc(int b, int& R, int& C) { const int st = b / 1024, sb = b % 1024, swz = sb ^ (((sb >> 9) & 1) << 5); R = (st >> 1) * 16 + swz / 64; C = (st & 1) * 32 + (swz % 64) / 2; }
__host__ __device__ __forceinline__ int perm32(int rho) { const int n = rho >> 4, i = rho & 15; return 8 * (i >> 2) + 4 * n + (i & 3); }
struct Unit { int pm, pn; long boff; long aoff; };
struct Gemm { const bf16_t* A; const bf16_t* Bt; int K, lda, ldb; int kmode = 0; int bdup = 0; };
struct StaticOrder {
    int nM, nN, nwg, G, c;
    __device__ void init(int M, int N, int G_, int c_) { nM = M / BM; nN = N / BM; nwg = nM * nN; G = G_; c = c_; }
    __device__ bool next(int i, Unit& u) const {
        const long L = (long)i * G + c; if (L >= nwg) return false;
        int wgid = (int)L; { const int q = nwg / NXCD, r = nwg % NXCD, xcd = wgid % NXCD, off = wgid / NXCD; wgid = (xcd < r ? xcd * (q + 1) : r * (q + 1) + (xcd - r) * q) + off; }
        const int nig = WGM * nN, gid = wgid / nig, fm = gid * WGM, gsz = (nM - fm) < WGM ? (nM - fm) : WGM;
        u.pm = fm + ((wgid % nig) % gsz); u.pn = (wgid % nig) / gsz; u.boff = 0; u.aoff = 0; return true;
    }
    __device__ __forceinline__ void a_ready(const Unit&) const {}
    __device__ __forceinline__ void done(const Unit&) const {}
};
struct MoeOrder {
    const int* tile_e; int nwg, G, c; long estride;
    __device__ bool next(int i, Unit& u) const {
        const long L = (long)i * G + c; if (L >= nwg) return false;
        u.pm = (int)(L >> 2); u.pn = (int)(L & 3); u.boff = (long)tile_e[u.pm] * estride; u.aoff = 0; return true;
    }
    __device__ __forceinline__ void a_ready(const Unit&) const {}
    __device__ __forceinline__ void done(const Unit&) const {}
};
struct CmpOrder {
    int G, c;
    __device__ bool next(int i, Unit& u) const {
        const int L = i * G + c; if (L >= 128) return false;
        const int kv = L >> 6, bg = (L >> 3) & 7, half = (L >> 2) & 1, kq = L & 3;
        u.pm = half; u.pn = (kv << 3) | bg;
        u.aoff = ((long)((bg >> 1) * T_ + 8 * kq) * LDP + (kv ? C_VC : C_KC) + (bg & 1) * 128) * 2;
        u.boff = ((long)kv * 128 * 4096 + kq * 1024) * 2;
        return true;
    }
    __device__ __forceinline__ void a_ready(const Unit&) const {}
    __device__ __forceinline__ void done(const Unit&) const {}
};
__device__ __forceinline__ unsigned cvt_pk_bf16(float lo, float hi) { return pk_bf16(lo, hi); }
__device__ __forceinline__ f32x4 unpk_lo(u32x4 w) { return (f32x4){__uint_as_float(w.x << 16), __uint_as_float(w.x & 0xFFFF0000u), __uint_as_float(w.y << 16), __uint_as_float(w.y & 0xFFFF0000u)}; }
__device__ __forceinline__ f32x4 unpk_hi(u32x4 w) { return (f32x4){__uint_as_float(w.z << 16), __uint_as_float(w.z & 0xFFFF0000u), __uint_as_float(w.w << 16), __uint_as_float(w.w & 0xFFFF0000u)}; }
__device__ __forceinline__ u32x4 pk8(f32x4 v0, f32x4 v1) { u32x4 w; w.x = cvt_pk_bf16(v0[0], v0[1]); w.y = cvt_pk_bf16(v0[2], v0[3]); w.z = cvt_pk_bf16(v1[0], v1[1]); w.w = cvt_pk_bf16(v1[2], v1[3]); return w; }
__device__ __forceinline__ f32x4 sig4(f32x4 v) { return (f32x4){sigmoidf_(v[0]), sigmoidf_(v[1]), sigmoidf_(v[2]), sigmoidf_(v[3])}; }
struct EpiProj {
    static constexpr bool PERM = true, AFTER_DRAIN = false, HAS_MID = false;
    bf16_t* proj; bf16_t* mg; float* gate; const float* bias;
    __device__ __forceinline__ void operator()(const f32x4 (&acc)[2][2][4][2], const Unit& u, int wr, int wc, int fr, int fq) const {
        const int row0 = u.pm * BM + wr * 64 + fr, c8 = u.pn * BM + wc * 32 + 8 * fq;
        f32x4 bv[2][2];
#pragma unroll
        for (int bj = 0; bj < 2; ++bj)
#pragma unroll
            for (int n = 0; n < 2; ++n) bv[bj][n] = *(const f32x4*)(bias + c8 + bj * HALF + 4 * n);
#pragma unroll
        for (int ai = 0; ai < 2; ++ai)
#pragma unroll
            for (int m = 0; m < 4; ++m) {
                const size_t row = (size_t)(row0 + ai * HALF + m * 16);
#pragma unroll
                for (int bj = 0; bj < 2; ++bj) {
                    const f32x4 v0 = acc[ai][bj][m][0] + bv[bj][0], v1 = acc[ai][bj][m][1] + bv[bj][1];
                    const int col = c8 + bj * HALF;
                    if (u.pn < 26) *(u32x4*)(proj + row * LDP + col) = pk8(v0, v1);
                    else if (u.pn < 34) *(u32x4*)(mg + row * 2048 + (col - 6656)) = pk8(sig4(v0), sig4(v1));
                    else if (col - 8704 < 24) { float* gp = gate + row * 24 + (col - 8704); *(f32x4*)gp = sig4(v0); *(f32x4*)(gp + 4) = sig4(v1); }
                }
            }
    }
};
struct EpiMrg {
    static constexpr bool PERM = true, AFTER_DRAIN = false, HAS_MID = true;
    const bf16_t* mg; bf16_t* mr;
    __device__ __forceinline__ void mid(f32x4 (&acc)[2][2][4][2], const Unit& u, int wr, int wc, int fr, int fq) const {
        const int row0 = u.pm * BM + wr * 64 + fr, c8 = u.pn * BM + wc * 32 + 8 * fq;
#pragma unroll
        for (int ai = 0; ai < 2; ++ai)
#pragma unroll
            for (int m = 0; m < 4; ++m) {
                const size_t row = (size_t)(row0 + ai * HALF + m * 16);
#pragma unroll
                for (int bj = 0; bj < 2; ++bj) {
                    const int col = c8 + bj * HALF;
                    const u32x4 hw = *(const u32x4*)(mg + row * 2048 + col), nw = *(const u32x4*)(mg + row * 2048 + 1024 + col);
                    const f32x4 h0 = unpk_lo(hw), h1 = unpk_hi(hw), n0 = unpk_lo(nw), n1 = unpk_hi(nw);
#pragma unroll
                    for (int j = 0; j < 4; ++j) { acc[ai][bj][m][0][j] *= h0[j] * __builtin_amdgcn_rcpf(fmaxf(n0[j], 8.673617e-19f)); acc[ai][bj][m][1][j] *= h1[j] * __builtin_amdgcn_rcpf(fmaxf(n1[j], 8.673617e-19f)); }
                    asm volatile("" ::: "memory");
                }
            }
    }
    __device__ __forceinline__ void operator()(const f32x4 (&acc)[2][2][4][2], const Unit& u, int wr, int wc, int fr, int fq) const {
        const int row0 = u.pm * BM + wr * 64 + fr, c8 = u.pn * BM + wc * 32 + 8 * fq;
#pragma unroll
        for (int ai = 0; ai < 2; ++ai)
#pragma unroll
            for (int m = 0; m < 4; ++m) {
                const size_t row = (size_t)(row0 + ai * HALF + m * 16);
#pragma unroll
                for (int bj = 0; bj < 2; ++bj) {
                    const int col = c8 + bj * HALF;
                    const u32x4 nw = *(const u32x4*)(mg + row * 2048 + 1024 + col);
                    f32x4 n0 = unpk_lo(nw), n1 = unpk_hi(nw);
#pragma unroll
                    for (int j = 0; j < 4; ++j) { n0[j] = fmaxf(n0[j], 8.673617e-19f); n1[j] = fmaxf(n1[j], 8.673617e-19f); }
                    *(u32x4*)(mr + row * 1024 + col) = pk8(n0 * acc[ai][bj][m][0], n1 * acc[ai][bj][m][1]);
                }
                asm volatile("" ::: "memory");
            }
    }
};
struct EpiWout {
    static constexpr bool PERM = false, AFTER_DRAIN = false, HAS_MID = false;
    const float* x; const float* mod; float* z;
    __device__ __forceinline__ void operator()(const f32x4 (&acc)[2][2][4][2], const Unit& u, int wr, int wc, int fr, int fq) const {
        const int row0 = u.pm * BM + wr * 64 + fr, col0 = u.pn * BM + wc * 32 + 4 * fq;
        const float* g1 = mod + ((u.pm * BM) / T_) * 6144 + 2048 + col0;
#pragma unroll
        for (int ai = 0; ai < 2; ++ai)
#pragma unroll
            for (int m = 0; m < 4; ++m) {
                const size_t ro = (size_t)(row0 + ai * HALF + m * 16) * 1024 + col0;
#pragma unroll
                for (int bj = 0; bj < 2; ++bj)
#pragma unroll
                    for (int n = 0; n < 2; ++n) { const f32x4 xv = *(const f32x4*)(x + ro + bj * HALF + n * 16), gv = *(const f32x4*)(g1 + bj * HALF + n * 16) + 1.0f;
                        *(f32x4*)(z + ro + bj * HALF + n * 16) = xv * ALPHA + gv * acc[ai][bj][m][n]; }
                if (m & 1) asm volatile("" ::: "memory");
            }
    }
};
struct EpiExp1 {
    static constexpr bool PERM = true, AFTER_DRAIN = false, HAS_MID = false;
    bf16_t* U;
    __device__ __forceinline__ void operator()(const f32x4 (&acc)[2][2][4][2], const Unit& u, int wr, int wc, int fr, int fq) const {
        const int row0 = u.pm * BM + wr * 64 + fr, c8 = u.pn * HALF + wc * 32 + 8 * fq;
#pragma unroll
        for (int ai = 0; ai < 2; ++ai)
#pragma unroll
            for (int m = 0; m < 4; ++m) {
                f32x4 r[2];
#pragma unroll
                for (int n = 0; n < 2; ++n)
#pragma unroll
                    for (int j = 0; j < 4; ++j) r[n][j] = siluf_(acc[ai][0][m][n][j]) * acc[ai][1][m][n][j];
                *(u32x4*)(U + (size_t)(row0 + ai * HALF + m * 16) * 512 + c8) = pk8(r[0], r[1]);
            }
    }
};
struct EpiCmpAcc {
    static constexpr bool PERM = false, AFTER_DRAIN = false, HAS_MID = false;
    float* hp;
    __device__ __forceinline__ void operator()(const f32x4 (&acc)[2][2][4][2], const Unit& u, int wr, int wc, int fr, int fq) const {
        const int row0 = u.pn * 512 + u.pm * BM + wr * 64 + fr, col0 = wc * 32 + 4 * fq;
#pragma unroll
        for (int ai = 0; ai < 2; ++ai)
#pragma unroll
            for (int m = 0; m < 4; ++m) { float* rp = hp + (size_t)(row0 + ai * HALF + m * 16) * 128 + col0;
#pragma unroll
                for (int n = 0; n < 2; ++n)
#pragma unroll
                    for (int j = 0; j < 4; ++j) atomicAdd(rp + n * 16 + j, acc[ai][0][m][n][j]); }
    }
};
struct EpiBf {
    static constexpr bool PERM = true, AFTER_DRAIN = false, HAS_MID = false;
    bf16_t* O; int ldo;
    __device__ __forceinline__ void operator()(const f32x4 (&acc)[2][2][4][2], const Unit& u, int wr, int wc, int fr, int fq) const {
        const int row0 = u.pm * BM + wr * 64 + fr, c8 = u.pn * BM + wc * 32 + 8 * fq;
#pragma unroll
        for (int ai = 0; ai < 2; ++ai)
#pragma unroll
            for (int m = 0; m < 4; ++m)
#pragma unroll
                for (int bj = 0; bj < 2; ++bj) *(u32x4*)(O + (size_t)(row0 + ai * HALF + m * 16) * ldo + c8 + bj * HALF) = pk8(acc[ai][bj][m][0], acc[ai][bj][m][1]);
    }
};
template <class Epi, class Sched>
__device__ __forceinline__ void gemm_phase(PG8_LAS unsigned char* lds, const Gemm g, const Sched& S, const Epi& E) {
    const int tid = tid_(), wid = __builtin_amdgcn_readfirstlane(tid >> 6), lane = tid & 63, wr = wid >> 2, wc = wid & 3, fr = lane & 15, fq = lane >> 4;
    const int K = g.K, nt = K / BK;
    unsigned voffA[2], voffB[2];
#pragma unroll
    for (int i = 0; i < 2; ++i) { int R, C; stage_rc(tid * 16 + i * 8192, R, C); const int Rb = Epi::PERM ? ((R & ~31) + perm32(R & 31)) : R;
        voffA[i] = (unsigned)(R * g.lda + C) * 2u; voffB[i] = (unsigned)(Rb * g.ldb + C) * 2u; }
    const size_t kstep = (size_t)(BK * 2);
#define PG8_KA(t) (g.kmode == 1 ? (size_t)((t) >> 1) * (LDP * 2) + (size_t)((t) & 1) * 128 : g.kmode == 2 ? (size_t)(t) * kstep + ((t) >= 16 ? (size_t)2048 : (size_t)0) : (size_t)(t) * kstep)
    const size_t hstepA = (size_t)HALF * g.lda * 2, hstepB = g.bdup ? (size_t)0 : (size_t)HALF * g.ldb * 2;
    const size_t tstepA = 2 * hstepA, tstepB = 2 * hstepB;
    const unsigned ldsw = (unsigned)wid * 1024u;
    const int aoff = lds_byte(wr * 64 + fr, fq * 8), boff = lds_byte(wc * 32 + fr, fq * 8);
#define PG8_SA(b, h) (((b) * 2 + (h)) * HTB)
#define PG8_SB(b, h) ((4 + (b) * 2 + (h)) * HTB)
#define PG8_STAGE(bufoff, gbase, voff) do { _Pragma("unroll") for (int _i = 0; _i < 2; ++_i) \
        __builtin_amdgcn_global_load_lds((const unsigned*)((const char*)(gbase) + (voff)[_i]), (PG8_LAS unsigned*)(lds + (bufoff) + ldsw + _i * 8192), 16, 0, 0); } while (0)
#define PG8_LDA(dst, b, h) do { _Pragma("unroll") for (int m = 0; m < 4; ++m) _Pragma("unroll") for (int k = 0; k < 2; ++k) dst[m][k] = *(const PG8_LAS bf16x8*)(lds + PG8_SA(b, h) + aoff + m * 2048 + k * 1024); } while (0)
#define PG8_LDB(dst, b, h) do { _Pragma("unroll") for (int n = 0; n < 2; ++n) _Pragma("unroll") for (int k = 0; k < 2; ++k) dst[n][k] = *(const PG8_LAS bf16x8*)(lds + PG8_SB(b, h) + boff + n * 2048 + k * 1024); } while (0)
#define PG8_MMA(ai, bj, At, Bt) do { __builtin_amdgcn_s_setprio(1); _Pragma("unroll") for (int m = 0; m < 4; ++m) _Pragma("unroll") for (int n = 0; n < 2; ++n) _Pragma("unroll") for (int k = 0; k < 2; ++k) \
        acc[ai][bj][m][n] = __builtin_amdgcn_mfma_f32_16x16x32_bf16(Bt[n][k], At[m][k], acc[ai][bj][m][n], 0, 0, 0); __builtin_amdgcn_s_setprio(0); } while (0)
#define PG8_WAIT_V(n) asm volatile("s_waitcnt vmcnt(" #n ")" ::: "memory")
#define PG8_WAIT_L(n) asm volatile("s_waitcnt lgkmcnt(" #n ")" ::: "memory")
#define PG8_BAR __builtin_amdgcn_s_barrier()
#define PG8_SCHED __builtin_amdgcn_sched_barrier(0)
    Unit cur, nxt; int ui = 0;
    if (!S.next(0, cur)) return;
    f32x4 acc[2][2][4][2];
#pragma unroll
    for (int a = 0; a < 2; ++a)
#pragma unroll
        for (int b = 0; b < 2; ++b)
#pragma unroll
            for (int m = 0; m < 4; ++m)
#pragma unroll
                for (int n = 0; n < 2; ++n) acc[a][b][m][n] = (f32x4){0.f, 0.f, 0.f, 0.f};
    bf16x8 At[4][2], B0[2][2], B1[2][2];
    const char* cA = (const char*)g.A + cur.aoff + (size_t)cur.pm * tstepA; const char* cB = (const char*)g.Bt + cur.boff + (size_t)cur.pn * tstepB;
    S.a_ready(cur);
    PG8_STAGE(PG8_SB(0, 0), cB, voffB); PG8_STAGE(PG8_SA(0, 0), cA, voffA); PG8_STAGE(PG8_SB(0, 1), cB + hstepB, voffB); PG8_STAGE(PG8_SA(0, 1), cA + hstepA, voffA);
    if (wr == 1) PG8_BAR;
    PG8_WAIT_V(4); PG8_BAR;
    PG8_STAGE(PG8_SB(1, 0), cB + kstep, voffB); PG8_STAGE(PG8_SA(1, 0), cA + PG8_KA(1), voffA); PG8_STAGE(PG8_SB(1, 1), cB + hstepB + kstep, voffB);
    PG8_WAIT_V(6); PG8_BAR;
    for (;;) {
        const bool has_next = S.next(ui + 1, nxt);
        const char* nA = has_next ? (const char*)g.A + nxt.aoff + (size_t)nxt.pm * tstepA : cA; const char* nB = has_next ? (const char*)g.Bt + nxt.boff + (size_t)nxt.pn * tstepB : cB;
        for (int t = 0; t < nt; t += 2) {
            const bool last = (t == nt - 2);
            const char* a1 = cA + PG8_KA(t + 1);
            const char* a2 = last ? nA : cA + PG8_KA(t + 2); const char* b2 = last ? nB : cB + (size_t)(t + 2) * kstep;
            const char* a3 = last ? nA + PG8_KA(1) : cA + PG8_KA(t + 3); const char* b3 = b2 + kstep;
            if (last && has_next) S.a_ready(nxt);
            if constexpr (Epi::HAS_MID) { if (t == 16) E.mid(acc, cur, wr, wc, fr, fq); }
            PG8_LDB(B0, 0, 0); PG8_SCHED; PG8_LDA(At, 0, 0); PG8_STAGE(PG8_SA(1, 1), a1 + hstepA, voffA);
            PG8_WAIT_L(8); PG8_BAR; PG8_WAIT_L(0); PG8_MMA(0, 0, At, B0); PG8_BAR; PG8_SCHED;
            PG8_LDB(B1, 0, 1); PG8_STAGE(PG8_SB(0, 0), b2, voffB);
            PG8_BAR; PG8_WAIT_L(0); PG8_MMA(0, 1, At, B1); PG8_BAR;
            PG8_LDA(At, 0, 1); PG8_STAGE(PG8_SA(0, 0), a2, voffA);
            PG8_BAR; PG8_WAIT_L(0); PG8_MMA(1, 0, At, B0); PG8_BAR; PG8_SCHED;
            PG8_STAGE(PG8_SB(0, 1), b2 + hstepB, voffB);
            PG8_WAIT_V(6); PG8_BAR; PG8_MMA(1, 1, At, B1); PG8_BAR;
            PG8_LDB(B0, 1, 0); PG8_SCHED; PG8_LDA(At, 1, 0); PG8_STAGE(PG8_SA(0, 1), a2 + hstepA, voffA);
            PG8_WAIT_L(8); PG8_BAR; PG8_WAIT_L(0); PG8_MMA(0, 0, At, B0); PG8_BAR; PG8_SCHED;
            PG8_LDB(B1, 1, 1); PG8_STAGE(PG8_SB(1, 0), b3, voffB);
            PG8_BAR; PG8_WAIT_L(0); PG8_MMA(0, 1, At, B1); PG8_BAR;
            PG8_LDA(At, 1, 1); PG8_STAGE(PG8_SA(1, 0), a3, voffA);
            PG8_BAR; PG8_WAIT_L(0); PG8_MMA(1, 0, At, B0); PG8_BAR; PG8_SCHED;
            PG8_STAGE(PG8_SB(1, 1), b3 + hstepB, voffB);
            PG8_WAIT_V(6); PG8_BAR; PG8_MMA(1, 1, At, B1); PG8_BAR;
        }
        if constexpr (!Epi::AFTER_DRAIN) { E(acc, cur, wr, wc, fr, fq); S.done(cur); }
        if (!has_next) break;
#pragma unroll
        for (int a = 0; a < 2; ++a)
#pragma unroll
            for (int b = 0; b < 2; ++b)
#pragma unroll
                for (int m = 0; m < 4; ++m)
#pragma unroll
                    for (int n = 0; n < 2; ++n) acc[a][b][m][n] = (f32x4){0.f, 0.f, 0.f, 0.f};
        cur = nxt; cA = nA; cB = nB; ++ui;
    }
    PG8_WAIT_V(0);
    if (wr == 0) PG8_BAR;
    PG8_BAR;
    if constexpr (Epi::AFTER_DRAIN) { E.fused(acc, cur, wr, wc, fr, fq, lds, wid, lane); S.done(cur); }
#undef PG8_SA
#undef PG8_SB
#undef PG8_STAGE
#undef PG8_LDA
#undef PG8_LDB
#undef PG8_MMA
#undef PG8_WAIT_V
#undef PG8_WAIT_L
#undef PG8_BAR
#undef PG8_SCHED
#undef PG8_KA
}
}

namespace nsa {
typedef short bf16x8 __attribute__((ext_vector_type(8)));
typedef short s16x4 __attribute__((ext_vector_type(4)));
typedef float f32x16 __attribute__((ext_vector_type(16)));
typedef float f32x4 __attribute__((ext_vector_type(4)));
typedef unsigned u32x4 __attribute__((ext_vector_type(4)));
constexpr int SHM_V = 16384, SHM_K = 16384;
constexpr int L_V = 0, L_K = 32768, L_WS = 65536, L_LUT = 67584, L_IMP = 69632, L_SEL = 102400, L_UNI = 103424, L_TL = 103488, L_END = 104064;
constexpr float LOG2E = 1.4426950408889634f, C2 = 0.08838834764831845f * LOG2E, THR2 = 11.5f;
#define KSWZ(row, colB) ((row) * 256 + ((colB) ^ (((row) & 7) << 4)))
#define SBAR() __builtin_amdgcn_sched_barrier(0)
__device__ __forceinline__ int v_st(int k, int c) { const int kk = (k & ~0xC) | ((k & 4) << 1) | ((k & 8) >> 1); return ((kk >> 3) * 4 + (c >> 5)) * 512 + ((kk & 7) * 32 + (c & 31)) * 2; }
__device__ __forceinline__ int v_rd_base(int lane) { return ((lane & 3) << 3) | (((lane >> 2) & 3) << 6) | (((lane >> 4) & 1) << 5) | (((lane >> 5) & 1) << 8); }
constexpr int v_rd_off(int d0, int ks, int half) { return d0 * 512 + ks * 4096 + half * 2048; }
__device__ __forceinline__ int crow(int r, int hi) { return (r & 3) + 8 * (r >> 2) + 4 * hi; }
__device__ __forceinline__ unsigned cvtpk(float lo, float hi) { unsigned r; asm volatile("v_cvt_pk_bf16_f32 %0, %1, %2" : "=v"(r) : "v"(lo), "v"(hi)); return r; }

template <int KB>
__device__ __forceinline__ void qkt(f32x16& p0, f32x16& p1, const char* K_lds, int r32, int hi, const bf16x8* qr) {
    p0 = f32x16{}; p1 = f32x16{};
    const char* kb[4];
#pragma unroll
    for (int dd = 0; dd < 4; ++dd) kb[dd] = K_lds + KB * SHM_K + KSWZ(r32, (dd * 16 + hi * 8) * 2);
#pragma unroll
    for (int d0 = 0; d0 < 8; ++d0) { const char* a = kb[d0 & 3] + (d0 >> 2) * 128;
        bf16x8 b0 = *reinterpret_cast<const bf16x8*>(a);
        bf16x8 b1 = *reinterpret_cast<const bf16x8*>(a + 32 * 256);
        p0 = __builtin_amdgcn_mfma_f32_32x32x16_bf16(b0, qr[d0], p0, 0, 0, 0);
        p1 = __builtin_amdgcn_mfma_f32_32x32x16_bf16(b1, qr[d0], p1, 0, 0, 0); }
}
template <int VB>
__device__ __forceinline__ void pv_tile(f32x16* o, int vb0, bf16x8 pa0, bf16x8 pa1, bf16x8 pa2, bf16x8 pa3) {
#define TRRD(dst, off) asm volatile("ds_read_b64_tr_b16 %0, %1 offset:%2" : "=&v"(dst) : "v"(vb0), "i"(off) : "memory")
#define PV_D0(d0) do { s16x4 l0, l1, l2, l3, h0, h1, h2, h3; constexpr int b_ = VB * SHM_V + v_rd_off(d0, 0, 0); \
        TRRD(l0, b_); TRRD(h0, b_ + 2048); TRRD(l1, b_ + 4096); TRRD(h1, b_ + 6144); TRRD(l2, b_ + 8192); TRRD(h2, b_ + 10240); TRRD(l3, b_ + 12288); TRRD(h3, b_ + 14336); \
        asm volatile("s_waitcnt lgkmcnt(0)" ::: "memory"); SBAR(); \
        o[d0] = __builtin_amdgcn_mfma_f32_32x32x16_bf16(pa0, (bf16x8){l0[0], l0[1], l0[2], l0[3], h0[0], h0[1], h0[2], h0[3]}, o[d0], 0, 0, 0); \
        o[d0] = __builtin_amdgcn_mfma_f32_32x32x16_bf16(pa1, (bf16x8){l1[0], l1[1], l1[2], l1[3], h1[0], h1[1], h1[2], h1[3]}, o[d0], 0, 0, 0); \
        o[d0] = __builtin_amdgcn_mfma_f32_32x32x16_bf16(pa2, (bf16x8){l2[0], l2[1], l2[2], l2[3], h2[0], h2[1], h2[2], h2[3]}, o[d0], 0, 0, 0); \
        o[d0] = __builtin_amdgcn_mfma_f32_32x32x16_bf16(pa3, (bf16x8){l3[0], l3[1], l3[2], l3[3], h3[0], h3[1], h3[2], h3[3]}, o[d0], 0, 0, 0); } while (0)
    PV_D0(0); PV_D0(1); PV_D0(2); PV_D0(3);
#undef PV_D0
#undef TRRD
}
__device__ __forceinline__ void mask_tile(f32x16& p0, f32x16& p1, int dq, unsigned W) {
    const float NEG = -__builtin_inff();
    asm volatile("" : "+v"(dq));
#pragma unroll
    for (int r = 0; r < 16; ++r) {
        const int c = (r & 3) + 8 * (r >> 2);
        if ((unsigned)(dq - c) >= W) p0[r] = NEG;
        if ((unsigned)(dq - c - 32) >= W) p1[r] = NEG;
    }
}
template <int STRIDE>
__device__ __forceinline__ void bias_near(f32x16& p0, f32x16& p1, int dbase, const float* lut) {
    asm volatile("" : "+v"(dbase));
#pragma unroll
    for (int r = 0; r < 16; ++r) {
        const int c = (r & 3) + 8 * (r >> 2);
        int d0 = dbase - STRIDE * c, d1 = dbase - STRIDE * (c + 32);
        d0 = d0 < 0 ? 0 : (d0 > 127 ? 127 : d0); d1 = d1 < 0 ? 0 : (d1 > 127 ? 127 : d1);
        p0[r] = fmaf(p0[r], C2, lut[d0]); p1[r] = fmaf(p1[r], C2, lut[d1]);
    }
}
__device__ __forceinline__ void bias_const(f32x16& p0, f32x16& p1, float cb) {
#pragma unroll
    for (int r = 0; r < 16; ++r) { p0[r] = fmaf(p0[r], C2, cb); p1[r] = fmaf(p1[r], C2, cb); }
}
__device__ __forceinline__ float half_max(float v) { auto rr = __builtin_amdgcn_permlane32_swap(__float_as_uint(v), __float_as_uint(v), false, false); return fmaxf(__uint_as_float(rr[0]), __uint_as_float(rr[1])); }
__device__ __forceinline__ float half_sum(float v) { auto rr = __builtin_amdgcn_permlane32_swap(__float_as_uint(v), __float_as_uint(v), false, false); return __uint_as_float(rr[0]) + __uint_as_float(rr[1]); }
__device__ __forceinline__ void softmax_online(f32x16& p0, f32x16& p1, float sc, float cb2, bool sel, float& m, float& l, float& alpha) {
    float pmax = p0[0];
#pragma unroll
    for (int r = 1; r < 16; ++r) pmax = fmaxf(pmax, p0[r]);
#pragma unroll
    for (int r = 0; r < 16; ++r) pmax = fmaxf(pmax, p1[r]);
    pmax = half_max(pmax);
    pmax = sel ? fmaf(pmax, sc, cb2) : -__builtin_inff();
    if (__all(pmax - m <= THR2)) alpha = 1.f;
    else { const float mn = fmaxf(m, pmax); alpha = __builtin_amdgcn_exp2f(m - mn); m = mn; }
    const float off = sel ? cb2 - m : -__builtin_inff();
#pragma unroll
    for (int r = 0; r < 16; ++r) { p0[r] = fmaf(p0[r], sc, off); p1[r] = fmaf(p1[r], sc, off); }
    SBAR();
#pragma unroll
    for (int r = 0; r < 16; ++r) { p0[r] = __builtin_amdgcn_exp2f(p0[r]); p1[r] = __builtin_amdgcn_exp2f(p1[r]); }
    SBAR();
    float ps = 0.f;
#pragma unroll
    for (int r = 0; r < 16; ++r) ps += p0[r] + p1[r];
    l = l * alpha + half_sum(ps);
}
__device__ __forceinline__ void pack_p(const f32x16& p0, const f32x16& p1, bf16x8& pa0, bf16x8& pa1, bf16x8& pa2, bf16x8& pa3) {
#define PK4(P, B_, OUT) do { unsigned a0 = cvtpk(P[B_+0], P[B_+1]), a1 = cvtpk(P[B_+2], P[B_+3]); \
        unsigned b0 = cvtpk(P[B_+4], P[B_+5]), b1 = cvtpk(P[B_+6], P[B_+7]); \
        auto r0 = __builtin_amdgcn_permlane32_swap(a0, b0, false, false); auto r1 = __builtin_amdgcn_permlane32_swap(a1, b1, false, false); \
        u32x4 w = {r0[0], r1[0], r0[1], r1[1]}; OUT = *reinterpret_cast<bf16x8*>(&w); } while (0)
    PK4(p0, 0, pa0); PK4(p0, 8, pa1); PK4(p1, 0, pa2); PK4(p1, 8, pa3);
#undef PK4
}
__device__ __forceinline__ void rescale_o(f32x16* o, float alpha, float* al_l, int r32, int hi) {
    if (__any(alpha < 1.f)) {
        if (hi == 0) al_l[r32] = alpha;
        asm volatile("s_waitcnt lgkmcnt(0)" ::: "memory");
#pragma unroll
        for (int r = 0; r < 16; ++r) { const float a = al_l[crow(r, hi)];
#pragma unroll
            for (int d = 0; d < 4; ++d) o[d][r] *= a; }
    }
}
__device__ __forceinline__ void flush_out(const f32x16* o, float lsum, int br, unsigned char* ws, char* lds, int b, int g, int qb, int wid, int lane_in, bool first) {
    int lane = lane_in; asm volatile("" : "+v"(lane));
    const int r32 = lane & 31, hi = lane >> 5, head = g * 4 + (wid >> 1);
    const size_t tok = (size_t)b * T_ + qb * 64 + (wid & 1) * 32;
    float* li_l = (float*)(lds + L_WS) + wid * 64;
    bf16_t* tb = (bf16_t*)(lds + wid * 8192);
    bf16_t* orow = (bf16_t*)(ws + OFF_PROJ) + tok * LDP + C_NQ + head * 128;
    const float gate = ((const float*)(ws + OFF_GATE))[(tok + r32) * 24 + head * 3 + br];
    const float f_lane = br == 0 ? gate : (lsum > 0.f ? gate / lsum : 0.f);
    if (hi == 0) li_l[r32] = f_lane;
    asm volatile("s_waitcnt lgkmcnt(0)" ::: "memory");
#pragma unroll
    for (int r = 0; r < 16; ++r) {
        const float f = li_l[crow(r, hi)];
#pragma unroll
        for (int d = 0; d < 4; ++d) tb[crow(r, hi) * 128 + d * 32 + r32] = f2bf(o[d][r] * f);
    }
    asm volatile("s_waitcnt lgkmcnt(0)" ::: "memory");
    uint4 gq[8];
    if (!first) {
#pragma unroll
        for (int i = 0; i < 8; ++i) { const int idx = i * 64 + lane, row = idx >> 4, ch = idx & 15; gq[i] = *(const uint4*)(orow + (size_t)row * LDP + ch * 8); }
    }
#pragma unroll
    for (int i = 0; i < 8; ++i) {
        const int idx = i * 64 + lane, row = idx >> 4, ch = idx & 15;
        uint4 w = *(const uint4*)(tb + row * 128 + ch * 8);
        uint4* gp = (uint4*)(orow + (size_t)row * LDP + ch * 8);
        if (!first) {
            const uint4 g = gq[i];
            w.x = cvtpk(__uint_as_float(w.x << 16) + __uint_as_float(g.x << 16), __uint_as_float(w.x & 0xFFFF0000u) + __uint_as_float(g.x & 0xFFFF0000u));
            w.y = cvtpk(__uint_as_float(w.y << 16) + __uint_as_float(g.y << 16), __uint_as_float(w.y & 0xFFFF0000u) + __uint_as_float(g.y & 0xFFFF0000u));
            w.z = cvtpk(__uint_as_float(w.z << 16) + __uint_as_float(g.z << 16), __uint_as_float(w.z & 0xFFFF0000u) + __uint_as_float(g.z & 0xFFFF0000u));
            w.w = cvtpk(__uint_as_float(w.w << 16) + __uint_as_float(g.w << 16), __uint_as_float(w.w & 0xFFFF0000u) + __uint_as_float(g.w & 0xFFFF0000u));
        }
        *gp = w;
    }
}

struct Src { const bf16_t* K; const bf16_t* V; int stride; };

template <int MODE>
__device__ __forceinline__ void branch(const Src s, char* lds, const bf16x8* qr, f32x16* o, float& m, float& l, int NTL, int jbase, int t, int qb, int wid, int lane, int tid,
                                       const unsigned (&selw)[4], float inv_l) {
    const int r32 = lane & 31, hi = lane >> 5, rh = wid >> 1, iq = (wid & 1) * 32 + r32;
    char* V_lds = lds + L_V; char* K_lds = lds + L_K;
    float* al_l = (float*)(lds + L_WS) + wid * 64 + 32;
    const float* lut = (const float*)(lds + L_LUT) + rh * 128;
    const int* tl = (const int*)(lds + L_TL);
    float* impL = (float*)(lds + L_IMP);
    const int vb0 = (int)(uintptr_t)V_lds + v_rd_base(lane);
    const float cb = lut[127];
    constexpr bool HASV = MODE != 0;
    LAS unsigned char* ldsl = (LAS unsigned char*)lds;
#define TILE_OF(n) (MODE == 2 ? tl[n] : jbase + (n))
#define DMA(j, bf) do { const bf16_t* kt_ = s.K + (size_t)(j) * 64 * s.stride; const bf16_t* vt_ = s.V + (size_t)(j) * 64 * s.stride; \
        int ln_ = lane; asm volatile("" : "+v"(ln_));        \
        _Pragma("unroll") for (int i_ = 0; i_ < 2; ++i_) { \
            const int row_ = i_ * 32 + wid * 4 + (ln_ >> 4), srcch_ = (ln_ & 15) ^ (row_ & 7); \
            __builtin_amdgcn_global_load_lds((const unsigned*)(kt_ + (row_ * s.stride + srcch_ * 8)), (LAS unsigned*)(ldsl + L_K + (bf) * SHM_K + i_ * 8192 + wid * 1024), 16, 0, 0); \
            if (HASV) { const int kk_ = (i_ * 4 + (wid >> 1)) * 8 + ((ln_ & 31) >> 2), k_ = (kk_ & ~0xC) | ((kk_ & 4) << 1) | ((kk_ & 8) >> 1), cc_ = ((wid & 1) * 2 + (ln_ >> 5)) * 32 + (ln_ & 3) * 8; \
                __builtin_amdgcn_global_load_lds((const unsigned*)(vt_ + (k_ * s.stride + cc_)), (LAS unsigned*)(ldsl + L_V + (bf) * SHM_V + i_ * 8192 + wid * 1024), 16, 0, 0); } } } while (0)
#define COMPUTE(n, BF) do { const int j_ = TILE_OF(n); \
        bool act_ = true; bool rowsel_ = true; \
        if (MODE == 2) { const unsigned w_ = j_ < 32 ? selw[0] : j_ < 64 ? selw[1] : j_ < 96 ? selw[2] : selw[3]; rowsel_ = (w_ >> (j_ & 31)) & 1u; act_ = __any(rowsel_); } \
        if (act_) { f32x16 p0, p1; \
            qkt<BF>(p0, p1, K_lds, r32, hi, qr); \
              \
            const bool plain_ = MODE >= 2 && (qb - j_ > 2) && !(MODE == 3 && j_ == qb - 8); \
            float sc_ = C2, cb_ = cb; bool sel_ = rowsel_; \
            if (!plain_) { sc_ = 1.f; cb_ = 0.f; sel_ = true; \
                if (MODE <= 1) { \
                    if (64 * j_ + 63 >= 4 * qb - 10) bias_near<16>(p0, p1, t - 31 - 16 * (64 * j_ + 4 * hi), lut); else bias_const(p0, p1, cb); \
                    if (64 * j_ + 63 > ((64 * qb - 31) >> 4)) mask_tile(p0, p1, ((t - 31) >> 4) - 64 * j_ - 4 * hi, 1u << 30); \
                } else { \
                    bias_near<1>(p0, p1, t - 64 * j_ - 4 * hi, lut); \
                    if (MODE == 2) { if (j_ == qb) mask_tile(p0, p1, t - 64 * j_ - 4 * hi, 1u << 30); \
                        if (!rowsel_) { const float NEG_ = -__builtin_inff(); _Pragma("unroll") for (int r = 0; r < 16; ++r) { p0[r] = NEG_; p1[r] = NEG_; } } } \
                    else { if (j_ == qb || j_ == qb - 8) mask_tile(p0, p1, t - 64 * j_ - 4 * hi, 512u); } \
                } \
            } \
            if (MODE == 1) { \
                _Pragma("unroll") for (int r = 0; r < 16; ++r) { p0[r] = __builtin_amdgcn_exp2f(p0[r] - m) * inv_l; p1[r] = __builtin_amdgcn_exp2f(p1[r] - m) * inv_l; } \
                _Pragma("unroll") for (int a = 0; a < 4; ++a) { \
                    const int jj0 = 16 * j_ + 2 * a + hi, jj1 = jj0 + 8; \
                    atomicAdd(&impL[iq * 128 + jj0], p0[4 * a] + p0[4 * a + 1] + p0[4 * a + 2] + p0[4 * a + 3]); \
                    atomicAdd(&impL[iq * 128 + jj1], p1[4 * a] + p1[4 * a + 1] + p1[4 * a + 2] + p1[4 * a + 3]); \
                    if (jj0 + 1 < 128) atomicAdd(&impL[iq * 128 + jj0 + 1], p0[4 * a + 3]); \
                    if (jj1 + 1 < 128) atomicAdd(&impL[iq * 128 + jj1 + 1], p1[4 * a + 3]); } \
            } else { float alpha_; softmax_online(p0, p1, sc_, cb_, sel_, m, l, alpha_); if (MODE != 0) rescale_o(o, alpha_, al_l, r32, hi); } \
            if (MODE != 0) { bf16x8 pa0, pa1, pa2, pa3; pack_p(p0, p1, pa0, pa1, pa2, pa3); pv_tile<BF>(o, vb0, pa0, pa1, pa2, pa3); } \
        } } while (0)
#define STEP(n, BF) do { \
        if ((n) + 1 < NTL) DMA(TILE_OF((n) + 1), 1 - (BF)); \
        SBAR(); COMPUTE(n, BF); SBAR(); \
        asm volatile("s_waitcnt vmcnt(0)" ::: "memory"); \
        __syncthreads(); } while (0)
    if (NTL > 0) {
        DMA(TILE_OF(0), 0); asm volatile("s_waitcnt vmcnt(0)" ::: "memory");
        __syncthreads();
        for (int n = 0; n < NTL; n += 2) { STEP(n, 0); if (n + 1 < NTL) STEP(n + 1, 1); }
    }
#undef TILE_OF
#undef DMA
#undef COMPUTE
#undef STEP
}

__device__ __forceinline__ void item(unsigned char* ws, int b, int g, int qb, char* lds) {
    const int tid = tid_(), wid = __builtin_amdgcn_readfirstlane(tid >> 6), lane = tid & 63, r32 = lane & 31, hi = lane >> 5, rh = wid >> 1, iq = (wid & 1) * 32 + r32;
    const int t = qb * 64 + iq, head = g * 4 + rh;
    bf16_t* proj = (bf16_t*)(ws + OFF_PROJ);
    const size_t tok0 = (size_t)b * T_;
    float* impL = (float*)(lds + L_IMP); unsigned* selL = (unsigned*)(lds + L_SEL); unsigned* uniL = (unsigned*)(lds + L_UNI); int* tl = (int*)(lds + L_TL);
    for (int i = tid; i < 64 * 128; i += 512) impL[i] = 0.f;
    if (tid < 4) uniL[tid] = 0u;
    { const float* lutg = (const float*)(ws + OFF_LUT) + (g * 4) * 128; ((float*)(lds + L_LUT))[tid] = lutg[tid] * LOG2E; }
    bf16x8 qr[8];
    { const bf16_t* qp = proj + (tok0 + t) * LDP + C_NQ + head * 128 + hi * 8;
#pragma unroll
      for (int d0 = 0; d0 < 8; ++d0) qr[d0] = *(const bf16x8*)(qp + d0 * 16); }
    unsigned selw[4] = {0u, 0u, 0u, 0u};
    f32x16 o[4];
    __syncthreads();
    {
        const Src s{(const bf16_t*)(ws + OFF_KCMP) + (size_t)(b * 2 + g) * 512 * 128, (const bf16_t*)(ws + OFF_VCMP) + (size_t)(b * 2 + g) * 512 * 128, 128};
        const int nct = ((4 * qb + 2) >> 6) + 1;
        float m = -1e30f, l = 0.f;
        branch<0>(s, lds, qr, o, m, l, nct, 0, t, qb, wid, lane, tid, selw, 0.f);
#pragma unroll
        for (int d = 0; d < 4; ++d) o[d] = f32x16{};
        const float inv_l = l > 0.f ? 1.f / l : 0.f;
        branch<1>(s, lds, qr, o, m, l, nct, 0, t, qb, wid, lane, tid, selw, inv_l);
        flush_out(o, 1.f, 0, ws, lds, b, g, qb, wid, lane, true);
    }
    __syncthreads();
    {
        const int q = wid * 8 + (lane >> 3), sub = lane & 7;
        unsigned m0 = 0u, m1 = 0u, m2 = 0u, m3 = 0u;
        if (qb <= 15) { m0 = qb == 31 ? 0xFFFFFFFFu : ((1u << (qb + 1)) - 1u); }
        else {
            unsigned key[16];
#pragma unroll
            for (int k = 0; k < 16; ++k) { const int j = sub * 16 + k; key[k] = (j >= 1 && j <= qb - 2) ? ((__float_as_uint(impL[q * 128 + j]) & ~0x7Fu) | (unsigned)(127 - j)) : 0u; }
            for (int it = 0; it < 13; ++it) {
                unsigned lm = key[0];
#pragma unroll
                for (int k = 1; k < 16; ++k) lm = lm > key[k] ? lm : key[k];
                unsigned gm = lm, x;
                x = (unsigned)__builtin_amdgcn_update_dpp(0, (int)gm, 0xB1, 0xF, 0xF, true); gm = gm > x ? gm : x;
                x = (unsigned)__builtin_amdgcn_update_dpp(0, (int)gm, 0x4E, 0xF, 0xF, true); gm = gm > x ? gm : x;
                x = (unsigned)__builtin_amdgcn_update_dpp(0, (int)gm, 0x141, 0xF, 0xF, true); gm = gm > x ? gm : x;
#pragma unroll
                for (int k = 0; k < 16; ++k) key[k] = key[k] == gm ? 0u : key[k];
                const int j = 127 - (int)(gm & 0x7Fu);
                const unsigned bit = 1u << (j & 31);
                m0 |= j < 32 ? bit : 0u; m1 |= (j >= 32 && j < 64) ? bit : 0u; m2 |= (j >= 64 && j < 96) ? bit : 0u; m3 |= j >= 96 ? bit : 0u;
            }
            m0 |= 1u;
            { const int j = qb; const unsigned bit = 1u << (j & 31); m0 |= j < 32 ? bit : 0u; m1 |= (j >= 32 && j < 64) ? bit : 0u; m2 |= (j >= 64 && j < 96) ? bit : 0u; m3 |= j >= 96 ? bit : 0u; }
            { const int j = qb - 1; const unsigned bit = 1u << (j & 31); m0 |= j < 32 ? bit : 0u; m1 |= (j >= 32 && j < 64) ? bit : 0u; m2 |= (j >= 64 && j < 96) ? bit : 0u; m3 |= j >= 96 ? bit : 0u; }
        }
        if (sub == 0) { selL[q * 4 + 0] = m0; selL[q * 4 + 1] = m1; selL[q * 4 + 2] = m2; selL[q * 4 + 3] = m3;
                        atomicOr(&uniL[0], m0); atomicOr(&uniL[1], m1); atomicOr(&uniL[2], m2); atomicOr(&uniL[3], m3); }
    }
    __syncthreads();
    int nsl = 0;
    {
        if (wid == 0) {
            const bool s0 = lane <= qb && ((uniL[lane >> 5] >> (lane & 31)) & 1u), s1 = lane + 64 <= qb && ((uniL[2 + (lane >> 5)] >> (lane & 31)) & 1u);
            const unsigned long long b0 = __ballot(s0), b1 = __ballot(s1), below = (1ull << lane) - 1ull;
            const int n0 = __popcll(b0);
            if (s0) tl[__popcll(b0 & below)] = lane;
            if (s1) tl[n0 + __popcll(b1 & below)] = lane + 64;
            if (lane == 0) tl[128] = n0 + __popcll(b1);
        }
        selw[0] = selL[iq * 4 + 0]; selw[1] = selL[iq * 4 + 1]; selw[2] = selL[iq * 4 + 2]; selw[3] = selL[iq * 4 + 3];
        __syncthreads();
        nsl = tl[128];
    }
    {
        const Src s{proj + tok0 * LDP + C_KS + g * 128, proj + tok0 * LDP + C_VS + g * 128, LDP};
        float m = -1e30f, l = 0.f;
#pragma unroll
        for (int d = 0; d < 4; ++d) o[d] = f32x16{};
        branch<2>(s, lds, qr, o, m, l, nsl, 0, t, qb, wid, lane, tid, selw, 0.f);
        flush_out(o, l, 1, ws, lds, b, g, qb, wid, lane, false);
    }
    __syncthreads();
    {
        const Src s{proj + tok0 * LDP + C_KW + g * 128, proj + tok0 * LDP + C_VW + g * 128, LDP};
        const int jlo = qb >= 8 ? qb - 8 : 0;
        float m = -1e30f, l = 0.f;
#pragma unroll
        for (int d = 0; d < 4; ++d) o[d] = f32x16{};
        branch<3>(s, lds, qr, o, m, l, qb - jlo + 1, jlo, t, qb, wid, lane, tid, selw, 0.f);
        flush_out(o, l, 2, ws, lds, b, g, qb, wid, lane, false);
    }
    __syncthreads();
}
#undef KSWZ
#undef SBAR
}

__device__ void ph_hpre(const Params& p, int u) {
    const int tid = tid_(), b = u >> 8, n = u & 255, c2 = tid * 2;
    char* proj = (char*)(p.ws + OFF_PROJ) + (size_t)(b * T_ + n * 32) * (LDP * 2);
    const unsigned vo = (unsigned)c2 * 2u;
    const float* lb = (const float*)(p.ws + OFF_LB);
    const float kb0 = 1.f - lb[c2], kb1 = 1.f - lb[c2 + 1];
    float b0[32], b1[32];
    unsigned wf[32], wq[32];
#pragma unroll
    for (int i = 0; i < 32; ++i) wf[i] = *(const unsigned*)(proj + ((size_t)i * (LDP * 2) + C_HF * 2) + vo);
#pragma unroll
    for (int i = 0; i < 32; ++i) wq[i] = *(const unsigned*)(proj + ((size_t)i * (LDP * 2) + C_HQ * 2) + vo);
    float s0 = 1.f, s1 = 1.f;
#pragma unroll
    for (int i = 0; i < 32; ++i) {
        const float r0 = __uint_as_float(wf[i] << 16), r1 = __uint_as_float(wf[i] & 0xFFFF0000u);
        const float k0 = kb0 * sigmoidf_(-r0), k1 = kb1 * sigmoidf_(-r1);
        s0 *= 1.f - k0; s1 *= 1.f - k1;
        b0[i] = s0; b1[i] = s1;
        wf[i] = pg8::cvt_pk_bf16(k0, k1);
    }
    const float il0 = __builtin_amdgcn_rcpf(fmaxf(s0, 1e-30f)), il1 = __builtin_amdgcn_rcpf(fmaxf(s1, 1e-30f));
#pragma unroll
    for (int i = 0; i < 32; ++i) {
        const float k0 = __uint_as_float(wf[i] << 16), k1 = __uint_as_float(wf[i] & 0xFFFF0000u);
        const float q0 = __uint_as_float(wq[i] << 16), q1 = __uint_as_float(wq[i] & 0xFFFF0000u);
        const float e0 = s0 * __builtin_amdgcn_rcpf(fmaxf(b0[i], 1e-30f)), e1 = s1 * __builtin_amdgcn_rcpf(fmaxf(b1[i], 1e-30f));
        unsigned long long ro = (unsigned long long)i * (LDP * 2); asm volatile("" : "+s"(ro));
        char* rp = proj + ro + vo;
        *(unsigned*)(rp + C_HQ * 2) = pg8::cvt_pk_bf16(q0 * (b0[i] * il0), q1 * (b1[i] * il1));
        *(unsigned*)(rp + C_HF * 2) = pg8::cvt_pk_bf16(k0 * e0, k1 * e1);
    }
    float* dec = (float*)(p.ws + OFF_DEC) + ((size_t)((b * 8 + (c2 >> 7)) * 256 + n)) * 256 + (c2 & 127);
    dec[0] = s0; dec[1] = s1;
}

namespace hg {
typedef short bf16x8 __attribute__((ext_vector_type(8)));
typedef short s16x4 __attribute__((ext_vector_type(4)));
typedef float f32x4 __attribute__((ext_vector_type(4)));
typedef unsigned u32x4 __attribute__((ext_vector_type(4)));
constexpr int BUF = 25600, L_QA = 0, L_KE = 8192, L_VV = 16384, L_DEC = 24576, L_OB = 51200, OBS = 132;
__device__ __forceinline__ unsigned off_b(unsigned row, unsigned ch) { return 256u * row + 16u * (ch ^ (((row & 3) << 2) | ((row >> 2) & 3))); }
__device__ __forceinline__ unsigned tr_addr16(unsigned lane, unsigned c, unsigned t) {
    const unsigned g = lane >> 4, q = (lane & 15) >> 2, pp = lane & 3;
    return off_b(8 * g + 4 * t + q, 2 * c + (pp >> 1)) + 8 * (pp & 1);
}
__device__ __forceinline__ unsigned cvtpk(float lo, float hi) { unsigned r; asm volatile("v_cvt_pk_bf16_f32 %0, %1, %2" : "=v"(r) : "v"(lo), "v"(hi)); return r; }
__device__ __forceinline__ bf16x8 pack8(f32x4 a, f32x4 b) { u32x4 w = {cvtpk(a[0], a[1]), cvtpk(a[2], a[3]), cvtpk(b[0], b[1]), cvtpk(b[2], b[3])}; return *reinterpret_cast<bf16x8*>(&w); }
__device__ __forceinline__ s16x4 tr_read(unsigned addr) { s16x4 r; asm volatile("ds_read_b64_tr_b16 %0, %1" : "=v"(r) : "v"(addr) : "memory"); return r; }

__device__ __forceinline__ void item(unsigned char* ws, const float* norm_w, int b, int h, char* lds) {
    const int tid = tid_(), wid = __builtin_amdgcn_readfirstlane(tid >> 6), lane = tid & 63, l15 = lane & 15, g = lane >> 4;
    bf16_t* proj = (bf16_t*)(ws + OFF_PROJ) + (size_t)b * T_ * LDP + h * 128;
    const float* decg = (const float*)(ws + OFF_DEC) + (size_t)(b * 8 + h) * 256 * 256;
    LAS unsigned char* ldsl = (LAS unsigned char*)lds;
    const unsigned ldsb = (unsigned)(uintptr_t)lds;
    const int drow = 4 * wid + (lane >> 4);
    const unsigned dsrc = (unsigned)(drow * LDP + (((lane & 15) ^ (((drow & 3) << 2) | ((drow >> 2) & 3))) * 8));
#define HDMA(n, bf) do { const bf16_t* cp_ = proj + (size_t)(n) * 32 * LDP + dsrc; \
        __builtin_amdgcn_global_load_lds((const unsigned*)(cp_ + C_HQ), (LAS unsigned*)(ldsl + (bf) * BUF + L_QA + wid * 1024), 16, 0, 0); \
        __builtin_amdgcn_global_load_lds((const unsigned*)(cp_ + C_HF), (LAS unsigned*)(ldsl + (bf) * BUF + L_KE + wid * 1024), 16, 0, 0); \
        __builtin_amdgcn_global_load_lds((const unsigned*)(cp_ + C_HI), (LAS unsigned*)(ldsl + (bf) * BUF + L_VV + wid * 1024), 16, 0, 0); \
        if (wid == 0) __builtin_amdgcn_global_load_lds((const unsigned*)(decg + (size_t)(n) * 256 + lane * 4), (LAS unsigned*)(ldsl + (bf) * BUF + L_DEC), 16, 0, 0); } while (0)
    unsigned a_ke[2], a_qa[2], a_qp[2], a_vt[2];
#pragma unroll
    for (int x = 0; x < 2; ++x) {
        a_ke[x] = off_b(8 * (l15 >> 2) + 4 * x + (l15 & 3), g);
        a_qa[x] = off_b(16 * x + l15, g);
        a_qp[x] = off_b(16 * x + l15, g >> 1) + 8 * (g & 1);
        a_vt[x] = tr_addr16(lane, wid, x);
    }
    const int ntok = tid >> 4, ndv = (tid & 15) * 8;
    f32x4 S[8];
#pragma unroll
    for (int i = 0; i < 8; ++i) S[i] = (f32x4){0.f, 0.f, 0.f, 0.f};
    float* obuf = (float*)(lds + L_OB);
    HDMA(0, 0); asm volatile("s_waitcnt vmcnt(0)" ::: "memory");
    __syncthreads();
    for (int n = 0; n < 256; ++n) {
        const int bf = n & 1;
        if (n + 1 < 256) HDMA(n + 1, bf ^ 1);
        const u32x4 hgw = *(const u32x4*)(proj + (size_t)(n * 32 + ntok) * LDP + C_HG + ndv);
        const unsigned B0 = ldsb + bf * BUF;
        f32x4 att[2][2];
#pragma unroll
        for (int x = 0; x < 2; ++x)
#pragma unroll
            for (int y = 0; y < 2; ++y) att[x][y] = (f32x4){0.f, 0.f, 0.f, 0.f};
#pragma unroll
        for (int ks = 0; ks < 4; ++ks) {
            bf16x8 ka[2], qb[2];
#pragma unroll
            for (int x = 0; x < 2; ++x) {
                const unsigned rj = 8 * (l15 >> 2) + 4 * x + (l15 & 3), ri = 16 * x + l15;
                ka[x] = *(const LAS bf16x8*)(uintptr_t)(B0 + L_KE + off_b(rj, 4 * ks + g));
                qb[x] = *(const LAS bf16x8*)(uintptr_t)(B0 + L_QA + off_b(ri, 4 * ks + g));
            }
#pragma unroll
            for (int x = 0; x < 2; ++x)
#pragma unroll
                for (int y = 0; y < 2; ++y) att[x][y] = __builtin_amdgcn_mfma_f32_16x16x32_bf16(ka[x], qb[y], att[x][y], 0, 0, 0);
        }
        bf16x8 attf[2];
#pragma unroll
        for (int y = 0; y < 2; ++y) {
            const int i = 16 * y + l15;
            f32x4 a0 = att[0][y], a1 = att[1][y];
#pragma unroll
            for (int r = 0; r < 4; ++r) { if (8 * g + r > i) a0[r] = 0.f; if (8 * g + 4 + r > i) a1[r] = 0.f; }
            attf[y] = pack8(a0, a1);
        }
        bf16x8 vf;
        { const s16x4 v0 = tr_read(B0 + L_VV + a_vt[0]), v1 = tr_read(B0 + L_VV + a_vt[1]);
          asm volatile("s_waitcnt lgkmcnt(0)" ::: "memory");
          vf = (bf16x8){v0[0], v0[1], v0[2], v0[3], v1[0], v1[1], v1[2], v1[3]}; }
        f32x4 o[2];
#pragma unroll
        for (int y = 0; y < 2; ++y) o[y] = __builtin_amdgcn_mfma_f32_16x16x32_bf16(vf, attf[y], (f32x4){0.f, 0.f, 0.f, 0.f}, 0, 0, 0);
#pragma unroll
        for (int dt = 0; dt < 8; ++dt) { const f32x4 d = *(const LAS f32x4*)(uintptr_t)(B0 + L_DEC + (16 * dt + 4 * g) * 4); S[dt] *= d; }
#pragma unroll
        for (int ks = 0; ks < 4; ++ks) {
            const bf16x8 sa = pack8(S[2 * ks], S[2 * ks + 1]);
#pragma unroll
            for (int y = 0; y < 2; ++y) {
                const unsigned ri = 16 * y + l15;
                const unsigned long long q0 = *(const LAS unsigned long long*)(uintptr_t)(B0 + L_QA + off_b(ri, 4 * ks + (g >> 1)) + 8 * (g & 1));
                const unsigned long long q1 = *(const LAS unsigned long long*)(uintptr_t)(B0 + L_QA + off_b(ri, 4 * ks + 2 + (g >> 1)) + 8 * (g & 1));
                u32x4 w = {(unsigned)q0, (unsigned)(q0 >> 32), (unsigned)q1, (unsigned)(q1 >> 32)};
                o[y] = __builtin_amdgcn_mfma_f32_16x16x32_bf16(sa, *reinterpret_cast<bf16x8*>(&w), o[y], 0, 0, 0);
            }
        }
#pragma unroll
        for (int dt = 0; dt < 8; ++dt) {
            const s16x4 k0 = tr_read(B0 + L_KE + tr_addr16(lane, dt, 0)), k1 = tr_read(B0 + L_KE + tr_addr16(lane, dt, 1));
            asm volatile("s_waitcnt lgkmcnt(0)" ::: "memory");
            const bf16x8 kf = (bf16x8){k0[0], k0[1], k0[2], k0[3], k1[0], k1[1], k1[2], k1[3]};
            S[dt] = __builtin_amdgcn_mfma_f32_16x16x32_bf16(kf, vf, S[dt], 0, 0, 0);
        }
#pragma unroll
        for (int y = 0; y < 2; ++y) *(f32x4*)(obuf + (16 * y + l15) * OBS + 16 * wid + 4 * g) = o[y];
        __syncthreads();
        {
            const f32x4 x0 = *(const f32x4*)(obuf + ntok * OBS + ndv), x1 = *(const f32x4*)(obuf + ntok * OBS + ndv + 4);
            float ss = x0[0] * x0[0] + x0[1] * x0[1] + x0[2] * x0[2] + x0[3] * x0[3] + x1[0] * x1[0] + x1[1] * x1[1] + x1[2] * x1[2] + x1[3] * x1[3];
            ss += __shfl_xor(ss, 1); ss += __shfl_xor(ss, 2); ss += __shfl_xor(ss, 4); ss += __shfl_xor(ss, 8);
            const float r = rsqrtf(ss * (1.f / 128.f) + 1e-6f);
            const float gv[8] = {__uint_as_float(hgw.x << 16), __uint_as_float(hgw.x & 0xFFFF0000u), __uint_as_float(hgw.y << 16), __uint_as_float(hgw.y & 0xFFFF0000u),
                                 __uint_as_float(hgw.z << 16), __uint_as_float(hgw.z & 0xFFFF0000u), __uint_as_float(hgw.w << 16), __uint_as_float(hgw.w & 0xFFFF0000u)};
            const float xv[8] = {x0[0], x0[1], x0[2], x0[3], x1[0], x1[1], x1[2], x1[3]};
            const f32x4 n0 = *(const f32x4*)(norm_w + h * 128 + ndv), n1 = *(const f32x4*)(norm_w + h * 128 + ndv + 4);
            const float nw[8] = {n0[0], n0[1], n0[2], n0[3], n1[0], n1[1], n1[2], n1[3]};
            float ov[8];
#pragma unroll
            for (int i = 0; i < 8; ++i) ov[i] = xv[i] * r * nw[i] * sigmoidf_(gv[i]);
            u32x4 w = {cvtpk(ov[0], ov[1]), cvtpk(ov[2], ov[3]), cvtpk(ov[4], ov[5]), cvtpk(ov[6], ov[7])};
            *(u32x4*)(proj + (size_t)(n * 32 + ntok) * LDP + C_HI + ndv) = w;
        }
        asm volatile("s_waitcnt vmcnt(0)" ::: "memory");
        __syncthreads();
    }
#undef HDMA
    (void)a_ke; (void)a_qa; (void)a_qp;
}
}

__device__ void cvt_tile(float* sm, const float* src, int ldsrc, int k0, int ns0, int nvalid, bf16_t* dst, int lddst, int nd0) {
    float(*t)[65] = (float(*)[65])sm;
    const int tid = tid_();
    float4 v[8];
#pragma unroll
    for (int r = 0; r < 8; ++r) {
        const int idx = tid + r * 512, k = idx >> 4, n4 = (idx & 15) * 4;
        v[r] = n4 < nvalid ? *(const float4*)(src + (size_t)(k0 + k) * ldsrc + ns0 + n4) : make_float4(0.f, 0.f, 0.f, 0.f);
    }
#pragma unroll
    for (int r = 0; r < 8; ++r) {
        const int idx = tid + r * 512, k = idx >> 4, n4 = (idx & 15) * 4;
        t[k][n4] = v[r].x; t[k][n4 + 1] = v[r].y; t[k][n4 + 2] = v[r].z; t[k][n4 + 3] = v[r].w;
    }
    __syncthreads();
#pragma unroll
    for (int r = 0; r < 4; ++r) {
        const int idx = tid + r * 512, kg = idx & 31, n = idx >> 5;
        uint4 w;
        w.x = (unsigned)f2bf(t[kg * 8 + 0][n]) | ((unsigned)f2bf(t[kg * 8 + 1][n]) << 16); w.y = (unsigned)f2bf(t[kg * 8 + 2][n]) | ((unsigned)f2bf(t[kg * 8 + 3][n]) << 16);
        w.z = (unsigned)f2bf(t[kg * 8 + 4][n]) | ((unsigned)f2bf(t[kg * 8 + 5][n]) << 16); w.w = (unsigned)f2bf(t[kg * 8 + 6][n]) | ((unsigned)f2bf(t[kg * 8 + 7][n]) << 16);
        *(uint4*)(dst + (size_t)(nd0 + n) * lddst + k0 + kg * 8) = w;
    }
    __syncthreads();
}
__device__ __forceinline__ int gemm1_src_col(int nd) { return nd < 6656 ? nd : nd < 8704 ? nd + 24 : nd < 8728 ? 6656 + (nd - 8704) : -1; }
__device__ void ph_cvt_win(const Params& p, int u, float* sm) {
    if (u < 560) {
        const int nt = u >> 2, kt = u & 3, nd0 = nt * 64;
        const int ns0 = nd0 < 6656 ? nd0 : nd0 < 8704 ? nd0 + 24 : 6656, nvalid = nd0 < 8704 ? 64 : nd0 == 8704 ? 24 : 0;
        cvt_tile(sm, p.w_in, DIN, kt * 256, ns0, nvalid, (bf16_t*)(p.ws + OFF_WINT), 1024, nd0);
    } else {
        float* b1 = (float*)(p.ws + OFF_BIAS1);
        for (int i = tid_(); i < N1; i += 512) { const int s = gemm1_src_col(i); b1[i] = s >= 0 ? p.b_in[s] : 0.f; }
    }
}
__device__ void ph_cvt_br(const Params& p, int u, float* sm) {
    const int w = u >> 6, t = u & 63, nt = t >> 2, kt = t & 3;
    if (w < 2) cvt_tile(sm, w == 0 ? p.w_br_hg : p.w_br_nsa, 1024, kt * 256, nt * 64, 64, (bf16_t*)(p.ws + OFF_WBRH) + w * 1024, 2048, nt * 64);
    else cvt_tile(sm, p.w_out, 1024, kt * 256, nt * 64, 64, (bf16_t*)(p.ws + OFF_WOUTT), 1024, nt * 64);
}
__device__ void ph_cvt_exp(const Params& p, int u, float* sm) {
    if (u < 2048) {
        const int e = u >> 6, t = u & 63, nt = t >> 2, kt = t & 3, nd0 = nt * 64, pn = nd0 >> 8, half = (nd0 >> 7) & 1, off = nd0 & 127;
        cvt_tile(sm, (half ? p.e_w3 : p.e_w1) + (size_t)e * 1024 * 512, 512, kt * 256, pn * 128 + off, 64, (bf16_t*)(p.ws + OFF_E13) + (size_t)e * 1024 * 1024, 1024, nd0);
    } else {
        const int v = u - 2048, e = v >> 5, t = v & 31, nt = t >> 1, kt = t & 1;
        cvt_tile(sm, p.e_w2 + (size_t)e * 512 * 1024, 1024, kt * 256, nt * 64, 64, (bf16_t*)(p.ws + OFF_E2T) + (size_t)e * 1024 * 512, 512, nt * 64);
    }
}
enum { PH_PRO = 0, PH_LN0, PH_CMP2, PH_FINAL };
__host__ __device__ constexpr int phase_units(int ph) { return ph == PH_PRO ? 99 : ph == PH_LN0 ? NT / 16 : ph == PH_CMP2 ? 64 : ph == PH_FINAL ? NT / 16 : 0; }

__device__ void ph_pro(const Params& p, int u, float* sm) {
    const int tid = tid_();
    float* mod = (float*)(p.ws + OFF_MOD);
    if (u < 96) {
        float* ca = sm;
        float* red = sm + 4096;
        for (int i = tid; i < 4096; i += 512) ca[i] = siluf_(p.c[i]);
        __syncthreads();
        const int col = u * 64 + (tid & 63), kg = tid >> 6;
        float a0 = 0.f, a1 = 0.f, a2 = 0.f, a3 = 0.f;
        for (int k = kg * 128; k < kg * 128 + 128; ++k) {
            const float w = p.ada_w[(size_t)k * 6144 + col];
            a0 = fmaf(ca[k], w, a0); a1 = fmaf(ca[1024 + k], w, a1); a2 = fmaf(ca[2048 + k], w, a2); a3 = fmaf(ca[3072 + k], w, a3);
        }
        red[(kg * 64 + (tid & 63)) * 4 + 0] = a0; red[(kg * 64 + (tid & 63)) * 4 + 1] = a1; red[(kg * 64 + (tid & 63)) * 4 + 2] = a2; red[(kg * 64 + (tid & 63)) * 4 + 3] = a3;
        __syncthreads();
        if (tid < 256) {
            const int cl = tid & 63, b = tid >> 6;
            float s = 0.f;
            for (int g = 0; g < 8; ++g) s += red[(g * 64 + cl) * 4 + b];
            mod[b * 6144 + u * 64 + cl] = s + p.ada_b[u * 64 + cl];
        }
        __syncthreads();
    } else if (u == 96) {
        float* lb = (float*)(p.ws + OFF_LB);
        float* lut = (float*)(p.ws + OFF_LUT);
        unsigned* cnt = (unsigned*)(p.ws + OFF_CNT);
        for (int i = tid; i < 1024; i += 512) {
            const float l0 = p.lb_logits[i], l1 = p.lb_logits[1024 + i];
            lb[i] = 1.f / (1.f + __expf(l1 - l0));
            const int h = i >> 7, d = i & 127;
            lut[i] = p.rel_bias[h * 32 + rel_bucket(d)];
        }
        if (tid < 64) cnt[tid] = 0u;
        if (tid < 8) ((unsigned*)(p.ws + OFF_QCTR))[tid * 64] = 0u;
        { bf16_t* kc = (bf16_t*)(p.ws + OFF_KCMP); bf16_t* vc = (bf16_t*)(p.ws + OFF_VCMP);
          for (int i = tid; i < 8 * 128; i += 512) { kc[(size_t)((i >> 7) * 512 + 511) * 128 + (i & 127)] = 0; vc[(size_t)((i >> 7) * 512 + 511) * 128 + (i & 127)] = 0; } }
    } else {
        const int kv = u - 97;
        float* cb = (float*)(p.ws + OFF_CB) + kv * 128;
        if (tid < 128) cb[tid] = (kv ? p.b1_v : p.b1_k)[tid];
    }
}
__device__ void ph_cmpconst(const Params& p, int u, float* sm) {
    const int tid = tid_(), kv = u >> 5, kc = u & 31;
    const float* pos = kv ? p.pos_v : p.pos_k; const float* w1 = kv ? p.w1_v : p.w1_k;
    const int n = tid & 127, kg = tid >> 7;
    float s = 0.f;
#pragma unroll 8
    for (int k = kc * 128 + kg * 32; k < kc * 128 + kg * 32 + 32; ++k) s = fmaf(pos[k], w1[(size_t)k * 128 + n], s);
    sm[kg * 128 + n] = s;
    __syncthreads();
    if (tid < 128) atomicAdd((float*)(p.ws + OFF_CB) + kv * 128 + tid, sm[tid] + sm[128 + tid] + sm[256 + tid] + sm[384 + tid]);
    __syncthreads();
}

__device__ void ph_ln0(const Params& p, int u) {
    const int tidx = tid_(), lane = tidx & 63;
    float4 v[2][4]; float s[2] = {0.f, 0.f}; int rowi[2];
#pragma unroll
    for (int k = 0; k < 2; ++k) {
        rowi[k] = (u + k * (NT / 16)) * 8 + (tidx >> 6);
        const float* xr = p.x + (size_t)rowi[k] * D_;
#pragma unroll
        for (int i = 0; i < 4; ++i) { v[k][i] = *(const float4*)(xr + (i * 64 + lane) * 4); s[k] += v[k][i].x + v[k][i].y + v[k][i].z + v[k][i].w; }
    }
#pragma unroll
    for (int k = 0; k < 2; ++k) {
        const float* mod = (const float*)(p.ws + OFF_MOD) + (rowi[k] / T_) * 6144;
        bf16_t* h = (bf16_t*)(p.ws + OFF_H) + (size_t)rowi[k] * D_;
        const float mu = wsum(s[k]) * (1.f / 1024.f);
        float q = 0.f;
#pragma unroll
        for (int i = 0; i < 4; ++i) { v[k][i].x -= mu; v[k][i].y -= mu; v[k][i].z -= mu; v[k][i].w -= mu; q += v[k][i].x * v[k][i].x + v[k][i].y * v[k][i].y + v[k][i].z * v[k][i].z + v[k][i].w * v[k][i].w; }
        const float rs = rsqrtf(wsum(q) * (1.f / 1024.f) + 1e-5f);
#pragma unroll
        for (int i = 0; i < 4; ++i) {
            const int c = (i * 64 + lane) * 4;
            const float4 sh = *(const float4*)(mod + c), sc = *(const float4*)(mod + 1024 + c);
            st_bf4(h + c, v[k][i].x * rs * (1.f + sc.x) + sh.x, v[k][i].y * rs * (1.f + sc.y) + sh.y, v[k][i].z * rs * (1.f + sc.z) + sh.z, v[k][i].w * rs * (1.f + sc.w) + sh.w);
        }
    }
}

__device__ void ph_cmp2(const Params& p, int u, float* sm) {
    const int tid = tid_(), kv = u >> 5, m0 = (u & 31) * 128;
    const float* w2 = kv ? p.w2_v : p.w2_k;
    const float* hid = (const float*)(p.ws + OFF_HID) + (size_t)kv * 4096 * 128;
    const float* cb = (const float*)(p.ws + OFF_CB) + kv * 128;
    bf16_t* dst = (bf16_t*)(p.ws + (kv ? OFF_VCMP : OFF_KCMP));
    float(*As)[132] = (float(*)[132])sm;
    float(*Bs)[132] = (float(*)[132])(sm + 128 * 132);
    float4 av[8], bv[8];
#pragma unroll
    for (int r = 0; r < 8; ++r) { const int idx = tid + r * 512, row = idx >> 5, k4 = (idx & 31) * 4; av[r] = *(const float4*)(hid + (size_t)(m0 + row) * 128 + k4); bv[r] = *(const float4*)(w2 + (size_t)row * 128 + k4); }
#pragma unroll
    for (int r = 0; r < 8; ++r) { const int idx = tid + r * 512, row = idx >> 5, k4 = (idx & 31) * 4;
        const float4 c4 = *(const float4*)(cb + k4);
        As[k4][row] = siluf_(av[r].x + c4.x); As[k4 + 1][row] = siluf_(av[r].y + c4.y); As[k4 + 2][row] = siluf_(av[r].z + c4.z); As[k4 + 3][row] = siluf_(av[r].w + c4.w);
        *(float4*)&Bs[row][k4] = bv[r]; }
    __syncthreads();
    const int tx = tid & 31, ty = tid >> 5;
    float acc[8][4];
#pragma unroll
    for (int i = 0; i < 8; ++i)
#pragma unroll
        for (int j = 0; j < 4; ++j) acc[i][j] = 0.f;
#pragma unroll 8
    for (int k = 0; k < 128; ++k) {
        const float4 a0 = *(const float4*)&As[k][ty * 8], a1 = *(const float4*)&As[k][ty * 8 + 4], bb = *(const float4*)&Bs[k][tx * 4];
        const float a_[8] = {a0.x, a0.y, a0.z, a0.w, a1.x, a1.y, a1.z, a1.w};
        const float b_[4] = {bb.x, bb.y, bb.z, bb.w};
#pragma unroll
        for (int i = 0; i < 8; ++i)
#pragma unroll
            for (int j = 0; j < 4; ++j) acc[i][j] = fmaf(a_[i], b_[j], acc[i][j]);
    }
#pragma unroll
    for (int i = 0; i < 8; ++i) {
        const int m = m0 + ty * 8 + i;
        const bool dead = (m & 511) == 511;
        st_bf4(dst + (size_t)m * 128 + tx * 4, dead ? 0.f : acc[i][0], dead ? 0.f : acc[i][1], dead ? 0.f : acc[i][2], dead ? 0.f : acc[i][3]);
    }
    __syncthreads();
}

constexpr int LR_A = 0, LR_AS = 1028, LR_P = 16 * LR_AS, LR_SLOT = LR_P + 8 * 16 * 48, LR_LC = LR_SLOT + 8 * 80, LR_LNP = LR_LC + 64;
struct Ln1rArgs { unsigned char* ws; const float *ln1_g, *ln1_b, *rg_b, *re_b; float* sm; };
struct Ln1rW { const float *rg_w, *re_w; };
#define GAS __attribute__((address_space(1)))
template <class T> __device__ __forceinline__ GAS T* gptr(T* q) { return (GAS T*)q; }
#define LR_LOADZ(U_) do { _Pragma("unroll") for (int k = 0; k < 2; ++k) { const GAS float* zr_ = (const GAS float*)(ws + OFF_Z) + (size_t)((U_) * 16 + 2 * w + k) * D_; \
        _Pragma("unroll") for (int i = 0; i < 4; ++i) { const pg8::f32x4 a = *(const GAS pg8::f32x4*)(zr_ + (i * 64 + lane) * 4); v[k][i * 4] = a[0]; v[k][i * 4 + 1] = a[1]; v[k][i * 4 + 2] = a[2]; v[k][i * 4 + 3] = a[3]; } } } while (0)
__device__ __forceinline__ void ph_ln1r_(const Ln1rArgs pa, const Ln1rW pw) {
    const int tidx = tid_(), lane = tidx & 63, w = tidx >> 6, n16 = lane & 15, kq = lane >> 4;
    GAS unsigned char* ws = gptr(pa.ws);
    const GAS float *ln1_g = gptr(pa.ln1_g), *ln1_b = gptr(pa.ln1_b), *rg_b = gptr(pa.rg_b), *re_b = gptr(pa.re_b), *rg_w = gptr(pw.rg_w), *re_w = gptr(pw.re_w);
    const int c = blockIdx.x, G = gridDim.x;
    LAS float* SM = (LAS float*)pa.sm;
    float v[2][16];
    LR_LOADZ(c);
    for (int i = tidx; i < 1024; i += 512) {
        SM[LR_LNP + i] = ln1_g[i]; SM[LR_LNP + 1024 + i] = ln1_b[i];
#pragma unroll
        for (int bb = 0; bb < 4; ++bb) { const GAS float* mod = (const GAS float*)(ws + OFF_MOD) + bb * 6144; SM[LR_LNP + 2048 + bb * 2048 + i] = mod[3072 + i]; SM[LR_LNP + 3072 + bb * 2048 + i] = 1.f + mod[4096 + i]; }
    }
    const int fa_k = lane >= 36 ? 1 : 0, fa_n = lane - 36 * fa_k, fb_n = lane < 8 ? 28 + lane : 35;
    const int fa_c = fa_n < 4 ? 32 + fa_n : fa_n - 4, fb_c = fb_n - 4;
    const float bias_a = fa_n < 4 ? rg_b[fa_n] : re_b[fa_n - 4], bias_b = re_b[fb_n - 4];
    float bw[3][32];
#pragma unroll
    for (int sj = 0; sj < 32; ++sj) {
        const int k = 128 * w + 16 * (sj >> 2) + 4 * kq + (sj & 3);
        bw[0][sj] = re_w[k * 32 + n16]; bw[1][sj] = re_w[k * 32 + 16 + n16]; bw[2][sj] = rg_w[k * 4 + (n16 & 3)];
    }
#pragma unroll
    for (int sj = 0; sj < 32; ++sj) bw[2][sj] = n16 < 4 ? bw[2][sj] : 0.f;
    __syncthreads();
    for (int u = c; u < NT / 16; u += G) {
        const int row0 = u * 16 + 2 * w, b = row0 / T_;
        const LAS float* lnp = SM + LR_LNP;
#pragma unroll
        for (int k = 0; k < 2; ++k) {
            GAS float* zr = (GAS float*)(ws + OFF_Z) + (size_t)(row0 + k) * D_;
            GAS bf16_t* h2 = (GAS bf16_t*)(ws + OFF_H) + (size_t)(row0 + k) * D_;
            float s1 = 0.f;
#pragma unroll
            for (int i = 0; i < 16; ++i) s1 += v[k][i];
            float mu = wsum(s1) * (1.f / 1024.f), q = 0.f;
#pragma unroll
            for (int i = 0; i < 16; ++i) { v[k][i] -= mu; q = fmaf(v[k][i], v[k][i], q); }
            float rs = rsqrtf(wsum(q) * (1.f / 1024.f) + 1e-5f);
            float s2 = 0.f;
#pragma unroll
            for (int i = 0; i < 4; ++i) {
                const int cc = (i * 64 + lane) * 4;
                const pg8::f32x4 gg = *(const LAS pg8::f32x4*)(lnp + cc), bb = *(const LAS pg8::f32x4*)(lnp + 1024 + cc);
                v[k][i * 4] = v[k][i * 4] * rs * gg[0] + bb[0]; v[k][i * 4 + 1] = v[k][i * 4 + 1] * rs * gg[1] + bb[1]; v[k][i * 4 + 2] = v[k][i * 4 + 2] * rs * gg[2] + bb[2]; v[k][i * 4 + 3] = v[k][i * 4 + 3] * rs * gg[3] + bb[3];
                *(GAS pg8::f32x4*)(zr + cc) = (pg8::f32x4){v[k][i * 4], v[k][i * 4 + 1], v[k][i * 4 + 2], v[k][i * 4 + 3]};
                s2 += v[k][i * 4] + v[k][i * 4 + 1] + v[k][i * 4 + 2] + v[k][i * 4 + 3];
            }
            mu = wsum(s2) * (1.f / 1024.f); q = 0.f;
#pragma unroll
            for (int i = 0; i < 16; ++i) { v[k][i] -= mu; q = fmaf(v[k][i], v[k][i], q); }
            rs = rsqrtf(wsum(q) * (1.f / 1024.f) + 1e-5f);
#pragma unroll
            for (int i = 0; i < 4; ++i) {
                const int cc = (i * 64 + lane) * 4;
                const pg8::f32x4 sh = *(const LAS pg8::f32x4*)(lnp + 2048 + b * 2048 + cc), sc = *(const LAS pg8::f32x4*)(lnp + 3072 + b * 2048 + cc);
                const pg8::f32x4 o = {v[k][i * 4] * rs * sc[0] + sh[0], v[k][i * 4 + 1] * rs * sc[1] + sh[1], v[k][i * 4 + 2] * rs * sc[2] + sh[2], v[k][i * 4 + 3] * rs * sc[3] + sh[3]};
                { pg8::u32x2 pk = {pk_bf16(o[0], o[1]), pk_bf16(o[2], o[3])}; *(GAS pg8::u32x2*)(h2 + cc) = pk; }
                *(LAS pg8::f32x4*)(SM + LR_A + (2 * w + k) * LR_AS + cc) = o;
            }
        }
        __syncthreads();
        if (u + G < NT / 16) LR_LOADZ(u + G);
        {
            pg8::f32x4 acc[3] = {{0.f, 0.f, 0.f, 0.f}, {0.f, 0.f, 0.f, 0.f}, {0.f, 0.f, 0.f, 0.f}};
            const LAS float* ar = SM + LR_A + n16 * LR_AS + 128 * w + 4 * kq;
            pg8::f32x4 a4[8];
#pragma unroll
            for (int sI = 0; sI < 8; ++sI) a4[sI] = *(const LAS pg8::f32x4*)(ar + 16 * sI);
#pragma unroll
            for (int sI = 0; sI < 8; ++sI)
#pragma unroll
                for (int j = 0; j < 4; ++j)
#pragma unroll
                    for (int t = 0; t < 3; ++t) acc[t] = __builtin_amdgcn_mfma_f32_16x16x4f32(a4[sI][j], bw[t][sI * 4 + j], acc[t], 0, 0, 0);
            LAS float* pp = SM + LR_P + (w * 16 + 4 * kq) * 48 + n16;
#pragma unroll
            for (int t = 0; t < 3; ++t)
#pragma unroll
                for (int e = 0; e < 4; ++e) pp[e * 48 + 16 * t] = acc[t][e];
        }
        __syncthreads();
        {
            LAS float* slot = SM + LR_SLOT + w * 80;
            {
                const LAS float* pa_ = SM + LR_P + (2 * w + fa_k) * 48 + fa_c;
                const LAS float* pb_ = SM + LR_P + (2 * w + 1) * 48 + fb_c;
                float ta = bias_a, tb = bias_b;
#pragma unroll
                for (int ww = 0; ww < 8; ++ww) { ta += pa_[ww * 16 * 48]; tb += pb_[ww * 16 * 48]; }
                slot[lane] = ta;
                if (lane < 8) slot[64 + lane] = tb;
            }
            asm volatile("s_waitcnt lgkmcnt(0)" ::: "memory");
            const int kr = lane >> 5, row = row0 + kr;
            float lg[36];
#pragma unroll
            for (int q = 0; q < 9; ++q) { const pg8::f32x4 w4 = *(const LAS pg8::f32x4*)(slot + kr * 36 + q * 4); lg[q * 4] = w4[0]; lg[q * 4 + 1] = w4[1]; lg[q * 4 + 2] = w4[2]; lg[q * 4 + 3] = w4[3]; }
            int gi = 0; float gm = lg[0];
#pragma unroll
            for (int j = 1; j < 4; ++j) if (lg[j] > gm) { gm = lg[j]; gi = j; }
            float gs = 0.f;
#pragma unroll
            for (int j = 0; j < 4; ++j) gs += __expf(lg[j] - gm);
            const float gp = __builtin_amdgcn_rcpf(gs);
            float el[8];
#pragma unroll
            for (int i = 0; i < 8; ++i) el[i] = gi == 0 ? lg[4 + i] : gi == 1 ? lg[12 + i] : gi == 2 ? lg[20 + i] : lg[28 + i];
            int i0 = 0; float l0 = el[0];
#pragma unroll
            for (int i = 1; i < 8; ++i) if (el[i] > l0) { l0 = el[i]; i0 = i; }
            int i1 = -1; float l1 = -3.0e38f;
#pragma unroll
            for (int i = 0; i < 8; ++i) if (i != i0 && el[i] > l1) { l1 = el[i]; i1 = i; }
            const float w0 = __builtin_amdgcn_rcpf(1.f + __expf(l1 - l0));
            if ((lane & 31) == 0) {
                GAS int* ti = (GAS int*)(ws + OFF_TOKI) + (size_t)row * 6;
                const int e0 = gi * 8 + i0, e1 = gi * 8 + i1;
                ti[0] = e0; ti[1] = e1;
                LAS unsigned* lc = (LAS unsigned*)(SM + LR_LC);
                ti[2] = (int)__hip_atomic_fetch_add(lc + e0, 1u, __ATOMIC_RELAXED, __HIP_MEMORY_SCOPE_WORKGROUP); ti[3] = (int)__hip_atomic_fetch_add(lc + e1, 1u, __ATOMIC_RELAXED, __HIP_MEMORY_SCOPE_WORKGROUP);
                ((GAS float*)ti)[4] = gp * w0; ((GAS float*)ti)[5] = gp * (1.f - w0);
            }
        }
    }
}
#undef LR_LOADZ

__device__ __forceinline__ int wave_offsets(const unsigned* cnt, int lane, int& pc_out, int& tot) {
    const int c = lane < 32 ? (int)cnt[lane] : 0;
    const int pc = ((c + 255) >> 8) << 8;
    int inc = pc;
    for (int o = 1; o < 64; o <<= 1) { const int t = __shfl_up(inc, o); if (lane >= o) inc += t; }
    tot = __shfl(inc, 63);
    pc_out = pc;
    return inc - pc;
}

__device__ void ph_final(const Params& p, int u) {
    const int tidx = tid_(), lane = tidx & 63;
    float v[2][16]; float s[2] = {0.f, 0.f};
    int rowi[2];
#pragma unroll
    for (int k = 0; k < 2; ++k) {
        const int row = (u + k * (NT / 16)) * 8 + (tidx >> 6), b = row / T_;
        rowi[k] = row;
        const float* x1 = (const float*)(p.ws + OFF_Z) + (size_t)row * D_;
        const float* mod = (const float*)(p.ws + OFF_MOD) + b * 6144 + 5120;
        const int* ti = (const int*)(p.ws + OFF_TOKI) + (size_t)row * 6;
        const int r0 = ti[2], r1 = ti[3]; const float w0 = ((const float*)ti)[4], w1 = ((const float*)ti)[5];
        const bf16_t* y0 = (const bf16_t*)(p.ws + OFF_XPAD) + (size_t)r0 * D_; const bf16_t* y1 = (const bf16_t*)(p.ws + OFF_XPAD) + (size_t)r1 * D_;
#pragma unroll
        for (int i = 0; i < 4; ++i) {
            const int c = (i * 64 + lane) * 4;
            const float4 xv = *(const float4*)(x1 + c), g2 = *(const float4*)(mod + c), a = ld_bf4(y0 + c), bb = ld_bf4(y1 + c);
            v[k][i * 4] = ALPHA * xv.x + (1.f + g2.x) * (w0 * a.x + w1 * bb.x); v[k][i * 4 + 1] = ALPHA * xv.y + (1.f + g2.y) * (w0 * a.y + w1 * bb.y);
            v[k][i * 4 + 2] = ALPHA * xv.z + (1.f + g2.z) * (w0 * a.z + w1 * bb.z); v[k][i * 4 + 3] = ALPHA * xv.w + (1.f + g2.w) * (w0 * a.w + w1 * bb.w);
            s[k] += v[k][i * 4] + v[k][i * 4 + 1] + v[k][i * 4 + 2] + v[k][i * 4 + 3];
        }
    }
#pragma unroll
    for (int k = 0; k < 2; ++k) {
        const float mu = wsum(s[k]) * (1.f / 1024.f); float q = 0.f;
#pragma unroll
        for (int i = 0; i < 16; ++i) { v[k][i] -= mu; q = fmaf(v[k][i], v[k][i], q); }
        const float rs = rsqrtf(wsum(q) * (1.f / 1024.f) + 1e-5f);
#pragma unroll
        for (int i = 0; i < 4; ++i) {
            const int c = (i * 64 + lane) * 4;
            const float4 gg = *(const float4*)(p.ln2_g + c), bb = *(const float4*)(p.ln2_b + c);
            *(float4*)(p.out + (size_t)rowi[k] * D_ + c) = make_float4(v[k][i * 4] * rs * gg.x + bb.x, v[k][i * 4 + 1] * rs * gg.y + bb.y, v[k][i * 4 + 2] * rs * gg.z + bb.z, v[k][i * 4 + 3] * rs * gg.w + bb.w);
        }
    }
}

template <int PH> __device__ __forceinline__ void run_unit(const Params& p, int u, float* sm) {
    if constexpr (PH == PH_PRO) ph_pro(p, u, sm);
    else if constexpr (PH == PH_LN0) ph_ln0(p, u);
    else if constexpr (PH == PH_CMP2) ph_cmp2(p, u, sm);
    else if constexpr (PH == PH_FINAL) ph_final(p, u);
}

constexpr int MEGA_LDS = 153600 + 16;
enum { Q_PRO = 0, Q_LN0, Q_GEMM1, Q_CMP1, Q_CMP2, Q_MIX, Q_MRG, Q_WOUT, Q_LN1R, Q_PAD, Q_EXP1, Q_EXP2, Q_FINAL };
template <int PH> __device__ __forceinline__ void unit_loop(const Params& p, float* sm) {
    for (int u = blockIdx.x; u < phase_units(PH); u += gridDim.x) run_unit<PH>(p, u, sm);
}
template <int Q> __device__ __forceinline__ void run_phase(const Params& p, float* sm) {
    PG8_LAS unsigned char* lds = (PG8_LAS unsigned char*)sm;
    const int G = gridDim.x, c = blockIdx.x;
    if constexpr (Q == Q_PRO) {
        unit_loop<PH_PRO>(p, sm); for (int u = c; u < 561; u += G) ph_cvt_win(p, u, sm);
        for (int u = c; u < 64; u += G) { const int kv = u >> 5, t = u & 31, nt = t >> 4, kt = t & 15;
            cvt_tile(sm, kv ? p.w1_v : p.w1_k, 128, kt * 256, nt * 64, 64, (bf16_t*)(p.ws + OFF_CMPW) + (size_t)kv * 128 * 4096, 4096, nt * 64); }
        { float4* hz = (float4*)(p.ws + OFF_HID); for (int i = c * 512 + threadIdx.x; i < 2 * 4096 * 128 / 4; i += G * 512) hz[i] = make_float4(0.f, 0.f, 0.f, 0.f); }
    }
    else if constexpr (Q == Q_LN0) { for (int u = c; u < 64; u += G) ph_cmpconst(p, u, sm); unit_loop<PH_LN0>(p, sm); }
    else if constexpr (Q == Q_GEMM1) {
        pg8::Gemm g{(const bf16_t*)(p.ws + OFF_H), (const bf16_t*)(p.ws + OFF_WINT), 1024, 1024, 1024};
        pg8::StaticOrder S; S.init(NT, N1, G, c);
        pg8::EpiProj E{(bf16_t*)(p.ws + OFF_PROJ), (bf16_t*)p.out, (float*)(p.ws + OFF_GATE), (const float*)(p.ws + OFF_BIAS1)};
        pg8::gemm_phase(lds, g, S, E);
    }
    else if constexpr (Q == Q_CMP1) {
        for (int u = c; u < 1024; u += G) ph_hpre(p, u);
        for (int u = c; u < 192; u += G) ph_cvt_br(p, u, sm);
        __syncthreads();
        pg8::Gemm g{(const bf16_t*)(p.ws + OFF_PROJ), (const bf16_t*)(p.ws + OFF_CMPW), 1024, 16 * LDP, 4096, 1, 1};
        pg8::CmpOrder S{G, c};
        pg8::EpiCmpAcc E{(float*)(p.ws + OFF_HID)};
        pg8::gemm_phase(lds, g, S, E);
    }
    else if constexpr (Q == Q_CMP2) unit_loop<PH_CMP2>(p, sm);
    else if constexpr (Q == Q_MIX) {
        unsigned* qc = (unsigned*)(p.ws + OFF_QCTR);
        volatile int* slot = (volatile int*)((char*)sm + 131072 - 64);
        for (int k = 0; k < 8; ++k) {
            const int q = (c + k) & 7;
            for (;;) {
                __syncthreads();
                if (threadIdx.x == 0) *slot = (int)__hip_atomic_fetch_add(qc + q * 64, 1u, __ATOMIC_RELAXED, __HIP_MEMORY_SCOPE_AGENT);
                __syncthreads();
                const int it = *slot;
                if (it >= 4 + 128) break;
                if (it < 4) hg::item(p.ws, p.hg_norm_w, q >> 1, (q & 1) * 4 + it, (char*)sm);
                else nsa::item(p.ws, q >> 1, q & 1, 127 - (it - 4), (char*)sm);
            }
        }
    }
    else if constexpr (Q == Q_MRG) {
        pg8::StaticOrder S; S.init(NT, 1024, G, c);
        pg8::Gemm g{(const bf16_t*)(p.ws + OFF_PROJ) + C_HI, (const bf16_t*)(p.ws + OFF_WBRH), 2048, LDP, 2048, 2, 0};
        pg8::EpiMrg E{(const bf16_t*)p.out, (bf16_t*)(p.ws + OFF_H)};
        pg8::gemm_phase(lds, g, S, E);
    }
    else if constexpr (Q == Q_WOUT) {
        for (int u = c; u < 3072; u += G) ph_cvt_exp(p, u, sm);
        pg8::Gemm g{(const bf16_t*)(p.ws + OFF_H), (const bf16_t*)(p.ws + OFF_WOUTT), 1024, 1024, 1024};
        pg8::StaticOrder S; S.init(NT, 1024, G, c);
        pg8::EpiWout E{p.x, (const float*)(p.ws + OFF_MOD), (float*)(p.ws + OFF_Z)};
        pg8::gemm_phase(lds, g, S, E);
    }
    else if constexpr (Q == Q_LN1R) {
        unsigned* lc = (unsigned*)(sm + LR_LC);
        if (threadIdx.x < 64) lc[threadIdx.x] = 0u;
        __syncthreads();
        ph_ln1r_(Ln1rArgs{p.ws, p.ln1_g, p.ln1_b, p.rg_b, p.re_b, sm}, Ln1rW{p.rg_w, p.re_w});
        __syncthreads();
        if (threadIdx.x < 32) lc[32 + threadIdx.x] = atomicAdd((unsigned*)(p.ws + OFF_CNT) + threadIdx.x, lc[threadIdx.x]);
        __syncthreads();
        for (int u = c; u < NT / 16; u += G) {
            if (threadIdx.x < 32) { int* ti = (int*)(p.ws + OFF_TOKI) + (size_t)(u * 16 + (threadIdx.x >> 1)) * 6; const int k = threadIdx.x & 1; ti[2 + k] += (int)lc[32 + ti[k]]; }
        }
        __syncthreads();
    }
    else if constexpr (Q == Q_PAD) {
        const int tidx = tid_(), lane = tidx & 63, w = tidx >> 6;
        const unsigned* cnt = (const unsigned*)(p.ws + OFF_CNT);
        bf16_t* xp = (bf16_t*)(p.ws + OFF_XPAD);
        int pc, tot; const int off = wave_offsets(cnt, lane, pc, tot);
#define PAD_LOAD(K_, ROW_) \
            const int rw##K_ = (ROW_) < NT ? (ROW_) : NT - 1; const int* tq##K_ = (const int*)(p.ws + OFF_TOKI) + (size_t)rw##K_ * 6; \
            const int ra##K_ = __shfl(off, tq##K_[0]) + tq##K_[2], rb##K_ = __shfl(off, tq##K_[1]) + tq##K_[3]; \
            const uint4* sp##K_ = (const uint4*)((const bf16_t*)(p.ws + OFF_H) + (size_t)rw##K_ * D_); const uint4 xa##K_ = sp##K_[lane], xb##K_ = sp##K_[64 + lane];
#define PAD_STORE(K_, ROW_) if ((ROW_) < NT) { uint4* d0 = (uint4*)(xp + (size_t)ra##K_ * D_); uint4* d1 = (uint4*)(xp + (size_t)rb##K_ * D_); \
            d0[lane] = xa##K_; d0[64 + lane] = xb##K_; d1[lane] = xa##K_; d1[64 + lane] = xb##K_; \
            if (lane == 0) { int* tw = (int*)(p.ws + OFF_TOKI) + (size_t)(ROW_) * 6; tw[2] = ra##K_; tw[3] = rb##K_; } }
        for (int base = c * 8 + w; base < NT; base += G * 16) {
            PAD_LOAD(0, base) PAD_LOAD(1, base + G * 8)
            PAD_STORE(0, base) PAD_STORE(1, base + G * 8)
        }
#undef PAD_LOAD
#undef PAD_STORE
        for (int e = c; e < 32; e += G) {
            const int oe = __shfl(off, e), ce = (int)cnt[e], pe = __shfl(pc, e);
            for (int r = oe + ce + w; r < oe + pe; r += 8) { uint4* d = (uint4*)(xp + (size_t)r * D_); d[lane] = make_uint4(0, 0, 0, 0); d[64 + lane] = make_uint4(0, 0, 0, 0); }
        }
        if (c == G - 1) {
            int* te = (int*)(p.ws + OFF_TILEE);
            if (tidx < 32) { for (int r = off; r < off + pc; r += 256) te[r >> 8] = tidx; }
            if (tidx == 0) te[511] = tot >> 8;
        }
    }
    else if constexpr (Q == Q_EXP1) {
        const int* te = (const int*)(p.ws + OFF_TILEE);
        pg8::Gemm g{(const bf16_t*)(p.ws + OFF_XPAD), (const bf16_t*)(p.ws + OFF_E13), 1024, 1024, 1024};
        pg8::MoeOrder S{te, te[511] * 4, G, c, (long)1024 * 1024 * 2};
        pg8::EpiExp1 E{(bf16_t*)p.out};
        pg8::gemm_phase(lds, g, S, E);
    }
    else if constexpr (Q == Q_EXP2) {
        const int* te = (const int*)(p.ws + OFF_TILEE);
        pg8::Gemm g{(const bf16_t*)p.out, (const bf16_t*)(p.ws + OFF_E2T), 512, 512, 512};
        pg8::MoeOrder S{te, te[511] * 4, G, c, (long)1024 * 512 * 2};
        pg8::EpiBf E{(bf16_t*)(p.ws + OFF_XPAD), 1024};
        pg8::gemm_phase(lds, g, S, E);
    }
    else if constexpr (Q == Q_FINAL) unit_loop<PH_FINAL>(p, sm);
}
__global__ void __launch_bounds__(512, 2) k_mega(Params p) {
    extern __shared__ __attribute__((aligned(16))) float smem[];
    volatile LAS unsigned* st = (volatile LAS unsigned*)(smem + 153600 / 4);
    if (threadIdx.x == 0) { st[0] = 0u; st[1] = 0u; st[2] = 0u; st[3] = 0u; }
    __syncthreads();
    XcdBarrier bar = xcd_barrier_post((unsigned*)(p.ws + OFF_BAR), st);
    run_phase<Q_PRO>(p, smem);   xcd_barrier(bar);
    run_phase<Q_LN0>(p, smem);   xcd_barrier(bar);
    run_phase<Q_GEMM1>(p, smem); xcd_barrier(bar);
    run_phase<Q_CMP1>(p, smem);  xcd_barrier(bar);
    run_phase<Q_CMP2>(p, smem);  xcd_barrier(bar);
    run_phase<Q_MIX>(p, smem);   xcd_barrier(bar);
    run_phase<Q_MRG>(p, smem);   xcd_barrier(bar);
    run_phase<Q_WOUT>(p, smem);  xcd_barrier(bar);
    run_phase<Q_LN1R>(p, smem);  xcd_barrier(bar);
    run_phase<Q_PAD>(p, smem);   xcd_barrier(bar);
    run_phase<Q_EXP1>(p, smem);  xcd_barrier(bar);
    run_phase<Q_EXP2>(p, smem);  xcd_barrier(bar);
    run_phase<Q_FINAL>(p, smem);
}

extern "C" void kernel_launch(void* const* d_in, const int* in_sizes, int n_in, void* d_out, int out_size, void* d_ws, size_t ws_size, hipStream_t stream) {
    Params p{};
    const float** fp = (const float**)&p;
    for (int i = 0; i < 31; ++i) fp[i] = (const float*)d_in[i];
    p.out = (float*)d_out; p.ws = (unsigned char*)d_ws;
    static int grid = 0;
    if (!grid) {
        int dev = 0, cus = 0, per_cu = 0;
        (void)hipGetDevice(&dev);
        (void)hipDeviceGetAttribute(&cus, hipDeviceAttributeMultiprocessorCount, dev);
        (void)hipFuncSetAttribute((const void*)k_mega, hipFuncAttributeMaxDynamicSharedMemorySize, MEGA_LDS);
        (void)hipOccupancyMaxActiveBlocksPerMultiprocessor(&per_cu, (const void*)k_mega, 512, MEGA_LDS);
        grid = cus * (per_cu < 1 ? per_cu : 1);
    }
    (void)hipMemsetAsync(p.ws + OFF_BAR, 0, XCD_BAR_WORDS * sizeof(unsigned), stream);
    hipLaunchKernelGGL(k_mega, dim3(grid), dim3(512), MEGA_LDS, stream, p);
}
```

```cpp
#include <hip/hip_runtime.h>
#include <stdint.h>

typedef unsigned short bf16_t;

constexpr int B_ = 4, T_ = 8192, D_ = 1024, NT = B_ * T_;
constexpr int DIN = 8728;
constexpr int LDP = 6656;
constexpr int C_HQ = 0, C_HF = 1024, C_HI = 2048, C_HG = 3072, C_NQ = 4096, C_KC = 5120, C_VC = 5376, C_KS = 5632, C_VS = 5888, C_KW = 6144, C_VW = 6400;
constexpr int NC = 511;
constexpr float ALPHA = 1.189207115002721f;
constexpr int MAXROWS = 73728;

constexpr size_t KB = 1024, MB = 1024 * 1024;
constexpr size_t OFF_BAR = 0, OFF_MOD = 16 * KB, OFF_LB = 112 * KB, OFF_LUT = 116 * KB, OFF_CB = 120 * KB, OFF_CNT = 124 * KB, OFF_TOKI = 128 * KB;
constexpr size_t OFF_GATE = 1 * MB, OFF_KCMP = 4 * MB, OFF_VCMP = 5 * MB, OFF_HID = 6 * MB;
constexpr size_t OFF_DEC = 18 * MB;
constexpr size_t OFF_QCTR = 960 * KB;
constexpr size_t OFF_CMPW = 10 * MB;
constexpr size_t OFF_H = 31 * MB;
constexpr size_t OFF_PROJ = 95 * MB;
constexpr size_t OFF_Z = OFF_PROJ, OFF_XPAD = OFF_PROJ + 128 * MB;
constexpr size_t OFF_BIAS1 = 896 * KB, OFF_TILEE = 940 * KB;
constexpr size_t OFF_WINT = 12 * MB;
constexpr size_t OFF_WBRH = 12 * MB, OFF_WBRN = 14 * MB, OFF_WOUTT = 16 * MB;
constexpr size_t OFF_E13 = OFF_PROJ + 272 * MB, OFF_E2T = OFF_PROJ + 336 * MB;
constexpr int N1 = 8960;

struct Params {
    const float *x, *c, *ada_w, *ada_b, *w_in, *b_in, *lb_logits, *hg_norm_w, *pos_k, *w1_k, *b1_k, *w2_k, *pos_v, *w1_v, *b1_v, *w2_v, *rel_bias,
        *w_br_hg, *w_br_nsa, *w_out, *ln1_g, *ln1_b, *rg_w, *rg_b, *re_w, *re_b, *e_w1, *e_w3, *e_w2, *ln2_g, *ln2_b;
    float* out; unsigned char* ws;
};

__device__ __forceinline__ int tid_() { int t = threadIdx.x; asm volatile("" : "+v"(t)); return t; }
__device__ __forceinline__ float bf2f(bf16_t v) { return __uint_as_float(((unsigned)v) << 16); }
__device__ __forceinline__ bf16_t f2bf(float f) { unsigned u = __float_as_uint(f); u += 0x7FFFu + ((u >> 16) & 1u); return (bf16_t)(u >> 16); }
__device__ __forceinline__ float sigmoidf_(float v) { return __builtin_amdgcn_rcpf(1.f + __expf(-v)); }
__device__ __forceinline__ float siluf_(float v) { return v * __builtin_amdgcn_rcpf(1.f + __expf(-v)); }
template <int CTRL> __device__ __forceinline__ float dpp_(float v) { return __int_as_float(__builtin_amdgcn_update_dpp(0, __float_as_int(v), CTRL, 0xF, 0xF, true)); }
__device__ __forceinline__ float rlane(float v, int l) { return __int_as_float(__builtin_amdgcn_readlane(__float_as_int(v), l)); }
__device__ __forceinline__ float wsum(float v) {
    v += dpp_<0xB1>(v); v += dpp_<0x4E>(v); v += dpp_<0x141>(v); v += dpp_<0x140>(v);
    return (rlane(v, 15) + rlane(v, 31)) + (rlane(v, 47) + rlane(v, 63));
}
__device__ __forceinline__ float rfl(float v) { return __int_as_float(__builtin_amdgcn_readfirstlane(__float_as_int(v))); }
__device__ __forceinline__ float wmax(float v) { for (int o = 32; o > 0; o >>= 1) v = fmaxf(v, __shfl_xor(v, o)); return v; }
__device__ __forceinline__ float4 ld_bf4(const bf16_t* p) { uint2 r = *(const uint2*)p; return make_float4(__uint_as_float(r.x << 16), __uint_as_float(r.x & 0xFFFF0000u), __uint_as_float(r.y << 16), __uint_as_float(r.y & 0xFFFF0000u)); }
typedef __bf16 bf16x2n __attribute__((ext_vector_type(2)));
typedef float f32x2n __attribute__((ext_vector_type(2)));
__device__ __forceinline__ unsigned pk_bf16(float lo, float hi) { const f32x2n v = {lo, hi}; const bf16x2n r = __builtin_convertvector(v, bf16x2n); return __builtin_bit_cast(unsigned, r); }
__device__ __forceinline__ void st_bf4(bf16_t* p, float a, float b, float c, float d) { uint2 r; r.x = pk_bf16(a, b); r.y = pk_bf16(c, d); *(uint2*)p = r; }
__device__ __forceinline__ int rel_bucket(int n) {
    if (n < 16) return n < 0 ? 0 : n;
    int b = 16;
    b += (n >= 19) + (n >= 21) + (n >= 24) + (n >= 27) + (n >= 31) + (n >= 35) + (n >= 40) + (n >= 46) + (n >= 52) + (n >= 59) + (n >= 67) + (n >= 77) + (n >= 87) + (n >= 99) + (n >= 113);
    return b;
}

template <class AF, class BF, class EF>
__device__ __forceinline__ void gemm128(float* sm, int m0, int n0, int K, AF af, BF bf, EF ef) {
    float(*As)[132] = (float(*)[132])sm;
    float(*Bs)[132] = (float(*)[132])(sm + 16 * 132);
    const int tid = tid_(), tx = tid & 31, ty = tid >> 5;
    const int ar = tid >> 2, ak = (tid & 3) * 4, bk = tid >> 5, bn = (tid & 31) * 4;
    float acc[8][4];
#pragma unroll
    for (int i = 0; i < 8; ++i)
#pragma unroll
        for (int j = 0; j < 4; ++j) acc[i][j] = 0.f;
    for (int k0 = 0; k0 < K; k0 += 16) {
        const float4 a = af(m0 + ar, k0 + ak);
        const float4 b = bf(k0 + bk, n0 + bn);
        __syncthreads();
        As[ak + 0][ar] = a.x; As[ak + 1][ar] = a.y; As[ak + 2][ar] = a.z; As[ak + 3][ar] = a.w;
        *(float4*)&Bs[bk][bn] = b;
        __syncthreads();
#pragma unroll
        for (int k = 0; k < 16; ++k) {
            const float4 a0 = *(const float4*)&As[k][ty * 8], a1 = *(const float4*)&As[k][ty * 8 + 4], bb = *(const float4*)&Bs[k][tx * 4];
            const float av[8] = {a0.x, a0.y, a0.z, a0.w, a1.x, a1.y, a1.z, a1.w};
            const float bv[4] = {bb.x, bb.y, bb.z, bb.w};
#pragma unroll
            for (int i = 0; i < 8; ++i)
#pragma unroll
                for (int j = 0; j < 4; ++j) acc[i][j] = fmaf(av[i], bv[j], acc[i][j]);
        }
    }
#pragma unroll
    for (int i = 0; i < 8; ++i) ef(m0 + ty * 8 + i, n0 + tx * 4, make_float4(acc[i][0], acc[i][1], acc[i][2], acc[i][3]));
    __syncthreads();
}


#define XB_TMO      128
#define XB_XCNT(j)  (256  + 64 * (j))
#define XB_XSUB(j)  (1280 + 64 * (j))
#define XB_XGEN(j)  (2304 + 64 * (j))
#define XB_TOP      3328
#define XB_TOPGEN   3392
#define XCD_BAR_WORDS 3456
#define XB_SPIN_CAP (1u << 22)
#define LAS __attribute__((address_space(3)))
__device__ __forceinline__ unsigned xb_ld(unsigned* p)              { return __hip_atomic_load(p, __ATOMIC_RELAXED, __HIP_MEMORY_SCOPE_AGENT); }
__device__ __forceinline__ unsigned xb_add(unsigned* p, unsigned v) { return __hip_atomic_fetch_add(p, v, __ATOMIC_RELAXED, __HIP_MEMORY_SCOPE_AGENT); }
__device__ __forceinline__ unsigned xb_xcc_id() { return (unsigned)__builtin_amdgcn_s_getreg((3 << 11) | 20) & 0xFu; }
#define XB_SPIN(cond, bar) do { unsigned _sp = 0; while (cond) { __builtin_amdgcn_s_sleep(1); \
    if ((++_sp & 255u) == 0u) { if (xb_ld(&(bar)[XB_TMO])) break; if (_sp > XB_SPIN_CAP) { atomicAdd(&(bar)[XB_TMO], 1u); break; } } } } while (0)
struct XcdBarrier { unsigned* bar; unsigned x; volatile LAS unsigned* st; };
__device__ __forceinline__ XcdBarrier xcd_barrier_post(unsigned* bar, volatile LAS unsigned* st) {
    XcdBarrier b; b.bar = bar; b.x = xb_xcc_id(); b.st = st;
    if (threadIdx.x == 0) (void)xb_add(&bar[XB_XCNT(b.x)], 1u);
    return b;
}
__device__ __forceinline__ void xcd_barrier_complete(unsigned* bar, unsigned x, unsigned& nloc, unsigned& nx) {
    const unsigned G = gridDim.x * gridDim.y * gridDim.z;
    unsigned sum, cnt, mine, sp = 0u;
    for (;;) {
        sum = 0u; cnt = 0u; mine = 0u;
#pragma unroll
        for (unsigned j = 0; j < 16; ++j) { const unsigned c = xb_ld(&bar[XB_XCNT(j)]); sum += c; cnt += (c > 0u) ? 1u : 0u; mine = (j == x) ? c : mine; }
        if (sum == G) break;
        __builtin_amdgcn_s_sleep(1);
        if ((++sp & 255u) == 0u) { if (xb_ld(&bar[XB_TMO])) break; if (sp > XB_SPIN_CAP) { atomicAdd(&bar[XB_TMO], 1u); break; } }
    }
    nloc = mine > 0u ? mine : 1u; nx = cnt > 0u ? cnt : 1u;
}
__device__ __forceinline__ void xcd_barrier(const XcdBarrier& b) {
    asm volatile("s_waitcnt vmcnt(0)" ::: "memory");
    __syncthreads();
    if (threadIdx.x == 0) {
        unsigned* bar = b.bar;
        __builtin_amdgcn_s_waitcnt(0);
        unsigned nloc = b.st[0], nx = b.st[1];
        if (nloc == 0u) { xcd_barrier_complete(bar, b.x, nloc, nx); b.st[0] = nloc; b.st[1] = nx; }
        const unsigned old = xb_add(&bar[XB_XSUB(b.x)], 1u);
        const unsigned gen = old / nloc;
        if (old + 1u == (gen + 1u) * nloc) {
            __builtin_amdgcn_fence(__ATOMIC_RELEASE, "agent");
            asm volatile("s_waitcnt vmcnt(0)" ::: "memory");
            const unsigned og = xb_add(&bar[XB_TOP], 1u);
            const unsigned tg = og / nx;
            if (og + 1u == (tg + 1u) * nx) xb_add(&bar[XB_TOPGEN], 1u);
            else XB_SPIN(xb_ld(&bar[XB_TOPGEN]) == tg, bar);
            __builtin_amdgcn_fence(__ATOMIC_ACQUIRE, "agent");
            xb_add(&bar[XB_XGEN(b.x)], 1u);
            asm volatile("s_waitcnt vmcnt(0)" ::: "memory");
        } else {
            XB_SPIN(xb_ld(&bar[XB_XGEN(b.x)]) == gen, bar);
            __builtin_amdgcn_fence(__ATOMIC_ACQUIRE, "agent");
            asm volatile("s_waitcnt vmcnt(0)" ::: "memory");
        }
    }
    __syncthreads();
}


namespace pg8 {
#define PG8_LAS __attribute__((address_space(3)))
typedef short bf16x8 __attribute__((ext_vector_type(8)));
typedef float f32x4 __attribute__((ext_vector_type(4)));
typedef unsigned u32x4 __attribute__((ext_vector_type(4)));
typedef unsigned u32x2 __attribute__((ext_vector_type(2)));
constexpr int BM = 256, BK = 64, HALF = 128, HTB = HALF * BK * 2, STAGE_BYTES = 8 * HTB, NXCD = 8, WGM = 8;
__host__ __device__ __forceinline__ int lds_byte(int r, int c) { const int st = (r >> 4) * 2 + (c >> 5), rr = r & 15, cc = c & 31, ob = rr * 64 + cc * 2; return st * 1024 + (ob ^ (((ob >> 9) & 1) << 5)); }
__host__ __device__ __forceinline__ void stage_rc(int b, int& R, int& C) { const int st = b / 1024, sb = b % 1024, swz = sb ^ (((sb >> 9) & 1) << 5); R = (st >> 1) * 16 + swz / 64; C = (st & 1) * 32 + (swz % 64) / 2; }
__host__ __device__ __forceinline__ int perm32(int rho) { const int n = rho >> 4, i = rho & 15; return 8 * (i >> 2) + 4 * n + (i & 3); }
struct Unit { int pm, pn; long boff; long aoff; };
struct Gemm { const bf16_t* A; const bf16_t* Bt; int K, lda, ldb; int kmode = 0; int bdup = 0; };
struct StaticOrder {
    int nM, nN, nwg, G, c;
    __device__ void init(int M, int N, int G_, int c_) { nM = M / BM; nN = N / BM; nwg = nM * nN; G = G_; c = c_; }
    __device__ bool next(int i, Unit& u) const {
        const long L = (long)i * G + c; if (L >= nwg) return false;
        int wgid = (int)L; { const int q = nwg / NXCD, r = nwg % NXCD, xcd = wgid % NXCD, off = wgid / NXCD; wgid = (xcd < r ? xcd * (q + 1) : r * (q + 1) + (xcd - r) * q) + off; }
        const int nig = WGM * nN, gid = wgid / nig, fm = gid * WGM, gsz = (nM - fm) < WGM ? (nM - fm) : WGM;
        u.pm = fm + ((wgid % nig) % gsz); u.pn = (wgid % nig) / gsz; u.boff = 0; u.aoff = 0; return true;
    }
    __device__ __forceinline__ void a_ready(const Unit&) const {}
    __device__ __forceinline__ void done(const Unit&) const {}
};
struct MoeOrder {
    const int* tile_e; int nwg, G, c; long estride;
    __device__ bool next(int i, Unit& u) const {
        const long L = (long)i * G + c; if (L >= nwg) return false;
        u.pm = (int)(L >> 2); u.pn = (int)(L & 3); u.boff = (long)tile_e[u.pm] * estride; u.aoff = 0; return true;
    }
    __device__ __forceinline__ void a_ready(const Unit&) const {}
    __device__ __forceinline__ void done(const Unit&) const {}
};
struct CmpOrder {
    int G, c;
    __device__ bool next(int i, Unit& u) const {
        const int L = i * G + c; if (L >= 128) return false;
        const int kv = L >> 6, bg = (L >> 3) & 7, half = (L >> 2) & 1, kq = L & 3;
        u.pm = half; u.pn = (kv << 3) | bg;
        u.aoff = ((long)((bg >> 1) * T_ + 8 * kq) * LDP + (kv ? C_VC : C_KC) + (bg & 1) * 128) * 2;
        u.boff = ((long)kv * 128 * 4096 + kq * 1024) * 2;
        return true;
    }
    __device__ __forceinline__ void a_ready(const Unit&) const {}
    __device__ __forceinline__ void done(const Unit&) const {}
};
__device__ __forceinline__ unsigned cvt_pk_bf16(float lo, float hi) { return pk_bf16(lo, hi); }
__device__ __forceinline__ f32x4 unpk_lo(u32x4 w) { return (f32x4){__uint_as_float(w.x << 16), __uint_as_float(w.x & 0xFFFF0000u), __uint_as_float(w.y << 16), __uint_as_float(w.y & 0xFFFF0000u)}; }
__device__ __forceinline__ f32x4 unpk_hi(u32x4 w) { return (f32x4){__uint_as_float(w.z << 16), __uint_as_float(w.z & 0xFFFF0000u), __uint_as_float(w.w << 16), __uint_as_float(w.w & 0xFFFF0000u)}; }
__device__ __forceinline__ u32x4 pk8(f32x4 v0, f32x4 v1) { u32x4 w; w.x = cvt_pk_bf16(v0[0], v0[1]); w.y = cvt_pk_bf16(v0[2], v0[3]); w.z = cvt_pk_bf16(v1[0], v1[1]); w.w = cvt_pk_bf16(v1[2], v1[3]); return w; }
__device__ __forceinline__ f32x4 sig4(f32x4 v) { return (f32x4){sigmoidf_(v[0]), sigmoidf_(v[1]), sigmoidf_(v[2]), sigmoidf_(v[3])}; }
struct EpiProj {
    static constexpr bool PERM = true, AFTER_DRAIN = false, HAS_MID = false;
    bf16_t* proj; bf16_t* mg; float* gate; const float* bias;
    __device__ __forceinline__ void operator()(const f32x4 (&acc)[2][2][4][2], const Unit& u, int wr, int wc, int fr, int fq) const {
        const int row0 = u.pm * BM + wr * 64 + fr, c8 = u.pn * BM + wc * 32 + 8 * fq;
        f32x4 bv[2][2];
#pragma unroll
        for (int bj = 0; bj < 2; ++bj)
#pragma unroll
            for (int n = 0; n < 2; ++n) bv[bj][n] = *(const f32x4*)(bias + c8 + bj * HALF + 4 * n);
#pragma unroll
        for (int ai = 0; ai < 2; ++ai)
#pragma unroll
            for (int m = 0; m < 4; ++m) {
                const size_t row = (size_t)(row0 + ai * HALF + m * 16);
#pragma unroll
                for (int bj = 0; bj < 2; ++bj) {
                    const f32x4 v0 = acc[ai][bj][m][0] + bv[bj][0], v1 = acc[ai][bj][m][1] + bv[bj][1];
                    const int col = c8 + bj * HALF;
                    if (u.pn < 26) *(u32x4*)(proj + row * LDP + col) = pk8(v0, v1);
                    else if (u.pn < 34) *(u32x4*)(mg + row * 2048 + (col - 6656)) = pk8(sig4(v0), sig4(v1));
                    else if (col - 8704 < 24) { float* gp = gate + row * 24 + (col - 8704); *(f32x4*)gp = sig4(v0); *(f32x4*)(gp + 4) = sig4(v1); }
                }
            }
    }
};
struct EpiMrg {
    static constexpr bool PERM = true, AFTER_DRAIN = false, HAS_MID = true;
    const bf16_t* mg; bf16_t* mr;
    __device__ __forceinline__ void mid(f32x4 (&acc)[2][2][4][2], const Unit& u, int wr, int wc, int fr, int fq) const {
        const int row0 = u.pm * BM + wr * 64 + fr, c8 = u.pn * BM + wc * 32 + 8 * fq;
#pragma unroll
        for (int ai = 0; ai < 2; ++ai)
#pragma unroll
            for (int m = 0; m < 4; ++m) {
                const size_t row = (size_t)(row0 + ai * HALF + m * 16);
#pragma unroll
                for (int bj = 0; bj < 2; ++bj) {
                    const int col = c8 + bj * HALF;
                    const u32x4 hw = *(const u32x4*)(mg + row * 2048 + col), nw = *(const u32x4*)(mg + row * 2048 + 1024 + col);
                    const f32x4 h0 = unpk_lo(hw), h1 = unpk_hi(hw), n0 = unpk_lo(nw), n1 = unpk_hi(nw);
#pragma unroll
                    for (int j = 0; j < 4; ++j) { acc[ai][bj][m][0][j] *= h0[j] * __builtin_amdgcn_rcpf(fmaxf(n0[j], 8.673617e-19f)); acc[ai][bj][m][1][j] *= h1[j] * __builtin_amdgcn_rcpf(fmaxf(n1[j], 8.673617e-19f)); }
                    asm volatile("" ::: "memory");
                }
            }
    }
    __device__ __forceinline__ void operator()(const f32x4 (&acc)[2][2][4][2], const Unit& u, int wr, int wc, int fr, int fq) const {
        const int row0 = u.pm * BM + wr * 64 + fr, c8 = u.pn * BM + wc * 32 + 8 * fq;
#pragma unroll
        for (int ai = 0; ai < 2; ++ai)
#pragma unroll
            for (int m = 0; m < 4; ++m) {
                const size_t row = (size_t)(row0 + ai * HALF + m * 16);
#pragma unroll
                for (int bj = 0; bj < 2; ++bj) {
                    const int col = c8 + bj * HALF;
                    const u32x4 nw = *(const u32x4*)(mg + row * 2048 + 1024 + col);
                    f32x4 n0 = unpk_lo(nw), n1 = unpk_hi(nw);
#pragma unroll
                    for (int j = 0; j < 4; ++j) { n0[j] = fmaxf(n0[j], 8.673617e-19f); n1[j] = fmaxf(n1[j], 8.673617e-19f); }
                    *(u32x4*)(mr + row * 1024 + col) = pk8(n0 * acc[ai][bj][m][0], n1 * acc[ai][bj][m][1]);
                }
                asm volatile("" ::: "memory");
            }
    }
};
struct EpiWout {
    static constexpr bool PERM = true, AFTER_DRAIN = false, HAS_MID = false;
    const float* x; const float* mod; bf16_t* z;
    __device__ __forceinline__ void operator()(const f32x4 (&acc)[2][2][4][2], const Unit& u, int wr, int wc, int fr, int fq) const {
        const int row0 = u.pm * BM + wr * 64 + fr, c8 = u.pn * BM + wc * 32 + 8 * fq;
        const float* g1 = mod + ((u.pm * BM) / T_) * 6144 + 2048 + c8;
#pragma unroll
        for (int ai = 0; ai < 2; ++ai)
#pragma unroll
            for (int m = 0; m < 4; ++m) {
                const size_t ro = (size_t)(row0 + ai * HALF + m * 16) * 1024 + c8;
#pragma unroll
                for (int bj = 0; bj < 2; ++bj) {
                    const f32x4 x0 = *(const f32x4*)(x + ro + bj * HALF), x1 = *(const f32x4*)(x + ro + bj * HALF + 4);
                    const f32x4 g0 = *(const f32x4*)(g1 + bj * HALF) + 1.0f, g4 = *(const f32x4*)(g1 + bj * HALF + 4) + 1.0f;
                    *(u32x4*)(z + ro + bj * HALF) = pk8(x0 * ALPHA + g0 * acc[ai][bj][m][0], x1 * ALPHA + g4 * acc[ai][bj][m][1]);
                }
                if (m & 1) asm volatile("" ::: "memory");
            }
    }
};
struct EpiExp1 {
    static constexpr bool PERM = true, AFTER_DRAIN = false, HAS_MID = false;
    bf16_t* U;
    __device__ __forceinline__ void operator()(const f32x4 (&acc)[2][2][4][2], const Unit& u, int wr, int wc, int fr, int fq) const {
        const int row0 = u.pm * BM + wr * 64 + fr, c8 = u.pn * HALF + wc * 32 + 8 * fq;
#pragma unroll
        for (int ai = 0; ai < 2; ++ai)
#pragma unroll
            for (int m = 0; m < 4; ++m) {
                f32x4 r[2];
#pragma unroll
                for (int n = 0; n < 2; ++n)
#pragma unroll
                    for (int j = 0; j < 4; ++j) r[n][j] = siluf_(acc[ai][0][m][n][j]) * acc[ai][1][m][n][j];
                *(u32x4*)(U + (size_t)(row0 + ai * HALF + m * 16) * 512 + c8) = pk8(r[0], r[1]);
            }
    }
};
struct EpiCmpAcc {
    static constexpr bool PERM = false, AFTER_DRAIN = false, HAS_MID = false;
    float* hp;
    __device__ __forceinline__ void operator()(const f32x4 (&acc)[2][2][4][2], const Unit& u, int wr, int wc, int fr, int fq) const {
        const int row0 = u.pn * 512 + u.pm * BM + wr * 64 + fr, col0 = wc * 32 + 4 * fq;
#pragma unroll
        for (int ai = 0; ai < 2; ++ai)
#pragma unroll
            for (int m = 0; m < 4; ++m) { float* rp = hp + (size_t)(row0 + ai * HALF + m * 16) * 128 + col0;
#pragma unroll
                for (int n = 0; n < 2; ++n)
#pragma unroll
                    for (int j = 0; j < 4; ++j) atomicAdd(rp + n * 16 + j, acc[ai][0][m][n][j]); }
    }
};
struct EpiBf {
    static constexpr bool PERM = true, AFTER_DRAIN = false, HAS_MID = false;
    bf16_t* O; int ldo;
    __device__ __forceinline__ void operator()(const f32x4 (&acc)[2][2][4][2], const Unit& u, int wr, int wc, int fr, int fq) const {
        const int row0 = u.pm * BM + wr * 64 + fr, c8 = u.pn * BM + wc * 32 + 8 * fq;
#pragma unroll
        for (int ai = 0; ai < 2; ++ai)
#pragma unroll
            for (int m = 0; m < 4; ++m)
#pragma unroll
                for (int bj = 0; bj < 2; ++bj) *(u32x4*)(O + (size_t)(row0 + ai * HALF + m * 16) * ldo + c8 + bj * HALF) = pk8(acc[ai][bj][m][0], acc[ai][bj][m][1]);
    }
};
template <class Epi, class Sched>
__device__ __forceinline__ void gemm_phase(PG8_LAS unsigned char* lds, const Gemm g, const Sched& S, const Epi& E) {
    const int tid = tid_(), wid = __builtin_amdgcn_readfirstlane(tid >> 6), lane = tid & 63, wr = wid >> 2, wc = wid & 3, fr = lane & 15, fq = lane >> 4;
    const int K = g.K, nt = K / BK;
    unsigned voffA[2], voffB[2];
#pragma unroll
    for (int i = 0; i < 2; ++i) { int R, C; stage_rc(tid * 16 + i * 8192, R, C); const int Rb = Epi::PERM ? ((R & ~31) + perm32(R & 31)) : R;
        voffA[i] = (unsigned)(R * g.lda + C) * 2u; voffB[i] = (unsigned)(Rb * g.ldb + C) * 2u; }
    const size_t kstep = (size_t)(BK * 2);
#define PG8_KA(t) (g.kmode == 1 ? (size_t)((t) >> 1) * (LDP * 2) + (size_t)((t) & 1) * 128 : g.kmode == 2 ? (size_t)(t) * kstep + ((t) >= 16 ? (size_t)2048 : (size_t)0) : (size_t)(t) * kstep)
    const size_t hstepA = (size_t)HALF * g.lda * 2, hstepB = g.bdup ? (size_t)0 : (size_t)HALF * g.ldb * 2;
    const size_t tstepA = 2 * hstepA, tstepB = 2 * hstepB;
    const unsigned ldsw = (unsigned)wid * 1024u;
    const int aoff = lds_byte(wr * 64 + fr, fq * 8), boff = lds_byte(wc * 32 + fr, fq * 8);
#define PG8_SA(b, h) (((b) * 2 + (h)) * HTB)
#define PG8_SB(b, h) ((4 + (b) * 2 + (h)) * HTB)
#define PG8_STAGE(bufoff, gbase, voff) do { _Pragma("unroll") for (int _i = 0; _i < 2; ++_i) \
        __builtin_amdgcn_global_load_lds((const unsigned*)((const char*)(gbase) + (voff)[_i]), (PG8_LAS unsigned*)(lds + (bufoff) + ldsw + _i * 8192), 16, 0, 0); } while (0)
#define PG8_LDA(dst, b, h) do { _Pragma("unroll") for (int m = 0; m < 4; ++m) _Pragma("unroll") for (int k = 0; k < 2; ++k) dst[m][k] = *(const PG8_LAS bf16x8*)(lds + PG8_SA(b, h) + aoff + m * 2048 + k * 1024); } while (0)
#define PG8_LDB(dst, b, h) do { _Pragma("unroll") for (int n = 0; n < 2; ++n) _Pragma("unroll") for (int k = 0; k < 2; ++k) dst[n][k] = *(const PG8_LAS bf16x8*)(lds + PG8_SB(b, h) + boff + n * 2048 + k * 1024); } while (0)
#define PG8_MMA(ai, bj, At, Bt) do { __builtin_amdgcn_s_setprio(1); _Pragma("unroll") for (int m = 0; m < 4; ++m) _Pragma("unroll") for (int n = 0; n < 2; ++n) _Pragma("unroll") for (int k = 0; k < 2; ++k) \
        acc[ai][bj][m][n] = __builtin_amdgcn_mfma_f32_16x16x32_bf16(Bt[n][k], At[m][k], acc[ai][bj][m][n], 0, 0, 0); __builtin_amdgcn_s_setprio(0); } while (0)
#define PG8_WAIT_V(n) asm volatile("s_waitcnt vmcnt(" #n ")" ::: "memory")
#define PG8_WAIT_L(n) asm volatile("s_waitcnt lgkmcnt(" #n ")" ::: "memory")
#define PG8_BAR __builtin_amdgcn_s_barrier()
#define PG8_SCHED __builtin_amdgcn_sched_barrier(0)
    Unit cur, nxt; int ui = 0;
    if (!S.next(0, cur)) return;
    f32x4 acc[2][2][4][2];
#pragma unroll
    for (int a = 0; a < 2; ++a)
#pragma unroll
        for (int b = 0; b < 2; ++b)
#pragma unroll
            for (int m = 0; m < 4; ++m)
#pragma unroll
                for (int n = 0; n < 2; ++n) acc[a][b][m][n] = (f32x4){0.f, 0.f, 0.f, 0.f};
    bf16x8 At[4][2], B0[2][2], B1[2][2];
    const char* cA = (const char*)g.A + cur.aoff + (size_t)cur.pm * tstepA; const char* cB = (const char*)g.Bt + cur.boff + (size_t)cur.pn * tstepB;
    S.a_ready(cur);
    PG8_STAGE(PG8_SB(0, 0), cB, voffB); PG8_STAGE(PG8_SA(0, 0), cA, voffA); PG8_STAGE(PG8_SB(0, 1), cB + hstepB, voffB); PG8_STAGE(PG8_SA(0, 1), cA + hstepA, voffA);
    if (wr == 1) PG8_BAR;
    PG8_WAIT_V(4); PG8_BAR;
    PG8_STAGE(PG8_SB(1, 0), cB + kstep, voffB); PG8_STAGE(PG8_SA(1, 0), cA + PG8_KA(1), voffA); PG8_STAGE(PG8_SB(1, 1), cB + hstepB + kstep, voffB);
    PG8_WAIT_V(6); PG8_BAR;
    for (;;) {
        const bool has_next = S.next(ui + 1, nxt);
        const char* nA = has_next ? (const char*)g.A + nxt.aoff + (size_t)nxt.pm * tstepA : cA; const char* nB = has_next ? (const char*)g.Bt + nxt.boff + (size_t)nxt.pn * tstepB : cB;
        for (int t = 0; t < nt; t += 2) {
            const bool last = (t == nt - 2);
            const char* a1 = cA + PG8_KA(t + 1);
            const char* a2 = last ? nA : cA + PG8_KA(t + 2); const char* b2 = last ? nB : cB + (size_t)(t + 2) * kstep;
            const char* a3 = last ? nA + PG8_KA(1) : cA + PG8_KA(t + 3); const char* b3 = b2 + kstep;
            if (last && has_next) S.a_ready(nxt);
            if constexpr (Epi::HAS_MID) { if (t == 16) E.mid(acc, cur, wr, wc, fr, fq); }
            PG8_LDB(B0, 0, 0); PG8_SCHED; PG8_LDA(At, 0, 0); PG8_STAGE(PG8_SA(1, 1), a1 + hstepA, voffA);
            PG8_WAIT_L(8); PG8_BAR; PG8_WAIT_L(0); PG8_MMA(0, 0, At, B0); PG8_BAR; PG8_SCHED;
            PG8_LDB(B1, 0, 1); PG8_STAGE(PG8_SB(0, 0), b2, voffB);
            PG8_BAR; PG8_WAIT_L(0); PG8_MMA(0, 1, At, B1); PG8_BAR;
            PG8_LDA(At, 0, 1); PG8_STAGE(PG8_SA(0, 0), a2, voffA);
            PG8_BAR; PG8_WAIT_L(0); PG8_MMA(1, 0, At, B0); PG8_BAR; PG8_SCHED;
            PG8_STAGE(PG8_SB(0, 1), b2 + hstepB, voffB);
            PG8_WAIT_V(6); PG8_BAR; PG8_MMA(1, 1, At, B1); PG8_BAR;
            PG8_LDB(B0, 1, 0); PG8_SCHED; PG8_LDA(At, 1, 0); PG8_STAGE(PG8_SA(0, 1), a2 + hstepA, voffA);
            PG8_WAIT_L(8); PG8_BAR; PG8_WAIT_L(0); PG8_MMA(0, 0, At, B0); PG8_BAR; PG8_SCHED;
            PG8_LDB(B1, 1, 1); PG8_STAGE(PG8_SB(1, 0), b3, voffB);
            PG8_BAR; PG8_WAIT_L(0); PG8_MMA(0, 1, At, B1); PG8_BAR;
            PG8_LDA(At, 1, 1); PG8_STAGE(PG8_SA(1, 0), a3, voffA);
            PG8_BAR; PG8_WAIT_L(0); PG8_MMA(1, 0, At, B0); PG8_BAR; PG8_SCHED;
            PG8_STAGE(PG8_SB(1, 1), b3 + hstepB, voffB);
            PG8_WAIT_V(6); PG8_BAR; PG8_MMA(1, 1, At, B1); PG8_BAR;
        }
        if constexpr (!Epi::AFTER_DRAIN) { E(acc, cur, wr, wc, fr, fq); S.done(cur); }
        if (!has_next) break;
#pragma unroll
        for (int a = 0; a < 2; ++a)
#pragma unroll
            for (int b = 0; b < 2; ++b)
#pragma unroll
                for (int m = 0; m < 4; ++m)
#pragma unroll
                    for (int n = 0; n < 2; ++n) acc[a][b][m][n] = (f32x4){0.f, 0.f, 0.f, 0.f};
        cur = nxt; cA = nA; cB = nB; ++ui;
    }
    PG8_WAIT_V(0);
    if (wr == 0) PG8_BAR;
    PG8_BAR;
    if constexpr (Epi::AFTER_DRAIN) { E.fused(acc, cur, wr, wc, fr, fq, lds, wid, lane); S.done(cur); }
#undef PG8_SA
#undef PG8_SB
#undef PG8_STAGE
#undef PG8_LDA
#undef PG8_LDB
#undef PG8_MMA
#undef PG8_WAIT_V
#undef PG8_WAIT_L
#undef PG8_BAR
#undef PG8_SCHED
#undef PG8_KA
}
}

namespace nsa {
typedef short bf16x8 __attribute__((ext_vector_type(8)));
typedef short s16x4 __attribute__((ext_vector_type(4)));
typedef float f32x16 __attribute__((ext_vector_type(16)));
typedef float f32x4 __attribute__((ext_vector_type(4)));
typedef unsigned u32x4 __attribute__((ext_vector_type(4)));
constexpr int SHM_V = 16384, SHM_K = 16384;
constexpr int L_V = 0, L_K = 32768, L_WS = 65536, L_LUT = 67584, L_IMP = 69632, L_SEL = 102400, L_UNI = 103424, L_TL = 103488, L_END = 104064;
constexpr float LOG2E = 1.4426950408889634f, C2 = 0.08838834764831845f * LOG2E, THR2 = 11.5f;
#define KSWZ(row, colB) ((row) * 256 + ((colB) ^ (((row) & 7) << 4)))
#define SBAR() __builtin_amdgcn_sched_barrier(0)
__device__ __forceinline__ int v_st(int k, int c) { const int kk = (k & ~0xC) | ((k & 4) << 1) | ((k & 8) >> 1); return ((kk >> 3) * 4 + (c >> 5)) * 512 + ((kk & 7) * 32 + (c & 31)) * 2; }
__device__ __forceinline__ int v_rd_base(int lane) { return ((lane & 3) << 3) | (((lane >> 2) & 3) << 6) | (((lane >> 4) & 1) << 5) | (((lane >> 5) & 1) << 8); }
constexpr int v_rd_off(int d0, int ks, int half) { return d0 * 512 + ks * 4096 + half * 2048; }
__device__ __forceinline__ int crow(int r, int hi) { return (r & 3) + 8 * (r >> 2) + 4 * hi; }
__device__ __forceinline__ unsigned cvtpk(float lo, float hi) { unsigned r; asm volatile("v_cvt_pk_bf16_f32 %0, %1, %2" : "=v"(r) : "v"(lo), "v"(hi)); return r; }

template <int KB>
__device__ __forceinline__ void qkt(f32x16& p0, f32x16& p1, const char* K_lds, int r32, int hi, const bf16x8* qr) {
    p0 = f32x16{}; p1 = f32x16{};
    const char* kb[4];
#pragma unroll
    for (int dd = 0; dd < 4; ++dd) kb[dd] = K_lds + KB * SHM_K + KSWZ(r32, (dd * 16 + hi * 8) * 2);
#pragma unroll
    for (int d0 = 0; d0 < 8; ++d0) { const char* a = kb[d0 & 3] + (d0 >> 2) * 128;
        bf16x8 b0 = *reinterpret_cast<const bf16x8*>(a);
        bf16x8 b1 = *reinterpret_cast<const bf16x8*>(a + 32 * 256);
        p0 = __builtin_amdgcn_mfma_f32_32x32x16_bf16(b0, qr[d0], p0, 0, 0, 0);
        p1 = __builtin_amdgcn_mfma_f32_32x32x16_bf16(b1, qr[d0], p1, 0, 0, 0); }
}
template <int VB>
__device__ __forceinline__ void pv_tile(f32x16* o, int vb0, bf16x8 pa0, bf16x8 pa1, bf16x8 pa2, bf16x8 pa3) {
#define TRRD(dst, off) asm volatile("ds_read_b64_tr_b16 %0, %1 offset:%2" : "=&v"(dst) : "v"(vb0), "i"(off) : "memory")
#define PV_D0(d0) do { s16x4 l0, l1, l2, l3, h0, h1, h2, h3; constexpr int b_ = VB * SHM_V + v_rd_off(d0, 0, 0); \
        TRRD(l0, b_); TRRD(h0, b_ + 2048); TRRD(l1, b_ + 4096); TRRD(h1, b_ + 6144); TRRD(l2, b_ + 8192); TRRD(h2, b_ + 10240); TRRD(l3, b_ + 12288); TRRD(h3, b_ + 14336); \
        asm volatile("s_waitcnt lgkmcnt(0)" ::: "memory"); SBAR(); \
        o[d0] = __builtin_amdgcn_mfma_f32_32x32x16_bf16(pa0, (bf16x8){l0[0], l0[1], l0[2], l0[3], h0[0], h0[1], h0[2], h0[3]}, o[d0], 0, 0, 0); \
        o[d0] = __builtin_amdgcn_mfma_f32_32x32x16_bf16(pa1, (bf16x8){l1[0], l1[1], l1[2], l1[3], h1[0], h1[1], h1[2], h1[3]}, o[d0], 0, 0, 0); \
        o[d0] = __builtin_amdgcn_mfma_f32_32x32x16_bf16(pa2, (bf16x8){l2[0], l2[1], l2[2], l2[3], h2[0], h2[1], h2[2], h2[3]}, o[d0], 0, 0, 0); \
        o[d0] = __builtin_amdgcn_mfma_f32_32x32x16_bf16(pa3, (bf16x8){l3[0], l3[1], l3[2], l3[3], h3[0], h3[1], h3[2], h3[3]}, o[d0], 0, 0, 0); } while (0)
    PV_D0(0); PV_D0(1); PV_D0(2); PV_D0(3);
#undef PV_D0
#undef TRRD
}
__device__ __forceinline__ void mask_tile(f32x16& p0, f32x16& p1, int dq, unsigned W) {
    const float NEG = -__builtin_inff();
    asm volatile("" : "+v"(dq));
#pragma unroll
    for (int r = 0; r < 16; ++r) {
        const int c = (r & 3) + 8 * (r >> 2);
        if ((unsigned)(dq - c) >= W) p0[r] = NEG;
        if ((unsigned)(dq - c - 32) >= W) p1[r] = NEG;
    }
}
template <int STRIDE>
__device__ __forceinline__ void bias_near(f32x16& p0, f32x16& p1, int dbase, const float* lut) {
    asm volatile("" : "+v"(dbase));
#pragma unroll
    for (int r = 0; r < 16; ++r) {
        const int c = (r & 3) + 8 * (r >> 2);
        int d0 = dbase - STRIDE * c, d1 = dbase - STRIDE * (c + 32);
        d0 = d0 < 0 ? 0 : (d0 > 127 ? 127 : d0); d1 = d1 < 0 ? 0 : (d1 > 127 ? 127 : d1);
        p0[r] = fmaf(p0[r], C2, lut[d0]); p1[r] = fmaf(p1[r], C2, lut[d1]);
    }
}
__device__ __forceinline__ void bias_const(f32x16& p0, f32x16& p1, float cb) {
#pragma unroll
    for (int r = 0; r < 16; ++r) { p0[r] = fmaf(p0[r], C2, cb); p1[r] = fmaf(p1[r], C2, cb); }
}
__device__ __forceinline__ float half_max(float v) { auto rr = __builtin_amdgcn_permlane32_swap(__float_as_uint(v), __float_as_uint(v), false, false); return fmaxf(__uint_as_float(rr[0]), __uint_as_float(rr[1])); }
__device__ __forceinline__ float half_sum(float v) { auto rr = __builtin_amdgcn_permlane32_swap(__float_as_uint(v), __float_as_uint(v), false, false); return __uint_as_float(rr[0]) + __uint_as_float(rr[1]); }
__device__ __forceinline__ void softmax_online(f32x16& p0, f32x16& p1, float sc, float cb2, bool sel, float& m, float& l, float& alpha) {
    float pmax = p0[0];
#pragma unroll
    for (int r = 1; r < 16; ++r) pmax = fmaxf(pmax, p0[r]);
#pragma unroll
    for (int r = 0; r < 16; ++r) pmax = fmaxf(pmax, p1[r]);
    pmax = half_max(pmax);
    pmax = sel ? fmaf(pmax, sc, cb2) : -__builtin_inff();
    if (__all(pmax - m <= THR2)) alpha = 1.f;
    else { const float mn = fmaxf(m, pmax); alpha = __builtin_amdgcn_exp2f(m - mn); m = mn; }
    const float off = sel ? cb2 - m : -__builtin_inff();
#pragma unroll
    for (int r = 0; r < 16; ++r) { p0[r] = fmaf(p0[r], sc, off); p1[r] = fmaf(p1[r], sc, off); }
    SBAR();
#pragma unroll
    for (int r = 0; r < 16; ++r) { p0[r] = __builtin_amdgcn_exp2f(p0[r]); p1[r] = __builtin_amdgcn_exp2f(p1[r]); }
    SBAR();
    float ps = 0.f;
#pragma unroll
    for (int r = 0; r < 16; ++r) ps += p0[r] + p1[r];
    l = l * alpha + half_sum(ps);
}
__device__ __forceinline__ void pack_p(const f32x16& p0, const f32x16& p1, bf16x8& pa0, bf16x8& pa1, bf16x8& pa2, bf16x8& pa3) {
#define PK4(P, B_, OUT) do { unsigned a0 = cvtpk(P[B_+0], P[B_+1]), a1 = cvtpk(P[B_+2], P[B_+3]); \
        unsigned b0 = cvtpk(P[B_+4], P[B_+5]), b1 = cvtpk(P[B_+6], P[B_+7]); \
        auto r0 = __builtin_amdgcn_permlane32_swap(a0, b0, false, false); auto r1 = __builtin_amdgcn_permlane32_swap(a1, b1, false, false); \
        u32x4 w = {r0[0], r1[0], r0[1], r1[1]}; OUT = *reinterpret_cast<bf16x8*>(&w); } while (0)
    PK4(p0, 0, pa0); PK4(p0, 8, pa1); PK4(p1, 0, pa2); PK4(p1, 8, pa3);
#undef PK4
}
__device__ __forceinline__ void rescale_o(f32x16* o, float alpha, float* al_l, int r32, int hi) {
    if (__any(alpha < 1.f)) {
        if (hi == 0) al_l[r32] = alpha;
        asm volatile("s_waitcnt lgkmcnt(0)" ::: "memory");
#pragma unroll
        for (int r = 0; r < 16; ++r) { const float a = al_l[crow(r, hi)];
#pragma unroll
            for (int d = 0; d < 4; ++d) o[d][r] *= a; }
    }
}
__device__ __forceinline__ void flush_out(const f32x16* o, float lsum, int br, unsigned char* ws, char* lds, int b, int g, int qb, int wid, int lane_in, bool first) {
    int lane = lane_in; asm volatile("" : "+v"(lane));
    const int r32 = lane & 31, hi = lane >> 5, head = g * 4 + (wid >> 1);
    const size_t tok = (size_t)b * T_ + qb * 64 + (wid & 1) * 32;
    float* li_l = (float*)(lds + L_WS) + wid * 64;
    bf16_t* tb = (bf16_t*)(lds + wid * 8192);
    bf16_t* orow = (bf16_t*)(ws + OFF_PROJ) + tok * LDP + C_NQ + head * 128;
    const float gate = ((const float*)(ws + OFF_GATE))[(tok + r32) * 24 + head * 3 + br];
    const float f_lane = br == 0 ? gate : (lsum > 0.f ? gate / lsum : 0.f);
    if (hi == 0) li_l[r32] = f_lane;
    asm volatile("s_waitcnt lgkmcnt(0)" ::: "memory");
#pragma unroll
    for (int r = 0; r < 16; ++r) {
        const float f = li_l[crow(r, hi)];
#pragma unroll
        for (int d = 0; d < 4; ++d) tb[crow(r, hi) * 128 + d * 32 + r32] = f2bf(o[d][r] * f);
    }
    asm volatile("s_waitcnt lgkmcnt(0)" ::: "memory");
    uint4 gq[8];
    if (!first) {
#pragma unroll
        for (int i = 0; i < 8; ++i) { const int idx = i * 64 + lane, row = idx >> 4, ch = idx & 15; gq[i] = *(const uint4*)(orow + (size_t)row * LDP + ch * 8); }
    }
#pragma unroll
    for (int i = 0; i < 8; ++i) {
        const int idx = i * 64 + lane, row = idx >> 4, ch = idx & 15;
        uint4 w = *(const uint4*)(tb + row * 128 + ch * 8);
        uint4* gp = (uint4*)(orow + (size_t)row * LDP + ch * 8);
        if (!first) {
            const uint4 g = gq[i];
            w.x = cvtpk(__uint_as_float(w.x << 16) + __uint_as_float(g.x << 16), __uint_as_float(w.x & 0xFFFF0000u) + __uint_as_float(g.x & 0xFFFF0000u));
            w.y = cvtpk(__uint_as_float(w.y << 16) + __uint_as_float(g.y << 16), __uint_as_float(w.y & 0xFFFF0000u) + __uint_as_float(g.y & 0xFFFF0000u));
            w.z = cvtpk(__uint_as_float(w.z << 16) + __uint_as_float(g.z << 16), __uint_as_float(w.z & 0xFFFF0000u) + __uint_as_float(g.z & 0xFFFF0000u));
            w.w = cvtpk(__uint_as_float(w.w << 16) + __uint_as_float(g.w << 16), __uint_as_float(w.w & 0xFFFF0000u) + __uint_as_float(g.w & 0xFFFF0000u));
        }
        *gp = w;
    }
}

struct Src { const bf16_t* K; const bf16_t* V; int stride; };

template <int MODE>
__device__ __forceinline__ void branch(const Src s, char* lds, const bf16x8* qr, f32x16* o, float& m, float& l, int NTL, int jbase, int t, int qb, int wid, int lane, int tid,
                                       const unsigned (&selw)[4], float inv_l) {
    const int r32 = lane & 31, hi = lane >> 5, rh = wid >> 1, iq = (wid & 1) * 32 + r32;
    char* V_lds = lds + L_V; char* K_lds = lds + L_K;
    float* al_l = (float*)(lds + L_WS) + wid * 64 + 32;
    const float* lut = (const float*)(lds + L_LUT) + rh * 128;
    const int* tl = (const int*)(lds + L_TL);
    float* impL = (float*)(lds + L_IMP);
    const int vb0 = (int)(uintptr_t)V_lds + v_rd_base(lane);
    const float cb = lut[127];
    constexpr bool HASV = MODE != 0;
    LAS unsigned char* ldsl = (LAS unsigned char*)lds;
#define TILE_OF(n) (MODE == 2 ? tl[n] : jbase + (n))
#define DMA(j, bf) do { const bf16_t* kt_ = s.K + (size_t)(j) * 64 * s.stride; const bf16_t* vt_ = s.V + (size_t)(j) * 64 * s.stride; \
        int ln_ = lane; asm volatile("" : "+v"(ln_));        \
        _Pragma("unroll") for (int i_ = 0; i_ < 2; ++i_) { \
            const int row_ = i_ * 32 + wid * 4 + (ln_ >> 4), srcch_ = (ln_ & 15) ^ (row_ & 7); \
            __builtin_amdgcn_global_load_lds((const unsigned*)(kt_ + (row_ * s.stride + srcch_ * 8)), (LAS unsigned*)(ldsl + L_K + (bf) * SHM_K + i_ * 8192 + wid * 1024), 16, 0, 0); \
            if (HASV) { const int kk_ = (i_ * 4 + (wid >> 1)) * 8 + ((ln_ & 31) >> 2), k_ = (kk_ & ~0xC) | ((kk_ & 4) << 1) | ((kk_ & 8) >> 1), cc_ = ((wid & 1) * 2 + (ln_ >> 5)) * 32 + (ln_ & 3) * 8; \
                __builtin_amdgcn_global_load_lds((const unsigned*)(vt_ + (k_ * s.stride + cc_)), (LAS unsigned*)(ldsl + L_V + (bf) * SHM_V + i_ * 8192 + wid * 1024), 16, 0, 0); } } } while (0)
#define COMPUTE(n, BF) do { const int j_ = TILE_OF(n); \
        bool act_ = true; bool rowsel_ = true; \
        if (MODE == 2) { const unsigned w_ = j_ < 32 ? selw[0] : j_ < 64 ? selw[1] : j_ < 96 ? selw[2] : selw[3]; rowsel_ = (w_ >> (j_ & 31)) & 1u; act_ = __any(rowsel_); } \
        if (act_) { f32x16 p0, p1; \
            qkt<BF>(p0, p1, K_lds, r32, hi, qr); \
              \
            const bool plain_ = MODE >= 2 && (qb - j_ > 2) && !(MODE == 3 && j_ == qb - 8); \
            float sc_ = C2, cb_ = cb; bool sel_ = rowsel_; \
            if (!plain_) { sc_ = 1.f; cb_ = 0.f; sel_ = true; \
                if (MODE <= 1) { \
                    if (64 * j_ + 63 >= 4 * qb - 10) bias_near<16>(p0, p1, t - 31 - 16 * (64 * j_ + 4 * hi), lut); else bias_const(p0, p1, cb); \
                    if (64 * j_ + 63 > ((64 * qb - 31) >> 4)) mask_tile(p0, p1, ((t - 31) >> 4) - 64 * j_ - 4 * hi, 1u << 30); \
                } else { \
                    bias_near<1>(p0, p1, t - 64 * j_ - 4 * hi, lut); \
                    if (MODE == 2) { if (j_ == qb) mask_tile(p0, p1, t - 64 * j_ - 4 * hi, 1u << 30); \
                        if (!rowsel_) { const float NEG_ = -__builtin_inff(); _Pragma("unroll") for (int r = 0; r < 16; ++r) { p0[r] = NEG_; p1[r] = NEG_; } } } \
                    else { if (j_ == qb || j_ == qb - 8) mask_tile(p0, p1, t - 64 * j_ - 4 * hi, 512u); } \
                } \
            } \
            if (MODE == 1) { \
                _Pragma("unroll") for (int r = 0; r < 16; ++r) { p0[r] = __builtin_amdgcn_exp2f(p0[r] - m) * inv_l; p1[r] = __builtin_amdgcn_exp2f(p1[r] - m) * inv_l; } \
                _Pragma("unroll") for (int a = 0; a < 4; ++a) { \
                    const int jj0 = 16 * j_ + 2 * a + hi, jj1 = jj0 + 8; \
                    atomicAdd(&impL[iq * 128 + jj0], p0[4 * a] + p0[4 * a + 1] + p0[4 * a + 2] + p0[4 * a + 3]); \
                    atomicAdd(&impL[iq * 128 + jj1], p1[4 * a] + p1[4 * a + 1] + p1[4 * a + 2] + p1[4 * a + 3]); \
                    if (jj0 + 1 < 128) atomicAdd(&impL[iq * 128 + jj0 + 1], p0[4 * a + 3]); \
                    if (jj1 + 1 < 128) atomicAdd(&impL[iq * 128 + jj1 + 1], p1[4 * a + 3]); } \
            } else { float alpha_; softmax_online(p0, p1, sc_, cb_, sel_, m, l, alpha_); if (MODE != 0) rescale_o(o, alpha_, al_l, r32, hi); } \
            if (MODE != 0) { bf16x8 pa0, pa1, pa2, pa3; pack_p(p0, p1, pa0, pa1, pa2, pa3); pv_tile<BF>(o, vb0, pa0, pa1, pa2, pa3); } \
        } } while (0)
#define STEP(n, BF) do { \
        if ((n) + 1 < NTL) DMA(TILE_OF((n) + 1), 1 - (BF)); \
        SBAR(); COMPUTE(n, BF); SBAR(); \
        asm volatile("s_waitcnt vmcnt(0)" ::: "memory"); \
        __syncthreads(); } while (0)
    if (NTL > 0) {
        DMA(TILE_OF(0), 0); asm volatile("s_waitcnt vmcnt(0)" ::: "memory");
        __syncthreads();
        for (int n = 0; n < NTL; n += 2) { STEP(n, 0); if (n + 1 < NTL) STEP(n + 1, 1); }
    }
#undef TILE_OF
#undef DMA
#undef COMPUTE
#undef STEP
}

__device__ __forceinline__ void item(unsigned char* ws, int b, int g, int qb, char* lds) {
    const int tid = tid_(), wid = __builtin_amdgcn_readfirstlane(tid >> 6), lane = tid & 63, r32 = lane & 31, hi = lane >> 5, rh = wid >> 1, iq = (wid & 1) * 32 + r32;
    const int t = qb * 64 + iq, head = g * 4 + rh;
    bf16_t* proj = (bf16_t*)(ws + OFF_PROJ);
    const size_t tok0 = (size_t)b * T_;
    float* impL = (float*)(lds + L_IMP); unsigned* selL = (unsigned*)(lds + L_SEL); unsigned* uniL = (unsigned*)(lds + L_UNI); int* tl = (int*)(lds + L_TL);
    for (int i = tid; i < 64 * 128; i += 512) impL[i] = 0.f;
    if (tid < 4) uniL[tid] = 0u;
    { const float* lutg = (const float*)(ws + OFF_LUT) + (g * 4) * 128; ((float*)(lds + L_LUT))[tid] = lutg[tid] * LOG2E; }
    bf16x8 qr[8];
    { const bf16_t* qp = proj + (tok0 + t) * LDP + C_NQ + head * 128 + hi * 8;
#pragma unroll
      for (int d0 = 0; d0 < 8; ++d0) qr[d0] = *(const bf16x8*)(qp + d0 * 16); }
    unsigned selw[4] = {0u, 0u, 0u, 0u};
    f32x16 o[4];
    __syncthreads();
    {
        const Src s{(const bf16_t*)(ws + OFF_KCMP) + (size_t)(b * 2 + g) * 512 * 128, (const bf16_t*)(ws + OFF_VCMP) + (size_t)(b * 2 + g) * 512 * 128, 128};
        const int nct = ((4 * qb + 2) >> 6) + 1;
        float m = -1e30f, l = 0.f;
        branch<0>(s, lds, qr, o, m, l, nct, 0, t, qb, wid, lane, tid, selw, 0.f);
#pragma unroll
        for (int d = 0; d < 4; ++d) o[d] = f32x16{};
        const float inv_l = l > 0.f ? 1.f / l : 0.f;
        branch<1>(s, lds, qr, o, m, l, nct, 0, t, qb, wid, lane, tid, selw, inv_l);
        flush_out(o, 1.f, 0, ws, lds, b, g, qb, wid, lane, true);
    }
    __syncthreads();
    {
        const int q = wid * 8 + (lane >> 3), sub = lane & 7;
        unsigned m0 = 0u, m1 = 0u, m2 = 0u, m3 = 0u;
        if (qb <= 15) { m0 = qb == 31 ? 0xFFFFFFFFu : ((1u << (qb + 1)) - 1u); }
        else {
            unsigned key[16];
#pragma unroll
            for (int k = 0; k < 16; ++k) { const int j = sub * 16 + k; key[k] = (j >= 1 && j <= qb - 2) ? ((__float_as_uint(impL[q * 128 + j]) & ~0x7Fu) | (unsigned)(127 - j)) : 0u; }
            for (int it = 0; it < 13; ++it) {
                unsigned lm = key[0];
#pragma unroll
                for (int k = 1; k < 16; ++k) lm = lm > key[k] ? lm : key[k];
                unsigned gm = lm, x;
                x = (unsigned)__builtin_amdgcn_update_dpp(0, (int)gm, 0xB1, 0xF, 0xF, true); gm = gm > x ? gm : x;
                x = (unsigned)__builtin_amdgcn_update_dpp(0, (int)gm, 0x4E, 0xF, 0xF, true); gm = gm > x ? gm : x;
                x = (unsigned)__builtin_amdgcn_update_dpp(0, (int)gm, 0x141, 0xF, 0xF, true); gm = gm > x ? gm : x;
#pragma unroll
                for (int k = 0; k < 16; ++k) key[k] = key[k] == gm ? 0u : key[k];
                const int j = 127 - (int)(gm & 0x7Fu);
                const unsigned bit = 1u << (j & 31);
                m0 |= j < 32 ? bit : 0u; m1 |= (j >= 32 && j < 64) ? bit : 0u; m2 |= (j >= 64 && j < 96) ? bit : 0u; m3 |= j >= 96 ? bit : 0u;
            }
            m0 |= 1u;
            { const int j = qb; const unsigned bit = 1u << (j & 31); m0 |= j < 32 ? bit : 0u; m1 |= (j >= 32 && j < 64) ? bit : 0u; m2 |= (j >= 64 && j < 96) ? bit : 0u; m3 |= j >= 96 ? bit : 0u; }
            { const int j = qb - 1; const unsigned bit = 1u << (j & 31); m0 |= j < 32 ? bit : 0u; m1 |= (j >= 32 && j < 64) ? bit : 0u; m2 |= (j >= 64 && j < 96) ? bit : 0u; m3 |= j >= 96 ? bit : 0u; }
        }
        if (sub == 0) { selL[q * 4 + 0] = m0; selL[q * 4 + 1] = m1; selL[q * 4 + 2] = m2; selL[q * 4 + 3] = m3;
                        atomicOr(&uniL[0], m0); atomicOr(&uniL[1], m1); atomicOr(&uniL[2], m2); atomicOr(&uniL[3], m3); }
    }
    __syncthreads();
    int nsl = 0;
    {
        if (wid == 0) {
            const bool s0 = lane <= qb && ((uniL[lane >> 5] >> (lane & 31)) & 1u), s1 = lane + 64 <= qb && ((uniL[2 + (lane >> 5)] >> (lane & 31)) & 1u);
            const unsigned long long b0 = __ballot(s0), b1 = __ballot(s1), below = (1ull << lane) - 1ull;
            const int n0 = __popcll(b0);
            if (s0) tl[__popcll(b0 & below)] = lane;
            if (s1) tl[n0 + __popcll(b1 & below)] = lane + 64;
            if (lane == 0) tl[128] = n0 + __popcll(b1);
        }
        selw[0] = selL[iq * 4 + 0]; selw[1] = selL[iq * 4 + 1]; selw[2] = selL[iq * 4 + 2]; selw[3] = selL[iq * 4 + 3];
        __syncthreads();
        nsl = tl[128];
    }
    {
        const Src s{proj + tok0 * LDP + C_KS + g * 128, proj + tok0 * LDP + C_VS + g * 128, LDP};
        float m = -1e30f, l = 0.f;
#pragma unroll
        for (int d = 0; d < 4; ++d) o[d] = f32x16{};
        branch<2>(s, lds, qr, o, m, l, nsl, 0, t, qb, wid, lane, tid, selw, 0.f);
        flush_out(o, l, 1, ws, lds, b, g, qb, wid, lane, false);
    }
    __syncthreads();
    {
        const Src s{proj + tok0 * LDP + C_KW + g * 128, proj + tok0 * LDP + C_VW + g * 128, LDP};
        const int jlo = qb >= 8 ? qb - 8 : 0;
        float m = -1e30f, l = 0.f;
#pragma unroll
        for (int d = 0; d < 4; ++d) o[d] = f32x16{};
        branch<3>(s, lds, qr, o, m, l, qb - jlo + 1, jlo, t, qb, wid, lane, tid, selw, 0.f);
        flush_out(o, l, 2, ws, lds, b, g, qb, wid, lane, false);
    }
    __syncthreads();
}
#undef KSWZ
#undef SBAR
}

__device__ void ph_hpre(const Params& p, int u) {
    const int tid = tid_(), b = u >> 8, n = u & 255, c2 = tid * 2;
    char* proj = (char*)(p.ws + OFF_PROJ) + (size_t)(b * T_ + n * 32) * (LDP * 2);
    const unsigned vo = (unsigned)c2 * 2u;
    const float* lb = (const float*)(p.ws + OFF_LB);
    const float kb0 = 1.f - lb[c2], kb1 = 1.f - lb[c2 + 1];
    float b0[32], b1[32];
    unsigned wf[32], wq[32];
#pragma unroll
    for (int i = 0; i < 32; ++i) wf[i] = *(const unsigned*)(proj + ((size_t)i * (LDP * 2) + C_HF * 2) + vo);
#pragma unroll
    for (int i = 0; i < 32; ++i) wq[i] = *(const unsigned*)(proj + ((size_t)i * (LDP * 2) + C_HQ * 2) + vo);
    float s0 = 1.f, s1 = 1.f;
#pragma unroll
    for (int i = 0; i < 32; ++i) {
        const float r0 = __uint_as_float(wf[i] << 16), r1 = __uint_as_float(wf[i] & 0xFFFF0000u);
        const float k0 = kb0 * sigmoidf_(-r0), k1 = kb1 * sigmoidf_(-r1);
        s0 *= 1.f - k0; s1 *= 1.f - k1;
        b0[i] = s0; b1[i] = s1;
        wf[i] = pg8::cvt_pk_bf16(k0, k1);
    }
    const float il0 = __builtin_amdgcn_rcpf(fmaxf(s0, 1e-30f)), il1 = __builtin_amdgcn_rcpf(fmaxf(s1, 1e-30f));
#pragma unroll
    for (int i = 0; i < 32; ++i) {
        const float k0 = __uint_as_float(wf[i] << 16), k1 = __uint_as_float(wf[i] & 0xFFFF0000u);
        const float q0 = __uint_as_float(wq[i] << 16), q1 = __uint_as_float(wq[i] & 0xFFFF0000u);
        const float e0 = s0 * __builtin_amdgcn_rcpf(fmaxf(b0[i], 1e-30f)), e1 = s1 * __builtin_amdgcn_rcpf(fmaxf(b1[i], 1e-30f));
        unsigned long long ro = (unsigned long long)i * (LDP * 2); asm volatile("" : "+s"(ro));
        char* rp = proj + ro + vo;
        *(unsigned*)(rp + C_HQ * 2) = pg8::cvt_pk_bf16(q0 * (b0[i] * il0), q1 * (b1[i] * il1));
        *(unsigned*)(rp + C_HF * 2) = pg8::cvt_pk_bf16(k0 * e0, k1 * e1);
    }
    float* dec = (float*)(p.ws + OFF_DEC) + ((size_t)((b * 8 + (c2 >> 7)) * 256 + n)) * 256 + (c2 & 127);
    dec[0] = s0; dec[1] = s1;
}

namespace hg {
typedef short bf16x8 __attribute__((ext_vector_type(8)));
typedef short s16x4 __attribute__((ext_vector_type(4)));
typedef float f32x4 __attribute__((ext_vector_type(4)));
typedef unsigned u32x4 __attribute__((ext_vector_type(4)));
constexpr int BUF = 25600, L_QA = 0, L_KE = 8192, L_VV = 16384, L_DEC = 24576, L_OB = 51200, OBS = 132;
__device__ __forceinline__ unsigned off_b(unsigned row, unsigned ch) { return 256u * row + 16u * (ch ^ (((row & 3) << 2) | ((row >> 2) & 3))); }
__device__ __forceinline__ unsigned tr_addr16(unsigned lane, unsigned c, unsigned t) {
    const unsigned g = lane >> 4, q = (lane & 15) >> 2, pp = lane & 3;
    return off_b(8 * g + 4 * t + q, 2 * c + (pp >> 1)) + 8 * (pp & 1);
}
__device__ __forceinline__ unsigned cvtpk(float lo, float hi) { unsigned r; asm volatile("v_cvt_pk_bf16_f32 %0, %1, %2" : "=v"(r) : "v"(lo), "v"(hi)); return r; }
__device__ __forceinline__ bf16x8 pack8(f32x4 a, f32x4 b) { u32x4 w = {cvtpk(a[0], a[1]), cvtpk(a[2], a[3]), cvtpk(b[0], b[1]), cvtpk(b[2], b[3])}; return *reinterpret_cast<bf16x8*>(&w); }
__device__ __forceinline__ s16x4 tr_read(unsigned addr) { s16x4 r; asm volatile("ds_read_b64_tr_b16 %0, %1" : "=v"(r) : "v"(addr) : "memory"); return r; }

__device__ __forceinline__ void item(unsigned char* ws, const float* norm_w, int b, int h, char* lds) {
    const int tid = tid_(), wid = __builtin_amdgcn_readfirstlane(tid >> 6), lane = tid & 63, l15 = lane & 15, g = lane >> 4;
    bf16_t* proj = (bf16_t*)(ws + OFF_PROJ) + (size_t)b * T_ * LDP + h * 128;
    const float* decg = (const float*)(ws + OFF_DEC) + (size_t)(b * 8 + h) * 256 * 256;
    LAS unsigned char* ldsl = (LAS unsigned char*)lds;
    const unsigned ldsb = (unsigned)(uintptr_t)lds;
    const int drow = 4 * wid + (lane >> 4);
    const unsigned dsrc = (unsigned)(drow * LDP + (((lane & 15) ^ (((drow & 3) << 2) | ((drow >> 2) & 3))) * 8));
#define HDMA(n, bf) do { const bf16_t* cp_ = proj + (size_t)(n) * 32 * LDP + dsrc; \
        __builtin_amdgcn_global_load_lds((const unsigned*)(cp_ + C_HQ), (LAS unsigned*)(ldsl + (bf) * BUF + L_QA + wid * 1024), 16, 0, 0); \
        __builtin_amdgcn_global_load_lds((const unsigned*)(cp_ + C_HF), (LAS unsigned*)(ldsl + (bf) * BUF + L_KE + wid * 1024), 16, 0, 0); \
        __builtin_amdgcn_global_load_lds((const unsigned*)(cp_ + C_HI), (LAS unsigned*)(ldsl + (bf) * BUF + L_VV + wid * 1024), 16, 0, 0); \
        if (wid == 0) __builtin_amdgcn_global_load_lds((const unsigned*)(decg + (size_t)(n) * 256 + lane * 4), (LAS unsigned*)(ldsl + (bf) * BUF + L_DEC), 16, 0, 0); } while (0)
    unsigned a_ke[2], a_qa[2], a_qp[2], a_vt[2];
#pragma unroll
    for (int x = 0; x < 2; ++x) {
        a_ke[x] = off_b(8 * (l15 >> 2) + 4 * x + (l15 & 3), g);
        a_qa[x] = off_b(16 * x + l15, g);
        a_qp[x] = off_b(16 * x + l15, g >> 1) + 8 * (g & 1);
        a_vt[x] = tr_addr16(lane, wid, x);
    }
    const int ntok = tid >> 4, ndv = (tid & 15) * 8;
    f32x4 S[8];
#pragma unroll
    for (int i = 0; i < 8; ++i) S[i] = (f32x4){0.f, 0.f, 0.f, 0.f};
    float* obuf = (float*)(lds + L_OB);
    HDMA(0, 0); asm volatile("s_waitcnt vmcnt(0)" ::: "memory");
    __syncthreads();
    for (int n = 0; n < 256; ++n) {
        const int bf = n & 1;
        if (n + 1 < 256) HDMA(n + 1, bf ^ 1);
        const u32x4 hgw = *(const u32x4*)(proj + (size_t)(n * 32 + ntok) * LDP + C_HG + ndv);
        const unsigned B0 = ldsb + bf * BUF;
        f32x4 att[2][2];
#pragma unroll
        for (int x = 0; x < 2; ++x)
#pragma unroll
            for (int y = 0; y < 2; ++y) att[x][y] = (f32x4){0.f, 0.f, 0.f, 0.f};
#pragma unroll
        for (int ks = 0; ks < 4; ++ks) {
            bf16x8 ka[2], qb[2];
#pragma unroll
            for (int x = 0; x < 2; ++x) {
                const unsigned rj = 8 * (l15 >> 2) + 4 * x + (l15 & 3), ri = 16 * x + l15;
                ka[x] = *(const LAS bf16x8*)(uintptr_t)(B0 + L_KE + off_b(rj, 4 * ks + g));
                qb[x] = *(const LAS bf16x8*)(uintptr_t)(B0 + L_QA + off_b(ri, 4 * ks + g));
            }
#pragma unroll
            for (int x = 0; x < 2; ++x)
#pragma unroll
                for (int y = 0; y < 2; ++y) att[x][y] = __builtin_amdgcn_mfma_f32_16x16x32_bf16(ka[x], qb[y], att[x][y], 0, 0, 0);
        }
        bf16x8 attf[2];
#pragma unroll
        for (int y = 0; y < 2; ++y) {
            const int i = 16 * y + l15;
            f32x4 a0 = att[0][y], a1 = att[1][y];
#pragma unroll
            for (int r = 0; r < 4; ++r) { if (8 * g + r > i) a0[r] = 0.f; if (8 * g + 4 + r > i) a1[r] = 0.f; }
            attf[y] = pack8(a0, a1);
        }
        bf16x8 vf;
        { const s16x4 v0 = tr_read(B0 + L_VV + a_vt[0]), v1 = tr_read(B0 + L_VV + a_vt[1]);
          asm volatile("s_waitcnt lgkmcnt(0)" ::: "memory");
          vf = (bf16x8){v0[0], v0[1], v0[2], v0[3], v1[0], v1[1], v1[2], v1[3]}; }
        f32x4 o[2];
#pragma unroll
        for (int y = 0; y < 2; ++y) o[y] = __builtin_amdgcn_mfma_f32_16x16x32_bf16(vf, attf[y], (f32x4){0.f, 0.f, 0.f, 0.f}, 0, 0, 0);
#pragma unroll
        for (int dt = 0; dt < 8; ++dt) { const f32x4 d = *(const LAS f32x4*)(uintptr_t)(B0 + L_DEC + (16 * dt + 4 * g) * 4); S[dt] *= d; }
#pragma unroll
        for (int ks = 0; ks < 4; ++ks) {
            const bf16x8 sa = pack8(S[2 * ks], S[2 * ks + 1]);
#pragma unroll
            for (int y = 0; y < 2; ++y) {
                const unsigned ri = 16 * y + l15;
                const unsigned long long q0 = *(const LAS unsigned long long*)(uintptr_t)(B0 + L_QA + off_b(ri, 4 * ks + (g >> 1)) + 8 * (g & 1));
                const unsigned long long q1 = *(const LAS unsigned long long*)(uintptr_t)(B0 + L_QA + off_b(ri, 4 * ks + 2 + (g >> 1)) + 8 * (g & 1));
                u32x4 w = {(unsigned)q0, (unsigned)(q0 >> 32), (unsigned)q1, (unsigned)(q1 >> 32)};
                o[y] = __builtin_amdgcn_mfma_f32_16x16x32_bf16(sa, *reinterpret_cast<bf16x8*>(&w), o[y], 0, 0, 0);
            }
        }
#pragma unroll
        for (int dt = 0; dt < 8; ++dt) {
            const s16x4 k0 = tr_read(B0 + L_KE + tr_addr16(lane, dt, 0)), k1 = tr_read(B0 + L_KE + tr_addr16(lane, dt, 1));
            asm volatile("s_waitcnt lgkmcnt(0)" ::: "memory");
            const bf16x8 kf = (bf16x8){k0[0], k0[1], k0[2], k0[3], k1[0], k1[1], k1[2], k1[3]};
            S[dt] = __builtin_amdgcn_mfma_f32_16x16x32_bf16(kf, vf, S[dt], 0, 0, 0);
        }
#pragma unroll
        for (int y = 0; y < 2; ++y) *(f32x4*)(obuf + (16 * y + l15) * OBS + 16 * wid + 4 * g) = o[y];
        __syncthreads();
        {
            const f32x4 x0 = *(const f32x4*)(obuf + ntok * OBS + ndv), x1 = *(const f32x4*)(obuf + ntok * OBS + ndv + 4);
            float ss = x0[0] * x0[0] + x0[1] * x0[1] + x0[2] * x0[2] + x0[3] * x0[3] + x1[0] * x1[0] + x1[1] * x1[1] + x1[2] * x1[2] + x1[3] * x1[3];
            ss += __shfl_xor(ss, 1); ss += __shfl_xor(ss, 2); ss += __shfl_xor(ss, 4); ss += __shfl_xor(ss, 8);
            const float r = rsqrtf(ss * (1.f / 128.f) + 1e-6f);
            const float gv[8] = {__uint_as_float(hgw.x << 16), __uint_as_float(hgw.x & 0xFFFF0000u), __uint_as_float(hgw.y << 16), __uint_as_float(hgw.y & 0xFFFF0000u),
                                 __uint_as_float(hgw.z << 16), __uint_as_float(hgw.z & 0xFFFF0000u), __uint_as_float(hgw.w << 16), __uint_as_float(hgw.w & 0xFFFF0000u)};
            const float xv[8] = {x0[0], x0[1], x0[2], x0[3], x1[0], x1[1], x1[2], x1[3]};
            const f32x4 n0 = *(const f32x4*)(norm_w + h * 128 + ndv), n1 = *(const f32x4*)(norm_w + h * 128 + ndv + 4);
            const float nw[8] = {n0[0], n0[1], n0[2], n0[3], n1[0], n1[1], n1[2], n1[3]};
            float ov[8];
#pragma unroll
            for (int i = 0; i < 8; ++i) ov[i] = xv[i] * r * nw[i] * sigmoidf_(gv[i]);
            u32x4 w = {cvtpk(ov[0], ov[1]), cvtpk(ov[2], ov[3]), cvtpk(ov[4], ov[5]), cvtpk(ov[6], ov[7])};
            *(u32x4*)(proj + (size_t)(n * 32 + ntok) * LDP + C_HI + ndv) = w;
        }
        asm volatile("s_waitcnt vmcnt(0)" ::: "memory");
        __syncthreads();
    }
#undef HDMA
    (void)a_ke; (void)a_qa; (void)a_qp;
}
}

__device__ void cvt_tile(float* sm, const float* src, int ldsrc, int k0, int ns0, int nvalid, bf16_t* dst, int lddst, int nd0) {
    float(*t)[65] = (float(*)[65])sm;
    const int tid = tid_();
    float4 v[8];
#pragma unroll
    for (int r = 0; r < 8; ++r) {
        const int idx = tid + r * 512, k = idx >> 4, n4 = (idx & 15) * 4;
        v[r] = n4 < nvalid ? *(const float4*)(src + (size_t)(k0 + k) * ldsrc + ns0 + n4) : make_float4(0.f, 0.f, 0.f, 0.f);
    }
#pragma unroll
    for (int r = 0; r < 8; ++r) {
        const int idx = tid + r * 512, k = idx >> 4, n4 = (idx & 15) * 4;
        t[k][n4] = v[r].x; t[k][n4 + 1] = v[r].y; t[k][n4 + 2] = v[r].z; t[k][n4 + 3] = v[r].w;
    }
    __syncthreads();
#pragma unroll
    for (int r = 0; r < 4; ++r) {
        const int idx = tid + r * 512, kg = idx & 31, n = idx >> 5;
        uint4 w;
        w.x = (unsigned)f2bf(t[kg * 8 + 0][n]) | ((unsigned)f2bf(t[kg * 8 + 1][n]) << 16); w.y = (unsigned)f2bf(t[kg * 8 + 2][n]) | ((unsigned)f2bf(t[kg * 8 + 3][n]) << 16);
        w.z = (unsigned)f2bf(t[kg * 8 + 4][n]) | ((unsigned)f2bf(t[kg * 8 + 5][n]) << 16); w.w = (unsigned)f2bf(t[kg * 8 + 6][n]) | ((unsigned)f2bf(t[kg * 8 + 7][n]) << 16);
        *(uint4*)(dst + (size_t)(nd0 + n) * lddst + k0 + kg * 8) = w;
    }
    __syncthreads();
}
__device__ __forceinline__ int gemm1_src_col(int nd) { return nd < 6656 ? nd : nd < 8704 ? nd + 24 : nd < 8728 ? 6656 + (nd - 8704) : -1; }
__device__ void ph_cvt_win(const Params& p, int u, float* sm) {
    if (u < 560) {
        const int nt = u >> 2, kt = u & 3, nd0 = nt * 64;
        const int ns0 = nd0 < 6656 ? nd0 : nd0 < 8704 ? nd0 + 24 : 6656, nvalid = nd0 < 8704 ? 64 : nd0 == 8704 ? 24 : 0;
        cvt_tile(sm, p.w_in, DIN, kt * 256, ns0, nvalid, (bf16_t*)(p.ws + OFF_WINT), 1024, nd0);
    } else {
        float* b1 = (float*)(p.ws + OFF_BIAS1);
        for (int i = tid_(); i < N1; i += 512) { const int s = gemm1_src_col(i); b1[i] = s >= 0 ? p.b_in[s] : 0.f; }
    }
}
__device__ void ph_cvt_br(const Params& p, int u, float* sm) {
    const int w = u >> 6, t = u & 63, nt = t >> 2, kt = t & 3;
    if (w < 2) cvt_tile(sm, w == 0 ? p.w_br_hg : p.w_br_nsa, 1024, kt * 256, nt * 64, 64, (bf16_t*)(p.ws + OFF_WBRH) + w * 1024, 2048, nt * 64);
    else cvt_tile(sm, p.w_out, 1024, kt * 256, nt * 64, 64, (bf16_t*)(p.ws + OFF_WOUTT), 1024, nt * 64);
}
__device__ void ph_cvt_exp(const Params& p, int u, float* sm) {
    if (u < 2048) {
        const int e = u >> 6, t = u & 63, nt = t >> 2, kt = t & 3, nd0 = nt * 64, pn = nd0 >> 8, half = (nd0 >> 7) & 1, off = nd0 & 127;
        cvt_tile(sm, (half ? p.e_w3 : p.e_w1) + (size_t)e * 1024 * 512, 512, kt * 256, pn * 128 + off, 64, (bf16_t*)(p.ws + OFF_E13) + (size_t)e * 1024 * 1024, 1024, nd0);
    } else {
        const int v = u - 2048, e = v >> 5, t = v & 31, nt = t >> 1, kt = t & 1;
        cvt_tile(sm, p.e_w2 + (size_t)e * 512 * 1024, 1024, kt * 256, nt * 64, 64, (bf16_t*)(p.ws + OFF_E2T) + (size_t)e * 1024 * 512, 512, nt * 64);
    }
}
enum { PH_PRO = 0, PH_LN0, PH_CMP2, PH_FINAL };
__host__ __device__ constexpr int phase_units(int ph) { return ph == PH_PRO ? 99 : ph == PH_LN0 ? NT / 16 : ph == PH_CMP2 ? 64 : ph == PH_FINAL ? NT / 16 : 0; }

__device__ void ph_pro(const Params& p, int u, float* sm) {
    const int tid = tid_();
    float* mod = (float*)(p.ws + OFF_MOD);
    if (u < 96) {
        float* ca = sm;
        float* red = sm + 4096;
        for (int i = tid; i < 4096; i += 512) ca[i] = siluf_(p.c[i]);
        __syncthreads();
        const int col = u * 64 + (tid & 63), kg = tid >> 6;
        float a0 = 0.f, a1 = 0.f, a2 = 0.f, a3 = 0.f;
        for (int k = kg * 128; k < kg * 128 + 128; ++k) {
            const float w = p.ada_w[(size_t)k * 6144 + col];
            a0 = fmaf(ca[k], w, a0); a1 = fmaf(ca[1024 + k], w, a1); a2 = fmaf(ca[2048 + k], w, a2); a3 = fmaf(ca[3072 + k], w, a3);
        }
        red[(kg * 64 + (tid & 63)) * 4 + 0] = a0; red[(kg * 64 + (tid & 63)) * 4 + 1] = a1; red[(kg * 64 + (tid & 63)) * 4 + 2] = a2; red[(kg * 64 + (tid & 63)) * 4 + 3] = a3;
        __syncthreads();
        if (tid < 256) {
            const int cl = tid & 63, b = tid >> 6;
            float s = 0.f;
            for (int g = 0; g < 8; ++g) s += red[(g * 64 + cl) * 4 + b];
            mod[b * 6144 + u * 64 + cl] = s + p.ada_b[u * 64 + cl];
        }
        __syncthreads();
    } else if (u == 96) {
        float* lb = (float*)(p.ws + OFF_LB);
        float* lut = (float*)(p.ws + OFF_LUT);
        unsigned* cnt = (unsigned*)(p.ws + OFF_CNT);
        for (int i = tid; i < 1024; i += 512) {
            const float l0 = p.lb_logits[i], l1 = p.lb_logits[1024 + i];
            lb[i] = 1.f / (1.f + __expf(l1 - l0));
            const int h = i >> 7, d = i & 127;
            lut[i] = p.rel_bias[h * 32 + rel_bucket(d)];
        }
        if (tid < 64) cnt[tid] = 0u;
        if (tid < 8) ((unsigned*)(p.ws + OFF_QCTR))[tid * 64] = 0u;
        { bf16_t* kc = (bf16_t*)(p.ws + OFF_KCMP); bf16_t* vc = (bf16_t*)(p.ws + OFF_VCMP);
          for (int i = tid; i < 8 * 128; i += 512) { kc[(size_t)((i >> 7) * 512 + 511) * 128 + (i & 127)] = 0; vc[(size_t)((i >> 7) * 512 + 511) * 128 + (i & 127)] = 0; } }
    } else {
        const int kv = u - 97;
        float* cb = (float*)(p.ws + OFF_CB) + kv * 128;
        if (tid < 128) cb[tid] = (kv ? p.b1_v : p.b1_k)[tid];
    }
}
__device__ void ph_cmpconst(const Params& p, int u, float* sm) {
    const int tid = tid_(), kv = u >> 5, kc = u & 31;
    const float* pos = kv ? p.pos_v : p.pos_k; const float* w1 = kv ? p.w1_v : p.w1_k;
    const int n = tid & 127, kg = tid >> 7;
    float s = 0.f;
#pragma unroll 8
    for (int k = kc * 128 + kg * 32; k < kc * 128 + kg * 32 + 32; ++k) s = fmaf(pos[k], w1[(size_t)k * 128 + n], s);
    sm[kg * 128 + n] = s;
    __syncthreads();
    if (tid < 128) atomicAdd((float*)(p.ws + OFF_CB) + kv * 128 + tid, sm[tid] + sm[128 + tid] + sm[256 + tid] + sm[384 + tid]);
    __syncthreads();
}

__device__ void ph_ln0(const Params& p, int u) {
    const int tidx = tid_(), lane = tidx & 63;
    float4 v[2][4]; float s[2] = {0.f, 0.f}; int rowi[2];
#pragma unroll
    for (int k = 0; k < 2; ++k) {
        rowi[k] = (u + k * (NT / 16)) * 8 + (tidx >> 6);
        const float* xr = p.x + (size_t)rowi[k] * D_;
#pragma unroll
        for (int i = 0; i < 4; ++i) { v[k][i] = *(const float4*)(xr + (i * 64 + lane) * 4); s[k] += v[k][i].x + v[k][i].y + v[k][i].z + v[k][i].w; }
    }
#pragma unroll
    for (int k = 0; k < 2; ++k) {
        const float* mod = (const float*)(p.ws + OFF_MOD) + (rowi[k] / T_) * 6144;
        bf16_t* h = (bf16_t*)(p.ws + OFF_H) + (size_t)rowi[k] * D_;
        const float mu = wsum(s[k]) * (1.f / 1024.f);
        float q = 0.f;
#pragma unroll
        for (int i = 0; i < 4; ++i) { v[k][i].x -= mu; v[k][i].y -= mu; v[k][i].z -= mu; v[k][i].w -= mu; q += v[k][i].x * v[k][i].x + v[k][i].y * v[k][i].y + v[k][i].z * v[k][i].z + v[k][i].w * v[k][i].w; }
        const float rs = rsqrtf(wsum(q) * (1.f / 1024.f) + 1e-5f);
#pragma unroll
        for (int i = 0; i < 4; ++i) {
            const int c = (i * 64 + lane) * 4;
            const float4 sh = *(const float4*)(mod + c), sc = *(const float4*)(mod + 1024 + c);
            st_bf4(h + c, v[k][i].x * rs * (1.f + sc.x) + sh.x, v[k][i].y * rs * (1.f + sc.y) + sh.y, v[k][i].z * rs * (1.f + sc.z) + sh.z, v[k][i].w * rs * (1.f + sc.w) + sh.w);
        }
    }
}

__device__ void ph_cmp2(const Params& p, int u, float* sm) {
    const int tid = tid_(), kv = u >> 5, m0 = (u & 31) * 128;
    const float* w2 = kv ? p.w2_v : p.w2_k;
    const float* hid = (const float*)(p.ws + OFF_HID) + (size_t)kv * 4096 * 128;
    const float* cb = (const float*)(p.ws + OFF_CB) + kv * 128;
    bf16_t* dst = (bf16_t*)(p.ws + (kv ? OFF_VCMP : OFF_KCMP));
    float(*As)[132] = (float(*)[132])sm;
    float(*Bs)[132] = (float(*)[132])(sm + 128 * 132);
    float4 av[8], bv[8];
#pragma unroll
    for (int r = 0; r < 8; ++r) { const int idx = tid + r * 512, row = idx >> 5, k4 = (idx & 31) * 4; av[r] = *(const float4*)(hid + (size_t)(m0 + row) * 128 + k4); bv[r] = *(const float4*)(w2 + (size_t)row * 128 + k4); }
#pragma unroll
    for (int r = 0; r < 8; ++r) { const int idx = tid + r * 512, row = idx >> 5, k4 = (idx & 31) * 4;
        const float4 c4 = *(const float4*)(cb + k4);
        As[k4][row] = siluf_(av[r].x + c4.x); As[k4 + 1][row] = siluf_(av[r].y + c4.y); As[k4 + 2][row] = siluf_(av[r].z + c4.z); As[k4 + 3][row] = siluf_(av[r].w + c4.w);
        *(float4*)&Bs[row][k4] = bv[r]; }
    __syncthreads();
    const int tx = tid & 31, ty = tid >> 5;
    float acc[8][4];
#pragma unroll
    for (int i = 0; i < 8; ++i)
#pragma unroll
        for (int j = 0; j < 4; ++j) acc[i][j] = 0.f;
#pragma unroll 8
    for (int k = 0; k < 128; ++k) {
        const float4 a0 = *(const float4*)&As[k][ty * 8], a1 = *(const float4*)&As[k][ty * 8 + 4], bb = *(const float4*)&Bs[k][tx * 4];
        const float a_[8] = {a0.x, a0.y, a0.z, a0.w, a1.x, a1.y, a1.z, a1.w};
        const float b_[4] = {bb.x, bb.y, bb.z, bb.w};
#pragma unroll
        for (int i = 0; i < 8; ++i)
#pragma unroll
            for (int j = 0; j < 4; ++j) acc[i][j] = fmaf(a_[i], b_[j], acc[i][j]);
    }
#pragma unroll
    for (int i = 0; i < 8; ++i) {
        const int m = m0 + ty * 8 + i;
        const bool dead = (m & 511) == 511;
        st_bf4(dst + (size_t)m * 128 + tx * 4, dead ? 0.f : acc[i][0], dead ? 0.f : acc[i][1], dead ? 0.f : acc[i][2], dead ? 0.f : acc[i][3]);
    }
    __syncthreads();
}

constexpr int LR_A = 0, LR_AS = 1028, LR_P = 16 * LR_AS, LR_SLOT = LR_P + 8 * 16 * 48, LR_LC = LR_SLOT + 8 * 80, LR_LNP = LR_LC + 64;
struct Ln1rArgs { unsigned char* ws; const float *ln1_g, *ln1_b, *rg_b, *re_b; float* sm; };
struct Ln1rW { const float *rg_w, *re_w; };
#define GAS __attribute__((address_space(1)))
template <class T> __device__ __forceinline__ GAS T* gptr(T* q) { return (GAS T*)q; }
#define LR_LOADZ(U_) do { _Pragma("unroll") for (int k = 0; k < 2; ++k) { const GAS bf16_t* zr_ = (const GAS bf16_t*)(ws + OFF_Z) + (size_t)((U_) * 16 + 2 * w + k) * D_; \
        _Pragma("unroll") for (int i = 0; i < 4; ++i) { const pg8::u32x2 a = *(const GAS pg8::u32x2*)(zr_ + (i * 64 + lane) * 4); v[k][i * 4] = __uint_as_float(a[0] << 16); v[k][i * 4 + 1] = __uint_as_float(a[0] & 0xFFFF0000u); \
            v[k][i * 4 + 2] = __uint_as_float(a[1] << 16); v[k][i * 4 + 3] = __uint_as_float(a[1] & 0xFFFF0000u); } } } while (0)
__device__ __forceinline__ void ph_ln1r_(const Ln1rArgs pa, const Ln1rW pw) {
    const int tidx = tid_(), lane = tidx & 63, w = tidx >> 6, n16 = lane & 15, kq = lane >> 4;
    GAS unsigned char* ws = gptr(pa.ws);
    const GAS float *ln1_g = gptr(pa.ln1_g), *ln1_b = gptr(pa.ln1_b), *rg_b = gptr(pa.rg_b), *re_b = gptr(pa.re_b), *rg_w = gptr(pw.rg_w), *re_w = gptr(pw.re_w);
    const int c = blockIdx.x, G = gridDim.x;
    LAS float* SM = (LAS float*)pa.sm;
    float v[2][16];
    LR_LOADZ(c);
    for (int i = tidx; i < 1024; i += 512) {
        SM[LR_LNP + i] = ln1_g[i]; SM[LR_LNP + 1024 + i] = ln1_b[i];
#pragma unroll
        for (int bb = 0; bb < 4; ++bb) { const GAS float* mod = (const GAS float*)(ws + OFF_MOD) + bb * 6144; SM[LR_LNP + 2048 + bb * 2048 + i] = mod[3072 + i]; SM[LR_LNP + 3072 + bb * 2048 + i] = 1.f + mod[4096 + i]; }
    }
    const int fa_k = lane >= 36 ? 1 : 0, fa_n = lane - 36 * fa_k, fb_n = lane < 8 ? 28 + lane : 35;
    const int fa_c = fa_n < 4 ? 32 + fa_n : fa_n - 4, fb_c = fb_n - 4;
    const float bias_a = fa_n < 4 ? rg_b[fa_n] : re_b[fa_n - 4], bias_b = re_b[fb_n - 4];
    float bw[3][32];
#pragma unroll
    for (int sj = 0; sj < 32; ++sj) {
        const int k = 128 * w + 16 * (sj >> 2) + 4 * kq + (sj & 3);
        bw[0][sj] = re_w[k * 32 + n16]; bw[1][sj] = re_w[k * 32 + 16 + n16]; bw[2][sj] = rg_w[k * 4 + (n16 & 3)];
    }
#pragma unroll
    for (int sj = 0; sj < 32; ++sj) bw[2][sj] = n16 < 4 ? bw[2][sj] : 0.f;
    __syncthreads();
    for (int u = c; u < NT / 16; u += G) {
        const int row0 = u * 16 + 2 * w, b = row0 / T_;
        const LAS float* lnp = SM + LR_LNP;
#pragma unroll
        for (int k = 0; k < 2; ++k) {
            GAS bf16_t* zr = (GAS bf16_t*)(ws + OFF_Z) + (size_t)(row0 + k) * D_;
            GAS bf16_t* h2 = (GAS bf16_t*)(ws + OFF_H) + (size_t)(row0 + k) * D_;
            float s1 = 0.f;
#pragma unroll
            for (int i = 0; i < 16; ++i) s1 += v[k][i];
            float mu = wsum(s1) * (1.f / 1024.f), q = 0.f;
#pragma unroll
            for (int i = 0; i < 16; ++i) { v[k][i] -= mu; q = fmaf(v[k][i], v[k][i], q); }
            float rs = rsqrtf(wsum(q) * (1.f / 1024.f) + 1e-5f);
            float s2 = 0.f;
#pragma unroll
            for (int i = 0; i < 4; ++i) {
                const int cc = (i * 64 + lane) * 4;
                const pg8::f32x4 gg = *(const LAS pg8::f32x4*)(lnp + cc), bb = *(const LAS pg8::f32x4*)(lnp + 1024 + cc);
                v[k][i * 4] = v[k][i * 4] * rs * gg[0] + bb[0]; v[k][i * 4 + 1] = v[k][i * 4 + 1] * rs * gg[1] + bb[1]; v[k][i * 4 + 2] = v[k][i * 4 + 2] * rs * gg[2] + bb[2]; v[k][i * 4 + 3] = v[k][i * 4 + 3] * rs * gg[3] + bb[3];
                { pg8::u32x2 pk = {pk_bf16(v[k][i * 4], v[k][i * 4 + 1]), pk_bf16(v[k][i * 4 + 2], v[k][i * 4 + 3])}; *(GAS pg8::u32x2*)(zr + cc) = pk; }
                s2 += v[k][i * 4] + v[k][i * 4 + 1] + v[k][i * 4 + 2] + v[k][i * 4 + 3];
            }
            mu = wsum(s2) * (1.f / 1024.f); q = 0.f;
#pragma unroll
            for (int i = 0; i < 16; ++i) { v[k][i] -= mu; q = fmaf(v[k][i], v[k][i], q); }
            rs = rsqrtf(wsum(q) * (1.f / 1024.f) + 1e-5f);
#pragma unroll
            for (int i = 0; i < 4; ++i) {
                const int cc = (i * 64 + lane) * 4;
                const pg8::f32x4 sh = *(const LAS pg8::f32x4*)(lnp + 2048 + b * 2048 + cc), sc = *(const LAS pg8::f32x4*)(lnp + 3072 + b * 2048 + cc);
                const pg8::f32x4 o = {v[k][i * 4] * rs * sc[0] + sh[0], v[k][i * 4 + 1] * rs * sc[1] + sh[1], v[k][i * 4 + 2] * rs * sc[2] + sh[2], v[k][i * 4 + 3] * rs * sc[3] + sh[3]};
                { pg8::u32x2 pk = {pk_bf16(o[0], o[1]), pk_bf16(o[2], o[3])}; *(GAS pg8::u32x2*)(h2 + cc) = pk; }
                *(LAS pg8::f32x4*)(SM + LR_A + (2 * w + k) * LR_AS + cc) = o;
            }
        }
        __syncthreads();
        if (u + G < NT / 16) LR_LOADZ(u + G);
        {
            pg8::f32x4 acc[3] = {{0.f, 0.f, 0.f, 0.f}, {0.f, 0.f, 0.f, 0.f}, {0.f, 0.f, 0.f, 0.f}};
            const LAS float* ar = SM + LR_A + n16 * LR_AS + 128 * w + 4 * kq;
            pg8::f32x4 a4[8];
#pragma unroll
            for (int sI = 0; sI < 8; ++sI) a4[sI] = *(const LAS pg8::f32x4*)(ar + 16 * sI);
#pragma unroll
            for (int sI = 0; sI < 8; ++sI)
#pragma unroll
                for (int j = 0; j < 4; ++j)
#pragma unroll
                    for (int t = 0; t < 3; ++t) acc[t] = __builtin_amdgcn_mfma_f32_16x16x4f32(a4[sI][j], bw[t][sI * 4 + j], acc[t], 0, 0, 0);
            LAS float* pp = SM + LR_P + (w * 16 + 4 * kq) * 48 + n16;
#pragma unroll
            for (int t = 0; t < 3; ++t)
#pragma unroll
                for (int e = 0; e < 4; ++e) pp[e * 48 + 16 * t] = acc[t][e];
        }
        __syncthreads();
        {
            LAS float* slot = SM + LR_SLOT + w * 80;
            {
                const LAS float* pa_ = SM + LR_P + (2 * w + fa_k) * 48 + fa_c;
                const LAS float* pb_ = SM + LR_P + (2 * w + 1) * 48 + fb_c;
                float ta = bias_a, tb = bias_b;
#pragma unroll
                for (int ww = 0; ww < 8; ++ww) { ta += pa_[ww * 16 * 48]; tb += pb_[ww * 16 * 48]; }
                slot[lane] = ta;
                if (lane < 8) slot[64 + lane] = tb;
            }
            asm volatile("s_waitcnt lgkmcnt(0)" ::: "memory");
            const int kr = lane >> 5, row = row0 + kr;
            float lg[36];
#pragma unroll
            for (int q = 0; q < 9; ++q) { const pg8::f32x4 w4 = *(const LAS pg8::f32x4*)(slot + kr * 36 + q * 4); lg[q * 4] = w4[0]; lg[q * 4 + 1] = w4[1]; lg[q * 4 + 2] = w4[2]; lg[q * 4 + 3] = w4[3]; }
            int gi = 0; float gm = lg[0];
#pragma unroll
            for (int j = 1; j < 4; ++j) if (lg[j] > gm) { gm = lg[j]; gi = j; }
            float gs = 0.f;
#pragma unroll
            for (int j = 0; j < 4; ++j) gs += __expf(lg[j] - gm);
            const float gp = __builtin_amdgcn_rcpf(gs);
            float el[8];
#pragma unroll
            for (int i = 0; i < 8; ++i) el[i] = gi == 0 ? lg[4 + i] : gi == 1 ? lg[12 + i] : gi == 2 ? lg[20 + i] : lg[28 + i];
            int i0 = 0; float l0 = el[0];
#pragma unroll
            for (int i = 1; i < 8; ++i) if (el[i] > l0) { l0 = el[i]; i0 = i; }
            int i1 = -1; float l1 = -3.0e38f;
#pragma unroll
            for (int i = 0; i < 8; ++i) if (i != i0 && el[i] > l1) { l1 = el[i]; i1 = i; }
            const float w0 = __builtin_amdgcn_rcpf(1.f + __expf(l1 - l0));
            if ((lane & 31) == 0) {
                GAS int* ti = (GAS int*)(ws + OFF_TOKI) + (size_t)row * 6;
                const int e0 = gi * 8 + i0, e1 = gi * 8 + i1;
                ti[0] = e0; ti[1] = e1;
                LAS unsigned* lc = (LAS unsigned*)(SM + LR_LC);
                ti[2] = (int)__hip_atomic_fetch_add(lc + e0, 1u, __ATOMIC_RELAXED, __HIP_MEMORY_SCOPE_WORKGROUP); ti[3] = (int)__hip_atomic_fetch_add(lc + e1, 1u, __ATOMIC_RELAXED, __HIP_MEMORY_SCOPE_WORKGROUP);
                ((GAS float*)ti)[4] = gp * w0; ((GAS float*)ti)[5] = gp * (1.f - w0);
            }
        }
    }
}
#undef LR_LOADZ

__device__ __forceinline__ int wave_offsets(const unsigned* cnt, int lane, int& pc_out, int& tot) {
    const int c = lane < 32 ? (int)cnt[lane] : 0;
    const int pc = ((c + 255) >> 8) << 8;
    int inc = pc;
    for (int o = 1; o < 64; o <<= 1) { const int t = __shfl_up(inc, o); if (lane >= o) inc += t; }
    tot = __shfl(inc, 63);
    pc_out = pc;
    return inc - pc;
}

__device__ void ph_final(const Params& p, int u) {
    const int tidx = tid_(), lane = tidx & 63;
    float v[2][16]; float s[2] = {0.f, 0.f};
    int rowi[2];
#pragma unroll
    for (int k = 0; k < 2; ++k) {
        const int row = (u + k * (NT / 16)) * 8 + (tidx >> 6), b = row / T_;
        rowi[k] = row;
        const bf16_t* x1 = (const bf16_t*)(p.ws + OFF_Z) + (size_t)row * D_;
        const float* mod = (const float*)(p.ws + OFF_MOD) + b * 6144 + 5120;
        const int* ti = (const int*)(p.ws + OFF_TOKI) + (size_t)row * 6;
        const int r0 = ti[2], r1 = ti[3]; const float w0 = ((const float*)ti)[4], w1 = ((const float*)ti)[5];
        const bf16_t* y0 = (const bf16_t*)(p.ws + OFF_XPAD) + (size_t)r0 * D_; const bf16_t* y1 = (const bf16_t*)(p.ws + OFF_XPAD) + (size_t)r1 * D_;
#pragma unroll
        for (int i = 0; i < 4; ++i) {
            const int c = (i * 64 + lane) * 4;
            const float4 xv = ld_bf4(x1 + c), g2 = *(const float4*)(mod + c), a = ld_bf4(y0 + c), bb = ld_bf4(y1 + c);
            v[k][i * 4] = ALPHA * xv.x + (1.f + g2.x) * (w0 * a.x + w1 * bb.x); v[k][i * 4 + 1] = ALPHA * xv.y + (1.f + g2.y) * (w0 * a.y + w1 * bb.y);
            v[k][i * 4 + 2] = ALPHA * xv.z + (1.f + g2.z) * (w0 * a.z + w1 * bb.z); v[k][i * 4 + 3] = ALPHA * xv.w + (1.f + g2.w) * (w0 * a.w + w1 * bb.w);
            s[k] += v[k][i * 4] + v[k][i * 4 + 1] + v[k][i * 4 + 2] + v[k][i * 4 + 3];
        }
    }
#pragma unroll
    for (int k = 0; k < 2; ++k) {
        const float mu = wsum(s[k]) * (1.f / 1024.f); float q = 0.f;
#pragma unroll
        for (int i = 0; i < 16; ++i) { v[k][i] -= mu; q = fmaf(v[k][i], v[k][i], q); }
        const float rs = rsqrtf(wsum(q) * (1.f / 1024.f) + 1e-5f);
#pragma unroll
        for (int i = 0; i < 4; ++i) {
            const int c = (i * 64 + lane) * 4;
            const float4 gg = *(const float4*)(p.ln2_g + c), bb = *(const float4*)(p.ln2_b + c);
            *(float4*)(p.out + (size_t)rowi[k] * D_ + c) = make_float4(v[k][i * 4] * rs * gg.x + bb.x, v[k][i * 4 + 1] * rs * gg.y + bb.y, v[k][i * 4 + 2] * rs * gg.z + bb.z, v[k][i * 4 + 3] * rs * gg.w + bb.w);
        }
    }
}

template <int PH> __device__ __forceinline__ void run_unit(const Params& p, int u, float* sm) {
    if constexpr (PH == PH_PRO) ph_pro(p, u, sm);
    else if constexpr (PH == PH_LN0) ph_ln0(p, u);
    else if constexpr (PH == PH_CMP2) ph_cmp2(p, u, sm);
    else if constexpr (PH == PH_FINAL) ph_final(p, u);
}

constexpr int MEGA_LDS = 153600 + 16;
enum { Q_PRO = 0, Q_LN0, Q_GEMM1, Q_CMP1, Q_CMP2, Q_MIX, Q_MRG, Q_WOUT, Q_LN1R, Q_PAD, Q_EXP1, Q_EXP2, Q_FINAL };
template <int PH> __device__ __forceinline__ void unit_loop(const Params& p, float* sm) {
    for (int u = blockIdx.x; u < phase_units(PH); u += gridDim.x) run_unit<PH>(p, u, sm);
}
template <int Q> __device__ __forceinline__ void run_phase(const Params& p, float* sm) {
    PG8_LAS unsigned char* lds = (PG8_LAS unsigned char*)sm;
    const int G = gridDim.x, c = blockIdx.x;
    if constexpr (Q == Q_PRO) {
        unit_loop<PH_PRO>(p, sm); for (int u = c; u < 561; u += G) ph_cvt_win(p, u, sm);
        for (int u = c; u < 64; u += G) { const int kv = u >> 5, t = u & 31, nt = t >> 4, kt = t & 15;
            cvt_tile(sm, kv ? p.w1_v : p.w1_k, 128, kt * 256, nt * 64, 64, (bf16_t*)(p.ws + OFF_CMPW) + (size_t)kv * 128 * 4096, 4096, nt * 64); }
        { float4* hz = (float4*)(p.ws + OFF_HID); for (int i = c * 512 + threadIdx.x; i < 2 * 4096 * 128 / 4; i += G * 512) hz[i] = make_float4(0.f, 0.f, 0.f, 0.f); }
    }
    else if constexpr (Q == Q_LN0) { for (int u = c; u < 64; u += G) ph_cmpconst(p, u, sm); unit_loop<PH_LN0>(p, sm); }
    else if constexpr (Q == Q_GEMM1) {
        pg8::Gemm g{(const bf16_t*)(p.ws + OFF_H), (const bf16_t*)(p.ws + OFF_WINT), 1024, 1024, 1024};
        pg8::StaticOrder S; S.init(NT, N1, G, c);
        pg8::EpiProj E{(bf16_t*)(p.ws + OFF_PROJ), (bf16_t*)p.out, (float*)(p.ws + OFF_GATE), (const float*)(p.ws + OFF_BIAS1)};
        pg8::gemm_phase(lds, g, S, E);
    }
    else if constexpr (Q == Q_CMP1) {
        for (int u = c; u < 1024; u += G) ph_hpre(p, u);
        for (int u = c; u < 192; u += G) ph_cvt_br(p, u, sm);
        __syncthreads();
        pg8::Gemm g{(const bf16_t*)(p.ws + OFF_PROJ), (const bf16_t*)(p.ws + OFF_CMPW), 1024, 16 * LDP, 4096, 1, 1};
        pg8::CmpOrder S{G, c};
        pg8::EpiCmpAcc E{(float*)(p.ws + OFF_HID)};
        pg8::gemm_phase(lds, g, S, E);
    }
    else if constexpr (Q == Q_CMP2) unit_loop<PH_CMP2>(p, sm);
    else if constexpr (Q == Q_MIX) {
        unsigned* qc = (unsigned*)(p.ws + OFF_QCTR);
        volatile int* slot = (volatile int*)((char*)sm + 131072 - 64);
        for (int k = 0; k < 8; ++k) {
            const int q = (c + k) & 7;
            for (;;) {
                __syncthreads();
                if (threadIdx.x == 0) *slot = (int)__hip_atomic_fetch_add(qc + q * 64, 1u, __ATOMIC_RELAXED, __HIP_MEMORY_SCOPE_AGENT);
                __syncthreads();
                const int it = *slot;
                if (it >= 4 + 128) break;
                if (it < 4) hg::item(p.ws, p.hg_norm_w, q >> 1, (q & 1) * 4 + it, (char*)sm);
                else nsa::item(p.ws, q >> 1, q & 1, 127 - (it - 4), (char*)sm);
            }
        }
    }
    else if constexpr (Q == Q_MRG) {
        pg8::StaticOrder S; S.init(NT, 1024, G, c);
        pg8::Gemm g{(const bf16_t*)(p.ws + OFF_PROJ) + C_HI, (const bf16_t*)(p.ws + OFF_WBRH), 2048, LDP, 2048, 2, 0};
        pg8::EpiMrg E{(const bf16_t*)p.out, (bf16_t*)(p.ws + OFF_H)};
        pg8::gemm_phase(lds, g, S, E);
    }
    else if constexpr (Q == Q_WOUT) {
        for (int u = c; u < 3072; u += G) ph_cvt_exp(p, u, sm);
        pg8::Gemm g{(const bf16_t*)(p.ws + OFF_H), (const bf16_t*)(p.ws + OFF_WOUTT), 1024, 1024, 1024};
        pg8::StaticOrder S; S.init(NT, 1024, G, c);
        pg8::EpiWout E{p.x, (const float*)(p.ws + OFF_MOD), (bf16_t*)(p.ws + OFF_Z)};
        pg8::gemm_phase(lds, g, S, E);
    }
    else if constexpr (Q == Q_LN1R) {
        unsigned* lc = (unsigned*)(sm + LR_LC);
        if (threadIdx.x < 64) lc[threadIdx.x] = 0u;
        __syncthreads();
        ph_ln1r_(Ln1rArgs{p.ws, p.ln1_g, p.ln1_b, p.rg_b, p.re_b, sm}, Ln1rW{p.rg_w, p.re_w});
        __syncthreads();
        if (threadIdx.x < 32) lc[32 + threadIdx.x] = atomicAdd((unsigned*)(p.ws + OFF_CNT) + threadIdx.x, lc[threadIdx.x]);
        __syncthreads();
        for (int u = c; u < NT / 16; u += G) {
            if (threadIdx.x < 32) { int* ti = (int*)(p.ws + OFF_TOKI) + (size_t)(u * 16 + (threadIdx.x >> 1)) * 6; const int k = threadIdx.x & 1; ti[2 + k] += (int)lc[32 + ti[k]]; }
        }
        __syncthreads();
    }
    else if constexpr (Q == Q_PAD) {
        const int tidx = tid_(), lane = tidx & 63, w = tidx >> 6;
        const unsigned* cnt = (const unsigned*)(p.ws + OFF_CNT);
        bf16_t* xp = (bf16_t*)(p.ws + OFF_XPAD);
        int pc, tot; const int off = wave_offsets(cnt, lane, pc, tot);
#define PAD_LOAD(K_, ROW_) \
            const int rw##K_ = (ROW_) < NT ? (ROW_) : NT - 1; const int* tq##K_ = (const int*)(p.ws + OFF_TOKI) + (size_t)rw##K_ * 6; \
            const int ra##K_ = __shfl(off, tq##K_[0]) + tq##K_[2], rb##K_ = __shfl(off, tq##K_[1]) + tq##K_[3]; \
            const uint4* sp##K_ = (const uint4*)((const bf16_t*)(p.ws + OFF_H) + (size_t)rw##K_ * D_); const uint4 xa##K_ = sp##K_[lane], xb##K_ = sp##K_[64 + lane];
#define PAD_STORE(K_, ROW_) if ((ROW_) < NT) { uint4* d0 = (uint4*)(xp + (size_t)ra##K_ * D_); uint4* d1 = (uint4*)(xp + (size_t)rb##K_ * D_); \
            d0[lane] = xa##K_; d0[64 + lane] = xb##K_; d1[lane] = xa##K_; d1[64 + lane] = xb##K_; \
            if (lane == 0) { int* tw = (int*)(p.ws + OFF_TOKI) + (size_t)(ROW_) * 6; tw[2] = ra##K_; tw[3] = rb##K_; } }
        for (int base = c * 8 + w; base < NT; base += G * 16) {
            PAD_LOAD(0, base) PAD_LOAD(1, base + G * 8)
            PAD_STORE(0, base) PAD_STORE(1, base + G * 8)
        }
#undef PAD_LOAD
#undef PAD_STORE
        for (int e = c; e < 32; e += G) {
            const int oe = __shfl(off, e), ce = (int)cnt[e], pe = __shfl(pc, e);
            for (int r = oe + ce + w; r < oe + pe; r += 8) { uint4* d = (uint4*)(xp + (size_t)r * D_); d[lane] = make_uint4(0, 0, 0, 0); d[64 + lane] = make_uint4(0, 0, 0, 0); }
        }
        if (c == G - 1) {
            int* te = (int*)(p.ws + OFF_TILEE);
            if (tidx < 32) { for (int r = off; r < off + pc; r += 256) te[r >> 8] = tidx; }
            if (tidx == 0) te[511] = tot >> 8;
        }
    }
    else if constexpr (Q == Q_EXP1) {
        const int* te = (const int*)(p.ws + OFF_TILEE);
        pg8::Gemm g{(const bf16_t*)(p.ws + OFF_XPAD), (const bf16_t*)(p.ws + OFF_E13), 1024, 1024, 1024};
        pg8::MoeOrder S{te, te[511] * 4, G, c, (long)1024 * 1024 * 2};
        pg8::EpiExp1 E{(bf16_t*)p.out};
        pg8::gemm_phase(lds, g, S, E);
    }
    else if constexpr (Q == Q_EXP2) {
        const int* te = (const int*)(p.ws + OFF_TILEE);
        pg8::Gemm g{(const bf16_t*)p.out, (const bf16_t*)(p.ws + OFF_E2T), 512, 512, 512};
        pg8::MoeOrder S{te, te[511] * 4, G, c, (long)1024 * 512 * 2};
        pg8::EpiBf E{(bf16_t*)(p.ws + OFF_XPAD), 1024};
        pg8::gemm_phase(lds, g, S, E);
    }
    else if constexpr (Q == Q_FINAL) unit_loop<PH_FINAL>(p, sm);
}
__global__ void __launch_bounds__(512, 2) k_mega(Params p) {
    extern __shared__ __attribute__((aligned(16))) float smem[];
    volatile LAS unsigned* st = (volatile LAS unsigned*)(smem + 153600 / 4);
    if (threadIdx.x == 0) { st[0] = 0u; st[1] = 0u; st[2] = 0u; st[3] = 0u; }
    __syncthreads();
    XcdBarrier bar = xcd_barrier_post((unsigned*)(p.ws + OFF_BAR), st);
    run_phase<Q_PRO>(p, smem);   xcd_barrier(bar);
    run_phase<Q_LN0>(p, smem);   xcd_barrier(bar);
    run_phase<Q_GEMM1>(p, smem); xcd_barrier(bar);
    run_phase<Q_CMP1>(p, smem);  xcd_barrier(bar);
    run_phase<Q_CMP2>(p, smem);  xcd_barrier(bar);
    run_phase<Q_MIX>(p, smem);   xcd_barrier(bar);
    run_phase<Q_MRG>(p, smem);   xcd_barrier(bar);
    run_phase<Q_WOUT>(p, smem);  xcd_barrier(bar);
    run_phase<Q_LN1R>(p, smem);  xcd_barrier(bar);
    run_phase<Q_PAD>(p, smem);   xcd_barrier(bar);
    run_phase<Q_EXP1>(p, smem);  xcd_barrier(bar);
    run_phase<Q_EXP2>(p, smem);  xcd_barrier(bar);
    run_phase<Q_FINAL>(p, smem);
}

extern "C" void kernel_launch(void* const* d_in, const int* in_sizes, int n_in, void* d_out, int out_size, void* d_ws, size_t ws_size, hipStream_t stream) {
    Params p{};
    const float** fp = (const float**)&p;
    for (int i = 0; i < 31; ++i) fp[i] = (const float*)d_in[i];
    p.out = (float*)d_out; p.ws = (unsigned char*)d_ws;
    static int grid = 0;
    if (!grid) {
        int dev = 0, cus = 0, per_cu = 0;
        (void)hipGetDevice(&dev);
        (void)hipDeviceGetAttribute(&cus, hipDeviceAttributeMultiprocessorCount, dev);
        (void)hipFuncSetAttribute((const void*)k_mega, hipFuncAttributeMaxDynamicSharedMemorySize, MEGA_LDS);
        (void)hipOccupancyMaxActiveBlocksPerMultiprocessor(&per_cu, (const void*)k_mega, 512, MEGA_LDS);
        grid = cus * (per_cu < 1 ? per_cu : 1);
    }
    (void)hipMemsetAsync(p.ws + OFF_BAR, 0, XCD_BAR_WORDS * sizeof(unsigned), stream);
    hipLaunchKernelGGL(k_mega, dim3(grid), dim3(512), MEGA_LDS, stream, p);
}
```

```cpp
#include <hip/hip_runtime.h>
#include <stdint.h>

typedef unsigned short bf16_t;

constexpr int B_ = 4, T_ = 8192, D_ = 1024, NT = B_ * T_;
constexpr int DIN = 8728;
constexpr int LDP = 6656;
constexpr int C_HQ = 0, C_HF = 1024, C_HI = 2048, C_HG = 3072, C_NQ = 4096, C_KC = 5120, C_VC = 5376, C_KS = 5632, C_VS = 5888, C_KW = 6144, C_VW = 6400;
constexpr int NC = 511;
constexpr float ALPHA = 1.189207115002721f;
constexpr int MAXROWS = 73728;

constexpr size_t KB = 1024, MB = 1024 * 1024;
constexpr size_t OFF_BAR = 0, OFF_MOD = 16 * KB, OFF_LB = 112 * KB, OFF_LUT = 116 * KB, OFF_CB = 120 * KB, OFF_CNT = 124 * KB, OFF_TOKI = 128 * KB;
constexpr size_t OFF_GATE = 1 * MB, OFF_KCMP = 4 * MB, OFF_VCMP = 5 * MB, OFF_HID = 6 * MB;
constexpr size_t OFF_DEC = 18 * MB;
constexpr size_t OFF_INV = 26 * MB;
constexpr size_t OFF_QCTR = 960 * KB;
constexpr size_t OFF_CMPW = 10 * MB;
constexpr size_t OFF_H = 31 * MB;
constexpr size_t OFF_PROJ = 95 * MB;
constexpr size_t OFF_Z = OFF_PROJ, OFF_XPAD = OFF_PROJ + 128 * MB;
constexpr size_t OFF_BIAS1 = 896 * KB, OFF_TILEE = 940 * KB;
constexpr size_t OFF_WINT = 12 * MB;
constexpr size_t OFF_WBRH = 12 * MB, OFF_WBRN = 14 * MB, OFF_WOUTT = 16 * MB;
constexpr size_t OFF_E13 = OFF_PROJ + 272 * MB, OFF_E2T = OFF_PROJ + 336 * MB;
constexpr int N1 = 8960;

struct Params {
    const float *x, *c, *ada_w, *ada_b, *w_in, *b_in, *lb_logits, *hg_norm_w, *pos_k, *w1_k, *b1_k, *w2_k, *pos_v, *w1_v, *b1_v, *w2_v, *rel_bias,
        *w_br_hg, *w_br_nsa, *w_out, *ln1_g, *ln1_b, *rg_w, *rg_b, *re_w, *re_b, *e_w1, *e_w3, *e_w2, *ln2_g, *ln2_b;
    float* out; unsigned char* ws;
};

__device__ __forceinline__ int tid_() { int t = threadIdx.x; asm volatile("" : "+v"(t)); return t; }
__device__ __forceinline__ float bf2f(bf16_t v) { return __uint_as_float(((unsigned)v) << 16); }
__device__ __forceinline__ bf16_t f2bf(float f) { unsigned u = __float_as_uint(f); u += 0x7FFFu + ((u >> 16) & 1u); return (bf16_t)(u >> 16); }
__device__ __forceinline__ float sigmoidf_(float v) { return __builtin_amdgcn_rcpf(1.f + __expf(-v)); }
__device__ __forceinline__ float siluf_(float v) { return v * __builtin_amdgcn_rcpf(1.f + __expf(-v)); }
template <int CTRL> __device__ __forceinline__ float dpp_(float v) { return __int_as_float(__builtin_amdgcn_update_dpp(0, __float_as_int(v), CTRL, 0xF, 0xF, true)); }
__device__ __forceinline__ float rlane(float v, int l) { return __int_as_float(__builtin_amdgcn_readlane(__float_as_int(v), l)); }
__device__ __forceinline__ float wsum(float v) {
    v += dpp_<0xB1>(v); v += dpp_<0x4E>(v); v += dpp_<0x141>(v); v += dpp_<0x140>(v);
    return (rlane(v, 15) + rlane(v, 31)) + (rlane(v, 47) + rlane(v, 63));
}
__device__ __forceinline__ float rfl(float v) { return __int_as_float(__builtin_amdgcn_readfirstlane(__float_as_int(v))); }
__device__ __forceinline__ float wmax(float v) { for (int o = 32; o > 0; o >>= 1) v = fmaxf(v, __shfl_xor(v, o)); return v; }
__device__ __forceinline__ float4 ld_bf4(const bf16_t* p) { uint2 r = *(const uint2*)p; return make_float4(__uint_as_float(r.x << 16), __uint_as_float(r.x & 0xFFFF0000u), __uint_as_float(r.y << 16), __uint_as_float(r.y & 0xFFFF0000u)); }
typedef __bf16 bf16x2n __attribute__((ext_vector_type(2)));
typedef float f32x2n __attribute__((ext_vector_type(2)));
__device__ __forceinline__ unsigned pk_bf16(float lo, float hi) { const f32x2n v = {lo, hi}; const bf16x2n r = __builtin_convertvector(v, bf16x2n); return __builtin_bit_cast(unsigned, r); }
__device__ __forceinline__ void st_bf4(bf16_t* p, float a, float b, float c, float d) { uint2 r; r.x = pk_bf16(a, b); r.y = pk_bf16(c, d); *(uint2*)p = r; }
__device__ __forceinline__ int rel_bucket(int n) {
    if (n < 16) return n < 0 ? 0 : n;
    int b = 16;
    b += (n >= 19) + (n >= 21) + (n >= 24) + (n >= 27) + (n >= 31) + (n >= 35) + (n >= 40) + (n >= 46) + (n >= 52) + (n >= 59) + (n >= 67) + (n >= 77) + (n >= 87) + (n >= 99) + (n >= 113);
    return b;
}

template <class AF, class BF, class EF>
__device__ __forceinline__ void gemm128(float* sm, int m0, int n0, int K, AF af, BF bf, EF ef) {
    float(*As)[132] = (float(*)[132])sm;
    float(*Bs)[132] = (float(*)[132])(sm + 16 * 132);
    const int tid = tid_(), tx = tid & 31, ty = tid >> 5;
    const int ar = tid >> 2, ak = (tid & 3) * 4, bk = tid >> 5, bn = (tid & 31) * 4;
    float acc[8][4];
#pragma unroll
    for (int i = 0; i < 8; ++i)
#pragma unroll
        for (int j = 0; j < 4; ++j) acc[i][j] = 0.f;
    for (int k0 = 0; k0 < K; k0 += 16) {
        const float4 a = af(m0 + ar, k0 + ak);
        const float4 b = bf(k0 + bk, n0 + bn);
        __syncthreads();
        As[ak + 0][ar] = a.x; As[ak + 1][ar] = a.y; As[ak + 2][ar] = a.z; As[ak + 3][ar] = a.w;
        *(float4*)&Bs[bk][bn] = b;
        __syncthreads();
#pragma unroll
        for (int k = 0; k < 16; ++k) {
            const float4 a0 = *(const float4*)&As[k][ty * 8], a1 = *(const float4*)&As[k][ty * 8 + 4], bb = *(const float4*)&Bs[k][tx * 4];
            const float av[8] = {a0.x, a0.y, a0.z, a0.w, a1.x, a1.y, a1.z, a1.w};
            const float bv[4] = {bb.x, bb.y, bb.z, bb.w};
#pragma unroll
            for (int i = 0; i < 8; ++i)
#pragma unroll
                for (int j = 0; j < 4; ++j) acc[i][j] = fmaf(av[i], bv[j], acc[i][j]);
        }
    }
#pragma unroll
    for (int i = 0; i < 8; ++i) ef(m0 + ty * 8 + i, n0 + tx * 4, make_float4(acc[i][0], acc[i][1], acc[i][2], acc[i][3]));
    __syncthreads();
}


#define XB_TMO      128
#define XB_XCNT(j)  (256  + 64 * (j))
#define XB_XSUB(j)  (1280 + 64 * (j))
#define XB_XGEN(j)  (2304 + 64 * (j))
#define XB_TOP      3328
#define XB_TOPGEN   3392
#define XCD_BAR_WORDS 3456
#define XB_SPIN_CAP (1u << 22)
#define LAS __attribute__((address_space(3)))
__device__ __forceinline__ unsigned xb_ld(unsigned* p)              { return __hip_atomic_load(p, __ATOMIC_RELAXED, __HIP_MEMORY_SCOPE_AGENT); }
__device__ __forceinline__ unsigned xb_add(unsigned* p, unsigned v) { return __hip_atomic_fetch_add(p, v, __ATOMIC_RELAXED, __HIP_MEMORY_SCOPE_AGENT); }
__device__ __forceinline__ unsigned xb_xcc_id() { return (unsigned)__builtin_amdgcn_s_getreg((3 << 11) | 20) & 0xFu; }
#define XB_SPIN(cond, bar) do { unsigned _sp = 0; while (cond) { __builtin_amdgcn_s_sleep(1); \
    if ((++_sp & 255u) == 0u) { if (xb_ld(&(bar)[XB_TMO])) break; if (_sp > XB_SPIN_CAP) { atomicAdd(&(bar)[XB_TMO], 1u); break; } } } } while (0)
struct XcdBarrier { unsigned* bar; unsigned x; volatile LAS unsigned* st; };
__device__ __forceinline__ XcdBarrier xcd_barrier_post(unsigned* bar, volatile LAS unsigned* st) {
    XcdBarrier b; b.bar = bar; b.x = xb_xcc_id(); b.st = st;
    if (threadIdx.x == 0) (void)xb_add(&bar[XB_XCNT(b.x)], 1u);
    return b;
}
__device__ __forceinline__ void xcd_barrier_complete(unsigned* bar, unsigned x, unsigned& nloc, unsigned& nx) {
    const unsigned G = gridDim.x * gridDim.y * gridDim.z;
    unsigned sum, cnt, mine, sp = 0u;
    for (;;) {
        sum = 0u; cnt = 0u; mine = 0u;
#pragma unroll
        for (unsigned j = 0; j < 16; ++j) { const unsigned c = xb_ld(&bar[XB_XCNT(j)]); sum += c; cnt += (c > 0u) ? 1u : 0u; mine = (j == x) ? c : mine; }
        if (sum == G) break;
        __builtin_amdgcn_s_sleep(1);
        if ((++sp & 255u) == 0u) { if (xb_ld(&bar[XB_TMO])) break; if (sp > XB_SPIN_CAP) { atomicAdd(&bar[XB_TMO], 1u); break; } }
    }
    nloc = mine > 0u ? mine : 1u; nx = cnt > 0u ? cnt : 1u;
}
__device__ __forceinline__ void xcd_barrier(const XcdBarrier& b) {
    asm volatile("s_waitcnt vmcnt(0)" ::: "memory");
    __syncthreads();
    if (threadIdx.x == 0) {
        unsigned* bar = b.bar;
        __builtin_amdgcn_s_waitcnt(0);
        unsigned nloc = b.st[0], nx = b.st[1];
        if (nloc == 0u) { xcd_barrier_complete(bar, b.x, nloc, nx); b.st[0] = nloc; b.st[1] = nx; }
        const unsigned old = xb_add(&bar[XB_XSUB(b.x)], 1u);
        const unsigned gen = old / nloc;
        if (old + 1u == (gen + 1u) * nloc) {
            __builtin_amdgcn_fence(__ATOMIC_RELEASE, "agent");
            asm volatile("s_waitcnt vmcnt(0)" ::: "memory");
            const unsigned og = xb_add(&bar[XB_TOP], 1u);
            const unsigned tg = og / nx;
            if (og + 1u == (tg + 1u) * nx) xb_add(&bar[XB_TOPGEN], 1u);
            else XB_SPIN(xb_ld(&bar[XB_TOPGEN]) == tg, bar);
            __builtin_amdgcn_fence(__ATOMIC_ACQUIRE, "agent");
            xb_add(&bar[XB_XGEN(b.x)], 1u);
            asm volatile("s_waitcnt vmcnt(0)" ::: "memory");
        } else {
            XB_SPIN(xb_ld(&bar[XB_XGEN(b.x)]) == gen, bar);
            __builtin_amdgcn_fence(__ATOMIC_ACQUIRE, "agent");
            asm volatile("s_waitcnt vmcnt(0)" ::: "memory");
        }
    }
    __syncthreads();
}


namespace pg8 {
#define PG8_LAS __attribute__((address_space(3)))
typedef short bf16x8 __attribute__((ext_vector_type(8)));
typedef float f32x4 __attribute__((ext_vector_type(4)));
typedef unsigned u32x4 __attribute__((ext_vector_type(4)));
typedef unsigned u32x2 __attribute__((ext_vector_type(2)));
constexpr int BM = 256, BK = 64, HALF = 128, HTB = HALF * BK * 2, STAGE_BYTES = 8 * HTB, NXCD = 8, WGM = 8;
__host__ __device__ __forceinline__ int lds_byte(int r, int c) { const int st = (r >> 4) * 2 + (c >> 5), rr = r & 15, cc = c & 31, ob = rr * 64 + cc * 2; return st * 1024 + (ob ^ (((ob >> 9) & 1) << 5)); }
__host__ __device__ __forceinline__ void stage_rc(int b, int& R, int& C) { const int st = b / 1024, sb = b % 1024, swz = sb ^ (((sb >> 9) & 1) << 5); R = (st >> 1) * 16 + swz / 64; C = (st & 1) * 32 + (swz % 64) / 2; }
__host__ __device__ __forceinline__ int perm32(int rho) { const int n = rho >> 4, i = rho & 15; return 8 * (i >> 2) + 4 * n + (i & 3); }
struct Unit { int pm, pn; long boff; long aoff; };
struct Gemm { const bf16_t* A; const bf16_t* Bt; int K, lda, ldb; int kmode = 0; int bdup = 0; };
struct StaticOrder {
    static constexpr bool GATHER = false;
    int nM, nN, nwg, G, c;
    __device__ void init(int M, int N, int G_, int c_) { nM = M / BM; nN = N / BM; nwg = nM * nN; G = G_; c = c_; }
    __device__ bool next(int i, Unit& u) const {
        const long L = (long)i * G + c; if (L >= nwg) return false;
        int wgid = (int)L; { const int q = nwg / NXCD, r = nwg % NXCD, xcd = wgid % NXCD, off = wgid / NXCD; wgid = (xcd < r ? xcd * (q + 1) : r * (q + 1) + (xcd - r) * q) + off; }
        const int nig = WGM * nN, gid = wgid / nig, fm = gid * WGM, gsz = (nM - fm) < WGM ? (nM - fm) : WGM;
        u.pm = fm + ((wgid % nig) % gsz); u.pn = (wgid % nig) / gsz; u.boff = 0; u.aoff = 0; return true;
    }
    __device__ __forceinline__ void a_ready(const Unit&) const {}
    __device__ __forceinline__ void done(const Unit&) const {}
};
struct MoeOrder {
    static constexpr bool GATHER = false;
    const int* tile_e; int nwg, G, c; long estride;
    __device__ bool next(int i, Unit& u) const {
        const long L = (long)i * G + c; if (L >= nwg) return false;
        u.pm = (int)(L >> 2); u.pn = (int)(L & 3); u.boff = (long)tile_e[u.pm] * estride; u.aoff = 0; return true;
    }
    __device__ __forceinline__ void a_ready(const Unit&) const {}
    __device__ __forceinline__ void done(const Unit&) const {}
};
struct MoeGatherOrder {
    static constexpr bool GATHER = true;
    const int* tile_e; const int* inv; int nwg, G, c; long estride;
    __device__ bool next(int i, Unit& u) const {
        const long L = (long)i * G + c; if (L >= nwg) return false;
        u.pm = (int)(L >> 2); u.pn = (int)(L & 3); u.boff = (long)tile_e[u.pm] * estride; u.aoff = 0; return true;
    }
    __device__ __forceinline__ void a_ready(const Unit&) const {}
    __device__ __forceinline__ void done(const Unit&) const {}
};
struct CmpOrder {
    static constexpr bool GATHER = false;
    int G, c;
    __device__ bool next(int i, Unit& u) const {
        const int L = i * G + c; if (L >= 128) return false;
        const int kv = L >> 6, bg = (L >> 3) & 7, half = (L >> 2) & 1, kq = L & 3;
        u.pm = half; u.pn = (kv << 3) | bg;
        u.aoff = ((long)((bg >> 1) * T_ + 8 * kq) * LDP + (kv ? C_VC : C_KC) + (bg & 1) * 128) * 2;
        u.boff = ((long)kv * 128 * 4096 + kq * 1024) * 2;
        return true;
    }
    __device__ __forceinline__ void a_ready(const Unit&) const {}
    __device__ __forceinline__ void done(const Unit&) const {}
};
__device__ __forceinline__ unsigned cvt_pk_bf16(float lo, float hi) { return pk_bf16(lo, hi); }
__device__ __forceinline__ f32x4 unpk_lo(u32x4 w) { return (f32x4){__uint_as_float(w.x << 16), __uint_as_float(w.x & 0xFFFF0000u), __uint_as_float(w.y << 16), __uint_as_float(w.y & 0xFFFF0000u)}; }
__device__ __forceinline__ f32x4 unpk_hi(u32x4 w) { return (f32x4){__uint_as_float(w.z << 16), __uint_as_float(w.z & 0xFFFF0000u), __uint_as_float(w.w << 16), __uint_as_float(w.w & 0xFFFF0000u)}; }
__device__ __forceinline__ u32x4 pk8(f32x4 v0, f32x4 v1) { u32x4 w; w.x = cvt_pk_bf16(v0[0], v0[1]); w.y = cvt_pk_bf16(v0[2], v0[3]); w.z = cvt_pk_bf16(v1[0], v1[1]); w.w = cvt_pk_bf16(v1[2], v1[3]); return w; }
__device__ __forceinline__ f32x4 sig4(f32x4 v) { return (f32x4){sigmoidf_(v[0]), sigmoidf_(v[1]), sigmoidf_(v[2]), sigmoidf_(v[3])}; }
struct EpiProj {
    static constexpr bool PERM = true, AFTER_DRAIN = false, HAS_MID = false;
    bf16_t* proj; bf16_t* mg; float* gate; const float* bias;
    __device__ __forceinline__ void operator()(const f32x4 (&acc)[2][2][4][2], const Unit& u, int wr, int wc, int fr, int fq) const {
        const int row0 = u.pm * BM + wr * 64 + fr, c8 = u.pn * BM + wc * 32 + 8 * fq;
        f32x4 bv[2][2];
#pragma unroll
        for (int bj = 0; bj < 2; ++bj)
#pragma unroll
            for (int n = 0; n < 2; ++n) bv[bj][n] = *(const f32x4*)(bias + c8 + bj * HALF + 4 * n);
#pragma unroll
        for (int ai = 0; ai < 2; ++ai)
#pragma unroll
            for (int m = 0; m < 4; ++m) {
                const size_t row = (size_t)(row0 + ai * HALF + m * 16);
#pragma unroll
                for (int bj = 0; bj < 2; ++bj) {
                    const f32x4 v0 = acc[ai][bj][m][0] + bv[bj][0], v1 = acc[ai][bj][m][1] + bv[bj][1];
                    const int col = c8 + bj * HALF;
                    if (u.pn < 26) *(u32x4*)(proj + row * LDP + col) = pk8(v0, v1);
                    else if (u.pn < 34) *(u32x4*)(mg + row * 2048 + (col - 6656)) = pk8(sig4(v0), sig4(v1));
                    else if (col - 8704 < 24) { float* gp = gate + row * 24 + (col - 8704); *(f32x4*)gp = sig4(v0); *(f32x4*)(gp + 4) = sig4(v1); }
                }
            }
    }
};
struct EpiMrg {
    static constexpr bool PERM = true, AFTER_DRAIN = false, HAS_MID = true;
    const bf16_t* mg; bf16_t* mr;
    __device__ __forceinline__ void mid(f32x4 (&acc)[2][2][4][2], const Unit& u, int wr, int wc, int fr, int fq) const {
        const int row0 = u.pm * BM + wr * 64 + fr, c8 = u.pn * BM + wc * 32 + 8 * fq;
#pragma unroll
        for (int ai = 0; ai < 2; ++ai)
#pragma unroll
            for (int m = 0; m < 4; ++m) {
                const size_t row = (size_t)(row0 + ai * HALF + m * 16);
#pragma unroll
                for (int bj = 0; bj < 2; ++bj) {
                    const int col = c8 + bj * HALF;
                    const u32x4 hw = *(const u32x4*)(mg + row * 2048 + col), nw = *(const u32x4*)(mg + row * 2048 + 1024 + col);
                    const f32x4 h0 = unpk_lo(hw), h1 = unpk_hi(hw), n0 = unpk_lo(nw), n1 = unpk_hi(nw);
#pragma unroll
                    for (int j = 0; j < 4; ++j) { acc[ai][bj][m][0][j] *= h0[j] * __builtin_amdgcn_rcpf(fmaxf(n0[j], 8.673617e-19f)); acc[ai][bj][m][1][j] *= h1[j] * __builtin_amdgcn_rcpf(fmaxf(n1[j], 8.673617e-19f)); }
                    asm volatile("" ::: "memory");
                }
            }
    }
    __device__ __forceinline__ void operator()(const f32x4 (&acc)[2][2][4][2], const Unit& u, int wr, int wc, int fr, int fq) const {
        const int row0 = u.pm * BM + wr * 64 + fr, c8 = u.pn * BM + wc * 32 + 8 * fq;
#pragma unroll
        for (int ai = 0; ai < 2; ++ai)
#pragma unroll
            for (int m = 0; m < 4; ++m) {
                const size_t row = (size_t)(row0 + ai * HALF + m * 16);
#pragma unroll
                for (int bj = 0; bj < 2; ++bj) {
                    const int col = c8 + bj * HALF;
                    const u32x4 nw = *(const u32x4*)(mg + row * 2048 + 1024 + col);
                    f32x4 n0 = unpk_lo(nw), n1 = unpk_hi(nw);
#pragma unroll
                    for (int j = 0; j < 4; ++j) { n0[j] = fmaxf(n0[j], 8.673617e-19f); n1[j] = fmaxf(n1[j], 8.673617e-19f); }
                    *(u32x4*)(mr + row * 1024 + col) = pk8(n0 * acc[ai][bj][m][0], n1 * acc[ai][bj][m][1]);
                }
                asm volatile("" ::: "memory");
            }
    }
};
struct EpiWout {
    static constexpr bool PERM = true, AFTER_DRAIN = false, HAS_MID = false;
    const float* x; const float* mod; bf16_t* z;
    __device__ __forceinline__ void operator()(const f32x4 (&acc)[2][2][4][2], const Unit& u, int wr, int wc, int fr, int fq) const {
        const int row0 = u.pm * BM + wr * 64 + fr, c8 = u.pn * BM + wc * 32 + 8 * fq;
        const float* g1 = mod + ((u.pm * BM) / T_) * 6144 + 2048 + c8;
#pragma unroll
        for (int ai = 0; ai < 2; ++ai)
#pragma unroll
            for (int m = 0; m < 4; ++m) {
                const size_t ro = (size_t)(row0 + ai * HALF + m * 16) * 1024 + c8;
#pragma unroll
                for (int bj = 0; bj < 2; ++bj) {
                    const f32x4 x0 = *(const f32x4*)(x + ro + bj * HALF), x1 = *(const f32x4*)(x + ro + bj * HALF + 4);
                    const f32x4 g0 = *(const f32x4*)(g1 + bj * HALF) + 1.0f, g4 = *(const f32x4*)(g1 + bj * HALF + 4) + 1.0f;
                    *(u32x4*)(z + ro + bj * HALF) = pk8(x0 * ALPHA + g0 * acc[ai][bj][m][0], x1 * ALPHA + g4 * acc[ai][bj][m][1]);
                }
                if (m & 1) asm volatile("" ::: "memory");
            }
    }
};
struct EpiExp1 {
    static constexpr bool PERM = true, AFTER_DRAIN = false, HAS_MID = false;
    bf16_t* U;
    __device__ __forceinline__ void operator()(const f32x4 (&acc)[2][2][4][2], const Unit& u, int wr, int wc, int fr, int fq) const {
        const int row0 = u.pm * BM + wr * 64 + fr, c8 = u.pn * HALF + wc * 32 + 8 * fq;
#pragma unroll
        for (int ai = 0; ai < 2; ++ai)
#pragma unroll
            for (int m = 0; m < 4; ++m) {
                f32x4 r[2];
#pragma unroll
                for (int n = 0; n < 2; ++n)
#pragma unroll
                    for (int j = 0; j < 4; ++j) r[n][j] = siluf_(acc[ai][0][m][n][j]) * acc[ai][1][m][n][j];
                *(u32x4*)(U + (size_t)(row0 + ai * HALF + m * 16) * 512 + c8) = pk8(r[0], r[1]);
            }
    }
};
struct EpiCmpAcc {
    static constexpr bool PERM = false, AFTER_DRAIN = false, HAS_MID = false;
    float* hp;
    __device__ __forceinline__ void operator()(const f32x4 (&acc)[2][2][4][2], const Unit& u, int wr, int wc, int fr, int fq) const {
        const int row0 = u.pn * 512 + u.pm * BM + wr * 64 + fr, col0 = wc * 32 + 4 * fq;
#pragma unroll
        for (int ai = 0; ai < 2; ++ai)
#pragma unroll
            for (int m = 0; m < 4; ++m) { float* rp = hp + (size_t)(row0 + ai * HALF + m * 16) * 128 + col0;
#pragma unroll
                for (int n = 0; n < 2; ++n)
#pragma unroll
                    for (int j = 0; j < 4; ++j) atomicAdd(rp + n * 16 + j, acc[ai][0][m][n][j]); }
    }
};
struct EpiBf {
    static constexpr bool PERM = true, AFTER_DRAIN = false, HAS_MID = false;
    bf16_t* O; int ldo;
    __device__ __forceinline__ void operator()(const f32x4 (&acc)[2][2][4][2], const Unit& u, int wr, int wc, int fr, int fq) const {
        const int row0 = u.pm * BM + wr * 64 + fr, c8 = u.pn * BM + wc * 32 + 8 * fq;
#pragma unroll
        for (int ai = 0; ai < 2; ++ai)
#pragma unroll
            for (int m = 0; m < 4; ++m)
#pragma unroll
                for (int bj = 0; bj < 2; ++bj) *(u32x4*)(O + (size_t)(row0 + ai * HALF + m * 16) * ldo + c8 + bj * HALF) = pk8(acc[ai][bj][m][0], acc[ai][bj][m][1]);
    }
};
template <class Epi, class Sched>
__device__ __forceinline__ void gemm_phase(PG8_LAS unsigned char* lds, const Gemm g, const Sched& S, const Epi& E) {
    const int tid = tid_(), wid = __builtin_amdgcn_readfirstlane(tid >> 6), lane = tid & 63, wr = wid >> 2, wc = wid & 3, fr = lane & 15, fq = lane >> 4;
    const int K = g.K, nt = K / BK;
    unsigned voffA[2], voffB[2];
#pragma unroll
    for (int i = 0; i < 2; ++i) { int R, C; stage_rc(tid * 16 + i * 8192, R, C); const int Rb = Epi::PERM ? ((R & ~31) + perm32(R & 31)) : R;
        voffA[i] = (unsigned)(R * g.lda + C) * 2u; voffB[i] = (unsigned)(Rb * g.ldb + C) * 2u; }
    const size_t kstep = (size_t)(BK * 2);
#define PG8_KA(t) (g.kmode == 1 ? (size_t)((t) >> 1) * (LDP * 2) + (size_t)((t) & 1) * 128 : g.kmode == 2 ? (size_t)(t) * kstep + ((t) >= 16 ? (size_t)2048 : (size_t)0) : (size_t)(t) * kstep)
    const size_t hstepA = Sched::GATHER ? (size_t)0 : (size_t)HALF * g.lda * 2, hstepB = g.bdup ? (size_t)0 : (size_t)HALF * g.ldb * 2;
    const size_t tstepA = 2 * hstepA, tstepB = 2 * hstepB;
    const unsigned ldsw = (unsigned)wid * 1024u;
    const int aoff = lds_byte(wr * 64 + fr, fq * 8), boff = lds_byte(wc * 32 + fr, fq * 8);
#define PG8_SA(b, h) (((b) * 2 + (h)) * HTB)
#define PG8_SB(b, h) ((4 + (b) * 2 + (h)) * HTB)
#define PG8_STAGE(bufoff, gbase, voff) do { _Pragma("unroll") for (int _i = 0; _i < 2; ++_i) \
        __builtin_amdgcn_global_load_lds((const unsigned*)((const char*)(gbase) + (voff)[_i]), (PG8_LAS unsigned*)(lds + (bufoff) + ldsw + _i * 8192), 16, 0, 0); } while (0)
    unsigned gA[2][2] = {{0u, 0u}, {0u, 0u}}, gN[2][2] = {{0u, 0u}, {0u, 0u}};
#define PG8_GMAP(dst, un) do { if constexpr (Sched::GATHER) { _Pragma("unroll") for (int _h = 0; _h < 2; ++_h) _Pragma("unroll") for (int _i = 0; _i < 2; ++_i) { int R_, C_; stage_rc(tid * 16 + _i * 8192, R_, C_); \
        dst[_h][_i] = (unsigned)S.inv[(un).pm * BM + _h * HALF + R_] * (unsigned)(g.lda * 2) + (unsigned)(C_ * 2); } } } while (0)
#define PG8_STAGE_A(bufoff, gbase, h, NX) do { if constexpr (Sched::GATHER) { if (NX) PG8_STAGE(bufoff, gbase, gN[h]); else PG8_STAGE(bufoff, gbase, gA[h]); } \
        else PG8_STAGE(bufoff, (gbase) + ((h) ? hstepA : (size_t)0), voffA); } while (0)
#define PG8_LDA(dst, b, h) do { _Pragma("unroll") for (int m = 0; m < 4; ++m) _Pragma("unroll") for (int k = 0; k < 2; ++k) dst[m][k] = *(const PG8_LAS bf16x8*)(lds + PG8_SA(b, h) + aoff + m * 2048 + k * 1024); } while (0)
#define PG8_LDB(dst, b, h) do { _Pragma("unroll") for (int n = 0; n < 2; ++n) _Pragma("unroll") for (int k = 0; k < 2; ++k) dst[n][k] = *(const PG8_LAS bf16x8*)(lds + PG8_SB(b, h) + boff + n * 2048 + k * 1024); } while (0)
#define PG8_MMA(ai, bj, At, Bt) do { __builtin_amdgcn_s_setprio(1); _Pragma("unroll") for (int m = 0; m < 4; ++m) _Pragma("unroll") for (int n = 0; n < 2; ++n) _Pragma("unroll") for (int k = 0; k < 2; ++k) \
        acc[ai][bj][m][n] = __builtin_amdgcn_mfma_f32_16x16x32_bf16(Bt[n][k], At[m][k], acc[ai][bj][m][n], 0, 0, 0); __builtin_amdgcn_s_setprio(0); } while (0)
#define PG8_WAIT_V(n) asm volatile("s_waitcnt vmcnt(" #n ")" ::: "memory")
#define PG8_WAIT_L(n) asm volatile("s_waitcnt lgkmcnt(" #n ")" ::: "memory")
#define PG8_BAR __builtin_amdgcn_s_barrier()
#define PG8_SCHED __builtin_amdgcn_sched_barrier(0)
    Unit cur, nxt; int ui = 0;
    if (!S.next(0, cur)) return;
    f32x4 acc[2][2][4][2];
#pragma unroll
    for (int a = 0; a < 2; ++a)
#pragma unroll
        for (int b = 0; b < 2; ++b)
#pragma unroll
            for (int m = 0; m < 4; ++m)
#pragma unroll
                for (int n = 0; n < 2; ++n) acc[a][b][m][n] = (f32x4){0.f, 0.f, 0.f, 0.f};
    bf16x8 At[4][2], B0[2][2], B1[2][2];
    const char* cA = (const char*)g.A + cur.aoff + (size_t)cur.pm * tstepA; const char* cB = (const char*)g.Bt + cur.boff + (size_t)cur.pn * tstepB;
    S.a_ready(cur);
    PG8_GMAP(gA, cur);
    PG8_STAGE(PG8_SB(0, 0), cB, voffB); PG8_STAGE_A(PG8_SA(0, 0), cA, 0, false); PG8_STAGE(PG8_SB(0, 1), cB + hstepB, voffB); PG8_STAGE_A(PG8_SA(0, 1), cA, 1, false);
    if (wr == 1) PG8_BAR;
    PG8_WAIT_V(4); PG8_BAR;
    PG8_STAGE(PG8_SB(1, 0), cB + kstep, voffB); PG8_STAGE_A(PG8_SA(1, 0), cA + PG8_KA(1), 0, false); PG8_STAGE(PG8_SB(1, 1), cB + hstepB + kstep, voffB);
    PG8_WAIT_V(6); PG8_BAR;
    for (;;) {
        const bool has_next = S.next(ui + 1, nxt);
        if constexpr (Sched::GATHER) { if (has_next) PG8_GMAP(gN, nxt); else { gN[0][0] = gA[0][0]; gN[0][1] = gA[0][1]; gN[1][0] = gA[1][0]; gN[1][1] = gA[1][1]; } }
        const char* nA = has_next ? (const char*)g.A + nxt.aoff + (size_t)nxt.pm * tstepA : cA; const char* nB = has_next ? (const char*)g.Bt + nxt.boff + (size_t)nxt.pn * tstepB : cB;
        for (int t = 0; t < nt; t += 2) {
            const bool last = (t == nt - 2);
            const char* a1 = cA + PG8_KA(t + 1);
            const char* a2 = last ? nA : cA + PG8_KA(t + 2); const char* b2 = last ? nB : cB + (size_t)(t + 2) * kstep;
            const char* a3 = last ? nA + PG8_KA(1) : cA + PG8_KA(t + 3); const char* b3 = b2 + kstep;
            if (last && has_next) S.a_ready(nxt);
            if constexpr (Epi::HAS_MID) { if (t == 16) E.mid(acc, cur, wr, wc, fr, fq); }
            PG8_LDB(B0, 0, 0); PG8_SCHED; PG8_LDA(At, 0, 0); PG8_STAGE_A(PG8_SA(1, 1), a1, 1, false);
            PG8_WAIT_L(8); PG8_BAR; PG8_WAIT_L(0); PG8_MMA(0, 0, At, B0); PG8_BAR; PG8_SCHED;
            PG8_LDB(B1, 0, 1); PG8_STAGE(PG8_SB(0, 0), b2, voffB);
            PG8_BAR; PG8_WAIT_L(0); PG8_MMA(0, 1, At, B1); PG8_BAR;
            PG8_LDA(At, 0, 1); PG8_STAGE_A(PG8_SA(0, 0), a2, 0, last);
            PG8_BAR; PG8_WAIT_L(0); PG8_MMA(1, 0, At, B0); PG8_BAR; PG8_SCHED;
            PG8_STAGE(PG8_SB(0, 1), b2 + hstepB, voffB);
            PG8_WAIT_V(6); PG8_BAR; PG8_MMA(1, 1, At, B1); PG8_BAR;
            PG8_LDB(B0, 1, 0); PG8_SCHED; PG8_LDA(At, 1, 0); PG8_STAGE_A(PG8_SA(0, 1), a2, 1, last);
            PG8_WAIT_L(8); PG8_BAR; PG8_WAIT_L(0); PG8_MMA(0, 0, At, B0); PG8_BAR; PG8_SCHED;
            PG8_LDB(B1, 1, 1); PG8_STAGE(PG8_SB(1, 0), b3, voffB);
            PG8_BAR; PG8_WAIT_L(0); PG8_MMA(0, 1, At, B1); PG8_BAR;
            PG8_LDA(At, 1, 1); PG8_STAGE_A(PG8_SA(1, 0), a3, 0, last);
            PG8_BAR; PG8_WAIT_L(0); PG8_MMA(1, 0, At, B0); PG8_BAR; PG8_SCHED;
            PG8_STAGE(PG8_SB(1, 1), b3 + hstepB, voffB);
            PG8_WAIT_V(6); PG8_BAR; PG8_MMA(1, 1, At, B1); PG8_BAR;
        }
        if constexpr (!Epi::AFTER_DRAIN) { E(acc, cur, wr, wc, fr, fq); S.done(cur); }
        if (!has_next) break;
#pragma unroll
        for (int a = 0; a < 2; ++a)
#pragma unroll
            for (int b = 0; b < 2; ++b)
#pragma unroll
                for (int m = 0; m < 4; ++m)
#pragma unroll
                    for (int n = 0; n < 2; ++n) acc[a][b][m][n] = (f32x4){0.f, 0.f, 0.f, 0.f};
        cur = nxt; cA = nA; cB = nB; ++ui;
        if constexpr (Sched::GATHER) { gA[0][0] = gN[0][0]; gA[0][1] = gN[0][1]; gA[1][0] = gN[1][0]; gA[1][1] = gN[1][1]; }
    }
    PG8_WAIT_V(0);
    if (wr == 0) PG8_BAR;
    PG8_BAR;
    if constexpr (Epi::AFTER_DRAIN) { E.fused(acc, cur, wr, wc, fr, fq, lds, wid, lane); S.done(cur); }
#undef PG8_SA
#undef PG8_SB
#undef PG8_STAGE
#undef PG8_STAGE_A
#undef PG8_GMAP
#undef PG8_LDA
#undef PG8_LDB
#undef PG8_MMA
#undef PG8_WAIT_V
#undef PG8_WAIT_L
#undef PG8_BAR
#undef PG8_SCHED
#undef PG8_KA
}
}

namespace nsa {
typedef short bf16x8 __attribute__((ext_vector_type(8)));
typedef short s16x4 __attribute__((ext_vector_type(4)));
typedef float f32x16 __attribute__((ext_vector_type(16)));
typedef float f32x4 __attribute__((ext_vector_type(4)));
typedef unsigned u32x4 __attribute__((ext_vector_type(4)));
constexpr int SHM_V = 16384, SHM_K = 16384;
constexpr int L_V = 0, L_K = 32768, L_WS = 65536, L_LUT = 67584, L_IMP = 69632, L_SEL = 102400, L_UNI = 103424, L_TL = 103488, L_END = 104064;
constexpr float LOG2E = 1.4426950408889634f, C2 = 0.08838834764831845f * LOG2E, THR2 = 11.5f;
#define KSWZ(row, colB) ((row) * 256 + ((colB) ^ (((row) & 7) << 4)))
#define SBAR() __builtin_amdgcn_sched_barrier(0)
__device__ __forceinline__ int v_st(int k, int c) { const int kk = (k & ~0xC) | ((k & 4) << 1) | ((k & 8) >> 1); return ((kk >> 3) * 4 + (c >> 5)) * 512 + ((kk & 7) * 32 + (c & 31)) * 2; }
__device__ __forceinline__ int v_rd_base(int lane) { return ((lane & 3) << 3) | (((lane >> 2) & 3) << 6) | (((lane >> 4) & 1) << 5) | (((lane >> 5) & 1) << 8); }
constexpr int v_rd_off(int d0, int ks, int half) { return d0 * 512 + ks * 4096 + half * 2048; }
__device__ __forceinline__ int crow(int r, int hi) { return (r & 3) + 8 * (r >> 2) + 4 * hi; }
__device__ __forceinline__ unsigned cvtpk(float lo, float hi) { unsigned r; asm volatile("v_cvt_pk_bf16_f32 %0, %1, %2" : "=v"(r) : "v"(lo), "v"(hi)); return r; }

template <int KB>
__device__ __forceinline__ void qkt(f32x16& p0, f32x16& p1, const char* K_lds, int r32, int hi, const bf16x8* qr) {
    p0 = f32x16{}; p1 = f32x16{};
    const char* kb[4];
#pragma unroll
    for (int dd = 0; dd < 4; ++dd) kb[dd] = K_lds + KB * SHM_K + KSWZ(r32, (dd * 16 + hi * 8) * 2);
#pragma unroll
    for (int d0 = 0; d0 < 8; ++d0) { const char* a = kb[d0 & 3] + (d0 >> 2) * 128;
        bf16x8 b0 = *reinterpret_cast<const bf16x8*>(a);
        bf16x8 b1 = *reinterpret_cast<const bf16x8*>(a + 32 * 256);
        p0 = __builtin_amdgcn_mfma_f32_32x32x16_bf16(b0, qr[d0], p0, 0, 0, 0);
        p1 = __builtin_amdgcn_mfma_f32_32x32x16_bf16(b1, qr[d0], p1, 0, 0, 0); }
}
template <int VB>
__device__ __forceinline__ void pv_tile(f32x16* o, int vb0, bf16x8 pa0, bf16x8 pa1, bf16x8 pa2, bf16x8 pa3) {
#define TRRD(dst, off) asm volatile("ds_read_b64_tr_b16 %0, %1 offset:%2" : "=&v"(dst) : "v"(vb0), "i"(off) : "memory")
#define PV_D0(d0) do { s16x4 l0, l1, l2, l3, h0, h1, h2, h3; constexpr int b_ = VB * SHM_V + v_rd_off(d0, 0, 0); \
        TRRD(l0, b_); TRRD(h0, b_ + 2048); TRRD(l1, b_ + 4096); TRRD(h1, b_ + 6144); TRRD(l2, b_ + 8192); TRRD(h2, b_ + 10240); TRRD(l3, b_ + 12288); TRRD(h3, b_ + 14336); \
        asm volatile("s_waitcnt lgkmcnt(0)" ::: "memory"); SBAR(); \
        o[d0] = __builtin_amdgcn_mfma_f32_32x32x16_bf16(pa0, (bf16x8){l0[0], l0[1], l0[2], l0[3], h0[0], h0[1], h0[2], h0[3]}, o[d0], 0, 0, 0); \
        o[d0] = __builtin_amdgcn_mfma_f32_32x32x16_bf16(pa1, (bf16x8){l1[0], l1[1], l1[2], l1[3], h1[0], h1[1], h1[2], h1[3]}, o[d0], 0, 0, 0); \
        o[d0] = __builtin_amdgcn_mfma_f32_32x32x16_bf16(pa2, (bf16x8){l2[0], l2[1], l2[2], l2[3], h2[0], h2[1], h2[2], h2[3]}, o[d0], 0, 0, 0); \
        o[d0] = __builtin_amdgcn_mfma_f32_32x32x16_bf16(pa3, (bf16x8){l3[0], l3[1], l3[2], l3[3], h3[0], h3[1], h3[2], h3[3]}, o[d0], 0, 0, 0); } while (0)
    PV_D0(0); PV_D0(1); PV_D0(2); PV_D0(3);
#undef PV_D0
#undef TRRD
}
__device__ __forceinline__ void mask_tile(f32x16& p0, f32x16& p1, int dq, unsigned W) {
    const float NEG = -__builtin_inff();
    asm volatile("" : "+v"(dq));
#pragma unroll
    for (int r = 0; r < 16; ++r) {
        const int c = (r & 3) + 8 * (r >> 2);
        if ((unsigned)(dq - c) >= W) p0[r] = NEG;
        if ((unsigned)(dq - c - 32) >= W) p1[r] = NEG;
    }
}
template <int STRIDE>
__device__ __forceinline__ void bias_near(f32x16& p0, f32x16& p1, int dbase, const float* lut) {
    asm volatile("" : "+v"(dbase));
#pragma unroll
    for (int r = 0; r < 16; ++r) {
        const int c = (r & 3) + 8 * (r >> 2);
        int d0 = dbase - STRIDE * c, d1 = dbase - STRIDE * (c + 32);
        d0 = d0 < 0 ? 0 : (d0 > 127 ? 127 : d0); d1 = d1 < 0 ? 0 : (d1 > 127 ? 127 : d1);
        p0[r] = fmaf(p0[r], C2, lut[d0]); p1[r] = fmaf(p1[r], C2, lut[d1]);
    }
}
__device__ __forceinline__ void bias_const(f32x16& p0, f32x16& p1, float cb) {
#pragma unroll
    for (int r = 0; r < 16; ++r) { p0[r] = fmaf(p0[r], C2, cb); p1[r] = fmaf(p1[r], C2, cb); }
}
__device__ __forceinline__ float half_max(float v) { auto rr = __builtin_amdgcn_permlane32_swap(__float_as_uint(v), __float_as_uint(v), false, false); return fmaxf(__uint_as_float(rr[0]), __uint_as_float(rr[1])); }
__device__ __forceinline__ float half_sum(float v) { auto rr = __builtin_amdgcn_permlane32_swap(__float_as_uint(v), __float_as_uint(v), false, false); return __uint_as_float(rr[0]) + __uint_as_float(rr[1]); }
__device__ __forceinline__ void softmax_online(f32x16& p0, f32x16& p1, float sc, float cb2, bool sel, float& m, float& l, float& alpha) {
    float pmax = p0[0];
#pragma unroll
    for (int r = 1; r < 16; ++r) pmax = fmaxf(pmax, p0[r]);
#pragma unroll
    for (int r = 0; r < 16; ++r) pmax = fmaxf(pmax, p1[r]);
    pmax = half_max(pmax);
    pmax = sel ? fmaf(pmax, sc, cb2) : -__builtin_inff();
    if (__all(pmax - m <= THR2)) alpha = 1.f;
    else { const float mn = fmaxf(m, pmax); alpha = __builtin_amdgcn_exp2f(m - mn); m = mn; }
    const float off = sel ? cb2 - m : -__builtin_inff();
#pragma unroll
    for (int r = 0; r < 16; ++r) { p0[r] = fmaf(p0[r], sc, off); p1[r] = fmaf(p1[r], sc, off); }
    SBAR();
#pragma unroll
    for (int r = 0; r < 16; ++r) { p0[r] = __builtin_amdgcn_exp2f(p0[r]); p1[r] = __builtin_amdgcn_exp2f(p1[r]); }
    SBAR();
    float ps = 0.f;
#pragma unroll
    for (int r = 0; r < 16; ++r) ps += p0[r] + p1[r];
    l = l * alpha + half_sum(ps);
}
__device__ __forceinline__ void pack_p(const f32x16& p0, const f32x16& p1, bf16x8& pa0, bf16x8& pa1, bf16x8& pa2, bf16x8& pa3) {
#define PK4(P, B_, OUT) do { unsigned a0 = cvtpk(P[B_+0], P[B_+1]), a1 = cvtpk(P[B_+2], P[B_+3]); \
        unsigned b0 = cvtpk(P[B_+4], P[B_+5]), b1 = cvtpk(P[B_+6], P[B_+7]); \
        auto r0 = __builtin_amdgcn_permlane32_swap(a0, b0, false, false); auto r1 = __builtin_amdgcn_permlane32_swap(a1, b1, false, false); \
        u32x4 w = {r0[0], r1[0], r0[1], r1[1]}; OUT = *reinterpret_cast<bf16x8*>(&w); } while (0)
    PK4(p0, 0, pa0); PK4(p0, 8, pa1); PK4(p1, 0, pa2); PK4(p1, 8, pa3);
#undef PK4
}
__device__ __forceinline__ void rescale_o(f32x16* o, float alpha, float* al_l, int r32, int hi) {
    if (__any(alpha < 1.f)) {
        if (hi == 0) al_l[r32] = alpha;
        asm volatile("s_waitcnt lgkmcnt(0)" ::: "memory");
#pragma unroll
        for (int r = 0; r < 16; ++r) { const float a = al_l[crow(r, hi)];
#pragma unroll
            for (int d = 0; d < 4; ++d) o[d][r] *= a; }
    }
}
__device__ __forceinline__ void flush_out(const f32x16* o, float lsum, int br, unsigned char* ws, char* lds, int b, int g, int qb, int wid, int lane_in, bool first) {
    int lane = lane_in; asm volatile("" : "+v"(lane));
    const int r32 = lane & 31, hi = lane >> 5, head = g * 4 + (wid >> 1);
    const size_t tok = (size_t)b * T_ + qb * 64 + (wid & 1) * 32;
    float* li_l = (float*)(lds + L_WS) + wid * 64;
    bf16_t* tb = (bf16_t*)(lds + wid * 8192);
    bf16_t* orow = (bf16_t*)(ws + OFF_PROJ) + tok * LDP + C_NQ + head * 128;
    const float gate = ((const float*)(ws + OFF_GATE))[(tok + r32) * 24 + head * 3 + br];
    const float f_lane = br == 0 ? gate : (lsum > 0.f ? gate / lsum : 0.f);
    if (hi == 0) li_l[r32] = f_lane;
    asm volatile("s_waitcnt lgkmcnt(0)" ::: "memory");
#pragma unroll
    for (int r = 0; r < 16; ++r) {
        const float f = li_l[crow(r, hi)];
#pragma unroll
        for (int d = 0; d < 4; ++d) tb[crow(r, hi) * 128 + d * 32 + r32] = f2bf(o[d][r] * f);
    }
    asm volatile("s_waitcnt lgkmcnt(0)" ::: "memory");
    uint4 gq[8];
    if (!first) {
#pragma unroll
        for (int i = 0; i < 8; ++i) { const int idx = i * 64 + lane, row = idx >> 4, ch = idx & 15; gq[i] = *(const uint4*)(orow + (size_t)row * LDP + ch * 8); }
    }
#pragma unroll
    for (int i = 0; i < 8; ++i) {
        const int idx = i * 64 + lane, row = idx >> 4, ch = idx & 15;
        uint4 w = *(const uint4*)(tb + row * 128 + ch * 8);
        uint4* gp = (uint4*)(orow + (size_t)row * LDP + ch * 8);
        if (!first) {
            const uint4 g = gq[i];
            w.x = cvtpk(__uint_as_float(w.x << 16) + __uint_as_float(g.x << 16), __uint_as_float(w.x & 0xFFFF0000u) + __uint_as_float(g.x & 0xFFFF0000u));
            w.y = cvtpk(__uint_as_float(w.y << 16) + __uint_as_float(g.y << 16), __uint_as_float(w.y & 0xFFFF0000u) + __uint_as_float(g.y & 0xFFFF0000u));
            w.z = cvtpk(__uint_as_float(w.z << 16) + __uint_as_float(g.z << 16), __uint_as_float(w.z & 0xFFFF0000u) + __uint_as_float(g.z & 0xFFFF0000u));
            w.w = cvtpk(__uint_as_float(w.w << 16) + __uint_as_float(g.w << 16), __uint_as_float(w.w & 0xFFFF0000u) + __uint_as_float(g.w & 0xFFFF0000u));
        }
        *gp = w;
    }
}

struct Src { const bf16_t* K; const bf16_t* V; int stride; };

template <int MODE>
__device__ __forceinline__ void branch(const Src s, char* lds, const bf16x8* qr, f32x16* o, float& m, float& l, int NTL, int jbase, int t, int qb, int wid, int lane, int tid,
                                       const unsigned (&selw)[4], float inv_l) {
    const int r32 = lane & 31, hi = lane >> 5, rh = wid >> 1, iq = (wid & 1) * 32 + r32;
    char* V_lds = lds + L_V; char* K_lds = lds + L_K;
    float* al_l = (float*)(lds + L_WS) + wid * 64 + 32;
    const float* lut = (const float*)(lds + L_LUT) + rh * 128;
    const int* tl = (const int*)(lds + L_TL);
    float* impL = (float*)(lds + L_IMP);
    const int vb0 = (int)(uintptr_t)V_lds + v_rd_base(lane);
    const float cb = lut[127];
    constexpr bool HASV = MODE != 0;
    LAS unsigned char* ldsl = (LAS unsigned char*)lds;
#define TILE_OF(n) (MODE == 2 ? tl[n] : jbase + (n))
#define DMA(j, bf) do { const bf16_t* kt_ = s.K + (size_t)(j) * 64 * s.stride; const bf16_t* vt_ = s.V + (size_t)(j) * 64 * s.stride; \
        int ln_ = lane; asm volatile("" : "+v"(ln_));        \
        _Pragma("unroll") for (int i_ = 0; i_ < 2; ++i_) { \
            const int row_ = i_ * 32 + wid * 4 + (ln_ >> 4), srcch_ = (ln_ & 15) ^ (row_ & 7); \
            __builtin_amdgcn_global_load_lds((const unsigned*)(kt_ + (row_ * s.stride + srcch_ * 8)), (LAS unsigned*)(ldsl + L_K + (bf) * SHM_K + i_ * 8192 + wid * 1024), 16, 0, 0); \
            if (HASV) { const int kk_ = (i_ * 4 + (wid >> 1)) * 8 + ((ln_ & 31) >> 2), k_ = (kk_ & ~0xC) | ((kk_ & 4) << 1) | ((kk_ & 8) >> 1), cc_ = ((wid & 1) * 2 + (ln_ >> 5)) * 32 + (ln_ & 3) * 8; \
                __builtin_amdgcn_global_load_lds((const unsigned*)(vt_ + (k_ * s.stride + cc_)), (LAS unsigned*)(ldsl + L_V + (bf) * SHM_V + i_ * 8192 + wid * 1024), 16, 0, 0); } } } while (0)
#define COMPUTE(n, BF) do { const int j_ = TILE_OF(n); \
        bool act_ = true; bool rowsel_ = true; \
        if (MODE == 2) { const unsigned w_ = j_ < 32 ? selw[0] : j_ < 64 ? selw[1] : j_ < 96 ? selw[2] : selw[3]; rowsel_ = (w_ >> (j_ & 31)) & 1u; act_ = __any(rowsel_); } \
        if (act_) { f32x16 p0, p1; \
            qkt<BF>(p0, p1, K_lds, r32, hi, qr); \
              \
            const bool plain_ = MODE >= 2 && (qb - j_ > 2) && !(MODE == 3 && j_ == qb - 8); \
            float sc_ = C2, cb_ = cb; bool sel_ = rowsel_; \
            if (!plain_) { sc_ = 1.f; cb_ = 0.f; sel_ = true; \
                if (MODE <= 1) { \
                    if (64 * j_ + 63 >= 4 * qb - 10) bias_near<16>(p0, p1, t - 31 - 16 * (64 * j_ + 4 * hi), lut); else bias_const(p0, p1, cb); \
                    if (64 * j_ + 63 > ((64 * qb - 31) >> 4)) mask_tile(p0, p1, ((t - 31) >> 4) - 64 * j_ - 4 * hi, 1u << 30); \
                } else { \
                    bias_near<1>(p0, p1, t - 64 * j_ - 4 * hi, lut); \
                    if (MODE == 2) { if (j_ == qb) mask_tile(p0, p1, t - 64 * j_ - 4 * hi, 1u << 30); \
                        if (!rowsel_) { const float NEG_ = -__builtin_inff(); _Pragma("unroll") for (int r = 0; r < 16; ++r) { p0[r] = NEG_; p1[r] = NEG_; } } } \
                    else { if (j_ == qb || j_ == qb - 8) mask_tile(p0, p1, t - 64 * j_ - 4 * hi, 512u); } \
                } \
            } \
            if (MODE == 1) { \
                _Pragma("unroll") for (int r = 0; r < 16; ++r) { p0[r] = __builtin_amdgcn_exp2f(p0[r] - m) * inv_l; p1[r] = __builtin_amdgcn_exp2f(p1[r] - m) * inv_l; } \
                _Pragma("unroll") for (int a = 0; a < 4; ++a) { \
                    const int jj0 = 16 * j_ + 2 * a + hi, jj1 = jj0 + 8; \
                    atomicAdd(&impL[iq * 128 + jj0], p0[4 * a] + p0[4 * a + 1] + p0[4 * a + 2] + p0[4 * a + 3]); \
                    atomicAdd(&impL[iq * 128 + jj1], p1[4 * a] + p1[4 * a + 1] + p1[4 * a + 2] + p1[4 * a + 3]); \
                    if (jj0 + 1 < 128) atomicAdd(&impL[iq * 128 + jj0 + 1], p0[4 * a + 3]); \
                    if (jj1 + 1 < 128) atomicAdd(&impL[iq * 128 + jj1 + 1], p1[4 * a + 3]); } \
            } else { float alpha_; softmax_online(p0, p1, sc_, cb_, sel_, m, l, alpha_); if (MODE != 0) rescale_o(o, alpha_, al_l, r32, hi); } \
            if (MODE != 0) { bf16x8 pa0, pa1, pa2, pa3; pack_p(p0, p1, pa0, pa1, pa2, pa3); pv_tile<BF>(o, vb0, pa0, pa1, pa2, pa3); } \
        } } while (0)
#define STEP(n, BF) do { \
        if ((n) + 1 < NTL) DMA(TILE_OF((n) + 1), 1 - (BF)); \
        SBAR(); COMPUTE(n, BF); SBAR(); \
        asm volatile("s_waitcnt vmcnt(0)" ::: "memory"); \
        __syncthreads(); } while (0)
    if (NTL > 0) {
        DMA(TILE_OF(0), 0); asm volatile("s_waitcnt vmcnt(0)" ::: "memory");
        __syncthreads();
        for (int n = 0; n < NTL; n += 2) { STEP(n, 0); if (n + 1 < NTL) STEP(n + 1, 1); }
    }
#undef TILE_OF
#undef DMA
#undef COMPUTE
#undef STEP
}

__device__ __forceinline__ void item(unsigned char* ws, int b, int g, int qb, char* lds) {
    const int tid = tid_(), wid = __builtin_amdgcn_readfirstlane(tid >> 6), lane = tid & 63, r32 = lane & 31, hi = lane >> 5, rh = wid >> 1, iq = (wid & 1) * 32 + r32;
    const int t = qb * 64 + iq, head = g * 4 + rh;
    bf16_t* proj = (bf16_t*)(ws + OFF_PROJ);
    const size_t tok0 = (size_t)b * T_;
    float* impL = (float*)(lds + L_IMP); unsigned* selL = (unsigned*)(lds + L_SEL); unsigned* uniL = (unsigned*)(lds + L_UNI); int* tl = (int*)(lds + L_TL);
    for (int i = tid; i < 64 * 128; i += 512) impL[i] = 0.f;
    if (tid < 4) uniL[tid] = 0u;
    { const float* lutg = (const float*)(ws + OFF_LUT) + (g * 4) * 128; ((float*)(lds + L_LUT))[tid] = lutg[tid] * LOG2E; }
    bf16x8 qr[8];
    { const bf16_t* qp = proj + (tok0 + t) * LDP + C_NQ + head * 128 + hi * 8;
#pragma unroll
      for (int d0 = 0; d0 < 8; ++d0) qr[d0] = *(const bf16x8*)(qp + d0 * 16); }
    unsigned selw[4] = {0u, 0u, 0u, 0u};
    f32x16 o[4];
    __syncthreads();
    {
        const Src s{(const bf16_t*)(ws + OFF_KCMP) + (size_t)(b * 2 + g) * 512 * 128, (const bf16_t*)(ws + OFF_VCMP) + (size_t)(b * 2 + g) * 512 * 128, 128};
        const int nct = ((4 * qb + 2) >> 6) + 1;
        float m = -1e30f, l = 0.f;
        branch<0>(s, lds, qr, o, m, l, nct, 0, t, qb, wid, lane, tid, selw, 0.f);
#pragma unroll
        for (int d = 0; d < 4; ++d) o[d] = f32x16{};
        const float inv_l = l > 0.f ? 1.f / l : 0.f;
        branch<1>(s, lds, qr, o, m, l, nct, 0, t, qb, wid, lane, tid, selw, inv_l);
        flush_out(o, 1.f, 0, ws, lds, b, g, qb, wid, lane, true);
    }
    __syncthreads();
    {
        const int q = wid * 8 + (lane >> 3), sub = lane & 7;
        unsigned m0 = 0u, m1 = 0u, m2 = 0u, m3 = 0u;
        if (qb <= 15) { m0 = qb == 31 ? 0xFFFFFFFFu : ((1u << (qb + 1)) - 1u); }
        else {
            unsigned key[16];
#pragma unroll
            for (int k = 0; k < 16; ++k) { const int j = sub * 16 + k; key[k] = (j >= 1 && j <= qb - 2) ? ((__float_as_uint(impL[q * 128 + j]) & ~0x7Fu) | (unsigned)(127 - j)) : 0u; }
            for (int it = 0; it < 13; ++it) {
                unsigned lm = key[0];
#pragma unroll
                for (int k = 1; k < 16; ++k) lm = lm > key[k] ? lm : key[k];
                unsigned gm = lm, x;
                x = (unsigned)__builtin_amdgcn_update_dpp(0, (int)gm, 0xB1, 0xF, 0xF, true); gm = gm > x ? gm : x;
                x = (unsigned)__builtin_amdgcn_update_dpp(0, (int)gm, 0x4E, 0xF, 0xF, true); gm = gm > x ? gm : x;
                x = (unsigned)__builtin_amdgcn_update_dpp(0, (int)gm, 0x141, 0xF, 0xF, true); gm = gm > x ? gm : x;
#pragma unroll
                for (int k = 0; k < 16; ++k) key[k] = key[k] == gm ? 0u : key[k];
                const int j = 127 - (int)(gm & 0x7Fu);
                const unsigned bit = 1u << (j & 31);
                m0 |= j < 32 ? bit : 0u; m1 |= (j >= 32 && j < 64) ? bit : 0u; m2 |= (j >= 64 && j < 96) ? bit : 0u; m3 |= j >= 96 ? bit : 0u;
            }
            m0 |= 1u;
            { const int j = qb; const unsigned bit = 1u << (j & 31); m0 |= j < 32 ? bit : 0u; m1 |= (j >= 32 && j < 64) ? bit : 0u; m2 |= (j >= 64 && j < 96) ? bit : 0u; m3 |= j >= 96 ? bit : 0u; }
            { const int j = qb - 1; const unsigned bit = 1u << (j & 31); m0 |= j < 32 ? bit : 0u; m1 |= (j >= 32 && j < 64) ? bit : 0u; m2 |= (j >= 64 && j < 96) ? bit : 0u; m3 |= j >= 96 ? bit : 0u; }
        }
        if (sub == 0) { selL[q * 4 + 0] = m0; selL[q * 4 + 1] = m1; selL[q * 4 + 2] = m2; selL[q * 4 + 3] = m3;
                        atomicOr(&uniL[0], m0); atomicOr(&uniL[1], m1); atomicOr(&uniL[2], m2); atomicOr(&uniL[3], m3); }
    }
    __syncthreads();
    int nsl = 0;
    {
        if (wid == 0) {
            const bool s0 = lane <= qb && ((uniL[lane >> 5] >> (lane & 31)) & 1u), s1 = lane + 64 <= qb && ((uniL[2 + (lane >> 5)] >> (lane & 31)) & 1u);
            const unsigned long long b0 = __ballot(s0), b1 = __ballot(s1), below = (1ull << lane) - 1ull;
            const int n0 = __popcll(b0);
            if (s0) tl[__popcll(b0 & below)] = lane;
            if (s1) tl[n0 + __popcll(b1 & below)] = lane + 64;
            if (lane == 0) tl[128] = n0 + __popcll(b1);
        }
        selw[0] = selL[iq * 4 + 0]; selw[1] = selL[iq * 4 + 1]; selw[2] = selL[iq * 4 + 2]; selw[3] = selL[iq * 4 + 3];
        __syncthreads();
        nsl = tl[128];
    }
    {
        const Src s{proj + tok0 * LDP + C_KS + g * 128, proj + tok0 * LDP + C_VS + g * 128, LDP};
        float m = -1e30f, l = 0.f;
#pragma unroll
        for (int d = 0; d < 4; ++d) o[d] = f32x16{};
        branch<2>(s, lds, qr, o, m, l, nsl, 0, t, qb, wid, lane, tid, selw, 0.f);
        flush_out(o, l, 1, ws, lds, b, g, qb, wid, lane, false);
    }
    __syncthreads();
    {
        const Src s{proj + tok0 * LDP + C_KW + g * 128, proj + tok0 * LDP + C_VW + g * 128, LDP};
        const int jlo = qb >= 8 ? qb - 8 : 0;
        float m = -1e30f, l = 0.f;
#pragma unroll
        for (int d = 0; d < 4; ++d) o[d] = f32x16{};
        branch<3>(s, lds, qr, o, m, l, qb - jlo + 1, jlo, t, qb, wid, lane, tid, selw, 0.f);
        flush_out(o, l, 2, ws, lds, b, g, qb, wid, lane, false);
    }
    __syncthreads();
}
#undef KSWZ
#undef SBAR
}

__device__ void ph_hpre(const Params& p, int u) {
    const int tid = tid_(), b = u >> 8, n = u & 255, c2 = tid * 2;
    char* proj = (char*)(p.ws + OFF_PROJ) + (size_t)(b * T_ + n * 32) * (LDP * 2);
    const unsigned vo = (unsigned)c2 * 2u;
    const float* lb = (const float*)(p.ws + OFF_LB);
    const float kb0 = 1.f - lb[c2], kb1 = 1.f - lb[c2 + 1];
    float b0[32], b1[32];
    unsigned wf[32], wq[32];
#pragma unroll
    for (int i = 0; i < 32; ++i) wf[i] = *(const unsigned*)(proj + ((size_t)i * (LDP * 2) + C_HF * 2) + vo);
#pragma unroll
    for (int i = 0; i < 32; ++i) wq[i] = *(const unsigned*)(proj + ((size_t)i * (LDP * 2) + C_HQ * 2) + vo);
    float s0 = 1.f, s1 = 1.f;
#pragma unroll
    for (int i = 0; i < 32; ++i) {
        const float r0 = __uint_as_float(wf[i] << 16), r1 = __uint_as_float(wf[i] & 0xFFFF0000u);
        const float k0 = kb0 * sigmoidf_(-r0), k1 = kb1 * sigmoidf_(-r1);
        s0 *= 1.f - k0; s1 *= 1.f - k1;
        b0[i] = s0; b1[i] = s1;
        wf[i] = pg8::cvt_pk_bf16(k0, k1);
    }
    const float il0 = __builtin_amdgcn_rcpf(fmaxf(s0, 1e-30f)), il1 = __builtin_amdgcn_rcpf(fmaxf(s1, 1e-30f));
#pragma unroll
    for (int i = 0; i < 32; ++i) {
        const float k0 = __uint_as_float(wf[i] << 16), k1 = __uint_as_float(wf[i] & 0xFFFF0000u);
        const float q0 = __uint_as_float(wq[i] << 16), q1 = __uint_as_float(wq[i] & 0xFFFF0000u);
        const float e0 = s0 * __builtin_amdgcn_rcpf(fmaxf(b0[i], 1e-30f)), e1 = s1 * __builtin_amdgcn_rcpf(fmaxf(b1[i], 1e-30f));
        unsigned long long ro = (unsigned long long)i * (LDP * 2); asm volatile("" : "+s"(ro));
        char* rp = proj + ro + vo;
        *(unsigned*)(rp + C_HQ * 2) = pg8::cvt_pk_bf16(q0 * (b0[i] * il0), q1 * (b1[i] * il1));
        *(unsigned*)(rp + C_HF * 2) = pg8::cvt_pk_bf16(k0 * e0, k1 * e1);
    }
    float* dec = (float*)(p.ws + OFF_DEC) + ((size_t)((b * 8 + (c2 >> 7)) * 256 + n)) * 256 + (c2 & 127);
    dec[0] = s0; dec[1] = s1;
}

namespace hg {
typedef short bf16x8 __attribute__((ext_vector_type(8)));
typedef short s16x4 __attribute__((ext_vector_type(4)));
typedef float f32x4 __attribute__((ext_vector_type(4)));
typedef unsigned u32x4 __attribute__((ext_vector_type(4)));
constexpr int BUF = 25600, L_QA = 0, L_KE = 8192, L_VV = 16384, L_DEC = 24576, L_OB = 51200, OBS = 132;
__device__ __forceinline__ unsigned off_b(unsigned row, unsigned ch) { return 256u * row + 16u * (ch ^ (((row & 3) << 2) | ((row >> 2) & 3))); }
__device__ __forceinline__ unsigned tr_addr16(unsigned lane, unsigned c, unsigned t) {
    const unsigned g = lane >> 4, q = (lane & 15) >> 2, pp = lane & 3;
    return off_b(8 * g + 4 * t + q, 2 * c + (pp >> 1)) + 8 * (pp & 1);
}
__device__ __forceinline__ unsigned cvtpk(float lo, float hi) { unsigned r; asm volatile("v_cvt_pk_bf16_f32 %0, %1, %2" : "=v"(r) : "v"(lo), "v"(hi)); return r; }
__device__ __forceinline__ bf16x8 pack8(f32x4 a, f32x4 b) { u32x4 w = {cvtpk(a[0], a[1]), cvtpk(a[2], a[3]), cvtpk(b[0], b[1]), cvtpk(b[2], b[3])}; return *reinterpret_cast<bf16x8*>(&w); }
__device__ __forceinline__ s16x4 tr_read(unsigned addr) { s16x4 r; asm volatile("ds_read_b64_tr_b16 %0, %1" : "=v"(r) : "v"(addr) : "memory"); return r; }

__device__ __forceinline__ void item(unsigned char* ws, const float* norm_w, int b, int h, char* lds) {
    const int tid = tid_(), wid = __builtin_amdgcn_readfirstlane(tid >> 6), lane = tid & 63, l15 = lane & 15, g = lane >> 4;
    bf16_t* proj = (bf16_t*)(ws + OFF_PROJ) + (size_t)b * T_ * LDP + h * 128;
    const float* decg = (const float*)(ws + OFF_DEC) + (size_t)(b * 8 + h) * 256 * 256;
    LAS unsigned char* ldsl = (LAS unsigned char*)lds;
    const unsigned ldsb = (unsigned)(uintptr_t)lds;
    const int drow = 4 * wid + (lane >> 4);
    const unsigned dsrc = (unsigned)(drow * LDP + (((lane & 15) ^ (((drow & 3) << 2) | ((drow >> 2) & 3))) * 8));
#define HDMA(n, bf) do { const bf16_t* cp_ = proj + (size_t)(n) * 32 * LDP + dsrc; \
        __builtin_amdgcn_global_load_lds((const unsigned*)(cp_ + C_HQ), (LAS unsigned*)(ldsl + (bf) * BUF + L_QA + wid * 1024), 16, 0, 0); \
        __builtin_amdgcn_global_load_lds((const unsigned*)(cp_ + C_HF), (LAS unsigned*)(ldsl + (bf) * BUF + L_KE + wid * 1024), 16, 0, 0); \
        __builtin_amdgcn_global_load_lds((const unsigned*)(cp_ + C_HI), (LAS unsigned*)(ldsl + (bf) * BUF + L_VV + wid * 1024), 16, 0, 0); \
        if (wid == 0) __builtin_amdgcn_global_load_lds((const unsigned*)(decg + (size_t)(n) * 256 + lane * 4), (LAS unsigned*)(ldsl + (bf) * BUF + L_DEC), 16, 0, 0); } while (0)
    unsigned a_ke[2], a_qa[2], a_qp[2], a_vt[2];
#pragma unroll
    for (int x = 0; x < 2; ++x) {
        a_ke[x] = off_b(8 * (l15 >> 2) + 4 * x + (l15 & 3), g);
        a_qa[x] = off_b(16 * x + l15, g);
        a_qp[x] = off_b(16 * x + l15, g >> 1) + 8 * (g & 1);
        a_vt[x] = tr_addr16(lane, wid, x);
    }
    const int ntok = tid >> 4, ndv = (tid & 15) * 8;
    f32x4 S[8];
#pragma unroll
    for (int i = 0; i < 8; ++i) S[i] = (f32x4){0.f, 0.f, 0.f, 0.f};
    float* obuf = (float*)(lds + L_OB);
    HDMA(0, 0); asm volatile("s_waitcnt vmcnt(0)" ::: "memory");
    __syncthreads();
    for (int n = 0; n < 256; ++n) {
        const int bf = n & 1;
        if (n + 1 < 256) HDMA(n + 1, bf ^ 1);
        const u32x4 hgw = *(const u32x4*)(proj + (size_t)(n * 32 + ntok) * LDP + C_HG + ndv);
        const unsigned B0 = ldsb + bf * BUF;
        f32x4 att[2][2];
#pragma unroll
        for (int x = 0; x < 2; ++x)
#pragma unroll
            for (int y = 0; y < 2; ++y) att[x][y] = (f32x4){0.f, 0.f, 0.f, 0.f};
#pragma unroll
        for (int ks = 0; ks < 4; ++ks) {
            bf16x8 ka[2], qb[2];
#pragma unroll
            for (int x = 0; x < 2; ++x) {
                const unsigned rj = 8 * (l15 >> 2) + 4 * x + (l15 & 3), ri = 16 * x + l15;
                ka[x] = *(const LAS bf16x8*)(uintptr_t)(B0 + L_KE + off_b(rj, 4 * ks + g));
                qb[x] = *(const LAS bf16x8*)(uintptr_t)(B0 + L_QA + off_b(ri, 4 * ks + g));
            }
#pragma unroll
            for (int x = 0; x < 2; ++x)
#pragma unroll
                for (int y = 0; y < 2; ++y) att[x][y] = __builtin_amdgcn_mfma_f32_16x16x32_bf16(ka[x], qb[y], att[x][y], 0, 0, 0);
        }
        bf16x8 attf[2];
#pragma unroll
        for (int y = 0; y < 2; ++y) {
            const int i = 16 * y + l15;
            f32x4 a0 = att[0][y], a1 = att[1][y];
#pragma unroll
            for (int r = 0; r < 4; ++r) { if (8 * g + r > i) a0[r] = 0.f; if (8 * g + 4 + r > i) a1[r] = 0.f; }
            attf[y] = pack8(a0, a1);
        }
        bf16x8 vf;
        { const s16x4 v0 = tr_read(B0 + L_VV + a_vt[0]), v1 = tr_read(B0 + L_VV + a_vt[1]);
          asm volatile("s_waitcnt lgkmcnt(0)" ::: "memory");
          vf = (bf16x8){v0[0], v0[1], v0[2], v0[3], v1[0], v1[1], v1[2], v1[3]}; }
        f32x4 o[2];
#pragma unroll
        for (int y = 0; y < 2; ++y) o[y] = __builtin_amdgcn_mfma_f32_16x16x32_bf16(vf, attf[y], (f32x4){0.f, 0.f, 0.f, 0.f}, 0, 0, 0);
#pragma unroll
        for (int dt = 0; dt < 8; ++dt) { const f32x4 d = *(const LAS f32x4*)(uintptr_t)(B0 + L_DEC + (16 * dt + 4 * g) * 4); S[dt] *= d; }
#pragma unroll
        for (int ks = 0; ks < 4; ++ks) {
            const bf16x8 sa = pack8(S[2 * ks], S[2 * ks + 1]);
#pragma unroll
            for (int y = 0; y < 2; ++y) {
                const unsigned ri = 16 * y + l15;
                const unsigned long long q0 = *(const LAS unsigned long long*)(uintptr_t)(B0 + L_QA + off_b(ri, 4 * ks + (g >> 1)) + 8 * (g & 1));
                const unsigned long long q1 = *(const LAS unsigned long long*)(uintptr_t)(B0 + L_QA + off_b(ri, 4 * ks + 2 + (g >> 1)) + 8 * (g & 1));
                u32x4 w = {(unsigned)q0, (unsigned)(q0 >> 32), (unsigned)q1, (unsigned)(q1 >> 32)};
                o[y] = __builtin_amdgcn_mfma_f32_16x16x32_bf16(sa, *reinterpret_cast<bf16x8*>(&w), o[y], 0, 0, 0);
            }
        }
#pragma unroll
        for (int dt = 0; dt < 8; ++dt) {
            const s16x4 k0 = tr_read(B0 + L_KE + tr_addr16(lane, dt, 0)), k1 = tr_read(B0 + L_KE + tr_addr16(lane, dt, 1));
            asm volatile("s_waitcnt lgkmcnt(0)" ::: "memory");
            const bf16x8 kf = (bf16x8){k0[0], k0[1], k0[2], k0[3], k1[0], k1[1], k1[2], k1[3]};
            S[dt] = __builtin_amdgcn_mfma_f32_16x16x32_bf16(kf, vf, S[dt], 0, 0, 0);
        }
#pragma unroll
        for (int y = 0; y < 2; ++y) *(f32x4*)(obuf + (16 * y + l15) * OBS + 16 * wid + 4 * g) = o[y];
        __syncthreads();
        {
            const f32x4 x0 = *(const f32x4*)(obuf + ntok * OBS + ndv), x1 = *(const f32x4*)(obuf + ntok * OBS + ndv + 4);
            float ss = x0[0] * x0[0] + x0[1] * x0[1] + x0[2] * x0[2] + x0[3] * x0[3] + x1[0] * x1[0] + x1[1] * x1[1] + x1[2] * x1[2] + x1[3] * x1[3];
            ss += __shfl_xor(ss, 1); ss += __shfl_xor(ss, 2); ss += __shfl_xor(ss, 4); ss += __shfl_xor(ss, 8);
            const float r = rsqrtf(ss * (1.f / 128.f) + 1e-6f);
            const float gv[8] = {__uint_as_float(hgw.x << 16), __uint_as_float(hgw.x & 0xFFFF0000u), __uint_as_float(hgw.y << 16), __uint_as_float(hgw.y & 0xFFFF0000u),
                                 __uint_as_float(hgw.z << 16), __uint_as_float(hgw.z & 0xFFFF0000u), __uint_as_float(hgw.w << 16), __uint_as_float(hgw.w & 0xFFFF0000u)};
            const float xv[8] = {x0[0], x0[1], x0[2], x0[3], x1[0], x1[1], x1[2], x1[3]};
            const f32x4 n0 = *(const f32x4*)(norm_w + h * 128 + ndv), n1 = *(const f32x4*)(norm_w + h * 128 + ndv + 4);
            const float nw[8] = {n0[0], n0[1], n0[2], n0[3], n1[0], n1[1], n1[2], n1[3]};
            float ov[8];
#pragma unroll
            for (int i = 0; i < 8; ++i) ov[i] = xv[i] * r * nw[i] * sigmoidf_(gv[i]);
            u32x4 w = {cvtpk(ov[0], ov[1]), cvtpk(ov[2], ov[3]), cvtpk(ov[4], ov[5]), cvtpk(ov[6], ov[7])};
            *(u32x4*)(proj + (size_t)(n * 32 + ntok) * LDP + C_HI + ndv) = w;
        }
        asm volatile("s_waitcnt vmcnt(0)" ::: "memory");
        __syncthreads();
    }
#undef HDMA
    (void)a_ke; (void)a_qa; (void)a_qp;
}
}

__device__ void cvt_tile(float* sm, const float* src, int ldsrc, int k0, int ns0, int nvalid, bf16_t* dst, int lddst, int nd0) {
    float(*t)[65] = (float(*)[65])sm;
    const int tid = tid_();
    float4 v[8];
#pragma unroll
    for (int r = 0; r < 8; ++r) {
        const int idx = tid + r * 512, k = idx >> 4, n4 = (idx & 15) * 4;
        v[r] = n4 < nvalid ? *(const float4*)(src + (size_t)(k0 + k) * ldsrc + ns0 + n4) : make_float4(0.f, 0.f, 0.f, 0.f);
    }
#pragma unroll
    for (int r = 0; r < 8; ++r) {
        const int idx = tid + r * 512, k = idx >> 4, n4 = (idx & 15) * 4;
        t[k][n4] = v[r].x; t[k][n4 + 1] = v[r].y; t[k][n4 + 2] = v[r].z; t[k][n4 + 3] = v[r].w;
    }
    __syncthreads();
#pragma unroll
    for (int r = 0; r < 4; ++r) {
        const int idx = tid + r * 512, kg = idx & 31, n = idx >> 5;
        uint4 w;
        w.x = (unsigned)f2bf(t[kg * 8 + 0][n]) | ((unsigned)f2bf(t[kg * 8 + 1][n]) << 16); w.y = (unsigned)f2bf(t[kg * 8 + 2][n]) | ((unsigned)f2bf(t[kg * 8 + 3][n]) << 16);
        w.z = (unsigned)f2bf(t[kg * 8 + 4][n]) | ((unsigned)f2bf(t[kg * 8 + 5][n]) << 16); w.w = (unsigned)f2bf(t[kg * 8 + 6][n]) | ((unsigned)f2bf(t[kg * 8 + 7][n]) << 16);
        *(uint4*)(dst + (size_t)(nd0 + n) * lddst + k0 + kg * 8) = w;
    }
    __syncthreads();
}
__device__ __forceinline__ int gemm1_src_col(int nd) { return nd < 6656 ? nd : nd < 8704 ? nd + 24 : nd < 8728 ? 6656 + (nd - 8704) : -1; }
__device__ void ph_cvt_win(const Params& p, int u, float* sm) {
    if (u < 560) {
        const int nt = u >> 2, kt = u & 3, nd0 = nt * 64;
        const int ns0 = nd0 < 6656 ? nd0 : nd0 < 8704 ? nd0 + 24 : 6656, nvalid = nd0 < 8704 ? 64 : nd0 == 8704 ? 24 : 0;
        cvt_tile(sm, p.w_in, DIN, kt * 256, ns0, nvalid, (bf16_t*)(p.ws + OFF_WINT), 1024, nd0);
    } else {
        float* b1 = (float*)(p.ws + OFF_BIAS1);
        for (int i = tid_(); i < N1; i += 512) { const int s = gemm1_src_col(i); b1[i] = s >= 0 ? p.b_in[s] : 0.f; }
    }
}
__device__ void ph_cvt_br(const Params& p, int u, float* sm) {
    const int w = u >> 6, t = u & 63, nt = t >> 2, kt = t & 3;
    if (w < 2) cvt_tile(sm, w == 0 ? p.w_br_hg : p.w_br_nsa, 1024, kt * 256, nt * 64, 64, (bf16_t*)(p.ws + OFF_WBRH) + w * 1024, 2048, nt * 64);
    else cvt_tile(sm, p.w_out, 1024, kt * 256, nt * 64, 64, (bf16_t*)(p.ws + OFF_WOUTT), 1024, nt * 64);
}
__device__ void ph_cvt_exp(const Params& p, int u, float* sm) {
    if (u < 2048) {
        const int e = u >> 6, t = u & 63, nt = t >> 2, kt = t & 3, nd0 = nt * 64, pn = nd0 >> 8, half = (nd0 >> 7) & 1, off = nd0 & 127;
        cvt_tile(sm, (half ? p.e_w3 : p.e_w1) + (size_t)e * 1024 * 512, 512, kt * 256, pn * 128 + off, 64, (bf16_t*)(p.ws + OFF_E13) + (size_t)e * 1024 * 1024, 1024, nd0);
    } else {
        const int v = u - 2048, e = v >> 5, t = v & 31, nt = t >> 1, kt = t & 1;
        cvt_tile(sm, p.e_w2 + (size_t)e * 512 * 1024, 1024, kt * 256, nt * 64, 64, (bf16_t*)(p.ws + OFF_E2T) + (size_t)e * 1024 * 512, 512, nt * 64);
    }
}
enum { PH_PRO = 0, PH_LN0, PH_CMP2, PH_FINAL };
__host__ __device__ constexpr int phase_units(int ph) { return ph == PH_PRO ? 99 : ph == PH_LN0 ? NT / 16 : ph == PH_CMP2 ? 64 : ph == PH_FINAL ? NT / 16 : 0; }

__device__ void ph_pro(const Params& p, int u, float* sm) {
    const int tid = tid_();
    float* mod = (float*)(p.ws + OFF_MOD);
    if (u < 96) {
        float* ca = sm;
        float* red = sm + 4096;
        for (int i = tid; i < 4096; i += 512) ca[i] = siluf_(p.c[i]);
        __syncthreads();
        const int col = u * 64 + (tid & 63), kg = tid >> 6;
        float a0 = 0.f, a1 = 0.f, a2 = 0.f, a3 = 0.f;
        for (int k = kg * 128; k < kg * 128 + 128; ++k) {
            const float w = p.ada_w[(size_t)k * 6144 + col];
            a0 = fmaf(ca[k], w, a0); a1 = fmaf(ca[1024 + k], w, a1); a2 = fmaf(ca[2048 + k], w, a2); a3 = fmaf(ca[3072 + k], w, a3);
        }
        red[(kg * 64 + (tid & 63)) * 4 + 0] = a0; red[(kg * 64 + (tid & 63)) * 4 + 1] = a1; red[(kg * 64 + (tid & 63)) * 4 + 2] = a2; red[(kg * 64 + (tid & 63)) * 4 + 3] = a3;
        __syncthreads();
        if (tid < 256) {
            const int cl = tid & 63, b = tid >> 6;
            float s = 0.f;
            for (int g = 0; g < 8; ++g) s += red[(g * 64 + cl) * 4 + b];
            mod[b * 6144 + u * 64 + cl] = s + p.ada_b[u * 64 + cl];
        }
        __syncthreads();
    } else if (u == 96) {
        float* lb = (float*)(p.ws + OFF_LB);
        float* lut = (float*)(p.ws + OFF_LUT);
        unsigned* cnt = (unsigned*)(p.ws + OFF_CNT);
        for (int i = tid; i < 1024; i += 512) {
            const float l0 = p.lb_logits[i], l1 = p.lb_logits[1024 + i];
            lb[i] = 1.f / (1.f + __expf(l1 - l0));
            const int h = i >> 7, d = i & 127;
            lut[i] = p.rel_bias[h * 32 + rel_bucket(d)];
        }
        if (tid < 64) cnt[tid] = 0u;
        if (tid < 8) ((unsigned*)(p.ws + OFF_QCTR))[tid * 64] = 0u;
        { bf16_t* kc = (bf16_t*)(p.ws + OFF_KCMP); bf16_t* vc = (bf16_t*)(p.ws + OFF_VCMP);
          for (int i = tid; i < 8 * 128; i += 512) { kc[(size_t)((i >> 7) * 512 + 511) * 128 + (i & 127)] = 0; vc[(size_t)((i >> 7) * 512 + 511) * 128 + (i & 127)] = 0; } }
    } else {
        const int kv = u - 97;
        float* cb = (float*)(p.ws + OFF_CB) + kv * 128;
        if (tid < 128) cb[tid] = (kv ? p.b1_v : p.b1_k)[tid];
    }
}
__device__ void ph_cmpconst(const Params& p, int u, float* sm) {
    const int tid = tid_(), kv = u >> 5, kc = u & 31;
    const float* pos = kv ? p.pos_v : p.pos_k; const float* w1 = kv ? p.w1_v : p.w1_k;
    const int n = tid & 127, kg = tid >> 7;
    float s = 0.f;
#pragma unroll 8
    for (int k = kc * 128 + kg * 32; k < kc * 128 + kg * 32 + 32; ++k) s = fmaf(pos[k], w1[(size_t)k * 128 + n], s);
    sm[kg * 128 + n] = s;
    __syncthreads();
    if (tid < 128) atomicAdd((float*)(p.ws + OFF_CB) + kv * 128 + tid, sm[tid] + sm[128 + tid] + sm[256 + tid] + sm[384 + tid]);
    __syncthreads();
}

__device__ void ph_ln0(const Params& p, int u) {
    const int tidx = tid_(), lane = tidx & 63;
    float4 v[2][4]; float s[2] = {0.f, 0.f}; int rowi[2];
#pragma unroll
    for (int k = 0; k < 2; ++k) {
        rowi[k] = (u + k * (NT / 16)) * 8 + (tidx >> 6);
        const float* xr = p.x + (size_t)rowi[k] * D_;
#pragma unroll
        for (int i = 0; i < 4; ++i) { v[k][i] = *(const float4*)(xr + (i * 64 + lane) * 4); s[k] += v[k][i].x + v[k][i].y + v[k][i].z + v[k][i].w; }
    }
#pragma unroll
    for (int k = 0; k < 2; ++k) {
        const float* mod = (const float*)(p.ws + OFF_MOD) + (rowi[k] / T_) * 6144;
        bf16_t* h = (bf16_t*)(p.ws + OFF_H) + (size_t)rowi[k] * D_;
        const float mu = wsum(s[k]) * (1.f / 1024.f);
        float q = 0.f;
#pragma unroll
        for (int i = 0; i < 4; ++i) { v[k][i].x -= mu; v[k][i].y -= mu; v[k][i].z -= mu; v[k][i].w -= mu; q += v[k][i].x * v[k][i].x + v[k][i].y * v[k][i].y + v[k][i].z * v[k][i].z + v[k][i].w * v[k][i].w; }
        const float rs = rsqrtf(wsum(q) * (1.f / 1024.f) + 1e-5f);
#pragma unroll
        for (int i = 0; i < 4; ++i) {
            const int c = (i * 64 + lane) * 4;
            const float4 sh = *(const float4*)(mod + c), sc = *(const float4*)(mod + 1024 + c);
            st_bf4(h + c, v[k][i].x * rs * (1.f + sc.x) + sh.x, v[k][i].y * rs * (1.f + sc.y) + sh.y, v[k][i].z * rs * (1.f + sc.z) + sh.z, v[k][i].w * rs * (1.f + sc.w) + sh.w);
        }
    }
}

__device__ void ph_cmp2(const Params& p, int u, float* sm) {
    const int tid = tid_(), kv = u >> 5, m0 = (u & 31) * 128;
    const float* w2 = kv ? p.w2_v : p.w2_k;
    const float* hid = (const float*)(p.ws + OFF_HID) + (size_t)kv * 4096 * 128;
    const float* cb = (const float*)(p.ws + OFF_CB) + kv * 128;
    bf16_t* dst = (bf16_t*)(p.ws + (kv ? OFF_VCMP : OFF_KCMP));
    float(*As)[132] = (float(*)[132])sm;
    float(*Bs)[132] = (float(*)[132])(sm + 128 * 132);
    float4 av[8], bv[8];
#pragma unroll
    for (int r = 0; r < 8; ++r) { const int idx = tid + r * 512, row = idx >> 5, k4 = (idx & 31) * 4; av[r] = *(const float4*)(hid + (size_t)(m0 + row) * 128 + k4); bv[r] = *(const float4*)(w2 + (size_t)row * 128 + k4); }
#pragma unroll
    for (int r = 0; r < 8; ++r) { const int idx = tid + r * 512, row = idx >> 5, k4 = (idx & 31) * 4;
        const float4 c4 = *(const float4*)(cb + k4);
        As[k4][row] = siluf_(av[r].x + c4.x); As[k4 + 1][row] = siluf_(av[r].y + c4.y); As[k4 + 2][row] = siluf_(av[r].z + c4.z); As[k4 + 3][row] = siluf_(av[r].w + c4.w);
        *(float4*)&Bs[row][k4] = bv[r]; }
    __syncthreads();
    const int tx = tid & 31, ty = tid >> 5;
    float acc[8][4];
#pragma unroll
    for (int i = 0; i < 8; ++i)
#pragma unroll
        for (int j = 0; j < 4; ++j) acc[i][j] = 0.f;
#pragma unroll 8
    for (int k = 0; k < 128; ++k) {
        const float4 a0 = *(const float4*)&As[k][ty * 8], a1 = *(const float4*)&As[k][ty * 8 + 4], bb = *(const float4*)&Bs[k][tx * 4];
        const float a_[8] = {a0.x, a0.y, a0.z, a0.w, a1.x, a1.y, a1.z, a1.w};
        const float b_[4] = {bb.x, bb.y, bb.z, bb.w};
#pragma unroll
        for (int i = 0; i < 8; ++i)
#pragma unroll
            for (int j = 0; j < 4; ++j) acc[i][j] = fmaf(a_[i], b_[j], acc[i][j]);
    }
#pragma unroll
    for (int i = 0; i < 8; ++i) {
        const int m = m0 + ty * 8 + i;
        const bool dead = (m & 511) == 511;
        st_bf4(dst + (size_t)m * 128 + tx * 4, dead ? 0.f : acc[i][0], dead ? 0.f : acc[i][1], dead ? 0.f : acc[i][2], dead ? 0.f : acc[i][3]);
    }
    __syncthreads();
}

constexpr int LR_A = 0, LR_AS = 1028, LR_P = 16 * LR_AS, LR_SLOT = LR_P + 8 * 16 * 48, LR_LC = LR_SLOT + 8 * 80, LR_LNP = LR_LC + 64;
struct Ln1rArgs { unsigned char* ws; const float *ln1_g, *ln1_b, *rg_b, *re_b; float* sm; };
struct Ln1rW { const float *rg_w, *re_w; };
#define GAS __attribute__((address_space(1)))
template <class T> __device__ __forceinline__ GAS T* gptr(T* q) { return (GAS T*)q; }
#define LR_LOADZ(U_) do { _Pragma("unroll") for (int k = 0; k < 2; ++k) { const GAS bf16_t* zr_ = (const GAS bf16_t*)(ws + OFF_Z) + (size_t)((U_) * 16 + 2 * w + k) * D_; \
        _Pragma("unroll") for (int i = 0; i < 4; ++i) { const pg8::u32x2 a = *(const GAS pg8::u32x2*)(zr_ + (i * 64 + lane) * 4); v[k][i * 4] = __uint_as_float(a[0] << 16); v[k][i * 4 + 1] = __uint_as_float(a[0] & 0xFFFF0000u); \
            v[k][i * 4 + 2] = __uint_as_float(a[1] << 16); v[k][i * 4 + 3] = __uint_as_float(a[1] & 0xFFFF0000u); } } } while (0)
__device__ __forceinline__ void ph_ln1r_(const Ln1rArgs pa, const Ln1rW pw) {
    const int tidx = tid_(), lane = tidx & 63, w = tidx >> 6, n16 = lane & 15, kq = lane >> 4;
    GAS unsigned char* ws = gptr(pa.ws);
    const GAS float *ln1_g = gptr(pa.ln1_g), *ln1_b = gptr(pa.ln1_b), *rg_b = gptr(pa.rg_b), *re_b = gptr(pa.re_b), *rg_w = gptr(pw.rg_w), *re_w = gptr(pw.re_w);
    const int c = blockIdx.x, G = gridDim.x;
    LAS float* SM = (LAS float*)pa.sm;
    float v[2][16];
    LR_LOADZ(c);
    for (int i = tidx; i < 1024; i += 512) {
        SM[LR_LNP + i] = ln1_g[i]; SM[LR_LNP + 1024 + i] = ln1_b[i];
#pragma unroll
        for (int bb = 0; bb < 4; ++bb) { const GAS float* mod = (const GAS float*)(ws + OFF_MOD) + bb * 6144; SM[LR_LNP + 2048 + bb * 2048 + i] = mod[3072 + i]; SM[LR_LNP + 3072 + bb * 2048 + i] = 1.f + mod[4096 + i]; }
    }
    const int fa_k = lane >= 36 ? 1 : 0, fa_n = lane - 36 * fa_k, fb_n = lane < 8 ? 28 + lane : 35;
    const int fa_c = fa_n < 4 ? 32 + fa_n : fa_n - 4, fb_c = fb_n - 4;
    const float bias_a = fa_n < 4 ? rg_b[fa_n] : re_b[fa_n - 4], bias_b = re_b[fb_n - 4];
    float bw[3][32];
#pragma unroll
    for (int sj = 0; sj < 32; ++sj) {
        const int k = 128 * w + 16 * (sj >> 2) + 4 * kq + (sj & 3);
        bw[0][sj] = re_w[k * 32 + n16]; bw[1][sj] = re_w[k * 32 + 16 + n16]; bw[2][sj] = rg_w[k * 4 + (n16 & 3)];
    }
#pragma unroll
    for (int sj = 0; sj < 32; ++sj) bw[2][sj] = n16 < 4 ? bw[2][sj] : 0.f;
    __syncthreads();
    for (int u = c; u < NT / 16; u += G) {
        const int row0 = u * 16 + 2 * w, b = row0 / T_;
        const LAS float* lnp = SM + LR_LNP;
#pragma unroll
        for (int k = 0; k < 2; ++k) {
            GAS bf16_t* zr = (GAS bf16_t*)(ws + OFF_Z) + (size_t)(row0 + k) * D_;
            GAS bf16_t* h2 = (GAS bf16_t*)(ws + OFF_H) + (size_t)(row0 + k) * D_;
            float s1 = 0.f;
#pragma unroll
            for (int i = 0; i < 16; ++i) s1 += v[k][i];
            float mu = wsum(s1) * (1.f / 1024.f), q = 0.f;
#pragma unroll
            for (int i = 0; i < 16; ++i) { v[k][i] -= mu; q = fmaf(v[k][i], v[k][i], q); }
            float rs = rsqrtf(wsum(q) * (1.f / 1024.f) + 1e-5f);
            float s2 = 0.f;
#pragma unroll
            for (int i = 0; i < 4; ++i) {
                const int cc = (i * 64 + lane) * 4;
                const pg8::f32x4 gg = *(const LAS pg8::f32x4*)(lnp + cc), bb = *(const LAS pg8::f32x4*)(lnp + 1024 + cc);
                v[k][i * 4] = v[k][i * 4] * rs * gg[0] + bb[0]; v[k][i * 4 + 1] = v[k][i * 4 + 1] * rs * gg[1] + bb[1]; v[k][i * 4 + 2] = v[k][i * 4 + 2] * rs * gg[2] + bb[2]; v[k][i * 4 + 3] = v[k][i * 4 + 3] * rs * gg[3] + bb[3];
                { pg8::u32x2 pk = {pk_bf16(v[k][i * 4], v[k][i * 4 + 1]), pk_bf16(v[k][i * 4 + 2], v[k][i * 4 + 3])}; *(GAS pg8::u32x2*)(zr + cc) = pk; }
                s2 += v[k][i * 4] + v[k][i * 4 + 1] + v[k][i * 4 + 2] + v[k][i * 4 + 3];
            }
            mu = wsum(s2) * (1.f / 1024.f); q = 0.f;
#pragma unroll
            for (int i = 0; i < 16; ++i) { v[k][i] -= mu; q = fmaf(v[k][i], v[k][i], q); }
            rs = rsqrtf(wsum(q) * (1.f / 1024.f) + 1e-5f);
#pragma unroll
            for (int i = 0; i < 4; ++i) {
                const int cc = (i * 64 + lane) * 4;
                const pg8::f32x4 sh = *(const LAS pg8::f32x4*)(lnp + 2048 + b * 2048 + cc), sc = *(const LAS pg8::f32x4*)(lnp + 3072 + b * 2048 + cc);
                const pg8::f32x4 o = {v[k][i * 4] * rs * sc[0] + sh[0], v[k][i * 4 + 1] * rs * sc[1] + sh[1], v[k][i * 4 + 2] * rs * sc[2] + sh[2], v[k][i * 4 + 3] * rs * sc[3] + sh[3]};
                { pg8::u32x2 pk = {pk_bf16(o[0], o[1]), pk_bf16(o[2], o[3])}; *(GAS pg8::u32x2*)(h2 + cc) = pk; }
                *(LAS pg8::f32x4*)(SM + LR_A + (2 * w + k) * LR_AS + cc) = o;
            }
        }
        __syncthreads();
        if (u + G < NT / 16) LR_LOADZ(u + G);
        {
            pg8::f32x4 acc[3] = {{0.f, 0.f, 0.f, 0.f}, {0.f, 0.f, 0.f, 0.f}, {0.f, 0.f, 0.f, 0.f}};
            const LAS float* ar = SM + LR_A + n16 * LR_AS + 128 * w + 4 * kq;
            pg8::f32x4 a4[8];
#pragma unroll
            for (int sI = 0; sI < 8; ++sI) a4[sI] = *(const LAS pg8::f32x4*)(ar + 16 * sI);
#pragma unroll
            for (int sI = 0; sI < 8; ++sI)
#pragma unroll
                for (int j = 0; j < 4; ++j)
#pragma unroll
                    for (int t = 0; t < 3; ++t) acc[t] = __builtin_amdgcn_mfma_f32_16x16x4f32(a4[sI][j], bw[t][sI * 4 + j], acc[t], 0, 0, 0);
            LAS float* pp = SM + LR_P + (w * 16 + 4 * kq) * 48 + n16;
#pragma unroll
            for (int t = 0; t < 3; ++t)
#pragma unroll
                for (int e = 0; e < 4; ++e) pp[e * 48 + 16 * t] = acc[t][e];
        }
        __syncthreads();
        {
            LAS float* slot = SM + LR_SLOT + w * 80;
            {
                const LAS float* pa_ = SM + LR_P + (2 * w + fa_k) * 48 + fa_c;
                const LAS float* pb_ = SM + LR_P + (2 * w + 1) * 48 + fb_c;
                float ta = bias_a, tb = bias_b;
#pragma unroll
                for (int ww = 0; ww < 8; ++ww) { ta += pa_[ww * 16 * 48]; tb += pb_[ww * 16 * 48]; }
                slot[lane] = ta;
                if (lane < 8) slot[64 + lane] = tb;
            }
            asm volatile("s_waitcnt lgkmcnt(0)" ::: "memory");
            const int kr = lane >> 5, row = row0 + kr;
            float lg[36];
#pragma unroll
            for (int q = 0; q < 9; ++q) { const pg8::f32x4 w4 = *(const LAS pg8::f32x4*)(slot + kr * 36 + q * 4); lg[q * 4] = w4[0]; lg[q * 4 + 1] = w4[1]; lg[q * 4 + 2] = w4[2]; lg[q * 4 + 3] = w4[3]; }
            int gi = 0; float gm = lg[0];
#pragma unroll
            for (int j = 1; j < 4; ++j) if (lg[j] > gm) { gm = lg[j]; gi = j; }
            float gs = 0.f;
#pragma unroll
            for (int j = 0; j < 4; ++j) gs += __expf(lg[j] - gm);
            const float gp = __builtin_amdgcn_rcpf(gs);
            float el[8];
#pragma unroll
            for (int i = 0; i < 8; ++i) el[i] = gi == 0 ? lg[4 + i] : gi == 1 ? lg[12 + i] : gi == 2 ? lg[20 + i] : lg[28 + i];
            int i0 = 0; float l0 = el[0];
#pragma unroll
            for (int i = 1; i < 8; ++i) if (el[i] > l0) { l0 = el[i]; i0 = i; }
            int i1 = -1; float l1 = -3.0e38f;
#pragma unroll
            for (int i = 0; i < 8; ++i) if (i != i0 && el[i] > l1) { l1 = el[i]; i1 = i; }
            const float w0 = __builtin_amdgcn_rcpf(1.f + __expf(l1 - l0));
            if ((lane & 31) == 0) {
                GAS int* ti = (GAS int*)(ws + OFF_TOKI) + (size_t)row * 6;
                const int e0 = gi * 8 + i0, e1 = gi * 8 + i1;
                ti[0] = e0; ti[1] = e1;
                LAS unsigned* lc = (LAS unsigned*)(SM + LR_LC);
                ti[2] = (int)__hip_atomic_fetch_add(lc + e0, 1u, __ATOMIC_RELAXED, __HIP_MEMORY_SCOPE_WORKGROUP); ti[3] = (int)__hip_atomic_fetch_add(lc + e1, 1u, __ATOMIC_RELAXED, __HIP_MEMORY_SCOPE_WORKGROUP);
                ((GAS float*)ti)[4] = gp * w0; ((GAS float*)ti)[5] = gp * (1.f - w0);
            }
        }
    }
}
#undef LR_LOADZ

__device__ __forceinline__ int wave_offsets(const unsigned* cnt, int lane, int& pc_out, int& tot) {
    const int c = lane < 32 ? (int)cnt[lane] : 0;
    const int pc = ((c + 255) >> 8) << 8;
    int inc = pc;
    for (int o = 1; o < 64; o <<= 1) { const int t = __shfl_up(inc, o); if (lane >= o) inc += t; }
    tot = __shfl(inc, 63);
    pc_out = pc;
    return inc - pc;
}

__device__ void ph_final(const Params& p, int u) {
    const int tidx = tid_(), lane = tidx & 63;
    float v[2][16]; float s[2] = {0.f, 0.f};
    int rowi[2];
#pragma unroll
    for (int k = 0; k < 2; ++k) {
        const int row = (u + k * (NT / 16)) * 8 + (tidx >> 6), b = row / T_;
        rowi[k] = row;
        const bf16_t* x1 = (const bf16_t*)(p.ws + OFF_Z) + (size_t)row * D_;
        const float* mod = (const float*)(p.ws + OFF_MOD) + b * 6144 + 5120;
        const int* ti = (const int*)(p.ws + OFF_TOKI) + (size_t)row * 6;
        const int r0 = ti[2], r1 = ti[3]; const float w0 = ((const float*)ti)[4], w1 = ((const float*)ti)[5];
        const bf16_t* y0 = (const bf16_t*)(p.ws + OFF_XPAD) + (size_t)r0 * D_; const bf16_t* y1 = (const bf16_t*)(p.ws + OFF_XPAD) + (size_t)r1 * D_;
#pragma unroll
        for (int i = 0; i < 4; ++i) {
            const int c = (i * 64 + lane) * 4;
            const float4 xv = ld_bf4(x1 + c), g2 = *(const float4*)(mod + c), a = ld_bf4(y0 + c), bb = ld_bf4(y1 + c);
            v[k][i * 4] = ALPHA * xv.x + (1.f + g2.x) * (w0 * a.x + w1 * bb.x); v[k][i * 4 + 1] = ALPHA * xv.y + (1.f + g2.y) * (w0 * a.y + w1 * bb.y);
            v[k][i * 4 + 2] = ALPHA * xv.z + (1.f + g2.z) * (w0 * a.z + w1 * bb.z); v[k][i * 4 + 3] = ALPHA * xv.w + (1.f + g2.w) * (w0 * a.w + w1 * bb.w);
            s[k] += v[k][i * 4] + v[k][i * 4 + 1] + v[k][i * 4 + 2] + v[k][i * 4 + 3];
        }
    }
#pragma unroll
    for (int k = 0; k < 2; ++k) {
        const float mu = wsum(s[k]) * (1.f / 1024.f); float q = 0.f;
#pragma unroll
        for (int i = 0; i < 16; ++i) { v[k][i] -= mu; q = fmaf(v[k][i], v[k][i], q); }
        const float rs = rsqrtf(wsum(q) * (1.f / 1024.f) + 1e-5f);
#pragma unroll
        for (int i = 0; i < 4; ++i) {
            const int c = (i * 64 + lane) * 4;
            const float4 gg = *(const float4*)(p.ln2_g + c), bb = *(const float4*)(p.ln2_b + c);
            *(float4*)(p.out + (size_t)rowi[k] * D_ + c) = make_float4(v[k][i * 4] * rs * gg.x + bb.x, v[k][i * 4 + 1] * rs * gg.y + bb.y, v[k][i * 4 + 2] * rs * gg.z + bb.z, v[k][i * 4 + 3] * rs * gg.w + bb.w);
        }
    }
}

template <int PH> __device__ __forceinline__ void run_unit(const Params& p, int u, float* sm) {
    if constexpr (PH == PH_PRO) ph_pro(p, u, sm);
    else if constexpr (PH == PH_LN0) ph_ln0(p, u);
    else if constexpr (PH == PH_CMP2) ph_cmp2(p, u, sm);
    else if constexpr (PH == PH_FINAL) ph_final(p, u);
}

constexpr int MEGA_LDS = 153600 + 16;
enum { Q_PRO = 0, Q_LN0, Q_GEMM1, Q_CMP1, Q_CMP2, Q_MIX, Q_MRG, Q_WOUT, Q_LN1R, Q_PAD, Q_EXP1, Q_EXP2, Q_FINAL };
template <int PH> __device__ __forceinline__ void unit_loop(const Params& p, float* sm) {
    for (int u = blockIdx.x; u < phase_units(PH); u += gridDim.x) run_unit<PH>(p, u, sm);
}
template <int Q> __device__ __forceinline__ void run_phase(const Params& p, float* sm) {
    PG8_LAS unsigned char* lds = (PG8_LAS unsigned char*)sm;
    const int G = gridDim.x, c = blockIdx.x;
    if constexpr (Q == Q_PRO) {
        unit_loop<PH_PRO>(p, sm); for (int u = c; u < 561; u += G) ph_cvt_win(p, u, sm);
        for (int u = c; u < 64; u += G) { const int kv = u >> 5, t = u & 31, nt = t >> 4, kt = t & 15;
            cvt_tile(sm, kv ? p.w1_v : p.w1_k, 128, kt * 256, nt * 64, 64, (bf16_t*)(p.ws + OFF_CMPW) + (size_t)kv * 128 * 4096, 4096, nt * 64); }
        { float4* hz = (float4*)(p.ws + OFF_HID); for (int i = c * 512 + threadIdx.x; i < 2 * 4096 * 128 / 4; i += G * 512) hz[i] = make_float4(0.f, 0.f, 0.f, 0.f); }
    }
    else if constexpr (Q == Q_LN0) { for (int u = c; u < 64; u += G) ph_cmpconst(p, u, sm); unit_loop<PH_LN0>(p, sm); }
    else if constexpr (Q == Q_GEMM1) {
        pg8::Gemm g{(const bf16_t*)(p.ws + OFF_H), (const bf16_t*)(p.ws + OFF_WINT), 1024, 1024, 1024};
        pg8::StaticOrder S; S.init(NT, N1, G, c);
        pg8::EpiProj E{(bf16_t*)(p.ws + OFF_PROJ), (bf16_t*)p.out, (float*)(p.ws + OFF_GATE), (const float*)(p.ws + OFF_BIAS1)};
        pg8::gemm_phase(lds, g, S, E);
    }
    else if constexpr (Q == Q_CMP1) {
        for (int u = c; u < 1024; u += G) ph_hpre(p, u);
        for (int u = c; u < 192; u += G) ph_cvt_br(p, u, sm);
        __syncthreads();
        pg8::Gemm g{(const bf16_t*)(p.ws + OFF_PROJ), (const bf16_t*)(p.ws + OFF_CMPW), 1024, 16 * LDP, 4096, 1, 1};
        pg8::CmpOrder S{G, c};
        pg8::EpiCmpAcc E{(float*)(p.ws + OFF_HID)};
        pg8::gemm_phase(lds, g, S, E);
    }
    else if constexpr (Q == Q_CMP2) unit_loop<PH_CMP2>(p, sm);
    else if constexpr (Q == Q_MIX) {
        unsigned* qc = (unsigned*)(p.ws + OFF_QCTR);
        volatile int* slot = (volatile int*)((char*)sm + 131072 - 64);
        for (int k = 0; k < 8; ++k) {
            const int q = (c + k) & 7;
            for (;;) {
                __syncthreads();
                if (threadIdx.x == 0) *slot = (int)__hip_atomic_fetch_add(qc + q * 64, 1u, __ATOMIC_RELAXED, __HIP_MEMORY_SCOPE_AGENT);
                __syncthreads();
                const int it = *slot;
                if (it >= 4 + 128) break;
                if (it < 4) hg::item(p.ws, p.hg_norm_w, q >> 1, (q & 1) * 4 + it, (char*)sm);
                else nsa::item(p.ws, q >> 1, q & 1, 127 - (it - 4), (char*)sm);
            }
        }
    }
    else if constexpr (Q == Q_MRG) {
        pg8::StaticOrder S; S.init(NT, 1024, G, c);
        pg8::Gemm g{(const bf16_t*)(p.ws + OFF_PROJ) + C_HI, (const bf16_t*)(p.ws + OFF_WBRH), 2048, LDP, 2048, 2, 0};
        pg8::EpiMrg E{(const bf16_t*)p.out, (bf16_t*)(p.ws + OFF_H)};
        pg8::gemm_phase(lds, g, S, E);
    }
    else if constexpr (Q == Q_WOUT) {
        for (int u = c; u < 3072; u += G) ph_cvt_exp(p, u, sm);
        pg8::Gemm g{(const bf16_t*)(p.ws + OFF_H), (const bf16_t*)(p.ws + OFF_WOUTT), 1024, 1024, 1024};
        pg8::StaticOrder S; S.init(NT, 1024, G, c);
        pg8::EpiWout E{p.x, (const float*)(p.ws + OFF_MOD), (bf16_t*)(p.ws + OFF_Z)};
        pg8::gemm_phase(lds, g, S, E);
    }
    else if constexpr (Q == Q_LN1R) {
        unsigned* lc = (unsigned*)(sm + LR_LC);
        if (threadIdx.x < 64) lc[threadIdx.x] = 0u;
        __syncthreads();
        ph_ln1r_(Ln1rArgs{p.ws, p.ln1_g, p.ln1_b, p.rg_b, p.re_b, sm}, Ln1rW{p.rg_w, p.re_w});
        __syncthreads();
        if (threadIdx.x < 32) lc[32 + threadIdx.x] = atomicAdd((unsigned*)(p.ws + OFF_CNT) + threadIdx.x, lc[threadIdx.x]);
        __syncthreads();
        for (int u = c; u < NT / 16; u += G) {
            if (threadIdx.x < 32) { int* ti = (int*)(p.ws + OFF_TOKI) + (size_t)(u * 16 + (threadIdx.x >> 1)) * 6; const int k = threadIdx.x & 1; ti[2 + k] += (int)lc[32 + ti[k]]; }
        }
        __syncthreads();
    }
    else if constexpr (Q == Q_PAD) {
        const int tidx = tid_(), lane = tidx & 63;
        const unsigned* cnt = (const unsigned*)(p.ws + OFF_CNT);
        int* inv = (int*)(p.ws + OFF_INV);
        int pc, tot; const int off = wave_offsets(cnt, lane, pc, tot);
        for (int base = c * 512; base < NT; base += G * 512) {
            const int tok = base + tidx;
            int* tw = (int*)(p.ws + OFF_TOKI) + (size_t)tok * 6;
            const int ra = __shfl(off, tw[0]) + tw[2], rb = __shfl(off, tw[1]) + tw[3];
            inv[ra] = tok; inv[rb] = tok; tw[2] = ra; tw[3] = rb;
        }
        for (int e = c; e < 32; e += G) {
            const int oe = __shfl(off, e), ce = (int)cnt[e], pe = __shfl(pc, e);
            for (int r = oe + ce + tidx; r < oe + pe; r += 512) inv[r] = 0;
        }
        if (c == G - 1) {
            int* te = (int*)(p.ws + OFF_TILEE);
            if (tidx < 32) { for (int r = off; r < off + pc; r += 256) te[r >> 8] = tidx; }
            if (tidx == 0) te[511] = tot >> 8;
        }
    }
    else if constexpr (Q == Q_EXP1) {
        const int* te = (const int*)(p.ws + OFF_TILEE);
        pg8::Gemm g{(const bf16_t*)(p.ws + OFF_H), (const bf16_t*)(p.ws + OFF_E13), 1024, 1024, 1024};
        pg8::MoeGatherOrder S{te, (const int*)(p.ws + OFF_INV), te[511] * 4, G, c, (long)1024 * 1024 * 2};
        pg8::EpiExp1 E{(bf16_t*)p.out};
        pg8::gemm_phase(lds, g, S, E);
    }
    else if constexpr (Q == Q_EXP2) {
        const int* te = (const int*)(p.ws + OFF_TILEE);
        pg8::Gemm g{(const bf16_t*)p.out, (const bf16_t*)(p.ws + OFF_E2T), 512, 512, 512};
        pg8::MoeOrder S{te, te[511] * 4, G, c, (long)1024 * 512 * 2};
        pg8::EpiBf E{(bf16_t*)(p.ws + OFF_XPAD), 1024};
        pg8::gemm_phase(lds, g, S, E);
    }
    else if constexpr (Q == Q_FINAL) unit_loop<PH_FINAL>(p, sm);
}
__global__ void __launch_bounds__(512, 2) k_mega(Params p) {
    extern __shared__ __attribute__((aligned(16))) float smem[];
    volatile LAS unsigned* st = (volatile LAS unsigned*)(smem + 153600 / 4);
    if (threadIdx.x == 0) { st[0] = 0u; st[1] = 0u; st[2] = 0u; st[3] = 0u; }
    __syncthreads();
    XcdBarrier bar = xcd_barrier_post((unsigned*)(p.ws + OFF_BAR), st);
    run_phase<Q_PRO>(p, smem);   xcd_barrier(bar);
    run_phase<Q_LN0>(p, smem);   xcd_barrier(bar);
    run_phase<Q_GEMM1>(p, smem); xcd_barrier(bar);
    run_phase<Q_CMP1>(p, smem);  xcd_barrier(bar);
    run_phase<Q_CMP2>(p, smem);  xcd_barrier(bar);
    run_phase<Q_MIX>(p, smem);   xcd_barrier(bar);
    run_phase<Q_MRG>(p, smem);   xcd_barrier(bar);
    run_phase<Q_WOUT>(p, smem);  xcd_barrier(bar);
    run_phase<Q_LN1R>(p, smem);  xcd_barrier(bar);
    run_phase<Q_PAD>(p, smem);   xcd_barrier(bar);
    run_phase<Q_EXP1>(p, smem);  xcd_barrier(bar);
    run_phase<Q_EXP2>(p, smem);  xcd_barrier(bar);
    run_phase<Q_FINAL>(p, smem);
}

extern "C" void kernel_launch(void* const* d_in, const int* in_sizes, int n_in, void* d_out, int out_size, void* d_ws, size_t ws_size, hipStream_t stream) {
    Params p{};
    const float** fp = (const float**)&p;
    for (int i = 0; i < 31; ++i) fp[i] = (const float*)d_in[i];
    p.out = (float*)d_out; p.ws = (unsigned char*)d_ws;
    static int grid = 0;
    if (!grid) {
        int dev = 0, cus = 0, per_cu = 0;
        (void)hipGetDevice(&dev);
        (void)hipDeviceGetAttribute(&cus, hipDeviceAttributeMultiprocessorCount, dev);
        (void)hipFuncSetAttribute((const void*)k_mega, hipFuncAttributeMaxDynamicSharedMemorySize, MEGA_LDS);
        (void)hipOccupancyMaxActiveBlocksPerMultiprocessor(&per_cu, (const void*)k_mega, 512, MEGA_LDS);
        grid = cus * (per_cu < 1 ? per_cu : 1);
    }
    (void)hipMemsetAsync(p.ws + OFF_BAR, 0, XCD_BAR_WORDS * sizeof(unsigned), stream);
    hipLaunchKernelGGL(k_mega, dim3(grid), dim3(512), MEGA_LDS, stream, p);
}
```

```cpp
#include <hip/hip_runtime.h>
#include <stdint.h>

typedef unsigned short bf16_t;

constexpr int B_ = 4, T_ = 8192, D_ = 1024, NT = B_ * T_;
constexpr int DIN = 8728;
constexpr int LDP = 6656;
constexpr int C_HQ = 0, C_HF = 1024, C_HI = 2048, C_HG = 3072, C_NQ = 4096, C_KC = 5120, C_VC = 5376, C_KS = 5632, C_VS = 5888, C_KW = 6144, C_VW = 6400;
constexpr int NC = 511;
constexpr float ALPHA = 1.189207115002721f;
constexpr int MAXROWS = 73728;

constexpr size_t KB = 1024, MB = 1024 * 1024;
constexpr size_t OFF_BAR = 0, OFF_MOD = 16 * KB, OFF_LB = 112 * KB, OFF_LUT = 116 * KB, OFF_CB = 120 * KB, OFF_CNT = 124 * KB, OFF_TOKI = 128 * KB;
constexpr size_t OFF_GATE = 1 * MB, OFF_KCMP = 4 * MB, OFF_VCMP = 5 * MB, OFF_HID = 6 * MB;
constexpr size_t OFF_DEC = 18 * MB;
constexpr size_t OFF_INV = 26 * MB;
constexpr size_t OFF_QCTR = 960 * KB;
constexpr size_t OFF_CMPW = 10 * MB;
constexpr size_t OFF_H = 31 * MB;
constexpr size_t OFF_PROJ = 95 * MB;
constexpr size_t OFF_Z = OFF_PROJ, OFF_XPAD = OFF_PROJ + 128 * MB;
constexpr size_t OFF_BIAS1 = 896 * KB, OFF_TILEE = 940 * KB;
constexpr size_t OFF_WINT = 12 * MB;
constexpr size_t OFF_WBRH = 12 * MB, OFF_WBRN = 14 * MB, OFF_WOUTT = 16 * MB;
constexpr size_t OFF_E13 = OFF_PROJ + 272 * MB, OFF_E2T = OFF_PROJ + 336 * MB;
constexpr int N1 = 8960;

struct Params {
    const float *x, *c, *ada_w, *ada_b, *w_in, *b_in, *lb_logits, *hg_norm_w, *pos_k, *w1_k, *b1_k, *w2_k, *pos_v, *w1_v, *b1_v, *w2_v, *rel_bias,
        *w_br_hg, *w_br_nsa, *w_out, *ln1_g, *ln1_b, *rg_w, *rg_b, *re_w, *re_b, *e_w1, *e_w3, *e_w2, *ln2_g, *ln2_b;
    float* out; unsigned char* ws;
};

__device__ __forceinline__ int tid_() { int t = threadIdx.x; asm volatile("" : "+v"(t)); return t; }
__device__ __forceinline__ float bf2f(bf16_t v) { return __uint_as_float(((unsigned)v) << 16); }
__device__ __forceinline__ bf16_t f2bf(float f) { unsigned u = __float_as_uint(f); u += 0x7FFFu + ((u >> 16) & 1u); return (bf16_t)(u >> 16); }
__device__ __forceinline__ float sigmoidf_(float v) { return __builtin_amdgcn_rcpf(1.f + __expf(-v)); }
__device__ __forceinline__ float siluf_(float v) { return v * __builtin_amdgcn_rcpf(1.f + __expf(-v)); }
template <int CTRL> __device__ __forceinline__ float dpp_(float v) { return __int_as_float(__builtin_amdgcn_update_dpp(0, __float_as_int(v), CTRL, 0xF, 0xF, true)); }
__device__ __forceinline__ float rlane(float v, int l) { return __int_as_float(__builtin_amdgcn_readlane(__float_as_int(v), l)); }
__device__ __forceinline__ float wsum(float v) {
    v += dpp_<0xB1>(v); v += dpp_<0x4E>(v); v += dpp_<0x141>(v); v += dpp_<0x140>(v);
    return (rlane(v, 15) + rlane(v, 31)) + (rlane(v, 47) + rlane(v, 63));
}
__device__ __forceinline__ float rfl(float v) { return __int_as_float(__builtin_amdgcn_readfirstlane(__float_as_int(v))); }
__device__ __forceinline__ float wmax(float v) { for (int o = 32; o > 0; o >>= 1) v = fmaxf(v, __shfl_xor(v, o)); return v; }
__device__ __forceinline__ float4 ld_bf4(const bf16_t* p) { uint2 r = *(const uint2*)p; return make_float4(__uint_as_float(r.x << 16), __uint_as_float(r.x & 0xFFFF0000u), __uint_as_float(r.y << 16), __uint_as_float(r.y & 0xFFFF0000u)); }
typedef __bf16 bf16x2n __attribute__((ext_vector_type(2)));
typedef float f32x2n __attribute__((ext_vector_type(2)));
__device__ __forceinline__ unsigned pk_bf16(float lo, float hi) { const f32x2n v = {lo, hi}; const bf16x2n r = __builtin_convertvector(v, bf16x2n); return __builtin_bit_cast(unsigned, r); }
__device__ __forceinline__ void st_bf4(bf16_t* p, float a, float b, float c, float d) { uint2 r; r.x = pk_bf16(a, b); r.y = pk_bf16(c, d); *(uint2*)p = r; }
__device__ __forceinline__ int rel_bucket(int n) {
    if (n < 16) return n < 0 ? 0 : n;
    int b = 16;
    b += (n >= 19) + (n >= 21) + (n >= 24) + (n >= 27) + (n >= 31) + (n >= 35) + (n >= 40) + (n >= 46) + (n >= 52) + (n >= 59) + (n >= 67) + (n >= 77) + (n >= 87) + (n >= 99) + (n >= 113);
    return b;
}

template <class AF, class BF, class EF>
__device__ __forceinline__ void gemm128(float* sm, int m0, int n0, int K, AF af, BF bf, EF ef) {
    float(*As)[132] = (float(*)[132])sm;
    float(*Bs)[132] = (float(*)[132])(sm + 16 * 132);
    const int tid = tid_(), tx = tid & 31, ty = tid >> 5;
    const int ar = tid >> 2, ak = (tid & 3) * 4, bk = tid >> 5, bn = (tid & 31) * 4;
    float acc[8][4];
#pragma unroll
    for (int i = 0; i < 8; ++i)
#pragma unroll
        for (int j = 0; j < 4; ++j) acc[i][j] = 0.f;
    for (int k0 = 0; k0 < K; k0 += 16) {
        const float4 a = af(m0 + ar, k0 + ak);
        const float4 b = bf(k0 + bk, n0 + bn);
        __syncthreads();
        As[ak + 0][ar] = a.x; As[ak + 1][ar] = a.y; As[ak + 2][ar] = a.z; As[ak + 3][ar] = a.w;
        *(float4*)&Bs[bk][bn] = b;
        __syncthreads();
#pragma unroll
        for (int k = 0; k < 16; ++k) {
            const float4 a0 = *(const float4*)&As[k][ty * 8], a1 = *(const float4*)&As[k][ty * 8 + 4], bb = *(const float4*)&Bs[k][tx * 4];
            const float av[8] = {a0.x, a0.y, a0.z, a0.w, a1.x, a1.y, a1.z, a1.w};
            const float bv[4] = {bb.x, bb.y, bb.z, bb.w};
#pragma unroll
            for (int i = 0; i < 8; ++i)
#pragma unroll
                for (int j = 0; j < 4; ++j) acc[i][j] = fmaf(av[i], bv[j], acc[i][j]);
        }
    }
#pragma unroll
    for (int i = 0; i < 8; ++i) ef(m0 + ty * 8 + i, n0 + tx * 4, make_float4(acc[i][0], acc[i][1], acc[i][2], acc[i][3]));
    __syncthreads();
}


#define XB_TMO      128
#define XB_XCNT(j)  (256  + 64 * (j))
#define XB_XSUB(j)  (1280 + 64 * (j))
#define XB_XGEN(j)  (2304 + 64 * (j))
#define XB_TOP      3328
#define XB_TOPGEN   3392
#define XCD_BAR_WORDS 3456
#define XB_SPIN_CAP (1u << 22)
#define LAS __attribute__((address_space(3)))
__device__ __forceinline__ unsigned xb_ld(unsigned* p)              { return __hip_atomic_load(p, __ATOMIC_RELAXED, __HIP_MEMORY_SCOPE_AGENT); }
__device__ __forceinline__ unsigned xb_add(unsigned* p, unsigned v) { return __hip_atomic_fetch_add(p, v, __ATOMIC_RELAXED, __HIP_MEMORY_SCOPE_AGENT); }
__device__ __forceinline__ unsigned xb_xcc_id() { return (unsigned)__builtin_amdgcn_s_getreg((3 << 11) | 20) & 0xFu; }
#define XB_SPIN(cond, bar) do { unsigned _sp = 0; while (cond) { __builtin_amdgcn_s_sleep(1); \
    if ((++_sp & 255u) == 0u) { if (xb_ld(&(bar)[XB_TMO])) break; if (_sp > XB_SPIN_CAP) { atomicAdd(&(bar)[XB_TMO], 1u); break; } } } } while (0)
struct XcdBarrier { unsigned* bar; unsigned x; volatile LAS unsigned* st; };
__device__ __forceinline__ XcdBarrier xcd_barrier_post(unsigned* bar, volatile LAS unsigned* st) {
    XcdBarrier b; b.bar = bar; b.x = xb_xcc_id(); b.st = st;
    if (threadIdx.x == 0) (void)xb_add(&bar[XB_XCNT(b.x)], 1u);
    return b;
}
__device__ __forceinline__ void xcd_barrier_complete(unsigned* bar, unsigned x, unsigned& nloc, unsigned& nx) {
    const unsigned G = gridDim.x * gridDim.y * gridDim.z;
    unsigned sum, cnt, mine, sp = 0u;
    for (;;) {
        sum = 0u; cnt = 0u; mine = 0u;
#pragma unroll
        for (unsigned j = 0; j < 16; ++j) { const unsigned c = xb_ld(&bar[XB_XCNT(j)]); sum += c; cnt += (c > 0u) ? 1u : 0u; mine = (j == x) ? c : mine; }
        if (sum == G) break;
        __builtin_amdgcn_s_sleep(1);
        if ((++sp & 255u) == 0u) { if (xb_ld(&bar[XB_TMO])) break; if (sp > XB_SPIN_CAP) { atomicAdd(&bar[XB_TMO], 1u); break; } }
    }
    nloc = mine > 0u ? mine : 1u; nx = cnt > 0u ? cnt : 1u;
}
__device__ __forceinline__ void xcd_barrier(const XcdBarrier& b) {
    asm volatile("s_waitcnt vmcnt(0)" ::: "memory");
    __syncthreads();
    if (threadIdx.x == 0) {
        unsigned* bar = b.bar;
        __builtin_amdgcn_s_waitcnt(0);
        unsigned nloc = b.st[0], nx = b.st[1];
        if (nloc == 0u) { xcd_barrier_complete(bar, b.x, nloc, nx); b.st[0] = nloc; b.st[1] = nx; }
        const unsigned old = xb_add(&bar[XB_XSUB(b.x)], 1u);
        const unsigned gen = old / nloc;
        if (old + 1u == (gen + 1u) * nloc) {
            __builtin_amdgcn_fence(__ATOMIC_RELEASE, "agent");
            asm volatile("s_waitcnt vmcnt(0)" ::: "memory");
            const unsigned og = xb_add(&bar[XB_TOP], 1u);
            const unsigned tg = og / nx;
            if (og + 1u == (tg + 1u) * nx) xb_add(&bar[XB_TOPGEN], 1u);
            else XB_SPIN(xb_ld(&bar[XB_TOPGEN]) == tg, bar);
            __builtin_amdgcn_fence(__ATOMIC_ACQUIRE, "agent");
            xb_add(&bar[XB_XGEN(b.x)], 1u);
            asm volatile("s_waitcnt vmcnt(0)" ::: "memory");
        } else {
            XB_SPIN(xb_ld(&bar[XB_XGEN(b.x)]) == gen, bar);
            __builtin_amdgcn_fence(__ATOMIC_ACQUIRE, "agent");
            asm volatile("s_waitcnt vmcnt(0)" ::: "memory");
        }
    }
    __syncthreads();
}


namespace pg8 {
#define PG8_LAS __attribute__((address_space(3)))
typedef short bf16x8 __attribute__((ext_vector_type(8)));
typedef float f32x4 __attribute__((ext_vector_type(4)));
typedef unsigned u32x4 __attribute__((ext_vector_type(4)));
typedef unsigned u32x2 __attribute__((ext_vector_type(2)));
constexpr int BM = 256, BK = 64, HALF = 128, HTB = HALF * BK * 2, STAGE_BYTES = 8 * HTB, NXCD = 8, WGM = 8;
__host__ __device__ __forceinline__ int lds_byte(int r, int c) { const int st = (r >> 4) * 2 + (c >> 5), rr = r & 15, cc = c & 31, ob = rr * 64 + cc * 2; return st * 1024 + (ob ^ (((ob >> 9) & 1) << 5)); }
__host__ __device__ __forceinline__ void stage_rc(int b, int& R, int& C) { const int st = b / 1024, sb = b % 1024, swz = sb ^ (((sb >> 9) & 1) << 5); R = (st >> 1) * 16 + swz / 64; C = (st & 1) * 32 + (swz % 64) / 2; }
__host__ __device__ __forceinline__ int perm32(int rho) { const int n = rho >> 4, i = rho & 15; return 8 * (i >> 2) + 4 * n + (i & 3); }
struct Unit { int pm, pn; long boff; long aoff; };
struct Gemm { const bf16_t* A; const bf16_t* Bt; int K, lda, ldb; int kmode = 0; int bdup = 0; };
struct StaticOrder {
    static constexpr bool GATHER = false;
    int nM, nN, nwg, G, c;
    __device__ void init(int M, int N, int G_, int c_) { nM = M / BM; nN = N / BM; nwg = nM * nN; G = G_; c = c_; }
    __device__ bool next(int i, Unit& u) const {
        const long L = (long)i * G + c; if (L >= nwg) return false;
        int wgid = (int)L; { const int q = nwg / NXCD, r = nwg % NXCD, xcd = wgid % NXCD, off = wgid / NXCD; wgid = (xcd < r ? xcd * (q + 1) : r * (q + 1) + (xcd - r) * q) + off; }
        const int nig = WGM * nN, gid = wgid / nig, fm = gid * WGM, gsz = (nM - fm) < WGM ? (nM - fm) : WGM;
        u.pm = fm + ((wgid % nig) % gsz); u.pn = (wgid % nig) / gsz; u.boff = 0; u.aoff = 0; return true;
    }
    __device__ __forceinline__ void a_ready(const Unit&) const {}
    __device__ __forceinline__ void done(const Unit&) const {}
};
struct MoeOrder {
    static constexpr bool GATHER = false;
    const int* tile_e; int nwg, G, c; long estride;
    __device__ bool next(int i, Unit& u) const {
        const long L = (long)i * G + c; if (L >= nwg) return false;
        u.pm = (int)(L >> 2); u.pn = (int)(L & 3); u.boff = (long)tile_e[u.pm] * estride; u.aoff = 0; return true;
    }
    __device__ __forceinline__ void a_ready(const Unit&) const {}
    __device__ __forceinline__ void done(const Unit&) const {}
};
struct MoeGatherOrder {
    static constexpr bool GATHER = true;
    const int* tile_e; const int* inv; int nwg, G, c; long estride;
    __device__ bool next(int i, Unit& u) const {
        const long L = (long)i * G + c; if (L >= nwg) return false;
        u.pm = (int)(L >> 2); u.pn = (int)(L & 3); u.boff = (long)tile_e[u.pm] * estride; u.aoff = 0; return true;
    }
    __device__ __forceinline__ void a_ready(const Unit&) const {}
    __device__ __forceinline__ void done(const Unit&) const {}
};
struct CmpOrder {
    static constexpr bool GATHER = false;
    int G, c;
    __device__ bool next(int i, Unit& u) const {
        const int L = i * G + c; if (L >= 128) return false;
        const int kv = L >> 6, bg = (L >> 3) & 7, half = (L >> 2) & 1, kq = L & 3;
        u.pm = half; u.pn = (kv << 3) | bg;
        u.aoff = ((long)((bg >> 1) * T_ + 8 * kq) * LDP + (kv ? C_VC : C_KC) + (bg & 1) * 128) * 2;
        u.boff = ((long)kv * 128 * 4096 + kq * 1024) * 2;
        return true;
    }
    __device__ __forceinline__ void a_ready(const Unit&) const {}
    __device__ __forceinline__ void done(const Unit&) const {}
};
__device__ __forceinline__ unsigned cvt_pk_bf16(float lo, float hi) { return pk_bf16(lo, hi); }
__device__ __forceinline__ f32x4 unpk_lo(u32x4 w) { return (f32x4){__uint_as_float(w.x << 16), __uint_as_float(w.x & 0xFFFF0000u), __uint_as_float(w.y << 16), __uint_as_float(w.y & 0xFFFF0000u)}; }
__device__ __forceinline__ f32x4 unpk_hi(u32x4 w) { return (f32x4){__uint_as_float(w.z << 16), __uint_as_float(w.z & 0xFFFF0000u), __uint_as_float(w.w << 16), __uint_as_float(w.w & 0xFFFF0000u)}; }
__device__ __forceinline__ u32x4 pk8(f32x4 v0, f32x4 v1) { u32x4 w; w.x = cvt_pk_bf16(v0[0], v0[1]); w.y = cvt_pk_bf16(v0[2], v0[3]); w.z = cvt_pk_bf16(v1[0], v1[1]); w.w = cvt_pk_bf16(v1[2], v1[3]); return w; }
__device__ __forceinline__ f32x4 sig4(f32x4 v) { return (f32x4){sigmoidf_(v[0]), sigmoidf_(v[1]), sigmoidf_(v[2]), sigmoidf_(v[3])}; }
struct EpiProj {
    static constexpr bool PERM = true, AFTER_DRAIN = false, HAS_MID = false;
    bf16_t* proj; bf16_t* mg; float* gate; const float* bias;
    __device__ __forceinline__ void operator()(const f32x4 (&acc)[2][2][4][2], const Unit& u, int wr, int wc, int fr, int fq) const {
        const int row0 = u.pm * BM + wr * 64 + fr, c8 = u.pn * BM + wc * 32 + 8 * fq;
        f32x4 bv[2][2];
#pragma unroll
        for (int bj = 0; bj < 2; ++bj)
#pragma unroll
            for (int n = 0; n < 2; ++n) bv[bj][n] = *(const f32x4*)(bias + c8 + bj * HALF + 4 * n);
#pragma unroll
        for (int ai = 0; ai < 2; ++ai)
#pragma unroll
            for (int m = 0; m < 4; ++m) {
                const size_t row = (size_t)(row0 + ai * HALF + m * 16);
#pragma unroll
                for (int bj = 0; bj < 2; ++bj) {
                    const f32x4 v0 = acc[ai][bj][m][0] + bv[bj][0], v1 = acc[ai][bj][m][1] + bv[bj][1];
                    const int col = c8 + bj * HALF;
                    if (u.pn < 26) *(u32x4*)(proj + row * LDP + col) = pk8(v0, v1);
                    else if (u.pn < 34) *(u32x4*)(mg + row * 2048 + (col - 6656)) = pk8(sig4(v0), sig4(v1));
                    else if (col - 8704 < 24) { float* gp = gate + row * 24 + (col - 8704); *(f32x4*)gp = sig4(v0); *(f32x4*)(gp + 4) = sig4(v1); }
                }
            }
    }
};
struct EpiMrg {
    static constexpr bool PERM = true, AFTER_DRAIN = false, HAS_MID = true;
    const bf16_t* mg; bf16_t* mr;
    __device__ __forceinline__ void mid(f32x4 (&acc)[2][2][4][2], const Unit& u, int wr, int wc, int fr, int fq) const {
        const int row0 = u.pm * BM + wr * 64 + fr, c8 = u.pn * BM + wc * 32 + 8 * fq;
#pragma unroll
        for (int ai = 0; ai < 2; ++ai)
#pragma unroll
            for (int m = 0; m < 4; ++m) {
                const size_t row = (size_t)(row0 + ai * HALF + m * 16);
#pragma unroll
                for (int bj = 0; bj < 2; ++bj) {
                    const int col = c8 + bj * HALF;
                    const u32x4 hw = *(const u32x4*)(mg + row * 2048 + col), nw = *(const u32x4*)(mg + row * 2048 + 1024 + col);
                    const f32x4 h0 = unpk_lo(hw), h1 = unpk_hi(hw), n0 = unpk_lo(nw), n1 = unpk_hi(nw);
#pragma unroll
                    for (int j = 0; j < 4; ++j) { acc[ai][bj][m][0][j] *= h0[j] * __builtin_amdgcn_rcpf(fmaxf(n0[j], 8.673617e-19f)); acc[ai][bj][m][1][j] *= h1[j] * __builtin_amdgcn_rcpf(fmaxf(n1[j], 8.673617e-19f)); }
                    asm volatile("" ::: "memory");
                }
            }
    }
    __device__ __forceinline__ void operator()(const f32x4 (&acc)[2][2][4][2], const Unit& u, int wr, int wc, int fr, int fq) const {
        const int row0 = u.pm * BM + wr * 64 + fr, c8 = u.pn * BM + wc * 32 + 8 * fq;
#pragma unroll
        for (int ai = 0; ai < 2; ++ai)
#pragma unroll
            for (int m = 0; m < 4; ++m) {
                const size_t row = (size_t)(row0 + ai * HALF + m * 16);
#pragma unroll
                for (int bj = 0; bj < 2; ++bj) {
                    const int col = c8 + bj * HALF;
                    const u32x4 nw = *(const u32x4*)(mg + row * 2048 + 1024 + col);
                    f32x4 n0 = unpk_lo(nw), n1 = unpk_hi(nw);
#pragma unroll
                    for (int j = 0; j < 4; ++j) { n0[j] = fmaxf(n0[j], 8.673617e-19f); n1[j] = fmaxf(n1[j], 8.673617e-19f); }
                    *(u32x4*)(mr + row * 1024 + col) = pk8(n0 * acc[ai][bj][m][0], n1 * acc[ai][bj][m][1]);
                }
                asm volatile("" ::: "memory");
            }
    }
};
struct EpiWout {
    static constexpr bool PERM = true, AFTER_DRAIN = false, HAS_MID = false;
    const float* x; const float* mod; bf16_t* z;
    __device__ __forceinline__ void operator()(const f32x4 (&acc)[2][2][4][2], const Unit& u, int wr, int wc, int fr, int fq) const {
        const int row0 = u.pm * BM + wr * 64 + fr, c8 = u.pn * BM + wc * 32 + 8 * fq;
        const float* g1 = mod + ((u.pm * BM) / T_) * 6144 + 2048 + c8;
#pragma unroll
        for (int ai = 0; ai < 2; ++ai)
#pragma unroll
            for (int m = 0; m < 4; ++m) {
                const size_t ro = (size_t)(row0 + ai * HALF + m * 16) * 1024 + c8;
#pragma unroll
                for (int bj = 0; bj < 2; ++bj) {
                    const f32x4 x0 = *(const f32x4*)(x + ro + bj * HALF), x1 = *(const f32x4*)(x + ro + bj * HALF + 4);
                    const f32x4 g0 = *(const f32x4*)(g1 + bj * HALF) + 1.0f, g4 = *(const f32x4*)(g1 + bj * HALF + 4) + 1.0f;
                    *(u32x4*)(z + ro + bj * HALF) = pk8(x0 * ALPHA + g0 * acc[ai][bj][m][0], x1 * ALPHA + g4 * acc[ai][bj][m][1]);
                }
                if (m & 1) asm volatile("" ::: "memory");
            }
    }
};
struct EpiExp1 {
    static constexpr bool PERM = true, AFTER_DRAIN = false, HAS_MID = false;
    bf16_t* U;
    __device__ __forceinline__ void operator()(const f32x4 (&acc)[2][2][4][2], const Unit& u, int wr, int wc, int fr, int fq) const {
        const int row0 = u.pm * BM + wr * 64 + fr, c8 = u.pn * HALF + wc * 32 + 8 * fq;
#pragma unroll
        for (int ai = 0; ai < 2; ++ai)
#pragma unroll
            for (int m = 0; m < 4; ++m) {
                f32x4 r[2];
#pragma unroll
                for (int n = 0; n < 2; ++n)
#pragma unroll
                    for (int j = 0; j < 4; ++j) r[n][j] = siluf_(acc[ai][0][m][n][j]) * acc[ai][1][m][n][j];
                *(u32x4*)(U + (size_t)(row0 + ai * HALF + m * 16) * 512 + c8) = pk8(r[0], r[1]);
            }
    }
};
struct EpiCmpAcc {
    static constexpr bool PERM = false, AFTER_DRAIN = false, HAS_MID = false;
    float* hp;
    __device__ __forceinline__ void operator()(const f32x4 (&acc)[2][2][4][2], const Unit& u, int wr, int wc, int fr, int fq) const {
        const int row0 = u.pn * 512 + u.pm * BM + wr * 64 + fr, col0 = wc * 32 + 4 * fq;
#pragma unroll
        for (int ai = 0; ai < 2; ++ai)
#pragma unroll
            for (int m = 0; m < 4; ++m) { float* rp = hp + (size_t)(row0 + ai * HALF + m * 16) * 128 + col0;
#pragma unroll
                for (int n = 0; n < 2; ++n)
#pragma unroll
                    for (int j = 0; j < 4; ++j) atomicAdd(rp + n * 16 + j, acc[ai][0][m][n][j]); }
    }
};
struct EpiBf {
    static constexpr bool PERM = true, AFTER_DRAIN = false, HAS_MID = false;
    bf16_t* O; int ldo;
    __device__ __forceinline__ void operator()(const f32x4 (&acc)[2][2][4][2], const Unit& u, int wr, int wc, int fr, int fq) const {
        const int row0 = u.pm * BM + wr * 64 + fr, c8 = u.pn * BM + wc * 32 + 8 * fq;
#pragma unroll
        for (int ai = 0; ai < 2; ++ai)
#pragma unroll
            for (int m = 0; m < 4; ++m)
#pragma unroll
                for (int bj = 0; bj < 2; ++bj) *(u32x4*)(O + (size_t)(row0 + ai * HALF + m * 16) * ldo + c8 + bj * HALF) = pk8(acc[ai][bj][m][0], acc[ai][bj][m][1]);
    }
};
template <class Epi, class Sched>
__device__ __forceinline__ void gemm_phase(PG8_LAS unsigned char* lds, const Gemm g, const Sched& S, const Epi& E) {
    const int tid = tid_(), wid = __builtin_amdgcn_readfirstlane(tid >> 6), lane = tid & 63, wr = wid >> 2, wc = wid & 3, fr = lane & 15, fq = lane >> 4;
    const int K = g.K, nt = K / BK;
    unsigned voffA[2], voffB[2];
#pragma unroll
    for (int i = 0; i < 2; ++i) { int R, C; stage_rc(tid * 16 + i * 8192, R, C); const int Rb = Epi::PERM ? ((R & ~31) + perm32(R & 31)) : R;
        voffA[i] = (unsigned)(R * g.lda + C) * 2u; voffB[i] = (unsigned)(Rb * g.ldb + C) * 2u; }
    const size_t kstep = (size_t)(BK * 2);
#define PG8_KA(t) (g.kmode == 1 ? (size_t)((t) >> 1) * (LDP * 2) + (size_t)((t) & 1) * 128 : g.kmode == 2 ? (size_t)(t) * kstep + ((t) >= 16 ? (size_t)2048 : (size_t)0) : (size_t)(t) * kstep)
    const size_t hstepA = Sched::GATHER ? (size_t)0 : (size_t)HALF * g.lda * 2, hstepB = g.bdup ? (size_t)0 : (size_t)HALF * g.ldb * 2;
    const size_t tstepA = 2 * hstepA, tstepB = 2 * hstepB;
    const unsigned ldsw = (unsigned)wid * 1024u;
    const int aoff = lds_byte(wr * 64 + fr, fq * 8), boff = lds_byte(wc * 32 + fr, fq * 8);
#define PG8_SA(b, h) (((b) * 2 + (h)) * HTB)
#define PG8_SB(b, h) ((4 + (b) * 2 + (h)) * HTB)
#define PG8_STAGE(bufoff, gbase, voff) do { _Pragma("unroll") for (int _i = 0; _i < 2; ++_i) \
        __builtin_amdgcn_global_load_lds((const unsigned*)((const char*)(gbase) + (voff)[_i]), (PG8_LAS unsigned*)(lds + (bufoff) + ldsw + _i * 8192), 16, 0, 0); } while (0)
    unsigned gA[2][2] = {{0u, 0u}, {0u, 0u}}, gN[2][2] = {{0u, 0u}, {0u, 0u}};
#define PG8_GMAP(dst, un) do { if constexpr (Sched::GATHER) { _Pragma("unroll") for (int _h = 0; _h < 2; ++_h) _Pragma("unroll") for (int _i = 0; _i < 2; ++_i) { int R_, C_; stage_rc(tid * 16 + _i * 8192, R_, C_); \
        dst[_h][_i] = (unsigned)S.inv[(un).pm * BM + _h * HALF + R_] * (unsigned)(g.lda * 2) + (unsigned)(C_ * 2); } } } while (0)
#define PG8_STAGE_A(bufoff, gbase, h, NX) do { if constexpr (Sched::GATHER) { if (NX) PG8_STAGE(bufoff, gbase, gN[h]); else PG8_STAGE(bufoff, gbase, gA[h]); } \
        else PG8_STAGE(bufoff, (gbase) + ((h) ? hstepA : (size_t)0), voffA); } while (0)
#define PG8_LDA(dst, b, h) do { _Pragma("unroll") for (int m = 0; m < 4; ++m) _Pragma("unroll") for (int k = 0; k < 2; ++k) dst[m][k] = *(const PG8_LAS bf16x8*)(lds + PG8_SA(b, h) + aoff + m * 2048 + k * 1024); } while (0)
#define PG8_LDB(dst, b, h) do { _Pragma("unroll") for (int n = 0; n < 2; ++n) _Pragma("unroll") for (int k = 0; k < 2; ++k) dst[n][k] = *(const PG8_LAS bf16x8*)(lds + PG8_SB(b, h) + boff + n * 2048 + k * 1024); } while (0)
#define PG8_MMA(ai, bj, At, Bt) do { __builtin_amdgcn_s_setprio(1); _Pragma("unroll") for (int m = 0; m < 4; ++m) _Pragma("unroll") for (int n = 0; n < 2; ++n) _Pragma("unroll") for (int k = 0; k < 2; ++k) \
        acc[ai][bj][m][n] = __builtin_amdgcn_mfma_f32_16x16x32_bf16(Bt[n][k], At[m][k], acc[ai][bj][m][n], 0, 0, 0); __builtin_amdgcn_s_setprio(0); } while (0)
#define PG8_WAIT_V(n) asm volatile("s_waitcnt vmcnt(" #n ")" ::: "memory")
#define PG8_WAIT_L(n) asm volatile("s_waitcnt lgkmcnt(" #n ")" ::: "memory")
#define PG8_BAR __builtin_amdgcn_s_barrier()
#define PG8_SCHED __builtin_amdgcn_sched_barrier(0)
    Unit cur, nxt; int ui = 0;
    if (!S.next(0, cur)) return;
    f32x4 acc[2][2][4][2];
#pragma unroll
    for (int a = 0; a < 2; ++a)
#pragma unroll
        for (int b = 0; b < 2; ++b)
#pragma unroll
            for (int m = 0; m < 4; ++m)
#pragma unroll
                for (int n = 0; n < 2; ++n) acc[a][b][m][n] = (f32x4){0.f, 0.f, 0.f, 0.f};
    bf16x8 At[4][2], B0[2][2], B1[2][2];
    const char* cA = (const char*)g.A + cur.aoff + (size_t)cur.pm * tstepA; const char* cB = (const char*)g.Bt + cur.boff + (size_t)cur.pn * tstepB;
    S.a_ready(cur);
    PG8_GMAP(gA, cur);
    PG8_STAGE(PG8_SB(0, 0), cB, voffB); PG8_STAGE_A(PG8_SA(0, 0), cA, 0, false); PG8_STAGE(PG8_SB(0, 1), cB + hstepB, voffB); PG8_STAGE_A(PG8_SA(0, 1), cA, 1, false);
    if (wr == 1) PG8_BAR;
    PG8_WAIT_V(4); PG8_BAR;
    PG8_STAGE(PG8_SB(1, 0), cB + kstep, voffB); PG8_STAGE_A(PG8_SA(1, 0), cA + PG8_KA(1), 0, false); PG8_STAGE(PG8_SB(1, 1), cB + hstepB + kstep, voffB);
    PG8_WAIT_V(6); PG8_BAR;
    for (;;) {
        const bool has_next = S.next(ui + 1, nxt);
        if constexpr (Sched::GATHER) { if (has_next) PG8_GMAP(gN, nxt); else { gN[0][0] = gA[0][0]; gN[0][1] = gA[0][1]; gN[1][0] = gA[1][0]; gN[1][1] = gA[1][1]; } }
        const char* nA = has_next ? (const char*)g.A + nxt.aoff + (size_t)nxt.pm * tstepA : cA; const char* nB = has_next ? (const char*)g.Bt + nxt.boff + (size_t)nxt.pn * tstepB : cB;
        for (int t = 0; t < nt; t += 2) {
            const bool last = (t == nt - 2);
            const char* a1 = cA + PG8_KA(t + 1);
            const char* a2 = last ? nA : cA + PG8_KA(t + 2); const char* b2 = last ? nB : cB + (size_t)(t + 2) * kstep;
            const char* a3 = last ? nA + PG8_KA(1) : cA + PG8_KA(t + 3); const char* b3 = b2 + kstep;
            if (last && has_next) S.a_ready(nxt);
            if constexpr (Epi::HAS_MID) { if (t == 16) E.mid(acc, cur, wr, wc, fr, fq); }
            PG8_LDB(B0, 0, 0); PG8_SCHED; PG8_LDA(At, 0, 0); PG8_STAGE_A(PG8_SA(1, 1), a1, 1, false);
            PG8_WAIT_L(8); PG8_BAR; PG8_WAIT_L(0); PG8_MMA(0, 0, At, B0); PG8_BAR; PG8_SCHED;
            PG8_LDB(B1, 0, 1); PG8_STAGE(PG8_SB(0, 0), b2, voffB);
            PG8_BAR; PG8_WAIT_L(0); PG8_MMA(0, 1, At, B1); PG8_BAR;
            PG8_LDA(At, 0, 1); PG8_STAGE_A(PG8_SA(0, 0), a2, 0, last);
            PG8_BAR; PG8_WAIT_L(0); PG8_MMA(1, 0, At, B0); PG8_BAR; PG8_SCHED;
            PG8_STAGE(PG8_SB(0, 1), b2 + hstepB, voffB);
            PG8_WAIT_V(6); PG8_BAR; PG8_MMA(1, 1, At, B1); PG8_BAR;
            PG8_LDB(B0, 1, 0); PG8_SCHED; PG8_LDA(At, 1, 0); PG8_STAGE_A(PG8_SA(0, 1), a2, 1, last);
            PG8_WAIT_L(8); PG8_BAR; PG8_WAIT_L(0); PG8_MMA(0, 0, At, B0); PG8_BAR; PG8_SCHED;
            PG8_LDB(B1, 1, 1); PG8_STAGE(PG8_SB(1, 0), b3, voffB);
            PG8_BAR; PG8_WAIT_L(0); PG8_MMA(0, 1, At, B1); PG8_BAR;
            PG8_LDA(At, 1, 1); PG8_STAGE_A(PG8_SA(1, 0), a3, 0, last);
            PG8_BAR; PG8_WAIT_L(0); PG8_MMA(1, 0, At, B0); PG8_BAR; PG8_SCHED;
            PG8_STAGE(PG8_SB(1, 1), b3 + hstepB, voffB);
            PG8_WAIT_V(6); PG8_BAR; PG8_MMA(1, 1, At, B1); PG8_BAR;
        }
        if constexpr (!Epi::AFTER_DRAIN) { E(acc, cur, wr, wc, fr, fq); S.done(cur); }
        if (!has_next) break;
#pragma unroll
        for (int a = 0; a < 2; ++a)
#pragma unroll
            for (int b = 0; b < 2; ++b)
#pragma unroll
                for (int m = 0; m < 4; ++m)
#pragma unroll
                    for (int n = 0; n < 2; ++n) acc[a][b][m][n] = (f32x4){0.f, 0.f, 0.f, 0.f};
        cur = nxt; cA = nA; cB = nB; ++ui;
        if constexpr (Sched::GATHER) { gA[0][0] = gN[0][0]; gA[0][1] = gN[0][1]; gA[1][0] = gN[1][0]; gA[1][1] = gN[1][1]; }
    }
    PG8_WAIT_V(0);
    if (wr == 0) PG8_BAR;
    PG8_BAR;
    if constexpr (Epi::AFTER_DRAIN) { E.fused(acc, cur, wr, wc, fr, fq, lds, wid, lane); S.done(cur); }
#undef PG8_SA
#undef PG8_SB
#undef PG8_STAGE
#undef PG8_STAGE_A
#undef PG8_GMAP
#undef PG8_LDA
#undef PG8_LDB
#undef PG8_MMA
#undef PG8_WAIT_V
#undef PG8_WAIT_L
#undef PG8_BAR
#undef PG8_SCHED
#undef PG8_KA
}
}

namespace nsa {
typedef short bf16x8 __attribute__((ext_vector_type(8)));
typedef short s16x4 __attribute__((ext_vector_type(4)));
typedef float f32x16 __attribute__((ext_vector_type(16)));
typedef float f32x4 __attribute__((ext_vector_type(4)));
typedef unsigned u32x4 __attribute__((ext_vector_type(4)));
constexpr int SHM_V = 16384, SHM_K = 16384;
constexpr int L_V = 0, L_K = 32768, L_WS = 65536, L_LUT = 67584, L_IMP = 69632, L_SEL = 102400, L_UNI = 103424, L_TL = 103488, L_END = 104064;
constexpr float LOG2E = 1.4426950408889634f, C2 = 0.08838834764831845f * LOG2E, THR2 = 11.5f;
#define KSWZ(row, colB) ((row) * 256 + ((colB) ^ (((row) & 7) << 4)))
#define SBAR() __builtin_amdgcn_sched_barrier(0)
__device__ __forceinline__ int v_st(int k, int c) { const int kk = (k & ~0xC) | ((k & 4) << 1) | ((k & 8) >> 1); return ((kk >> 3) * 4 + (c >> 5)) * 512 + ((kk & 7) * 32 + (c & 31)) * 2; }
__device__ __forceinline__ int v_rd_base(int lane) { return ((lane & 3) << 3) | (((lane >> 2) & 3) << 6) | (((lane >> 4) & 1) << 5) | (((lane >> 5) & 1) << 8); }
constexpr int v_rd_off(int d0, int ks, int half) { return d0 * 512 + ks * 4096 + half * 2048; }
__device__ __forceinline__ int crow(int r, int hi) { return (r & 3) + 8 * (r >> 2) + 4 * hi; }
__device__ __forceinline__ unsigned cvtpk(float lo, float hi) { unsigned r; asm volatile("v_cvt_pk_bf16_f32 %0, %1, %2" : "=v"(r) : "v"(lo), "v"(hi)); return r; }

template <int KB>
__device__ __forceinline__ void qkt(f32x16& p0, f32x16& p1, const char* K_lds, int r32, int hi, const bf16x8* qr) {
    p0 = f32x16{}; p1 = f32x16{};
    const char* kb[4];
#pragma unroll
    for (int dd = 0; dd < 4; ++dd) kb[dd] = K_lds + KB * SHM_K + KSWZ(r32, (dd * 16 + hi * 8) * 2);
#pragma unroll
    for (int d0 = 0; d0 < 8; ++d0) { const char* a = kb[d0 & 3] + (d0 >> 2) * 128;
        bf16x8 b0 = *reinterpret_cast<const bf16x8*>(a);
        bf16x8 b1 = *reinterpret_cast<const bf16x8*>(a + 32 * 256);
        p0 = __builtin_amdgcn_mfma_f32_32x32x16_bf16(b0, qr[d0], p0, 0, 0, 0);
        p1 = __builtin_amdgcn_mfma_f32_32x32x16_bf16(b1, qr[d0], p1, 0, 0, 0); }
}
template <int VB>
__device__ __forceinline__ void pv_tile(f32x16* o, int vb0, bf16x8 pa0, bf16x8 pa1, bf16x8 pa2, bf16x8 pa3) {
#define TRRD(dst, off) asm volatile("ds_read_b64_tr_b16 %0, %1 offset:%2" : "=&v"(dst) : "v"(vb0), "i"(off) : "memory")
#define PV_D0(d0) do { s16x4 l0, l1, l2, l3, h0, h1, h2, h3; constexpr int b_ = VB * SHM_V + v_rd_off(d0, 0, 0); \
        TRRD(l0, b_); TRRD(h0, b_ + 2048); TRRD(l1, b_ + 4096); TRRD(h1, b_ + 6144); TRRD(l2, b_ + 8192); TRRD(h2, b_ + 10240); TRRD(l3, b_ + 12288); TRRD(h3, b_ + 14336); \
        asm volatile("s_waitcnt lgkmcnt(0)" ::: "memory"); SBAR(); \
        o[d0] = __builtin_amdgcn_mfma_f32_32x32x16_bf16(pa0, (bf16x8){l0[0], l0[1], l0[2], l0[3], h0[0], h0[1], h0[2], h0[3]}, o[d0], 0, 0, 0); \
        o[d0] = __builtin_amdgcn_mfma_f32_32x32x16_bf16(pa1, (bf16x8){l1[0], l1[1], l1[2], l1[3], h1[0], h1[1], h1[2], h1[3]}, o[d0], 0, 0, 0); \
        o[d0] = __builtin_amdgcn_mfma_f32_32x32x16_bf16(pa2, (bf16x8){l2[0], l2[1], l2[2], l2[3], h2[0], h2[1], h2[2], h2[3]}, o[d0], 0, 0, 0); \
        o[d0] = __builtin_amdgcn_mfma_f32_32x32x16_bf16(pa3, (bf16x8){l3[0], l3[1], l3[2], l3[3], h3[0], h3[1], h3[2], h3[3]}, o[d0], 0, 0, 0); } while (0)
    PV_D0(0); PV_D0(1); PV_D0(2); PV_D0(3);
#undef PV_D0
#undef TRRD
}
__device__ __forceinline__ void mask_tile(f32x16& p0, f32x16& p1, int dq, unsigned W) {
    const float NEG = -__builtin_inff();
    asm volatile("" : "+v"(dq));
#pragma unroll
    for (int r = 0; r < 16; ++r) {
        const int c = (r & 3) + 8 * (r >> 2);
        if ((unsigned)(dq - c) >= W) p0[r] = NEG;
        if ((unsigned)(dq - c - 32) >= W) p1[r] = NEG;
    }
}
template <int STRIDE>
__device__ __forceinline__ void bias_near(f32x16& p0, f32x16& p1, int dbase, const float* lut) {
    asm volatile("" : "+v"(dbase));
#pragma unroll
    for (int r = 0; r < 16; ++r) {
        const int c = (r & 3) + 8 * (r >> 2);
        int d0 = dbase - STRIDE * c, d1 = dbase - STRIDE * (c + 32);
        d0 = d0 < 0 ? 0 : (d0 > 127 ? 127 : d0); d1 = d1 < 0 ? 0 : (d1 > 127 ? 127 : d1);
        p0[r] = fmaf(p0[r], C2, lut[d0]); p1[r] = fmaf(p1[r], C2, lut[d1]);
    }
}
__device__ __forceinline__ void bias_const(f32x16& p0, f32x16& p1, float cb) {
#pragma unroll
    for (int r = 0; r < 16; ++r) { p0[r] = fmaf(p0[r], C2, cb); p1[r] = fmaf(p1[r], C2, cb); }
}
__device__ __forceinline__ float half_max(float v) { auto rr = __builtin_amdgcn_permlane32_swap(__float_as_uint(v), __float_as_uint(v), false, false); return fmaxf(__uint_as_float(rr[0]), __uint_as_float(rr[1])); }
__device__ __forceinline__ float half_sum(float v) { auto rr = __builtin_amdgcn_permlane32_swap(__float_as_uint(v), __float_as_uint(v), false, false); return __uint_as_float(rr[0]) + __uint_as_float(rr[1]); }
__device__ __forceinline__ void softmax_online(f32x16& p0, f32x16& p1, float sc, float cb2, bool sel, float& m, float& l, float& alpha) {
    float pmax = p0[0];
#pragma unroll
    for (int r = 1; r < 16; ++r) pmax = fmaxf(pmax, p0[r]);
#pragma unroll
    for (int r = 0; r < 16; ++r) pmax = fmaxf(pmax, p1[r]);
    pmax = half_max(pmax);
    pmax = sel ? fmaf(pmax, sc, cb2) : -__builtin_inff();
    if (__all(pmax - m <= THR2)) alpha = 1.f;
    else { const float mn = fmaxf(m, pmax); alpha = __builtin_amdgcn_exp2f(m - mn); m = mn; }
    const float off = sel ? cb2 - m : -__builtin_inff();
#pragma unroll
    for (int r = 0; r < 16; ++r) { p0[r] = fmaf(p0[r], sc, off); p1[r] = fmaf(p1[r], sc, off); }
    SBAR();
#pragma unroll
    for (int r = 0; r < 16; ++r) { p0[r] = __builtin_amdgcn_exp2f(p0[r]); p1[r] = __builtin_amdgcn_exp2f(p1[r]); }
    SBAR();
    float ps = 0.f;
#pragma unroll
    for (int r = 0; r < 16; ++r) ps += p0[r] + p1[r];
    l = l * alpha + half_sum(ps);
}
__device__ __forceinline__ void pack_p(const f32x16& p0, const f32x16& p1, bf16x8& pa0, bf16x8& pa1, bf16x8& pa2, bf16x8& pa3) {
#define PK4(P, B_, OUT) do { unsigned a0 = cvtpk(P[B_+0], P[B_+1]), a1 = cvtpk(P[B_+2], P[B_+3]); \
        unsigned b0 = cvtpk(P[B_+4], P[B_+5]), b1 = cvtpk(P[B_+6], P[B_+7]); \
        auto r0 = __builtin_amdgcn_permlane32_swap(a0, b0, false, false); auto r1 = __builtin_amdgcn_permlane32_swap(a1, b1, false, false); \
        u32x4 w = {r0[0], r1[0], r0[1], r1[1]}; OUT = *reinterpret_cast<bf16x8*>(&w); } while (0)
    PK4(p0, 0, pa0); PK4(p0, 8, pa1); PK4(p1, 0, pa2); PK4(p1, 8, pa3);
#undef PK4
}
__device__ __forceinline__ void rescale_o(f32x16* o, float alpha, float* al_l, int r32, int hi) {
    if (__any(alpha < 1.f)) {
        if (hi == 0) al_l[r32] = alpha;
        asm volatile("s_waitcnt lgkmcnt(0)" ::: "memory");
#pragma unroll
        for (int r = 0; r < 16; ++r) { const float a = al_l[crow(r, hi)];
#pragma unroll
            for (int d = 0; d < 4; ++d) o[d][r] *= a; }
    }
}
__device__ __forceinline__ void flush_out(const f32x16* o, float lsum, int br, unsigned char* ws, char* lds, int b, int g, int qb, int wid, int lane_in, bool first) {
    int lane = lane_in; asm volatile("" : "+v"(lane));
    const int r32 = lane & 31, hi = lane >> 5, head = g * 4 + (wid >> 1);
    const size_t tok = (size_t)b * T_ + qb * 64 + (wid & 1) * 32;
    float* li_l = (float*)(lds + L_WS) + wid * 64;
    bf16_t* tb = (bf16_t*)(lds + wid * 8192);
    bf16_t* orow = (bf16_t*)(ws + OFF_PROJ) + tok * LDP + C_NQ + head * 128;
    const float gate = ((const float*)(ws + OFF_GATE))[(tok + r32) * 24 + head * 3 + br];
    const float f_lane = br == 0 ? gate : (lsum > 0.f ? gate / lsum : 0.f);
    if (hi == 0) li_l[r32] = f_lane;
    asm volatile("s_waitcnt lgkmcnt(0)" ::: "memory");
#pragma unroll
    for (int r = 0; r < 16; ++r) {
        const float f = li_l[crow(r, hi)];
#pragma unroll
        for (int d = 0; d < 4; ++d) tb[crow(r, hi) * 128 + d * 32 + r32] = f2bf(o[d][r] * f);
    }
    asm volatile("s_waitcnt lgkmcnt(0)" ::: "memory");
    uint4 gq[8];
    if (!first) {
#pragma unroll
        for (int i = 0; i < 8; ++i) { const int idx = i * 64 + lane, row = idx >> 4, ch = idx & 15; gq[i] = *(const uint4*)(orow + (size_t)row * LDP + ch * 8); }
    }
#pragma unroll
    for (int i = 0; i < 8; ++i) {
        const int idx = i * 64 + lane, row = idx >> 4, ch = idx & 15;
        uint4 w = *(const uint4*)(tb + row * 128 + ch * 8);
        uint4* gp = (uint4*)(orow + (size_t)row * LDP + ch * 8);
        if (!first) {
            const uint4 g = gq[i];
            w.x = cvtpk(__uint_as_float(w.x << 16) + __uint_as_float(g.x << 16), __uint_as_float(w.x & 0xFFFF0000u) + __uint_as_float(g.x & 0xFFFF0000u));
            w.y = cvtpk(__uint_as_float(w.y << 16) + __uint_as_float(g.y << 16), __uint_as_float(w.y & 0xFFFF0000u) + __uint_as_float(g.y & 0xFFFF0000u));
            w.z = cvtpk(__uint_as_float(w.z << 16) + __uint_as_float(g.z << 16), __uint_as_float(w.z & 0xFFFF0000u) + __uint_as_float(g.z & 0xFFFF0000u));
            w.w = cvtpk(__uint_as_float(w.w << 16) + __uint_as_float(g.w << 16), __uint_as_float(w.w & 0xFFFF0000u) + __uint_as_float(g.w & 0xFFFF0000u));
        }
        *gp = w;
    }
}

struct Src { const bf16_t* K; const bf16_t* V; int stride; };

template <int MODE>
__device__ __forceinline__ void branch(const Src s, char* lds, const bf16x8* qr, f32x16* o, float& m, float& l, int NTL, int jbase, int t, int qb, int wid, int lane, int tid,
                                       const unsigned (&selw)[4], float inv_l) {
    const int r32 = lane & 31, hi = lane >> 5, rh = wid >> 1, iq = (wid & 1) * 32 + r32;
    char* V_lds = lds + L_V; char* K_lds = lds + L_K;
    float* al_l = (float*)(lds + L_WS) + wid * 64 + 32;
    const float* lut = (const float*)(lds + L_LUT) + rh * 128;
    const int* tl = (const int*)(lds + L_TL);
    float* impL = (float*)(lds + L_IMP);
    const int vb0 = (int)(uintptr_t)V_lds + v_rd_base(lane);
    const float cb = lut[127];
    constexpr bool HASV = MODE != 0;
    LAS unsigned char* ldsl = (LAS unsigned char*)lds;
#define TILE_OF(n) (MODE == 2 ? tl[n] : jbase + (n))
#define DMA(j, bf) do { const bf16_t* kt_ = s.K + (size_t)(j) * 64 * s.stride; const bf16_t* vt_ = s.V + (size_t)(j) * 64 * s.stride; \
        int ln_ = lane; asm volatile("" : "+v"(ln_));        \
        _Pragma("unroll") for (int i_ = 0; i_ < 2; ++i_) { \
            const int row_ = i_ * 32 + wid * 4 + (ln_ >> 4), srcch_ = (ln_ & 15) ^ (row_ & 7); \
            __builtin_amdgcn_global_load_lds((const unsigned*)(kt_ + (row_ * s.stride + srcch_ * 8)), (LAS unsigned*)(ldsl + L_K + (bf) * SHM_K + i_ * 8192 + wid * 1024), 16, 0, 0); \
            if (HASV) { const int kk_ = (i_ * 4 + (wid >> 1)) * 8 + ((ln_ & 31) >> 2), k_ = (kk_ & ~0xC) | ((kk_ & 4) << 1) | ((kk_ & 8) >> 1), cc_ = ((wid & 1) * 2 + (ln_ >> 5)) * 32 + (ln_ & 3) * 8; \
                __builtin_amdgcn_global_load_lds((const unsigned*)(vt_ + (k_ * s.stride + cc_)), (LAS unsigned*)(ldsl + L_V + (bf) * SHM_V + i_ * 8192 + wid * 1024), 16, 0, 0); } } } while (0)
#define COMPUTE(n, BF) do { const int j_ = TILE_OF(n); \
        bool act_ = true; bool rowsel_ = true; \
        if (MODE == 2) { const unsigned w_ = j_ < 32 ? selw[0] : j_ < 64 ? selw[1] : j_ < 96 ? selw[2] : selw[3]; rowsel_ = (w_ >> (j_ & 31)) & 1u; act_ = __any(rowsel_); } \
        if (act_) { f32x16 p0, p1; \
            qkt<BF>(p0, p1, K_lds, r32, hi, qr); \
              \
            const bool plain_ = MODE >= 2 && (qb - j_ > 2) && !(MODE == 3 && j_ == qb - 8); \
            float sc_ = C2, cb_ = cb; bool sel_ = rowsel_; \
            if (!plain_) { sc_ = 1.f; cb_ = 0.f; sel_ = true; \
                if (MODE <= 1) { \
                    if (64 * j_ + 63 >= 4 * qb - 10) bias_near<16>(p0, p1, t - 31 - 16 * (64 * j_ + 4 * hi), lut); else bias_const(p0, p1, cb); \
                    if (64 * j_ + 63 > ((64 * qb - 31) >> 4)) mask_tile(p0, p1, ((t - 31) >> 4) - 64 * j_ - 4 * hi, 1u << 30); \
                } else { \
                    bias_near<1>(p0, p1, t - 64 * j_ - 4 * hi, lut); \
                    if (MODE == 2) { if (j_ == qb) mask_tile(p0, p1, t - 64 * j_ - 4 * hi, 1u << 30); \
                        if (!rowsel_) { const float NEG_ = -__builtin_inff(); _Pragma("unroll") for (int r = 0; r < 16; ++r) { p0[r] = NEG_; p1[r] = NEG_; } } } \
                    else { if (j_ == qb || j_ == qb - 8) mask_tile(p0, p1, t - 64 * j_ - 4 * hi, 512u); } \
                } \
            } \
            if (MODE == 1) { \
                _Pragma("unroll") for (int r = 0; r < 16; ++r) { p0[r] = __builtin_amdgcn_exp2f(p0[r] - m) * inv_l; p1[r] = __builtin_amdgcn_exp2f(p1[r] - m) * inv_l; } \
                _Pragma("unroll") for (int a = 0; a < 4; ++a) { \
                    const int jj0 = 16 * j_ + 2 * a + hi, jj1 = jj0 + 8; \
                    atomicAdd(&impL[iq * 128 + jj0], p0[4 * a] + p0[4 * a + 1] + p0[4 * a + 2] + p0[4 * a + 3]); \
                    atomicAdd(&impL[iq * 128 + jj1], p1[4 * a] + p1[4 * a + 1] + p1[4 * a + 2] + p1[4 * a + 3]); \
                    if (jj0 + 1 < 128) atomicAdd(&impL[iq * 128 + jj0 + 1], p0[4 * a + 3]); \
                    if (jj1 + 1 < 128) atomicAdd(&impL[iq * 128 + jj1 + 1], p1[4 * a + 3]); } \
            } else { float alpha_; softmax_online(p0, p1, sc_, cb_, sel_, m, l, alpha_); if (MODE != 0) rescale_o(o, alpha_, al_l, r32, hi); } \
            if (MODE != 0) { bf16x8 pa0, pa1, pa2, pa3; pack_p(p0, p1, pa0, pa1, pa2, pa3); pv_tile<BF>(o, vb0, pa0, pa1, pa2, pa3); } \
        } } while (0)
#define STEP(n, BF) do { \
        if ((n) + 1 < NTL) DMA(TILE_OF((n) + 1), 1 - (BF)); \
        SBAR(); COMPUTE(n, BF); SBAR(); \
        asm volatile("s_waitcnt vmcnt(0)" ::: "memory"); \
        __syncthreads(); } while (0)
    if (NTL > 0) {
        DMA(TILE_OF(0), 0); asm volatile("s_waitcnt vmcnt(0)" ::: "memory");
        __syncthreads();
        for (int n = 0; n < NTL; n += 2) { STEP(n, 0); if (n + 1 < NTL) STEP(n + 1, 1); }
    }
#undef TILE_OF
#undef DMA
#undef COMPUTE
#undef STEP
}

__device__ __forceinline__ void item(unsigned char* ws, int b, int g, int qb, char* lds) {
    const int tid = tid_(), wid = __builtin_amdgcn_readfirstlane(tid >> 6), lane = tid & 63, r32 = lane & 31, hi = lane >> 5, rh = wid >> 1, iq = (wid & 1) * 32 + r32;
    const int t = qb * 64 + iq, head = g * 4 + rh;
    bf16_t* proj = (bf16_t*)(ws + OFF_PROJ);
    const size_t tok0 = (size_t)b * T_;
    float* impL = (float*)(lds + L_IMP); unsigned* selL = (unsigned*)(lds + L_SEL); unsigned* uniL = (unsigned*)(lds + L_UNI); int* tl = (int*)(lds + L_TL);
    for (int i = tid; i < 64 * 128; i += 512) impL[i] = 0.f;
    if (tid < 4) uniL[tid] = 0u;
    { const float* lutg = (const float*)(ws + OFF_LUT) + (g * 4) * 128; ((float*)(lds + L_LUT))[tid] = lutg[tid] * LOG2E; }
    bf16x8 qr[8];
    { const bf16_t* qp = proj + (tok0 + t) * LDP + C_NQ + head * 128 + hi * 8;
#pragma unroll
      for (int d0 = 0; d0 < 8; ++d0) qr[d0] = *(const bf16x8*)(qp + d0 * 16); }
    unsigned selw[4] = {0u, 0u, 0u, 0u};
    f32x16 o[4];
    __syncthreads();
    {
        const Src s{(const bf16_t*)(ws + OFF_KCMP) + (size_t)(b * 2 + g) * 512 * 128, (const bf16_t*)(ws + OFF_VCMP) + (size_t)(b * 2 + g) * 512 * 128, 128};
        const int nct = ((4 * qb + 2) >> 6) + 1;
        float m = -1e30f, l = 0.f;
        branch<0>(s, lds, qr, o, m, l, nct, 0, t, qb, wid, lane, tid, selw, 0.f);
#pragma unroll
        for (int d = 0; d < 4; ++d) o[d] = f32x16{};
        const float inv_l = l > 0.f ? 1.f / l : 0.f;
        branch<1>(s, lds, qr, o, m, l, nct, 0, t, qb, wid, lane, tid, selw, inv_l);
        flush_out(o, 1.f, 0, ws, lds, b, g, qb, wid, lane, true);
    }
    __syncthreads();
    {
        const int q = wid * 8 + (lane >> 3), sub = lane & 7;
        unsigned m0 = 0u, m1 = 0u, m2 = 0u, m3 = 0u;
        if (qb <= 15) { m0 = qb == 31 ? 0xFFFFFFFFu : ((1u << (qb + 1)) - 1u); }
        else {
            unsigned key[16];
#pragma unroll
            for (int k = 0; k < 16; ++k) { const int j = sub * 16 + k; key[k] = (j >= 1 && j <= qb - 2) ? ((__float_as_uint(impL[q * 128 + j]) & ~0x7Fu) | (unsigned)(127 - j)) : 0u; }
            for (int it = 0; it < 13; ++it) {
                unsigned lm = key[0];
#pragma unroll
                for (int k = 1; k < 16; ++k) lm = lm > key[k] ? lm : key[k];
                unsigned gm = lm, x;
                x = (unsigned)__builtin_amdgcn_update_dpp(0, (int)gm, 0xB1, 0xF, 0xF, true); gm = gm > x ? gm : x;
                x = (unsigned)__builtin_amdgcn_update_dpp(0, (int)gm, 0x4E, 0xF, 0xF, true); gm = gm > x ? gm : x;
                x = (unsigned)__builtin_amdgcn_update_dpp(0, (int)gm, 0x141, 0xF, 0xF, true); gm = gm > x ? gm : x;
#pragma unroll
                for (int k = 0; k < 16; ++k) key[k] = key[k] == gm ? 0u : key[k];
                const int j = 127 - (int)(gm & 0x7Fu);
                const unsigned bit = 1u << (j & 31);
                m0 |= j < 32 ? bit : 0u; m1 |= (j >= 32 && j < 64) ? bit : 0u; m2 |= (j >= 64 && j < 96) ? bit : 0u; m3 |= j >= 96 ? bit : 0u;
            }
            m0 |= 1u;
            { const int j = qb; const unsigned bit = 1u << (j & 31); m0 |= j < 32 ? bit : 0u; m1 |= (j >= 32 && j < 64) ? bit : 0u; m2 |= (j >= 64 && j < 96) ? bit : 0u; m3 |= j >= 96 ? bit : 0u; }
            { const int j = qb - 1; const unsigned bit = 1u << (j & 31); m0 |= j < 32 ? bit : 0u; m1 |= (j >= 32 && j < 64) ? bit : 0u; m2 |= (j >= 64 && j < 96) ? bit : 0u; m3 |= j >= 96 ? bit : 0u; }
        }
        if (sub == 0) { selL[q * 4 + 0] = m0; selL[q * 4 + 1] = m1; selL[q * 4 + 2] = m2; selL[q * 4 + 3] = m3;
                        atomicOr(&uniL[0], m0); atomicOr(&uniL[1], m1); atomicOr(&uniL[2], m2); atomicOr(&uniL[3], m3); }
    }
    __syncthreads();
    int nsl = 0;
    {
        if (wid == 0) {
            const bool s0 = lane <= qb && ((uniL[lane >> 5] >> (lane & 31)) & 1u), s1 = lane + 64 <= qb && ((uniL[2 + (lane >> 5)] >> (lane & 31)) & 1u);
            const unsigned long long b0 = __ballot(s0), b1 = __ballot(s1), below = (1ull << lane) - 1ull;
            const int n0 = __popcll(b0);
            if (s0) tl[__popcll(b0 & below)] = lane;
            if (s1) tl[n0 + __popcll(b1 & below)] = lane + 64;
            if (lane == 0) tl[128] = n0 + __popcll(b1);
        }
        selw[0] = selL[iq * 4 + 0]; selw[1] = selL[iq * 4 + 1]; selw[2] = selL[iq * 4 + 2]; selw[3] = selL[iq * 4 + 3];
        __syncthreads();
        nsl = tl[128];
    }
    {
        const Src s{proj + tok0 * LDP + C_KS + g * 128, proj + tok0 * LDP + C_VS + g * 128, LDP};
        float m = -1e30f, l = 0.f;
#pragma unroll
        for (int d = 0; d < 4; ++d) o[d] = f32x16{};
        branch<2>(s, lds, qr, o, m, l, nsl, 0, t, qb, wid, lane, tid, selw, 0.f);
        flush_out(o, l, 1, ws, lds, b, g, qb, wid, lane, false);
    }
    __syncthreads();
    {
        const Src s{proj + tok0 * LDP + C_KW + g * 128, proj + tok0 * LDP + C_VW + g * 128, LDP};
        const int jlo = qb >= 8 ? qb - 8 : 0;
        float m = -1e30f, l = 0.f;
#pragma unroll
        for (int d = 0; d < 4; ++d) o[d] = f32x16{};
        branch<3>(s, lds, qr, o, m, l, qb - jlo + 1, jlo, t, qb, wid, lane, tid, selw, 0.f);
        flush_out(o, l, 2, ws, lds, b, g, qb, wid, lane, false);
    }
    __syncthreads();
}
#undef KSWZ
#undef SBAR
}

__device__ void ph_hpre(const Params& p, int u) {
    const int tid = tid_(), b = u >> 8, n = u & 255, c2 = tid * 2;
    char* proj = (char*)(p.ws + OFF_PROJ) + (size_t)(b * T_ + n * 32) * (LDP * 2);
    const unsigned vo = (unsigned)c2 * 2u;
    const float* lb = (const float*)(p.ws + OFF_LB);
    const float kb0 = 1.f - lb[c2], kb1 = 1.f - lb[c2 + 1];
    float b0[32], b1[32];
    unsigned wf[32], wq[32];
#pragma unroll
    for (int i = 0; i < 32; ++i) wf[i] = *(const unsigned*)(proj + ((size_t)i * (LDP * 2) + C_HF * 2) + vo);
#pragma unroll
    for (int i = 0; i < 32; ++i) wq[i] = *(const unsigned*)(proj + ((size_t)i * (LDP * 2) + C_HQ * 2) + vo);
    float s0 = 1.f, s1 = 1.f;
#pragma unroll
    for (int i = 0; i < 32; ++i) {
        const float r0 = __uint_as_float(wf[i] << 16), r1 = __uint_as_float(wf[i] & 0xFFFF0000u);
        const float k0 = kb0 * sigmoidf_(-r0), k1 = kb1 * sigmoidf_(-r1);
        s0 *= 1.f - k0; s1 *= 1.f - k1;
        b0[i] = s0; b1[i] = s1;
        wf[i] = pg8::cvt_pk_bf16(k0, k1);
    }
    const float il0 = __builtin_amdgcn_rcpf(fmaxf(s0, 1e-30f)), il1 = __builtin_amdgcn_rcpf(fmaxf(s1, 1e-30f));
#pragma unroll
    for (int i = 0; i < 32; ++i) {
        const float k0 = __uint_as_float(wf[i] << 16), k1 = __uint_as_float(wf[i] & 0xFFFF0000u);
        const float q0 = __uint_as_float(wq[i] << 16), q1 = __uint_as_float(wq[i] & 0xFFFF0000u);
        const float e0 = s0 * __builtin_amdgcn_rcpf(fmaxf(b0[i], 1e-30f)), e1 = s1 * __builtin_amdgcn_rcpf(fmaxf(b1[i], 1e-30f));
        unsigned long long ro = (unsigned long long)i * (LDP * 2); asm volatile("" : "+s"(ro));
        char* rp = proj + ro + vo;
        *(unsigned*)(rp + C_HQ * 2) = pg8::cvt_pk_bf16(q0 * (b0[i] * il0), q1 * (b1[i] * il1));
        *(unsigned*)(rp + C_HF * 2) = pg8::cvt_pk_bf16(k0 * e0, k1 * e1);
    }
    float* dec = (float*)(p.ws + OFF_DEC) + ((size_t)((b * 8 + (c2 >> 7)) * 256 + n)) * 256 + (c2 & 127);
    dec[0] = s0; dec[1] = s1;
}

namespace hg {
typedef short bf16x8 __attribute__((ext_vector_type(8)));
typedef short s16x4 __attribute__((ext_vector_type(4)));
typedef float f32x4 __attribute__((ext_vector_type(4)));
typedef unsigned u32x4 __attribute__((ext_vector_type(4)));
constexpr int BUF = 25600, L_QA = 0, L_KE = 8192, L_VV = 16384, L_DEC = 24576, L_OB = 51200, OBS = 132;
__device__ __forceinline__ unsigned off_b(unsigned row, unsigned ch) { return 256u * row + 16u * (ch ^ (((row & 3) << 2) | ((row >> 2) & 3))); }
__device__ __forceinline__ unsigned tr_addr16(unsigned lane, unsigned c, unsigned t) {
    const unsigned g = lane >> 4, q = (lane & 15) >> 2, pp = lane & 3;
    return off_b(8 * g + 4 * t + q, 2 * c + (pp >> 1)) + 8 * (pp & 1);
}
__device__ __forceinline__ unsigned cvtpk(float lo, float hi) { unsigned r; asm volatile("v_cvt_pk_bf16_f32 %0, %1, %2" : "=v"(r) : "v"(lo), "v"(hi)); return r; }
__device__ __forceinline__ bf16x8 pack8(f32x4 a, f32x4 b) { u32x4 w = {cvtpk(a[0], a[1]), cvtpk(a[2], a[3]), cvtpk(b[0], b[1]), cvtpk(b[2], b[3])}; return *reinterpret_cast<bf16x8*>(&w); }
__device__ __forceinline__ s16x4 tr_read(unsigned addr) { s16x4 r; asm volatile("ds_read_b64_tr_b16 %0, %1" : "=v"(r) : "v"(addr) : "memory"); return r; }

__device__ __forceinline__ void item(unsigned char* ws, const float* norm_w, int b, int h, char* lds) {
    const int tid = tid_(), wid = __builtin_amdgcn_readfirstlane(tid >> 6), lane = tid & 63, l15 = lane & 15, g = lane >> 4;
    bf16_t* proj = (bf16_t*)(ws + OFF_PROJ) + (size_t)b * T_ * LDP + h * 128;
    const float* decg = (const float*)(ws + OFF_DEC) + (size_t)(b * 8 + h) * 256 * 256;
    LAS unsigned char* ldsl = (LAS unsigned char*)lds;
    const unsigned ldsb = (unsigned)(uintptr_t)lds;
    const int drow = 4 * wid + (lane >> 4);
    const unsigned dsrc = (unsigned)(drow * LDP + (((lane & 15) ^ (((drow & 3) << 2) | ((drow >> 2) & 3))) * 8));
#define HDMA(n, bf) do { const bf16_t* cp_ = proj + (size_t)(n) * 32 * LDP + dsrc; \
        __builtin_amdgcn_global_load_lds((const unsigned*)(cp_ + C_HQ), (LAS unsigned*)(ldsl + (bf) * BUF + L_QA + wid * 1024), 16, 0, 0); \
        __builtin_amdgcn_global_load_lds((const unsigned*)(cp_ + C_HF), (LAS unsigned*)(ldsl + (bf) * BUF + L_KE + wid * 1024), 16, 0, 0); \
        __builtin_amdgcn_global_load_lds((const unsigned*)(cp_ + C_HI), (LAS unsigned*)(ldsl + (bf) * BUF + L_VV + wid * 1024), 16, 0, 0); \
        if (wid == 0) __builtin_amdgcn_global_load_lds((const unsigned*)(decg + (size_t)(n) * 256 + lane * 4), (LAS unsigned*)(ldsl + (bf) * BUF + L_DEC), 16, 0, 0); } while (0)
    unsigned a_ke[2], a_qa[2], a_qp[2], a_vt[2];
#pragma unroll
    for (int x = 0; x < 2; ++x) {
        a_ke[x] = off_b(8 * (l15 >> 2) + 4 * x + (l15 & 3), g);
        a_qa[x] = off_b(16 * x + l15, g);
        a_qp[x] = off_b(16 * x + l15, g >> 1) + 8 * (g & 1);
        a_vt[x] = tr_addr16(lane, wid, x);
    }
    const int ntok = tid >> 4, ndv = (tid & 15) * 8;
    f32x4 S[8];
#pragma unroll
    for (int i = 0; i < 8; ++i) S[i] = (f32x4){0.f, 0.f, 0.f, 0.f};
    float* obuf = (float*)(lds + L_OB);
    HDMA(0, 0); asm volatile("s_waitcnt vmcnt(0)" ::: "memory");
    __syncthreads();
    for (int n = 0; n < 256; ++n) {
        const int bf = n & 1;
        if (n + 1 < 256) HDMA(n + 1, bf ^ 1);
        const u32x4 hgw = *(const u32x4*)(proj + (size_t)(n * 32 + ntok) * LDP + C_HG + ndv);
        const unsigned B0 = ldsb + bf * BUF;
        f32x4 att[2][2];
#pragma unroll
        for (int x = 0; x < 2; ++x)
#pragma unroll
            for (int y = 0; y < 2; ++y) att[x][y] = (f32x4){0.f, 0.f, 0.f, 0.f};
#pragma unroll
        for (int ks = 0; ks < 4; ++ks) {
            bf16x8 ka[2], qb[2];
#pragma unroll
            for (int x = 0; x < 2; ++x) {
                const unsigned rj = 8 * (l15 >> 2) + 4 * x + (l15 & 3), ri = 16 * x + l15;
                ka[x] = *(const LAS bf16x8*)(uintptr_t)(B0 + L_KE + off_b(rj, 4 * ks + g));
                qb[x] = *(const LAS bf16x8*)(uintptr_t)(B0 + L_QA + off_b(ri, 4 * ks + g));
            }
#pragma unroll
            for (int x = 0; x < 2; ++x)
#pragma unroll
                for (int y = 0; y < 2; ++y) att[x][y] = __builtin_amdgcn_mfma_f32_16x16x32_bf16(ka[x], qb[y], att[x][y], 0, 0, 0);
        }
        bf16x8 attf[2];
#pragma unroll
        for (int y = 0; y < 2; ++y) {
            const int i = 16 * y + l15;
            f32x4 a0 = att[0][y], a1 = att[1][y];
#pragma unroll
            for (int r = 0; r < 4; ++r) { if (8 * g + r > i) a0[r] = 0.f; if (8 * g + 4 + r > i) a1[r] = 0.f; }
            attf[y] = pack8(a0, a1);
        }
        bf16x8 vf;
        { const s16x4 v0 = tr_read(B0 + L_VV + a_vt[0]), v1 = tr_read(B0 + L_VV + a_vt[1]);
          asm volatile("s_waitcnt lgkmcnt(0)" ::: "memory");
          vf = (bf16x8){v0[0], v0[1], v0[2], v0[3], v1[0], v1[1], v1[2], v1[3]}; }
        f32x4 o[2];
#pragma unroll
        for (int y = 0; y < 2; ++y) o[y] = __builtin_amdgcn_mfma_f32_16x16x32_bf16(vf, attf[y], (f32x4){0.f, 0.f, 0.f, 0.f}, 0, 0, 0);
#pragma unroll
        for (int dt = 0; dt < 8; ++dt) { const f32x4 d = *(const LAS f32x4*)(uintptr_t)(B0 + L_DEC + (16 * dt + 4 * g) * 4); S[dt] *= d; }
#pragma unroll
        for (int ks = 0; ks < 4; ++ks) {
            const bf16x8 sa = pack8(S[2 * ks], S[2 * ks + 1]);
#pragma unroll
            for (int y = 0; y < 2; ++y) {
                const unsigned ri = 16 * y + l15;
                const unsigned long long q0 = *(const LAS unsigned long long*)(uintptr_t)(B0 + L_QA + off_b(ri, 4 * ks + (g >> 1)) + 8 * (g & 1));
                const unsigned long long q1 = *(const LAS unsigned long long*)(uintptr_t)(B0 + L_QA + off_b(ri, 4 * ks + 2 + (g >> 1)) + 8 * (g & 1));
                u32x4 w = {(unsigned)q0, (unsigned)(q0 >> 32), (unsigned)q1, (unsigned)(q1 >> 32)};
                o[y] = __builtin_amdgcn_mfma_f32_16x16x32_bf16(sa, *reinterpret_cast<bf16x8*>(&w), o[y], 0, 0, 0);
            }
        }
#pragma unroll
        for (int dt = 0; dt < 8; ++dt) {
            const s16x4 k0 = tr_read(B0 + L_KE + tr_addr16(lane, dt, 0)), k1 = tr_read(B0 + L_KE + tr_addr16(lane, dt, 1));
            asm volatile("s_waitcnt lgkmcnt(0)" ::: "memory");
            const bf16x8 kf = (bf16x8){k0[0], k0[1], k0[2], k0[3], k1[0], k1[1], k1[2], k1[3]};
            S[dt] = __builtin_amdgcn_mfma_f32_16x16x32_bf16(kf, vf, S[dt], 0, 0, 0);
        }
#pragma unroll
        for (int y = 0; y < 2; ++y) *(f32x4*)(obuf + (16 * y + l15) * OBS + 16 * wid + 4 * g) = o[y];
        __syncthreads();
        {
            const f32x4 x0 = *(const f32x4*)(obuf + ntok * OBS + ndv), x1 = *(const f32x4*)(obuf + ntok * OBS + ndv + 4);
            float ss = x0[0] * x0[0] + x0[1] * x0[1] + x0[2] * x0[2] + x0[3] * x0[3] + x1[0] * x1[0] + x1[1] * x1[1] + x1[2] * x1[2] + x1[3] * x1[3];
            ss += __shfl_xor(ss, 1); ss += __shfl_xor(ss, 2); ss += __shfl_xor(ss, 4); ss += __shfl_xor(ss, 8);
            const float r = rsqrtf(ss * (1.f / 128.f) + 1e-6f);
            const float gv[8] = {__uint_as_float(hgw.x << 16), __uint_as_float(hgw.x & 0xFFFF0000u), __uint_as_float(hgw.y << 16), __uint_as_float(hgw.y & 0xFFFF0000u),
                                 __uint_as_float(hgw.z << 16), __uint_as_float(hgw.z & 0xFFFF0000u), __uint_as_float(hgw.w << 16), __uint_as_float(hgw.w & 0xFFFF0000u)};
            const float xv[8] = {x0[0], x0[1], x0[2], x0[3], x1[0], x1[1], x1[2], x1[3]};
            const f32x4 n0 = *(const f32x4*)(norm_w + h * 128 + ndv), n1 = *(const f32x4*)(norm_w + h * 128 + ndv + 4);
            const float nw[8] = {n0[0], n0[1], n0[2], n0[3], n1[0], n1[1], n1[2], n1[3]};
            float ov[8];
#pragma unroll
            for (int i = 0; i < 8; ++i) ov[i] = xv[i] * r * nw[i] * sigmoidf_(gv[i]);
            u32x4 w = {cvtpk(ov[0], ov[1]), cvtpk(ov[2], ov[3]), cvtpk(ov[4], ov[5]), cvtpk(ov[6], ov[7])};
            *(u32x4*)(proj + (size_t)(n * 32 + ntok) * LDP + C_HI + ndv) = w;
        }
        asm volatile("s_waitcnt vmcnt(0)" ::: "memory");
        __syncthreads();
    }
#undef HDMA
    (void)a_ke; (void)a_qa; (void)a_qp;
}
}

__device__ void cvt_tile(float* sm, const float* src, int ldsrc, int k0, int ns0, int nvalid, bf16_t* dst, int lddst, int nd0) {
    float(*t)[65] = (float(*)[65])sm;
    const int tid = tid_();
    float4 v[8];
#pragma unroll
    for (int r = 0; r < 8; ++r) {
        const int idx = tid + r * 512, k = idx >> 4, n4 = (idx & 15) * 4;
        v[r] = n4 < nvalid ? *(const float4*)(src + (size_t)(k0 + k) * ldsrc + ns0 + n4) : make_float4(0.f, 0.f, 0.f, 0.f);
    }
#pragma unroll
    for (int r = 0; r < 8; ++r) {
        const int idx = tid + r * 512, k = idx >> 4, n4 = (idx & 15) * 4;
        t[k][n4] = v[r].x; t[k][n4 + 1] = v[r].y; t[k][n4 + 2] = v[r].z; t[k][n4 + 3] = v[r].w;
    }
    __syncthreads();
#pragma unroll
    for (int r = 0; r < 4; ++r) {
        const int idx = tid + r * 512, kg = idx & 31, n = idx >> 5;
        uint4 w;
        w.x = (unsigned)f2bf(t[kg * 8 + 0][n]) | ((unsigned)f2bf(t[kg * 8 + 1][n]) << 16); w.y = (unsigned)f2bf(t[kg * 8 + 2][n]) | ((unsigned)f2bf(t[kg * 8 + 3][n]) << 16);
        w.z = (unsigned)f2bf(t[kg * 8 + 4][n]) | ((unsigned)f2bf(t[kg * 8 + 5][n]) << 16); w.w = (unsigned)f2bf(t[kg * 8 + 6][n]) | ((unsigned)f2bf(t[kg * 8 + 7][n]) << 16);
        *(uint4*)(dst + (size_t)(nd0 + n) * lddst + k0 + kg * 8) = w;
    }
    __syncthreads();
}
__device__ __forceinline__ int gemm1_src_col(int nd) { return nd < 6656 ? nd : nd < 8704 ? nd + 24 : nd < 8728 ? 6656 + (nd - 8704) : -1; }
__device__ void ph_cvt_win(const Params& p, int u, float* sm) {
    if (u < 560) {
        const int nt = u >> 2, kt = u & 3, nd0 = nt * 64;
        const int ns0 = nd0 < 6656 ? nd0 : nd0 < 8704 ? nd0 + 24 : 6656, nvalid = nd0 < 8704 ? 64 : nd0 == 8704 ? 24 : 0;
        cvt_tile(sm, p.w_in, DIN, kt * 256, ns0, nvalid, (bf16_t*)(p.ws + OFF_WINT), 1024, nd0);
    } else {
        float* b1 = (float*)(p.ws + OFF_BIAS1);
        for (int i = tid_(); i < N1; i += 512) { const int s = gemm1_src_col(i); b1[i] = s >= 0 ? p.b_in[s] : 0.f; }
    }
}
__device__ void ph_cvt_br(const Params& p, int u, float* sm) {
    const int w = u >> 6, t = u & 63, nt = t >> 2, kt = t & 3;
    if (w < 2) cvt_tile(sm, w == 0 ? p.w_br_hg : p.w_br_nsa, 1024, kt * 256, nt * 64, 64, (bf16_t*)(p.ws + OFF_WBRH) + w * 1024, 2048, nt * 64);
    else cvt_tile(sm, p.w_out, 1024, kt * 256, nt * 64, 64, (bf16_t*)(p.ws + OFF_WOUTT), 1024, nt * 64);
}
__device__ void ph_cvt_exp(const Params& p, int u, float* sm) {
    if (u < 2048) {
        const int e = u >> 6, t = u & 63, nt = t >> 2, kt = t & 3, nd0 = nt * 64, pn = nd0 >> 8, half = (nd0 >> 7) & 1, off = nd0 & 127;
        cvt_tile(sm, (half ? p.e_w3 : p.e_w1) + (size_t)e * 1024 * 512, 512, kt * 256, pn * 128 + off, 64, (bf16_t*)(p.ws + OFF_E13) + (size_t)e * 1024 * 1024, 1024, nd0);
    } else {
        const int v = u - 2048, e = v >> 5, t = v & 31, nt = t >> 1, kt = t & 1;
        cvt_tile(sm, p.e_w2 + (size_t)e * 512 * 1024, 1024, kt * 256, nt * 64, 64, (bf16_t*)(p.ws + OFF_E2T) + (size_t)e * 1024 * 512, 512, nt * 64);
    }
}
enum { PH_PRO = 0, PH_LN0, PH_CMP2, PH_FINAL };
__host__ __device__ constexpr int phase_units(int ph) { return ph == PH_PRO ? 99 : ph == PH_LN0 ? NT / 16 : ph == PH_CMP2 ? 64 : ph == PH_FINAL ? NT / 16 : 0; }

__device__ void ph_pro(const Params& p, int u, float* sm) {
    const int tid = tid_();
    float* mod = (float*)(p.ws + OFF_MOD);
    if (u < 192) {
        const int lane = tid & 63, w = tid >> 6, cq = lane & 7, kr = lane >> 3;
        float* ca = sm;
        float* red = sm + 4096;
        for (int i = tid; i < 4096; i += 512) ca[i] = siluf_(p.c[i]);
        __syncthreads();
        const float* wp = p.ada_w + (size_t)(w * 128 + kr) * 6144 + u * 32 + cq * 4;
        float4 wv[16];
#pragma unroll
        for (int i = 0; i < 16; ++i) wv[i] = *(const float4*)(wp + (size_t)(8 * i) * 6144);
        float4 acc[4];
#pragma unroll
        for (int b = 0; b < 4; ++b) acc[b] = make_float4(0.f, 0.f, 0.f, 0.f);
#pragma unroll
        for (int i = 0; i < 16; ++i)
#pragma unroll
            for (int b = 0; b < 4; ++b) { const float cv = ca[b * 1024 + w * 128 + 8 * i + kr]; acc[b].x = fmaf(cv, wv[i].x, acc[b].x); acc[b].y = fmaf(cv, wv[i].y, acc[b].y); acc[b].z = fmaf(cv, wv[i].z, acc[b].z); acc[b].w = fmaf(cv, wv[i].w, acc[b].w); }
#pragma unroll
        for (int b = 0; b < 4; ++b) *(float4*)(red + ((w * 8 + kr) * 4 + b) * 32 + cq * 4) = acc[b];
        __syncthreads();
        if (tid < 128) {
            const int b = tid >> 5, cl = tid & 31;
            float s = p.ada_b[u * 32 + cl];
#pragma unroll 8
            for (int g = 0; g < 64; ++g) s += red[(g * 4 + b) * 32 + cl];
            mod[b * 6144 + u * 32 + cl] = s;
        }
        __syncthreads();
    } else if (u < 256) {
        const int v = u - 192, kv = v >> 5, kc = v & 31;
        const float* pos = kv ? p.pos_v : p.pos_k; const float* w1 = kv ? p.w1_v : p.w1_k;
        const int n = tid & 127, kg = tid >> 7;
        float s = 0.f;
#pragma unroll 8
        for (int k = kc * 128 + kg * 32; k < kc * 128 + kg * 32 + 32; ++k) s = fmaf(pos[k], w1[(size_t)k * 128 + n], s);
        sm[kg * 128 + n] = s;
        __syncthreads();
        if (tid < 128) atomicAdd((float*)(p.ws + OFF_CB) + kv * 128 + tid, sm[tid] + sm[128 + tid] + sm[256 + tid] + sm[384 + tid] + (kc == 0 ? (kv ? p.b1_v : p.b1_k)[tid] : 0.f));
        __syncthreads();
    } else {
        float* lb = (float*)(p.ws + OFF_LB);
        float* lut = (float*)(p.ws + OFF_LUT);
        unsigned* cnt = (unsigned*)(p.ws + OFF_CNT);
        for (int i = tid; i < 1024; i += 512) {
            const float l0 = p.lb_logits[i], l1 = p.lb_logits[1024 + i];
            lb[i] = 1.f / (1.f + __expf(l1 - l0));
            const int h = i >> 7, d = i & 127;
            lut[i] = p.rel_bias[h * 32 + rel_bucket(d)];
        }
        if (tid < 64) cnt[tid] = 0u;
        if (tid < 8) ((unsigned*)(p.ws + OFF_QCTR))[tid * 64] = 0u;
        { bf16_t* kc = (bf16_t*)(p.ws + OFF_KCMP); bf16_t* vc = (bf16_t*)(p.ws + OFF_VCMP);
          for (int i = tid; i < 8 * 128; i += 512) { kc[(size_t)((i >> 7) * 512 + 511) * 128 + (i & 127)] = 0; vc[(size_t)((i >> 7) * 512 + 511) * 128 + (i & 127)] = 0; } }
    }
}

__device__ void ph_ln0_all(const Params& p, float* sm) {
    const int tidx = tid_(), lane = tidx & 63, w = tidx >> 6, c = blockIdx.x, G = gridDim.x;
    for (int i = tidx; i < 4096; i += 512) { const int b = i >> 10, cc = i & 1023; const float* mod = (const float*)(p.ws + OFF_MOD) + b * 6144; sm[b * 2048 + cc] = mod[cc]; sm[b * 2048 + 1024 + cc] = 1.f + mod[1024 + cc]; }
    __syncthreads();
    pg8::f32x4 cur[2][4], nxt[2][4];
#define LN0_LOAD(dst, U_) do { _Pragma("unroll") for (int k = 0; k < 2; ++k) { const float* xr = p.x + (size_t)(((U_) + k * (NT / 16)) * 8 + w) * D_; \
        _Pragma("unroll") for (int i = 0; i < 4; ++i) dst[k][i] = *(const pg8::f32x4*)(xr + (i * 64 + lane) * 4); } } while (0)
    LN0_LOAD(cur, c);
    for (int u = c; u < NT / 16; u += G) {
        const bool hn = u + G < NT / 16;
        if (hn) LN0_LOAD(nxt, u + G);
#pragma unroll
        for (int k = 0; k < 2; ++k) {
            const int row = (u + k * (NT / 16)) * 8 + w;
            const LAS float* ml = (const LAS float*)sm + (row / T_) * 2048;
            bf16_t* h = (bf16_t*)(p.ws + OFF_H) + (size_t)row * D_;
            float s = 0.f;
#pragma unroll
            for (int i = 0; i < 4; ++i) s += (cur[k][i][0] + cur[k][i][1]) + (cur[k][i][2] + cur[k][i][3]);
            const float mu = wsum(s) * (1.f / 1024.f);
            float q = 0.f;
#pragma unroll
            for (int i = 0; i < 4; ++i) { cur[k][i] -= mu; q += cur[k][i][0] * cur[k][i][0] + cur[k][i][1] * cur[k][i][1] + cur[k][i][2] * cur[k][i][2] + cur[k][i][3] * cur[k][i][3]; }
            const float rs = rsqrtf(wsum(q) * (1.f / 1024.f) + 1e-5f);
#pragma unroll
            for (int i = 0; i < 4; ++i) {
                const int cc = (i * 64 + lane) * 4;
                const pg8::f32x4 sh = *(const LAS pg8::f32x4*)(ml + cc), sc = *(const LAS pg8::f32x4*)(ml + 1024 + cc);
                const pg8::f32x4 o = cur[k][i] * rs * sc + sh;
                st_bf4(h + cc, o[0], o[1], o[2], o[3]);
            }
        }
        if (hn) {
#pragma unroll
            for (int k = 0; k < 2; ++k)
#pragma unroll
                for (int i = 0; i < 4; ++i) cur[k][i] = nxt[k][i];
        }
    }
#undef LN0_LOAD
    __syncthreads();
}

__device__ void ph_cmp2(const Params& p, int u, float* sm) {
    const int tid = tid_(), kv = u >> 5, m0 = (u & 31) * 128;
    const float* w2 = kv ? p.w2_v : p.w2_k;
    const float* hid = (const float*)(p.ws + OFF_HID) + (size_t)kv * 4096 * 128;
    const float* cb = (const float*)(p.ws + OFF_CB) + kv * 128;
    bf16_t* dst = (bf16_t*)(p.ws + (kv ? OFF_VCMP : OFF_KCMP));
    float(*As)[132] = (float(*)[132])sm;
    float(*Bs)[132] = (float(*)[132])(sm + 128 * 132);
    float4 av[8], bv[8];
#pragma unroll
    for (int r = 0; r < 8; ++r) { const int idx = tid + r * 512, row = idx >> 5, k4 = (idx & 31) * 4; av[r] = *(const float4*)(hid + (size_t)(m0 + row) * 128 + k4); bv[r] = *(const float4*)(w2 + (size_t)row * 128 + k4); }
#pragma unroll
    for (int r = 0; r < 8; ++r) { const int idx = tid + r * 512, row = idx >> 5, k4 = (idx & 31) * 4;
        const float4 c4 = *(const float4*)(cb + k4);
        As[k4][row] = siluf_(av[r].x + c4.x); As[k4 + 1][row] = siluf_(av[r].y + c4.y); As[k4 + 2][row] = siluf_(av[r].z + c4.z); As[k4 + 3][row] = siluf_(av[r].w + c4.w);
        *(float4*)&Bs[row][k4] = bv[r]; }
    __syncthreads();
    const int tx = tid & 31, ty = tid >> 5;
    float acc[8][4];
#pragma unroll
    for (int i = 0; i < 8; ++i)
#pragma unroll
        for (int j = 0; j < 4; ++j) acc[i][j] = 0.f;
#pragma unroll 8
    for (int k = 0; k < 128; ++k) {
        const float4 a0 = *(const float4*)&As[k][ty * 8], a1 = *(const float4*)&As[k][ty * 8 + 4], bb = *(const float4*)&Bs[k][tx * 4];
        const float a_[8] = {a0.x, a0.y, a0.z, a0.w, a1.x, a1.y, a1.z, a1.w};
        const float b_[4] = {bb.x, bb.y, bb.z, bb.w};
#pragma unroll
        for (int i = 0; i < 8; ++i)
#pragma unroll
            for (int j = 0; j < 4; ++j) acc[i][j] = fmaf(a_[i], b_[j], acc[i][j]);
    }
#pragma unroll
    for (int i = 0; i < 8; ++i) {
        const int m = m0 + ty * 8 + i;
        const bool dead = (m & 511) == 511;
        st_bf4(dst + (size_t)m * 128 + tx * 4, dead ? 0.f : acc[i][0], dead ? 0.f : acc[i][1], dead ? 0.f : acc[i][2], dead ? 0.f : acc[i][3]);
    }
    __syncthreads();
}

constexpr int LR_A = 0, LR_AS = 1028, LR_P = 16 * LR_AS, LR_SLOT = LR_P + 8 * 16 * 48, LR_LC = LR_SLOT + 8 * 80, LR_LNP = LR_LC + 64;
struct Ln1rArgs { unsigned char* ws; const float *ln1_g, *ln1_b, *rg_b, *re_b; float* sm; };
struct Ln1rW { const float *rg_w, *re_w; };
#define GAS __attribute__((address_space(1)))
template <class T> __device__ __forceinline__ GAS T* gptr(T* q) { return (GAS T*)q; }
#define LR_LOADZ(U_) do { _Pragma("unroll") for (int k = 0; k < 2; ++k) { const GAS bf16_t* zr_ = (const GAS bf16_t*)(ws + OFF_Z) + (size_t)((U_) * 16 + 2 * w + k) * D_; \
        _Pragma("unroll") for (int i = 0; i < 4; ++i) { const pg8::u32x2 a = *(const GAS pg8::u32x2*)(zr_ + (i * 64 + lane) * 4); v[k][i * 4] = __uint_as_float(a[0] << 16); v[k][i * 4 + 1] = __uint_as_float(a[0] & 0xFFFF0000u); \
            v[k][i * 4 + 2] = __uint_as_float(a[1] << 16); v[k][i * 4 + 3] = __uint_as_float(a[1] & 0xFFFF0000u); } } } while (0)
__device__ __forceinline__ void ph_ln1r_(const Ln1rArgs pa, const Ln1rW pw) {
    const int tidx = tid_(), lane = tidx & 63, w = tidx >> 6, n16 = lane & 15, kq = lane >> 4;
    GAS unsigned char* ws = gptr(pa.ws);
    const GAS float *ln1_g = gptr(pa.ln1_g), *ln1_b = gptr(pa.ln1_b), *rg_b = gptr(pa.rg_b), *re_b = gptr(pa.re_b), *rg_w = gptr(pw.rg_w), *re_w = gptr(pw.re_w);
    const int c = blockIdx.x, G = gridDim.x;
    LAS float* SM = (LAS float*)pa.sm;
    float v[2][16];
    LR_LOADZ(c);
    for (int i = tidx; i < 1024; i += 512) {
        SM[LR_LNP + i] = ln1_g[i]; SM[LR_LNP + 1024 + i] = ln1_b[i];
#pragma unroll
        for (int bb = 0; bb < 4; ++bb) { const GAS float* mod = (const GAS float*)(ws + OFF_MOD) + bb * 6144; SM[LR_LNP + 2048 + bb * 2048 + i] = mod[3072 + i]; SM[LR_LNP + 3072 + bb * 2048 + i] = 1.f + mod[4096 + i]; }
    }
    const int fa_k = lane >= 36 ? 1 : 0, fa_n = lane - 36 * fa_k, fb_n = lane < 8 ? 28 + lane : 35;
    const int fa_c = fa_n < 4 ? 32 + fa_n : fa_n - 4, fb_c = fb_n - 4;
    const float bias_a = fa_n < 4 ? rg_b[fa_n] : re_b[fa_n - 4], bias_b = re_b[fb_n - 4];
    float bw[3][32];
#pragma unroll
    for (int sj = 0; sj < 32; ++sj) {
        const int k = 128 * w + 16 * (sj >> 2) + 4 * kq + (sj & 3);
        bw[0][sj] = re_w[k * 32 + n16]; bw[1][sj] = re_w[k * 32 + 16 + n16]; bw[2][sj] = rg_w[k * 4 + (n16 & 3)];
    }
#pragma unroll
    for (int sj = 0; sj < 32; ++sj) bw[2][sj] = n16 < 4 ? bw[2][sj] : 0.f;
    __syncthreads();
    for (int u = c; u < NT / 16; u += G) {
        const int row0 = u * 16 + 2 * w, b = row0 / T_;
        const LAS float* lnp = SM + LR_LNP;
#pragma unroll
        for (int k = 0; k < 2; ++k) {
            GAS bf16_t* zr = (GAS bf16_t*)(ws + OFF_Z) + (size_t)(row0 + k) * D_;
            GAS bf16_t* h2 = (GAS bf16_t*)(ws + OFF_H) + (size_t)(row0 + k) * D_;
            float s1 = 0.f;
#pragma unroll
            for (int i = 0; i < 16; ++i) s1 += v[k][i];
            float mu = wsum(s1) * (1.f / 1024.f), q = 0.f;
#pragma unroll
            for (int i = 0; i < 16; ++i) { v[k][i] -= mu; q = fmaf(v[k][i], v[k][i], q); }
            float rs = rsqrtf(wsum(q) * (1.f / 1024.f) + 1e-5f);
            float s2 = 0.f;
#pragma unroll
            for (int i = 0; i < 4; ++i) {
                const int cc = (i * 64 + lane) * 4;
                const pg8::f32x4 gg = *(const LAS pg8::f32x4*)(lnp + cc), bb = *(const LAS pg8::f32x4*)(lnp + 1024 + cc);
                v[k][i * 4] = v[k][i * 4] * rs * gg[0] + bb[0]; v[k][i * 4 + 1] = v[k][i * 4 + 1] * rs * gg[1] + bb[1]; v[k][i * 4 + 2] = v[k][i * 4 + 2] * rs * gg[2] + bb[2]; v[k][i * 4 + 3] = v[k][i * 4 + 3] * rs * gg[3] + bb[3];
                { pg8::u32x2 pk = {pk_bf16(v[k][i * 4], v[k][i * 4 + 1]), pk_bf16(v[k][i * 4 + 2], v[k][i * 4 + 3])}; *(GAS pg8::u32x2*)(zr + cc) = pk; }
                s2 += v[k][i * 4] + v[k][i * 4 + 1] + v[k][i * 4 + 2] + v[k][i * 4 + 3];
            }
            mu = wsum(s2) * (1.f / 1024.f); q = 0.f;
#pragma unroll
            for (int i = 0; i < 16; ++i) { v[k][i] -= mu; q = fmaf(v[k][i], v[k][i], q); }
            rs = rsqrtf(wsum(q) * (1.f / 1024.f) + 1e-5f);
#pragma unroll
            for (int i = 0; i < 4; ++i) {
                const int cc = (i * 64 + lane) * 4;
                const pg8::f32x4 sh = *(const LAS pg8::f32x4*)(lnp + 2048 + b * 2048 + cc), sc = *(const LAS pg8::f32x4*)(lnp + 3072 + b * 2048 + cc);
                const pg8::f32x4 o = {v[k][i * 4] * rs * sc[0] + sh[0], v[k][i * 4 + 1] * rs * sc[1] + sh[1], v[k][i * 4 + 2] * rs * sc[2] + sh[2], v[k][i * 4 + 3] * rs * sc[3] + sh[3]};
                { pg8::u32x2 pk = {pk_bf16(o[0], o[1]), pk_bf16(o[2], o[3])}; *(GAS pg8::u32x2*)(h2 + cc) = pk; }
                *(LAS pg8::f32x4*)(SM + LR_A + (2 * w + k) * LR_AS + cc) = o;
            }
        }
        __syncthreads();
        if (u + G < NT / 16) LR_LOADZ(u + G);
        {
            pg8::f32x4 acc[3] = {{0.f, 0.f, 0.f, 0.f}, {0.f, 0.f, 0.f, 0.f}, {0.f, 0.f, 0.f, 0.f}};
            const LAS float* ar = SM + LR_A + n16 * LR_AS + 128 * w + 4 * kq;
            pg8::f32x4 a4[8];
#pragma unroll
            for (int sI = 0; sI < 8; ++sI) a4[sI] = *(const LAS pg8::f32x4*)(ar + 16 * sI);
#pragma unroll
            for (int sI = 0; sI < 8; ++sI)
#pragma unroll
                for (int j = 0; j < 4; ++j)
#pragma unroll
                    for (int t = 0; t < 3; ++t) acc[t] = __builtin_amdgcn_mfma_f32_16x16x4f32(a4[sI][j], bw[t][sI * 4 + j], acc[t], 0, 0, 0);
            LAS float* pp = SM + LR_P + (w * 16 + 4 * kq) * 48 + n16;
#pragma unroll
            for (int t = 0; t < 3; ++t)
#pragma unroll
                for (int e = 0; e < 4; ++e) pp[e * 48 + 16 * t] = acc[t][e];
        }
        __syncthreads();
        {
            LAS float* slot = SM + LR_SLOT + w * 80;
            {
                const LAS float* pa_ = SM + LR_P + (2 * w + fa_k) * 48 + fa_c;
                const LAS float* pb_ = SM + LR_P + (2 * w + 1) * 48 + fb_c;
                float ta = bias_a, tb = bias_b;
#pragma unroll
                for (int ww = 0; ww < 8; ++ww) { ta += pa_[ww * 16 * 48]; tb += pb_[ww * 16 * 48]; }
                slot[lane] = ta;
                if (lane < 8) slot[64 + lane] = tb;
            }
            asm volatile("s_waitcnt lgkmcnt(0)" ::: "memory");
            const int kr = lane >> 5, row = row0 + kr;
            float lg[36];
#pragma unroll
            for (int q = 0; q < 9; ++q) { const pg8::f32x4 w4 = *(const LAS pg8::f32x4*)(slot + kr * 36 + q * 4); lg[q * 4] = w4[0]; lg[q * 4 + 1] = w4[1]; lg[q * 4 + 2] = w4[2]; lg[q * 4 + 3] = w4[3]; }
            int gi = 0; float gm = lg[0];
#pragma unroll
            for (int j = 1; j < 4; ++j) if (lg[j] > gm) { gm = lg[j]; gi = j; }
            float gs = 0.f;
#pragma unroll
            for (int j = 0; j < 4; ++j) gs += __expf(lg[j] - gm);
            const float gp = __builtin_amdgcn_rcpf(gs);
            float el[8];
#pragma unroll
            for (int i = 0; i < 8; ++i) el[i] = gi == 0 ? lg[4 + i] : gi == 1 ? lg[12 + i] : gi == 2 ? lg[20 + i] : lg[28 + i];
            int i0 = 0; float l0 = el[0];
#pragma unroll
            for (int i = 1; i < 8; ++i) if (el[i] > l0) { l0 = el[i]; i0 = i; }
            int i1 = -1; float l1 = -3.0e38f;
#pragma unroll
            for (int i = 0; i < 8; ++i) if (i != i0 && el[i] > l1) { l1 = el[i]; i1 = i; }
            const float w0 = __builtin_amdgcn_rcpf(1.f + __expf(l1 - l0));
            if ((lane & 31) == 0) {
                GAS int* ti = (GAS int*)(ws + OFF_TOKI) + (size_t)row * 6;
                const int e0 = gi * 8 + i0, e1 = gi * 8 + i1;
                ti[0] = e0; ti[1] = e1;
                LAS unsigned* lc = (LAS unsigned*)(SM + LR_LC);
                ti[2] = (int)__hip_atomic_fetch_add(lc + e0, 1u, __ATOMIC_RELAXED, __HIP_MEMORY_SCOPE_WORKGROUP); ti[3] = (int)__hip_atomic_fetch_add(lc + e1, 1u, __ATOMIC_RELAXED, __HIP_MEMORY_SCOPE_WORKGROUP);
                ((GAS float*)ti)[4] = gp * w0; ((GAS float*)ti)[5] = gp * (1.f - w0);
            }
        }
    }
}
#undef LR_LOADZ

__device__ __forceinline__ int wave_offsets(const unsigned* cnt, int lane, int& pc_out, int& tot) {
    const int c = lane < 32 ? (int)cnt[lane] : 0;
    const int pc = ((c + 255) >> 8) << 8;
    int inc = pc;
    for (int o = 1; o < 64; o <<= 1) { const int t = __shfl_up(inc, o); if (lane >= o) inc += t; }
    tot = __shfl(inc, 63);
    pc_out = pc;
    return inc - pc;
}

__device__ void ph_final(const Params& p, int u) {
    const int tidx = tid_(), lane = tidx & 63;
    float v[2][16]; float s[2] = {0.f, 0.f};
    int rowi[2];
#pragma unroll
    for (int k = 0; k < 2; ++k) {
        const int row = (u + k * (NT / 16)) * 8 + (tidx >> 6), b = row / T_;
        rowi[k] = row;
        const bf16_t* x1 = (const bf16_t*)(p.ws + OFF_Z) + (size_t)row * D_;
        const float* mod = (const float*)(p.ws + OFF_MOD) + b * 6144 + 5120;
        const int* ti = (const int*)(p.ws + OFF_TOKI) + (size_t)row * 6;
        const int r0 = ti[2], r1 = ti[3]; const float w0 = ((const float*)ti)[4], w1 = ((const float*)ti)[5];
        const bf16_t* y0 = (const bf16_t*)(p.ws + OFF_XPAD) + (size_t)r0 * D_; const bf16_t* y1 = (const bf16_t*)(p.ws + OFF_XPAD) + (size_t)r1 * D_;
#pragma unroll
        for (int i = 0; i < 4; ++i) {
            const int c = (i * 64 + lane) * 4;
            const float4 xv = ld_bf4(x1 + c), g2 = *(const float4*)(mod + c), a = ld_bf4(y0 + c), bb = ld_bf4(y1 + c);
            v[k][i * 4] = ALPHA * xv.x + (1.f + g2.x) * (w0 * a.x + w1 * bb.x); v[k][i * 4 + 1] = ALPHA * xv.y + (1.f + g2.y) * (w0 * a.y + w1 * bb.y);
            v[k][i * 4 + 2] = ALPHA * xv.z + (1.f + g2.z) * (w0 * a.z + w1 * bb.z); v[k][i * 4 + 3] = ALPHA * xv.w + (1.f + g2.w) * (w0 * a.w + w1 * bb.w);
            s[k] += v[k][i * 4] + v[k][i * 4 + 1] + v[k][i * 4 + 2] + v[k][i * 4 + 3];
        }
    }
#pragma unroll
    for (int k = 0; k < 2; ++k) {
        const float mu = wsum(s[k]) * (1.f / 1024.f); float q = 0.f;
#pragma unroll
        for (int i = 0; i < 16; ++i) { v[k][i] -= mu; q = fmaf(v[k][i], v[k][i], q); }
        const float rs = rsqrtf(wsum(q) * (1.f / 1024.f) + 1e-5f);
#pragma unroll
        for (int i = 0; i < 4; ++i) {
            const int c = (i * 64 + lane) * 4;
            const float4 gg = *(const float4*)(p.ln2_g + c), bb = *(const float4*)(p.ln2_b + c);
            *(float4*)(p.out + (size_t)rowi[k] * D_ + c) = make_float4(v[k][i * 4] * rs * gg.x + bb.x, v[k][i * 4 + 1] * rs * gg.y + bb.y, v[k][i * 4 + 2] * rs * gg.z + bb.z, v[k][i * 4 + 3] * rs * gg.w + bb.w);
        }
    }
}

template <int PH> __device__ __forceinline__ void run_unit(const Params& p, int u, float* sm) {
    if constexpr (PH == PH_CMP2) ph_cmp2(p, u, sm);
    else if constexpr (PH == PH_FINAL) ph_final(p, u);
}

constexpr int MEGA_LDS = 153600 + 16;
enum { Q_PRO = 0, Q_LN0, Q_GEMM1, Q_CMP1, Q_CMP2, Q_MIX, Q_MRG, Q_WOUT, Q_LN1R, Q_PAD, Q_EXP1, Q_EXP2, Q_FINAL };
template <int PH> __device__ __forceinline__ void unit_loop(const Params& p, float* sm) {
    for (int u = blockIdx.x; u < phase_units(PH); u += gridDim.x) run_unit<PH>(p, u, sm);
}
template <int Q> __device__ __forceinline__ void run_phase(const Params& p, float* sm) {
    PG8_LAS unsigned char* lds = (PG8_LAS unsigned char*)sm;
    const int G = gridDim.x, c = blockIdx.x;
    if constexpr (Q == Q_PRO) {
        for (int L = c; L < 882; L += G) {
            if (L < 257) ph_pro(p, L, sm);
            else if (L < 321) { const int u = L - 257, kv = u >> 5, t = u & 31, nt = t >> 4, kt = t & 15;
                cvt_tile(sm, kv ? p.w1_v : p.w1_k, 128, kt * 256, nt * 64, 64, (bf16_t*)(p.ws + OFF_CMPW) + (size_t)kv * 128 * 4096, 4096, nt * 64); }
            else ph_cvt_win(p, L - 321, sm);
        }
        { float4* hz = (float4*)(p.ws + OFF_HID); for (int i = c * 512 + threadIdx.x; i < 2 * 4096 * 128 / 4; i += G * 512) hz[i] = make_float4(0.f, 0.f, 0.f, 0.f); }
    }
    else if constexpr (Q == Q_LN0) ph_ln0_all(p, sm);
    else if constexpr (Q == Q_GEMM1) {
        pg8::Gemm g{(const bf16_t*)(p.ws + OFF_H), (const bf16_t*)(p.ws + OFF_WINT), 1024, 1024, 1024};
        pg8::StaticOrder S; S.init(NT, N1, G, c);
        pg8::EpiProj E{(bf16_t*)(p.ws + OFF_PROJ), (bf16_t*)p.out, (float*)(p.ws + OFF_GATE), (const float*)(p.ws + OFF_BIAS1)};
        pg8::gemm_phase(lds, g, S, E);
    }
    else if constexpr (Q == Q_CMP1) {
        for (int u = c; u < 1024; u += G) ph_hpre(p, u);
        for (int u = c; u < 192; u += G) ph_cvt_br(p, u, sm);
        __syncthreads();
        pg8::Gemm g{(const bf16_t*)(p.ws + OFF_PROJ), (const bf16_t*)(p.ws + OFF_CMPW), 1024, 16 * LDP, 4096, 1, 1};
        pg8::CmpOrder S{G, c};
        pg8::EpiCmpAcc E{(float*)(p.ws + OFF_HID)};
        pg8::gemm_phase(lds, g, S, E);
    }
    else if constexpr (Q == Q_CMP2) unit_loop<PH_CMP2>(p, sm);
    else if constexpr (Q == Q_MIX) {
        unsigned* qc = (unsigned*)(p.ws + OFF_QCTR);
        volatile int* slot = (volatile int*)((char*)sm + 131072 - 64);
        for (int k = 0; k < 8; ++k) {
            const int q = (c + k) & 7;
            for (;;) {
                __syncthreads();
                if (threadIdx.x == 0) *slot = (int)__hip_atomic_fetch_add(qc + q * 64, 1u, __ATOMIC_RELAXED, __HIP_MEMORY_SCOPE_AGENT);
                __syncthreads();
                const int it = *slot;
                if (it >= 4 + 128) break;
                if (it < 4) hg::item(p.ws, p.hg_norm_w, q >> 1, (q & 1) * 4 + it, (char*)sm);
                else nsa::item(p.ws, q >> 1, q & 1, 127 - (it - 4), (char*)sm);
            }
        }
    }
    else if constexpr (Q == Q_MRG) {
        pg8::StaticOrder S; S.init(NT, 1024, G, c);
        pg8::Gemm g{(const bf16_t*)(p.ws + OFF_PROJ) + C_HI, (const bf16_t*)(p.ws + OFF_WBRH), 2048, LDP, 2048, 2, 0};
        pg8::EpiMrg E{(const bf16_t*)p.out, (bf16_t*)(p.ws + OFF_H)};
        pg8::gemm_phase(lds, g, S, E);
    }
    else if constexpr (Q == Q_WOUT) {
        for (int u = c; u < 3072; u += G) ph_cvt_exp(p, u, sm);
        pg8::Gemm g{(const bf16_t*)(p.ws + OFF_H), (const bf16_t*)(p.ws + OFF_WOUTT), 1024, 1024, 1024};
        pg8::StaticOrder S; S.init(NT, 1024, G, c);
        pg8::EpiWout E{p.x, (const float*)(p.ws + OFF_MOD), (bf16_t*)(p.ws + OFF_Z)};
        pg8::gemm_phase(lds, g, S, E);
    }
    else if constexpr (Q == Q_LN1R) {
        unsigned* lc = (unsigned*)(sm + LR_LC);
        if (threadIdx.x < 64) lc[threadIdx.x] = 0u;
        __syncthreads();
        ph_ln1r_(Ln1rArgs{p.ws, p.ln1_g, p.ln1_b, p.rg_b, p.re_b, sm}, Ln1rW{p.rg_w, p.re_w});
        __syncthreads();
        if (threadIdx.x < 32) lc[32 + threadIdx.x] = atomicAdd((unsigned*)(p.ws + OFF_CNT) + threadIdx.x, lc[threadIdx.x]);
        __syncthreads();
        for (int u = c; u < NT / 16; u += G) {
            if (threadIdx.x < 32) { int* ti = (int*)(p.ws + OFF_TOKI) + (size_t)(u * 16 + (threadIdx.x >> 1)) * 6; const int k = threadIdx.x & 1; ti[2 + k] += (int)lc[32 + ti[k]]; }
        }
        __syncthreads();
    }
    else if constexpr (Q == Q_PAD) {
        const int tidx = tid_(), lane = tidx & 63;
        const unsigned* cnt = (const unsigned*)(p.ws + OFF_CNT);
        int* inv = (int*)(p.ws + OFF_INV);
        int pc, tot; const int off = wave_offsets(cnt, lane, pc, tot);
        for (int base = c * 512; base < NT; base += G * 512) {
            const int tok = base + tidx;
            int* tw = (int*)(p.ws + OFF_TOKI) + (size_t)tok * 6;
            const int ra = __shfl(off, tw[0]) + tw[2], rb = __shfl(off, tw[1]) + tw[3];
            inv[ra] = tok; inv[rb] = tok; tw[2] = ra; tw[3] = rb;
        }
        for (int e = c; e < 32; e += G) {
            const int oe = __shfl(off, e), ce = (int)cnt[e], pe = __shfl(pc, e);
            for (int r = oe + ce + tidx; r < oe + pe; r += 512) inv[r] = 0;
        }
        if (c == G - 1) {
            int* te = (int*)(p.ws + OFF_TILEE);
            if (tidx < 32) { for (int r = off; r < off + pc; r += 256) te[r >> 8] = tidx; }
            if (tidx == 0) te[511] = tot >> 8;
        }
    }
    else if constexpr (Q == Q_EXP1) {
        const int* te = (const int*)(p.ws + OFF_TILEE);
        pg8::Gemm g{(const bf16_t*)(p.ws + OFF_H), (const bf16_t*)(p.ws + OFF_E13), 1024, 1024, 1024};
        pg8::MoeGatherOrder S{te, (const int*)(p.ws + OFF_INV), te[511] * 4, G, c, (long)1024 * 1024 * 2};
        pg8::EpiExp1 E{(bf16_t*)p.out};
        pg8::gemm_phase(lds, g, S, E);
    }
    else if constexpr (Q == Q_EXP2) {
        const int* te = (const int*)(p.ws + OFF_TILEE);
        pg8::Gemm g{(const bf16_t*)p.out, (const bf16_t*)(p.ws + OFF_E2T), 512, 512, 512};
        pg8::MoeOrder S{te, te[511] * 4, G, c, (long)1024 * 512 * 2};
        pg8::EpiBf E{(bf16_t*)(p.ws + OFF_XPAD), 1024};
        pg8::gemm_phase(lds, g, S, E);
    }
    else if constexpr (Q == Q_FINAL) unit_loop<PH_FINAL>(p, sm);
}
__global__ void __launch_bounds__(512, 2) k_mega(Params p) {
    extern __shared__ __attribute__((aligned(16))) float smem[];
    volatile LAS unsigned* st = (volatile LAS unsigned*)(smem + 153600 / 4);
    if (threadIdx.x == 0) { st[0] = 0u; st[1] = 0u; st[2] = 0u; st[3] = 0u; }
    __syncthreads();
    XcdBarrier bar = xcd_barrier_post((unsigned*)(p.ws + OFF_BAR), st);
    run_phase<Q_PRO>(p, smem);   xcd_barrier(bar);
    run_phase<Q_LN0>(p, smem);   xcd_barrier(bar);
    run_phase<Q_GEMM1>(p, smem); xcd_barrier(bar);
    run_phase<Q_CMP1>(p, smem);  xcd_barrier(bar);
    run_phase<Q_CMP2>(p, smem);  xcd_barrier(bar);
    run_phase<Q_MIX>(p, smem);   xcd_barrier(bar);
    run_phase<Q_MRG>(p, smem);   xcd_barrier(bar);
    run_phase<Q_WOUT>(p, smem);  xcd_barrier(bar);
    run_phase<Q_LN1R>(p, smem);  xcd_barrier(bar);
    run_phase<Q_PAD>(p, smem);   xcd_barrier(bar);
    run_phase<Q_EXP1>(p, smem);  xcd_barrier(bar);
    run_phase<Q_EXP2>(p, smem);  xcd_barrier(bar);
    run_phase<Q_FINAL>(p, smem);
}

extern "C" void kernel_launch(void* const* d_in, const int* in_sizes, int n_in, void* d_out, int out_size, void* d_ws, size_t ws_size, hipStream_t stream) {
    Params p{};
    const float** fp = (const float**)&p;
    for (int i = 0; i < 31; ++i) fp[i] = (const float*)d_in[i];
    p.out = (float*)d_out; p.ws = (unsigned char*)d_ws;
    static int grid = 0;
    if (!grid) {
        int dev = 0, cus = 0, per_cu = 0;
        (void)hipGetDevice(&dev);
        (void)hipDeviceGetAttribute(&cus, hipDeviceAttributeMultiprocessorCount, dev);
        (void)hipFuncSetAttribute((const void*)k_mega, hipFuncAttributeMaxDynamicSharedMemorySize, MEGA_LDS);
        (void)hipOccupancyMaxActiveBlocksPerMultiprocessor(&per_cu, (const void*)k_mega, 512, MEGA_LDS);
        grid = cus * (per_cu < 1 ? per_cu : 1);
    }
    (void)hipMemsetAsync(p.ws + OFF_BAR, 0, OFF_CNT, stream);
    hipLaunchKernelGGL(k_mega, dim3(grid), dim3(512), MEGA_LDS, stream, p);
}
```

```cpp
#include <hip/hip_runtime.h>
#include <stdint.h>

typedef unsigned short bf16_t;

constexpr int B_ = 4, T_ = 8192, D_ = 1024, NT = B_ * T_;
constexpr int DIN = 8728;
constexpr int LDP = 6656;
constexpr int C_HQ = 0, C_HF = 1024, C_HI = 2048, C_HG = 3072, C_NQ = 4096, C_KC = 5120, C_VC = 5376, C_KS = 5632, C_VS = 5888, C_KW = 6144, C_VW = 6400;
constexpr int NC = 511;
constexpr float ALPHA = 1.189207115002721f;
constexpr int MAXROWS = 73728;

constexpr size_t KB = 1024, MB = 1024 * 1024;
constexpr size_t OFF_BAR = 0, OFF_MOD = 16 * KB, OFF_LB = 112 * KB, OFF_LUT = 116 * KB, OFF_CB = 120 * KB, OFF_CNT = 124 * KB, OFF_TOKI = 128 * KB;
constexpr size_t OFF_GATE = 1 * MB, OFF_KCMP = 4 * MB, OFF_VCMP = 5 * MB, OFF_HID = 6 * MB;
constexpr size_t OFF_DEC = 18 * MB;
constexpr size_t OFF_PART = 31 * MB;
constexpr size_t OFF_INV = 26 * MB;
constexpr size_t OFF_QCTR = 960 * KB;
constexpr size_t OFF_CMPW = 10 * MB;
constexpr size_t OFF_H = 31 * MB;
constexpr size_t OFF_PROJ = 95 * MB;
constexpr size_t OFF_Z = OFF_PROJ, OFF_XPAD = OFF_PROJ + 128 * MB;
constexpr size_t OFF_BIAS1 = 896 * KB, OFF_TILEE = 940 * KB;
constexpr size_t OFF_WINT = 12 * MB;
constexpr size_t OFF_WBRH = 12 * MB, OFF_WBRN = 14 * MB, OFF_WOUTT = 16 * MB;
constexpr size_t OFF_E13 = OFF_PROJ + 272 * MB, OFF_E2T = OFF_PROJ + 336 * MB;
constexpr int N1 = 8704;

struct Params {
    const float *x, *c, *ada_w, *ada_b, *w_in, *b_in, *lb_logits, *hg_norm_w, *pos_k, *w1_k, *b1_k, *w2_k, *pos_v, *w1_v, *b1_v, *w2_v, *rel_bias,
        *w_br_hg, *w_br_nsa, *w_out, *ln1_g, *ln1_b, *rg_w, *rg_b, *re_w, *re_b, *e_w1, *e_w3, *e_w2, *ln2_g, *ln2_b;
    float* out; unsigned char* ws;
};

__device__ __forceinline__ int tid_() { int t = threadIdx.x; asm volatile("" : "+v"(t)); return t; }
__device__ __forceinline__ float bf2f(bf16_t v) { return __uint_as_float(((unsigned)v) << 16); }
__device__ __forceinline__ bf16_t f2bf(float f) { unsigned u = __float_as_uint(f); u += 0x7FFFu + ((u >> 16) & 1u); return (bf16_t)(u >> 16); }
__device__ __forceinline__ float sigmoidf_(float v) { return __builtin_amdgcn_rcpf(1.f + __expf(-v)); }
__device__ __forceinline__ float siluf_(float v) { return v * __builtin_amdgcn_rcpf(1.f + __expf(-v)); }
template <int CTRL> __device__ __forceinline__ float dpp_(float v) { return __int_as_float(__builtin_amdgcn_update_dpp(0, __float_as_int(v), CTRL, 0xF, 0xF, true)); }
__device__ __forceinline__ float rlane(float v, int l) { return __int_as_float(__builtin_amdgcn_readlane(__float_as_int(v), l)); }
__device__ __forceinline__ float wsum(float v) {
    v += dpp_<0xB1>(v); v += dpp_<0x4E>(v); v += dpp_<0x141>(v); v += dpp_<0x140>(v);
    return (rlane(v, 15) + rlane(v, 31)) + (rlane(v, 47) + rlane(v, 63));
}
__device__ __forceinline__ float rfl(float v) { return __int_as_float(__builtin_amdgcn_readfirstlane(__float_as_int(v))); }
__device__ __forceinline__ float wmax(float v) { for (int o = 32; o > 0; o >>= 1) v = fmaxf(v, __shfl_xor(v, o)); return v; }
__device__ __forceinline__ float4 ld_bf4(const bf16_t* p) { uint2 r = *(const uint2*)p; return make_float4(__uint_as_float(r.x << 16), __uint_as_float(r.x & 0xFFFF0000u), __uint_as_float(r.y << 16), __uint_as_float(r.y & 0xFFFF0000u)); }
typedef __bf16 bf16x2n __attribute__((ext_vector_type(2)));
typedef float f32x2n __attribute__((ext_vector_type(2)));
__device__ __forceinline__ unsigned pk_bf16(float lo, float hi) { const f32x2n v = {lo, hi}; const bf16x2n r = __builtin_convertvector(v, bf16x2n); return __builtin_bit_cast(unsigned, r); }
__device__ __forceinline__ void st_bf4(bf16_t* p, float a, float b, float c, float d) { uint2 r; r.x = pk_bf16(a, b); r.y = pk_bf16(c, d); *(uint2*)p = r; }
__device__ __forceinline__ int rel_bucket(int n) {
    if (n < 16) return n < 0 ? 0 : n;
    int b = 16;
    b += (n >= 19) + (n >= 21) + (n >= 24) + (n >= 27) + (n >= 31) + (n >= 35) + (n >= 40) + (n >= 46) + (n >= 52) + (n >= 59) + (n >= 67) + (n >= 77) + (n >= 87) + (n >= 99) + (n >= 113);
    return b;
}

template <class AF, class BF, class EF>
__device__ __forceinline__ void gemm128(float* sm, int m0, int n0, int K, AF af, BF bf, EF ef) {
    float(*As)[132] = (float(*)[132])sm;
    float(*Bs)[132] = (float(*)[132])(sm + 16 * 132);
    const int tid = tid_(), tx = tid & 31, ty = tid >> 5;
    const int ar = tid >> 2, ak = (tid & 3) * 4, bk = tid >> 5, bn = (tid & 31) * 4;
    float acc[8][4];
#pragma unroll
    for (int i = 0; i < 8; ++i)
#pragma unroll
        for (int j = 0; j < 4; ++j) acc[i][j] = 0.f;
    for (int k0 = 0; k0 < K; k0 += 16) {
        const float4 a = af(m0 + ar, k0 + ak);
        const float4 b = bf(k0 + bk, n0 + bn);
        __syncthreads();
        As[ak + 0][ar] = a.x; As[ak + 1][ar] = a.y; As[ak + 2][ar] = a.z; As[ak + 3][ar] = a.w;
        *(float4*)&Bs[bk][bn] = b;
        __syncthreads();
#pragma unroll
        for (int k = 0; k < 16; ++k) {
            const float4 a0 = *(const float4*)&As[k][ty * 8], a1 = *(const float4*)&As[k][ty * 8 + 4], bb = *(const float4*)&Bs[k][tx * 4];
            const float av[8] = {a0.x, a0.y, a0.z, a0.w, a1.x, a1.y, a1.z, a1.w};
            const float bv[4] = {bb.x, bb.y, bb.z, bb.w};
#pragma unroll
            for (int i = 0; i < 8; ++i)
#pragma unroll
                for (int j = 0; j < 4; ++j) acc[i][j] = fmaf(av[i], bv[j], acc[i][j]);
        }
    }
#pragma unroll
    for (int i = 0; i < 8; ++i) ef(m0 + ty * 8 + i, n0 + tx * 4, make_float4(acc[i][0], acc[i][1], acc[i][2], acc[i][3]));
    __syncthreads();
}


#define XB_TMO      128
#define XB_XCNT(j)  (256  + 64 * (j))
#define XB_XSUB(j)  (1280 + 64 * (j))
#define XB_XGEN(j)  (2304 + 64 * (j))
#define XB_TOP      3328
#define XB_TOPGEN   3392
#define XCD_BAR_WORDS 3456
#define XB_SPIN_CAP (1u << 22)
#define LAS __attribute__((address_space(3)))
__device__ __forceinline__ unsigned xb_ld(unsigned* p)              { return __hip_atomic_load(p, __ATOMIC_RELAXED, __HIP_MEMORY_SCOPE_AGENT); }
__device__ __forceinline__ unsigned xb_add(unsigned* p, unsigned v) { return __hip_atomic_fetch_add(p, v, __ATOMIC_RELAXED, __HIP_MEMORY_SCOPE_AGENT); }
__device__ __forceinline__ unsigned xb_xcc_id() { return (unsigned)__builtin_amdgcn_s_getreg((3 << 11) | 20) & 0xFu; }
#define XB_SPIN(cond, bar) do { unsigned _sp = 0; while (cond) { __builtin_amdgcn_s_sleep(0); \
    if ((++_sp & 255u) == 0u) { if (xb_ld(&(bar)[XB_TMO])) break; if (_sp > XB_SPIN_CAP) { atomicAdd(&(bar)[XB_TMO], 1u); break; } } } } while (0)
struct XcdBarrier { unsigned* bar; unsigned x; volatile LAS unsigned* st; };
__device__ __forceinline__ XcdBarrier xcd_barrier_post(unsigned* bar, volatile LAS unsigned* st) {
    XcdBarrier b; b.bar = bar; b.x = xb_xcc_id(); b.st = st;
    if (threadIdx.x == 0) (void)xb_add(&bar[XB_XCNT(b.x)], 1u);
    return b;
}
__device__ __forceinline__ void xcd_barrier_complete(unsigned* bar, unsigned x, unsigned& nloc, unsigned& nx) {
    const unsigned G = gridDim.x * gridDim.y * gridDim.z;
    unsigned sum, cnt, mine, sp = 0u;
    for (;;) {
        sum = 0u; cnt = 0u; mine = 0u;
#pragma unroll
        for (unsigned j = 0; j < 16; ++j) { const unsigned c = xb_ld(&bar[XB_XCNT(j)]); sum += c; cnt += (c > 0u) ? 1u : 0u; mine = (j == x) ? c : mine; }
        if (sum == G) break;
        __builtin_amdgcn_s_sleep(1);
        if ((++sp & 255u) == 0u) { if (xb_ld(&bar[XB_TMO])) break; if (sp > XB_SPIN_CAP) { atomicAdd(&bar[XB_TMO], 1u); break; } }
    }
    nloc = mine > 0u ? mine : 1u; nx = cnt > 0u ? cnt : 1u;
}
__device__ __forceinline__ void xcd_barrier(const XcdBarrier& b) {
    asm volatile("s_waitcnt vmcnt(0)" ::: "memory");
    __syncthreads();
    if (threadIdx.x == 0) {
        unsigned* bar = b.bar;
        __builtin_amdgcn_s_waitcnt(0);
        unsigned nloc = b.st[0], nx = b.st[1];
        if (nloc == 0u) { xcd_barrier_complete(bar, b.x, nloc, nx); b.st[0] = nloc; b.st[1] = nx; }
        const unsigned old = xb_add(&bar[XB_XSUB(b.x)], 1u);
        const unsigned gen = old / nloc;
        if (old + 1u == (gen + 1u) * nloc) {
            __builtin_amdgcn_fence(__ATOMIC_RELEASE, "agent");
            asm volatile("s_waitcnt vmcnt(0)" ::: "memory");
            const unsigned og = xb_add(&bar[XB_TOP], 1u);
            const unsigned tg = og / nx;
            if (og + 1u == (tg + 1u) * nx) xb_add(&bar[XB_TOPGEN], 1u);
            else XB_SPIN(xb_ld(&bar[XB_TOPGEN]) == tg, bar);
            __builtin_amdgcn_fence(__ATOMIC_ACQUIRE, "agent");
            xb_add(&bar[XB_XGEN(b.x)], 1u);
            asm volatile("s_waitcnt vmcnt(0)" ::: "memory");
        } else {
            XB_SPIN(xb_ld(&bar[XB_XGEN(b.x)]) == gen, bar);
            __builtin_amdgcn_fence(__ATOMIC_ACQUIRE, "agent");
            asm volatile("s_waitcnt vmcnt(0)" ::: "memory");
        }
    }
    __syncthreads();
}


namespace pg8 {
#define PG8_LAS __attribute__((address_space(3)))
typedef short bf16x8 __attribute__((ext_vector_type(8)));
typedef float f32x4 __attribute__((ext_vector_type(4)));
typedef unsigned u32x4 __attribute__((ext_vector_type(4)));
typedef unsigned u32x2 __attribute__((ext_vector_type(2)));
constexpr int BM = 256, BK = 64, HALF = 128, HTB = HALF * BK * 2, STAGE_BYTES = 8 * HTB, NXCD = 8, WGM = 4;
__host__ __device__ __forceinline__ int lds_byte(int r, int c) { const int st = (r >> 4) * 2 + (c >> 5), rr = r & 15, cc = c & 31, ob = rr * 64 + cc * 2; return st * 1024 + (ob ^ (((ob >> 9) & 1) << 5)); }
__host__ __device__ __forceinline__ void stage_rc(int b, int& R, int& C) { const int st = b / 1024, sb = b % 1024, swz = sb ^ (((sb >> 9) & 1) << 5); R = (st >> 1) * 16 + swz / 64; C = (st & 1) * 32 + (swz % 64) / 2; }
__host__ __device__ __forceinline__ int perm32(int rho) { const int n = rho >> 4, i = rho & 15; return 8 * (i >> 2) + 4 * n + (i & 3); }
struct Unit { int pm, pn; long boff; long aoff; };
struct Gemm { const bf16_t* A; const bf16_t* Bt; int K, lda, ldb; int kmode = 0; int bdup = 0; };
struct StaticOrder {
    static constexpr bool GATHER = false;
    int nM, nN, nwg, G, c;
    __device__ void init(int M, int N, int G_, int c_) { nM = M / BM; nN = N / BM; nwg = nM * nN; G = G_; c = c_; }
    __device__ bool next(int i, Unit& u) const {
        const long L = (long)i * G + c; if (L >= nwg) return false;
        int wgid = (int)L; { const int q = nwg / NXCD, r = nwg % NXCD, xcd = wgid % NXCD, off = wgid / NXCD; wgid = (xcd < r ? xcd * (q + 1) : r * (q + 1) + (xcd - r) * q) + off; }
        const int nig = WGM * nN, gid = wgid / nig, fm = gid * WGM, gsz = (nM - fm) < WGM ? (nM - fm) : WGM;
        u.pm = fm + ((wgid % nig) % gsz); u.pn = (wgid % nig) / gsz; u.boff = 0; u.aoff = 0; return true;
    }
    __device__ __forceinline__ void a_ready(const Unit&) const {}
    __device__ __forceinline__ void done(const Unit&) const {}
};
struct MoeOrder {
    static constexpr bool GATHER = false;
    const int* tile_e; int nwg, G, c; long estride;
    __device__ bool next(int i, Unit& u) const {
        const long L = (long)i * G + c; if (L >= nwg) return false;
        u.pm = (int)(L >> 2); u.pn = (int)(L & 3); u.boff = (long)tile_e[u.pm] * estride; u.aoff = 0; return true;
    }
    __device__ __forceinline__ void a_ready(const Unit&) const {}
    __device__ __forceinline__ void done(const Unit&) const {}
};
struct MoeGatherOrder {
    static constexpr bool GATHER = true;
    const int* tile_e; const int* inv; int nwg, G, c; long estride;
    __device__ bool next(int i, Unit& u) const {
        const long L = (long)i * G + c; if (L >= nwg) return false;
        u.pm = (int)(L >> 2); u.pn = (int)(L & 3); u.boff = (long)tile_e[u.pm] * estride; u.aoff = 0; return true;
    }
    __device__ __forceinline__ void a_ready(const Unit&) const {}
    __device__ __forceinline__ void done(const Unit&) const {}
};
struct CmpOrder {
    static constexpr bool GATHER = false;
    int G, c;
    __device__ bool next(int i, Unit& u) const {
        const int L = i * G + c; if (L >= 128) return false;
        const int kv = L >> 6, bg = (L >> 3) & 7, half = (L >> 2) & 1, kq = L & 3;
        u.pm = half; u.pn = (kq << 4) | (kv << 3) | bg;
        u.aoff = ((long)((bg >> 1) * T_ + 4 * kq) * LDP + (kv ? C_VC : C_KC) + (bg & 1) * 128) * 2;
        u.boff = ((long)kv * 128 * 4096 + kq * 512) * 2;
        return true;
    }
    __device__ __forceinline__ void a_ready(const Unit&) const {}
    __device__ __forceinline__ void done(const Unit&) const {}
};
__device__ __forceinline__ unsigned cvt_pk_bf16(float lo, float hi) { return pk_bf16(lo, hi); }
__device__ __forceinline__ f32x4 unpk_lo(u32x4 w) { return (f32x4){__uint_as_float(w.x << 16), __uint_as_float(w.x & 0xFFFF0000u), __uint_as_float(w.y << 16), __uint_as_float(w.y & 0xFFFF0000u)}; }
__device__ __forceinline__ f32x4 unpk_hi(u32x4 w) { return (f32x4){__uint_as_float(w.z << 16), __uint_as_float(w.z & 0xFFFF0000u), __uint_as_float(w.w << 16), __uint_as_float(w.w & 0xFFFF0000u)}; }
__device__ __forceinline__ u32x4 pk8(f32x4 v0, f32x4 v1) { u32x4 w; w.x = cvt_pk_bf16(v0[0], v0[1]); w.y = cvt_pk_bf16(v0[2], v0[3]); w.z = cvt_pk_bf16(v1[0], v1[1]); w.w = cvt_pk_bf16(v1[2], v1[3]); return w; }
__device__ __forceinline__ f32x4 sig4(f32x4 v) { return (f32x4){sigmoidf_(v[0]), sigmoidf_(v[1]), sigmoidf_(v[2]), sigmoidf_(v[3])}; }
struct EpiProj {
    static constexpr bool PERM = true, AFTER_DRAIN = false, HAS_MID = false, HAS_INIT = true;
    bf16_t* proj; bf16_t* mg; float* gate; const float* bias;
    __device__ __forceinline__ void init_load(f32x4 (&bi)[2][2], const Unit& u, int wc, int fq) const {
        int fq_ = fq; asm volatile("" : "+v"(fq_));
        const float* bp = bias + u.pn * BM + wc * 32 + 8 * fq_;
#pragma unroll
        for (int bj = 0; bj < 2; ++bj)
#pragma unroll
            for (int n = 0; n < 2; ++n) bi[bj][n] = *(const f32x4*)(bp + bj * HALF + 4 * n);
        asm volatile("" ::: "memory");
    }
    __device__ __forceinline__ void operator()(const f32x4 (&acc)[2][2][4][2], const Unit& u, int wr, int wc, int fr, int fq) const {
        int fr_ = fr, fq_ = fq; asm volatile("" : "+v"(fr_), "+v"(fq_));
        const int row0 = u.pm * BM + wr * 64 + fr_, c8 = u.pn * BM + wc * 32 + 8 * fq_;
#pragma unroll
        for (int ai = 0; ai < 2; ++ai)
#pragma unroll
            for (int m = 0; m < 4; ++m) {
                const size_t row = (size_t)(row0 + ai * HALF + m * 16);
                if (u.pn >= 26 && u.pn < 34) {
                    bf16_t* mp_ = mg + row * 2048 + (u.pn - 26) * 128 + (c8 - u.pn * BM);
#pragma unroll
                    for (int n = 0; n < 2; ++n) {
                        f32x4 nn = sig4(acc[ai][1][m][n]), hh = sig4(acc[ai][0][m][n]);
#pragma unroll
                        for (int j = 0; j < 4; ++j) { nn[j] = fmaxf(nn[j], 8.673617e-19f); hh[j] *= __builtin_amdgcn_rcpf(nn[j]); }
                        const u32x2 rp = {cvt_pk_bf16(hh[0], hh[1]), cvt_pk_bf16(hh[2], hh[3])}, np = {cvt_pk_bf16(nn[0], nn[1]), cvt_pk_bf16(nn[2], nn[3])};
                        *(u32x2*)(mp_ + 4 * n) = rp; *(u32x2*)(mp_ + 1024 + 4 * n) = np;
                    }
                } else {
#pragma unroll
                for (int bj = 0; bj < 2; ++bj) {
                    const f32x4 v0 = acc[ai][bj][m][0], v1 = acc[ai][bj][m][1];
                    const int col = c8 + bj * HALF;
                    *(u32x4*)(proj + row * LDP + col) = pk8(v0, v1);
                }
                }
            }
    }
};
struct EpiMrg {
    static constexpr bool PERM = true, AFTER_DRAIN = false, HAS_MID = true, HAS_INIT = false;
    const bf16_t* mg; bf16_t* mr;
    __device__ __forceinline__ void mid(f32x4 (&acc)[2][2][4][2], const Unit& u, int wr, int wc, int fr, int fq) const {
        int fr_ = fr, fq_ = fq; asm volatile("" : "+v"(fr_), "+v"(fq_));
        const int row0 = u.pm * BM + wr * 64 + fr_, c8 = u.pn * BM + wc * 32 + 8 * fq_;
#pragma unroll
        for (int ai = 0; ai < 2; ++ai) {
            u32x4 rw[4][2];
#pragma unroll
            for (int m = 0; m < 4; ++m)
#pragma unroll
                for (int bj = 0; bj < 2; ++bj) rw[m][bj] = *(const u32x4*)(mg + (size_t)(row0 + ai * HALF + m * 16) * 2048 + c8 + bj * HALF);
#pragma unroll
            for (int m = 0; m < 4; ++m)
#pragma unroll
                for (int bj = 0; bj < 2; ++bj) { acc[ai][bj][m][0] *= unpk_lo(rw[m][bj]); acc[ai][bj][m][1] *= unpk_hi(rw[m][bj]); }
            asm volatile("" ::: "memory");
        }
    }
    __device__ __forceinline__ void operator()(const f32x4 (&acc)[2][2][4][2], const Unit& u, int wr, int wc, int fr, int fq) const {
        int fr_ = fr, fq_ = fq; asm volatile("" : "+v"(fr_), "+v"(fq_));
        const int row0 = u.pm * BM + wr * 64 + fr_, c8 = u.pn * BM + wc * 32 + 8 * fq_;
#pragma unroll
        for (int ai = 0; ai < 2; ++ai) {
            u32x4 nw[4][2];
#pragma unroll
            for (int m = 0; m < 4; ++m)
#pragma unroll
                for (int bj = 0; bj < 2; ++bj) nw[m][bj] = *(const u32x4*)(mg + (size_t)(row0 + ai * HALF + m * 16) * 2048 + 1024 + c8 + bj * HALF);
#pragma unroll
            for (int m = 0; m < 4; ++m)
#pragma unroll
                for (int bj = 0; bj < 2; ++bj)
                    *(u32x4*)(mr + (size_t)(row0 + ai * HALF + m * 16) * 1024 + c8 + bj * HALF) = pk8(unpk_lo(nw[m][bj]) * acc[ai][bj][m][0], unpk_hi(nw[m][bj]) * acc[ai][bj][m][1]);
            asm volatile("" ::: "memory");
        }
    }
};
struct EpiWout {
    static constexpr bool PERM = true, AFTER_DRAIN = false, HAS_MID = false, HAS_INIT = false;
    const float* x; const float* mod; bf16_t* z;
    __device__ __forceinline__ void operator()(const f32x4 (&acc)[2][2][4][2], const Unit& u, int wr, int wc, int fr, int fq) const {
        const int row0 = u.pm * BM + wr * 64 + fr, c8 = u.pn * BM + wc * 32 + 8 * fq;
        const float* g1 = mod + ((u.pm * BM) / T_) * 6144 + 2048 + c8;
        f32x4 gv[2][2];
#pragma unroll
        for (int bj = 0; bj < 2; ++bj) { gv[bj][0] = *(const f32x4*)(g1 + bj * HALF) + 1.0f; gv[bj][1] = *(const f32x4*)(g1 + bj * HALF + 4) + 1.0f; }
#pragma unroll
        for (int ai = 0; ai < 2; ++ai)
#pragma unroll
            for (int mp = 0; mp < 2; ++mp) {
                f32x4 xv[2][2][2];
#pragma unroll
                for (int mm = 0; mm < 2; ++mm)
#pragma unroll
                    for (int bj = 0; bj < 2; ++bj) { const float* xp = x + (size_t)(row0 + ai * HALF + (mp * 2 + mm) * 16) * 1024 + c8 + bj * HALF; xv[mm][bj][0] = *(const f32x4*)xp; xv[mm][bj][1] = *(const f32x4*)(xp + 4); }
#pragma unroll
                for (int mm = 0; mm < 2; ++mm)
#pragma unroll
                    for (int bj = 0; bj < 2; ++bj) { const int m = mp * 2 + mm;
                        *(u32x4*)(z + (size_t)(row0 + ai * HALF + m * 16) * 1024 + c8 + bj * HALF) = pk8(xv[mm][bj][0] * ALPHA + gv[bj][0] * acc[ai][bj][m][0], xv[mm][bj][1] * ALPHA + gv[bj][1] * acc[ai][bj][m][1]); }
                asm volatile("" ::: "memory");
            }
    }
};
struct EpiExp1 {
    static constexpr bool PERM = true, AFTER_DRAIN = false, HAS_MID = false, HAS_INIT = false;
    bf16_t* U;
    __device__ __forceinline__ void operator()(const f32x4 (&acc)[2][2][4][2], const Unit& u, int wr, int wc, int fr, int fq) const {
        const int row0 = u.pm * BM + wr * 64 + fr, c8 = u.pn * HALF + wc * 32 + 8 * fq;
#pragma unroll
        for (int ai = 0; ai < 2; ++ai)
#pragma unroll
            for (int m = 0; m < 4; ++m) {
                f32x4 r[2];
#pragma unroll
                for (int n = 0; n < 2; ++n)
#pragma unroll
                    for (int j = 0; j < 4; ++j) r[n][j] = siluf_(acc[ai][0][m][n][j]) * acc[ai][1][m][n][j];
                *(u32x4*)(U + (size_t)(row0 + ai * HALF + m * 16) * 512 + c8) = pk8(r[0], r[1]);
            }
    }
};
struct EpiCmpAcc {
    static constexpr bool PERM = false, AFTER_DRAIN = false, HAS_MID = false, HAS_INIT = false;
    float* hp;
    __device__ __forceinline__ void operator()(const f32x4 (&acc)[2][2][4][2], const Unit& u, int wr, int wc, int fr, int fq) const {
        const int row0 = (u.pn >> 4) * 8192 + (u.pn & 15) * 512 + u.pm * BM + wr * 64 + fr, col0 = wc * 32 + 4 * fq;
#pragma unroll
        for (int ai = 0; ai < 2; ++ai)
#pragma unroll
            for (int m = 0; m < 4; ++m) { float* rp = hp + (size_t)(row0 + ai * HALF + m * 16) * 256 + col0;
#pragma unroll
                for (int bj = 0; bj < 2; ++bj)
#pragma unroll
                    for (int n = 0; n < 2; ++n) *(f32x4*)(rp + bj * HALF + n * 16) = acc[ai][bj][m][n]; }
    }
};
struct EpiBf {
    static constexpr bool PERM = true, AFTER_DRAIN = false, HAS_MID = false, HAS_INIT = false;
    bf16_t* O; int ldo;
    __device__ __forceinline__ void operator()(const f32x4 (&acc)[2][2][4][2], const Unit& u, int wr, int wc, int fr, int fq) const {
        const int row0 = u.pm * BM + wr * 64 + fr, c8 = u.pn * BM + wc * 32 + 8 * fq;
#pragma unroll
        for (int ai = 0; ai < 2; ++ai)
#pragma unroll
            for (int m = 0; m < 4; ++m)
#pragma unroll
                for (int bj = 0; bj < 2; ++bj) *(u32x4*)(O + (size_t)(row0 + ai * HALF + m * 16) * ldo + c8 + bj * HALF) = pk8(acc[ai][bj][m][0], acc[ai][bj][m][1]);
    }
};
template <class Epi, class Sched>
__device__ __forceinline__ void gemm_phase(PG8_LAS unsigned char* lds, const Gemm g, const Sched& S, const Epi& E) {
    const int tid = tid_(), wid = __builtin_amdgcn_readfirstlane(tid >> 6), lane = tid & 63, wr = wid >> 2, wc = wid & 3, fr = lane & 15, fq = lane >> 4;
    const int K = g.K, nt = K / BK;
    unsigned voffA[2], voffB[2];
#pragma unroll
    for (int i = 0; i < 2; ++i) { int R, C; stage_rc(tid * 16 + i * 8192, R, C); const int Rb = Epi::PERM ? ((R & ~31) + perm32(R & 31)) : R;
        voffA[i] = (unsigned)(R * g.lda + C) * 2u; voffB[i] = (unsigned)(Rb * g.ldb + C) * 2u; }
    const size_t kstep = (size_t)(BK * 2);
#define PG8_KA(t) (g.kmode == 1 ? (size_t)((t) >> 1) * (LDP * 2) + (size_t)((t) & 1) * 128 : g.kmode == 2 ? (size_t)(t) * kstep + ((t) >= 16 ? (size_t)2048 : (size_t)0) : (size_t)(t) * kstep)
    const size_t hstepA = Sched::GATHER ? (size_t)0 : (size_t)HALF * g.lda * 2, hstepB = g.bdup == 1 ? (size_t)0 : g.bdup == 2 ? (size_t)4096 : (size_t)HALF * g.ldb * 2;
    const size_t tstepA = 2 * hstepA, tstepB = g.bdup ? (size_t)0 : 2 * hstepB;
    const unsigned ldsw = (unsigned)wid * 1024u;
    const int aoff = lds_byte(wr * 64 + fr, fq * 8), boff = lds_byte(wc * 32 + fr, fq * 8);
#define PG8_SA(b, h) (((b) * 2 + (h)) * HTB)
#define PG8_SB(b, h) ((4 + (b) * 2 + (h)) * HTB)
#define PG8_STAGE(bufoff, gbase, voff) do { _Pragma("unroll") for (int _i = 0; _i < 2; ++_i) \
        __builtin_amdgcn_global_load_lds((const unsigned*)((const char*)(gbase) + (voff)[_i]), (PG8_LAS unsigned*)(lds + (bufoff) + ldsw + _i * 8192), 16, 0, 0); } while (0)
    unsigned gA[2][2] = {{0u, 0u}, {0u, 0u}}, gN[2][2] = {{0u, 0u}, {0u, 0u}};
#define PG8_GMAP(dst, un) do { if constexpr (Sched::GATHER) { _Pragma("unroll") for (int _h = 0; _h < 2; ++_h) _Pragma("unroll") for (int _i = 0; _i < 2; ++_i) { int R_, C_; stage_rc(tid * 16 + _i * 8192, R_, C_); \
        dst[_h][_i] = (unsigned)S.inv[(un).pm * BM + _h * HALF + R_] * (unsigned)(g.lda * 2) + (unsigned)(C_ * 2); } } } while (0)
#define PG8_STAGE_A(bufoff, gbase, h, NX) do { if constexpr (Sched::GATHER) { if (NX) PG8_STAGE(bufoff, gbase, gN[h]); else PG8_STAGE(bufoff, gbase, gA[h]); } \
        else PG8_STAGE(bufoff, (gbase) + ((h) ? hstepA : (size_t)0), voffA); } while (0)
#define PG8_LDA(dst, b, h) do { _Pragma("unroll") for (int m = 0; m < 4; ++m) _Pragma("unroll") for (int k = 0; k < 2; ++k) dst[m][k] = *(const PG8_LAS bf16x8*)(lds + PG8_SA(b, h) + aoff + m * 2048 + k * 1024); } while (0)
#define PG8_LDB(dst, b, h) do { _Pragma("unroll") for (int n = 0; n < 2; ++n) _Pragma("unroll") for (int k = 0; k < 2; ++k) dst[n][k] = *(const PG8_LAS bf16x8*)(lds + PG8_SB(b, h) + boff + n * 2048 + k * 1024); } while (0)
#define PG8_MMA(ai, bj, At, Bt) do { __builtin_amdgcn_s_setprio(1); _Pragma("unroll") for (int m = 0; m < 4; ++m) _Pragma("unroll") for (int n = 0; n < 2; ++n) _Pragma("unroll") for (int k = 0; k < 2; ++k) \
        acc[ai][bj][m][n] = __builtin_amdgcn_mfma_f32_16x16x32_bf16(Bt[n][k], At[m][k], acc[ai][bj][m][n], 0, 0, 0); __builtin_amdgcn_s_setprio(0); } while (0)
#define PG8_WAIT_V(n) asm volatile("s_waitcnt vmcnt(" #n ")" ::: "memory")
#define PG8_WAIT_L(n) asm volatile("s_waitcnt lgkmcnt(" #n ")" ::: "memory")
#define PG8_BAR __builtin_amdgcn_s_barrier()
#define PG8_SCHED __builtin_amdgcn_sched_barrier(0)
    Unit cur, nxt; int ui = 0;
    if (!S.next(0, cur)) return;
    f32x4 acc[2][2][4][2];
    f32x4 binit[2][2] = {{{0.f, 0.f, 0.f, 0.f}, {0.f, 0.f, 0.f, 0.f}}, {{0.f, 0.f, 0.f, 0.f}, {0.f, 0.f, 0.f, 0.f}}};
    if constexpr (Epi::HAS_INIT) E.init_load(binit, cur, wc, fq);
#pragma unroll
    for (int a = 0; a < 2; ++a)
#pragma unroll
        for (int b = 0; b < 2; ++b)
#pragma unroll
            for (int m = 0; m < 4; ++m)
#pragma unroll
                for (int n = 0; n < 2; ++n) acc[a][b][m][n] = binit[b][n];
    bf16x8 At[4][2], B0[2][2], B1[2][2];
    const char* cA = (const char*)g.A + cur.aoff + (size_t)cur.pm * tstepA; const char* cB = (const char*)g.Bt + cur.boff + (size_t)cur.pn * tstepB;
    S.a_ready(cur);
    PG8_GMAP(gA, cur);
    PG8_STAGE(PG8_SB(0, 0), cB, voffB); PG8_STAGE_A(PG8_SA(0, 0), cA, 0, false); PG8_STAGE(PG8_SB(0, 1), cB + hstepB, voffB); PG8_STAGE_A(PG8_SA(0, 1), cA, 1, false);
    if (wr == 1) PG8_BAR;
    PG8_WAIT_V(4); PG8_BAR;
    PG8_STAGE(PG8_SB(1, 0), cB + kstep, voffB); PG8_STAGE_A(PG8_SA(1, 0), cA + PG8_KA(1), 0, false); PG8_STAGE(PG8_SB(1, 1), cB + hstepB + kstep, voffB);
    PG8_WAIT_V(6); PG8_BAR;
    for (;;) {
        const bool has_next = S.next(ui + 1, nxt);
        if constexpr (Sched::GATHER) { if (has_next) PG8_GMAP(gN, nxt); else { gN[0][0] = gA[0][0]; gN[0][1] = gA[0][1]; gN[1][0] = gA[1][0]; gN[1][1] = gA[1][1]; } }
        const char* nA = has_next ? (const char*)g.A + nxt.aoff + (size_t)nxt.pm * tstepA : cA; const char* nB = has_next ? (const char*)g.Bt + nxt.boff + (size_t)nxt.pn * tstepB : cB;
        for (int t = 0; t < nt; t += 2) {
            const bool last = (t == nt - 2);
            const char* a1 = cA + PG8_KA(t + 1);
            const char* a2 = last ? nA : cA + PG8_KA(t + 2); const char* b2 = last ? nB : cB + (size_t)(t + 2) * kstep;
            const char* a3 = last ? nA + PG8_KA(1) : cA + PG8_KA(t + 3); const char* b3 = b2 + kstep;
            if (last && has_next) S.a_ready(nxt);
            if constexpr (Epi::HAS_MID) { if (t == 16) E.mid(acc, cur, wr, wc, fr, fq); }
            PG8_LDB(B0, 0, 0); PG8_SCHED; PG8_LDA(At, 0, 0); PG8_STAGE_A(PG8_SA(1, 1), a1, 1, false);
            PG8_WAIT_L(8); PG8_BAR; PG8_WAIT_L(0); PG8_MMA(0, 0, At, B0); PG8_BAR; PG8_SCHED;
            PG8_LDB(B1, 0, 1); PG8_STAGE(PG8_SB(0, 0), b2, voffB);
            PG8_BAR; PG8_WAIT_L(0); PG8_MMA(0, 1, At, B1); PG8_BAR;
            PG8_LDA(At, 0, 1); PG8_STAGE_A(PG8_SA(0, 0), a2, 0, last);
            PG8_BAR; PG8_WAIT_L(0); PG8_MMA(1, 0, At, B0); PG8_BAR; PG8_SCHED;
            PG8_STAGE(PG8_SB(0, 1), b2 + hstepB, voffB);
            PG8_WAIT_V(6); PG8_BAR; PG8_MMA(1, 1, At, B1); PG8_BAR;
            PG8_LDB(B0, 1, 0); PG8_SCHED; PG8_LDA(At, 1, 0); PG8_STAGE_A(PG8_SA(0, 1), a2, 1, last);
            PG8_WAIT_L(8); PG8_BAR; PG8_WAIT_L(0); PG8_MMA(0, 0, At, B0); PG8_BAR; PG8_SCHED;
            PG8_LDB(B1, 1, 1); PG8_STAGE(PG8_SB(1, 0), b3, voffB);
            PG8_BAR; PG8_WAIT_L(0); PG8_MMA(0, 1, At, B1); PG8_BAR;
            PG8_LDA(At, 1, 1); PG8_STAGE_A(PG8_SA(1, 0), a3, 0, last);
            PG8_BAR; PG8_WAIT_L(0); PG8_MMA(1, 0, At, B0); PG8_BAR; PG8_SCHED;
            PG8_STAGE(PG8_SB(1, 1), b3 + hstepB, voffB);
            PG8_WAIT_V(6); PG8_BAR; PG8_MMA(1, 1, At, B1); PG8_BAR;
        }
        if constexpr (Epi::HAS_INIT) { if (has_next) E.init_load(binit, nxt, wc, fq); }
        if constexpr (!Epi::AFTER_DRAIN) { E(acc, cur, wr, wc, fr, fq); S.done(cur); }
        if (!has_next) break;
#pragma unroll
        for (int a = 0; a < 2; ++a)
#pragma unroll
            for (int b = 0; b < 2; ++b)
#pragma unroll
                for (int m = 0; m < 4; ++m)
#pragma unroll
                    for (int n = 0; n < 2; ++n) acc[a][b][m][n] = binit[b][n];
        cur = nxt; cA = nA; cB = nB; ++ui;
        if constexpr (Sched::GATHER) { gA[0][0] = gN[0][0]; gA[0][1] = gN[0][1]; gA[1][0] = gN[1][0]; gA[1][1] = gN[1][1]; }
    }
    PG8_WAIT_V(0);
    if (wr == 0) PG8_BAR;
    PG8_BAR;
    if constexpr (Epi::AFTER_DRAIN) { E.fused(acc, cur, wr, wc, fr, fq, lds, wid, lane); S.done(cur); }
#undef PG8_SA
#undef PG8_SB
#undef PG8_STAGE
#undef PG8_STAGE_A
#undef PG8_GMAP
#undef PG8_LDA
#undef PG8_LDB
#undef PG8_MMA
#undef PG8_WAIT_V
#undef PG8_WAIT_L
#undef PG8_BAR
#undef PG8_SCHED
#undef PG8_KA
}
}

namespace nsa {
typedef short bf16x8 __attribute__((ext_vector_type(8)));
typedef short s16x4 __attribute__((ext_vector_type(4)));
typedef float f32x16 __attribute__((ext_vector_type(16)));
typedef float f32x4 __attribute__((ext_vector_type(4)));
typedef unsigned u32x4 __attribute__((ext_vector_type(4)));
constexpr int SHM_V = 16384, SHM_K = 16384;
constexpr int L_V = 0, L_K = 32768, L_WS = 65536, L_LUT = 67584, L_IMP = 69632, L_SEL = 102400, L_UNI = 103424, L_TL = 103488, L_END = 104064;
constexpr float LOG2E = 1.4426950408889634f, C2 = 0.08838834764831845f * LOG2E, THR2 = 11.5f;
#define KSWZ(row, colB) ((row) * 256 + ((colB) ^ (((row) & 7) << 4)))
#define SBAR() __builtin_amdgcn_sched_barrier(0)
__device__ __forceinline__ int v_st(int k, int c) { const int kk = (k & ~0xC) | ((k & 4) << 1) | ((k & 8) >> 1); return ((kk >> 3) * 4 + (c >> 5)) * 512 + ((kk & 7) * 32 + (c & 31)) * 2; }
__device__ __forceinline__ int v_rd_base(int lane) { return ((lane & 3) << 3) | (((lane >> 2) & 3) << 6) | (((lane >> 4) & 1) << 5) | (((lane >> 5) & 1) << 8); }
constexpr int v_rd_off(int d0, int ks, int half) { return d0 * 512 + ks * 4096 + half * 2048; }
__device__ __forceinline__ int crow(int r, int hi) { return (r & 3) + 8 * (r >> 2) + 4 * hi; }
__device__ __forceinline__ unsigned cvtpk(float lo, float hi) { unsigned r; asm volatile("v_cvt_pk_bf16_f32 %0, %1, %2" : "=v"(r) : "v"(lo), "v"(hi)); return r; }

template <int KB>
__device__ __forceinline__ void qkt(f32x16& p0, f32x16& p1, const char* K_lds, int r32, int hi, const bf16x8* qr) {
    p0 = f32x16{}; p1 = f32x16{};
    __builtin_amdgcn_s_setprio(1);
    const char* kb[4];
#pragma unroll
    for (int dd = 0; dd < 4; ++dd) kb[dd] = K_lds + KB * SHM_K + KSWZ(r32, (dd * 16 + hi * 8) * 2);
#pragma unroll
    for (int d0 = 0; d0 < 8; ++d0) { const char* a = kb[d0 & 3] + (d0 >> 2) * 128;
        bf16x8 b0 = *reinterpret_cast<const bf16x8*>(a);
        bf16x8 b1 = *reinterpret_cast<const bf16x8*>(a + 32 * 256);
        p0 = __builtin_amdgcn_mfma_f32_32x32x16_bf16(b0, qr[d0], p0, 0, 0, 0);
        p1 = __builtin_amdgcn_mfma_f32_32x32x16_bf16(b1, qr[d0], p1, 0, 0, 0); }
    __builtin_amdgcn_s_setprio(0);
}
template <int VB>
__device__ __forceinline__ void pv_tile(f32x16* o, int vb0, bf16x8 pa0, bf16x8 pa1, bf16x8 pa2, bf16x8 pa3) {
#define TRRD(dst, off) asm volatile("ds_read_b64_tr_b16 %0, %1 offset:%2" : "=&v"(dst) : "v"(vb0), "i"(off) : "memory")
#define PV_D0(d0) do { s16x4 l0, l1, l2, l3, h0, h1, h2, h3; constexpr int b_ = VB * SHM_V + v_rd_off(d0, 0, 0); \
        TRRD(l0, b_); TRRD(h0, b_ + 2048); TRRD(l1, b_ + 4096); TRRD(h1, b_ + 6144); TRRD(l2, b_ + 8192); TRRD(h2, b_ + 10240); TRRD(l3, b_ + 12288); TRRD(h3, b_ + 14336); \
        asm volatile("s_waitcnt lgkmcnt(0)" ::: "memory"); SBAR(); \
        o[d0] = __builtin_amdgcn_mfma_f32_32x32x16_bf16(pa0, (bf16x8){l0[0], l0[1], l0[2], l0[3], h0[0], h0[1], h0[2], h0[3]}, o[d0], 0, 0, 0); \
        o[d0] = __builtin_amdgcn_mfma_f32_32x32x16_bf16(pa1, (bf16x8){l1[0], l1[1], l1[2], l1[3], h1[0], h1[1], h1[2], h1[3]}, o[d0], 0, 0, 0); \
        o[d0] = __builtin_amdgcn_mfma_f32_32x32x16_bf16(pa2, (bf16x8){l2[0], l2[1], l2[2], l2[3], h2[0], h2[1], h2[2], h2[3]}, o[d0], 0, 0, 0); \
        o[d0] = __builtin_amdgcn_mfma_f32_32x32x16_bf16(pa3, (bf16x8){l3[0], l3[1], l3[2], l3[3], h3[0], h3[1], h3[2], h3[3]}, o[d0], 0, 0, 0); } while (0)
    __builtin_amdgcn_s_setprio(1); PV_D0(0); PV_D0(1); PV_D0(2); PV_D0(3); __builtin_amdgcn_s_setprio(0);
#undef PV_D0
#undef TRRD
}
__device__ __forceinline__ void mask_tile(f32x16& p0, f32x16& p1, int dq, unsigned W) {
    const float NEG = -__builtin_inff();
    asm volatile("" : "+v"(dq));
#pragma unroll
    for (int r = 0; r < 16; ++r) {
        const int c = (r & 3) + 8 * (r >> 2);
        if ((unsigned)(dq - c) >= W) p0[r] = NEG;
        if ((unsigned)(dq - c - 32) >= W) p1[r] = NEG;
    }
}
template <int STRIDE>
__device__ __forceinline__ void bias_near(f32x16& p0, f32x16& p1, int dbase, const float* lut) {
    asm volatile("" : "+v"(dbase));
#pragma unroll
    for (int r = 0; r < 16; ++r) {
        const int c = (r & 3) + 8 * (r >> 2);
        int d0 = dbase - STRIDE * c, d1 = dbase - STRIDE * (c + 32);
        d0 = d0 < 0 ? 0 : (d0 > 127 ? 127 : d0); d1 = d1 < 0 ? 0 : (d1 > 127 ? 127 : d1);
        p0[r] = fmaf(p0[r], C2, lut[d0]); p1[r] = fmaf(p1[r], C2, lut[d1]);
    }
}
__device__ __forceinline__ void bias_const(f32x16& p0, f32x16& p1, float cb) {
#pragma unroll
    for (int r = 0; r < 16; ++r) { p0[r] = fmaf(p0[r], C2, cb); p1[r] = fmaf(p1[r], C2, cb); }
}
__device__ __forceinline__ float half_max(float v) { auto rr = __builtin_amdgcn_permlane32_swap(__float_as_uint(v), __float_as_uint(v), false, false); return fmaxf(__uint_as_float(rr[0]), __uint_as_float(rr[1])); }
__device__ __forceinline__ float half_sum(float v) { auto rr = __builtin_amdgcn_permlane32_swap(__float_as_uint(v), __float_as_uint(v), false, false); return __uint_as_float(rr[0]) + __uint_as_float(rr[1]); }
__device__ __forceinline__ void softmax_online(f32x16& p0, f32x16& p1, float sc, float cb2, bool sel, float& m, float& l, float& alpha) {
    float pmax = p0[0];
#pragma unroll
    for (int r = 1; r < 16; ++r) pmax = fmaxf(pmax, p0[r]);
#pragma unroll
    for (int r = 0; r < 16; ++r) pmax = fmaxf(pmax, p1[r]);
    pmax = half_max(pmax);
    pmax = sel ? fmaf(pmax, sc, cb2) : -__builtin_inff();
    if (__all(pmax - m <= THR2)) alpha = 1.f;
    else { const float mn = fmaxf(m, pmax); alpha = __builtin_amdgcn_exp2f(m - mn); m = mn; }
    const float off = sel ? cb2 - m : -__builtin_inff();
#pragma unroll
    for (int r = 0; r < 16; ++r) { p0[r] = fmaf(p0[r], sc, off); p1[r] = fmaf(p1[r], sc, off); }
    SBAR();
#pragma unroll
    for (int r = 0; r < 16; ++r) { p0[r] = __builtin_amdgcn_exp2f(p0[r]); p1[r] = __builtin_amdgcn_exp2f(p1[r]); }
    SBAR();
    float ps = 0.f;
#pragma unroll
    for (int r = 0; r < 16; ++r) ps += p0[r] + p1[r];
    l = l * alpha + half_sum(ps);
}
__device__ __forceinline__ void pack_p(const f32x16& p0, const f32x16& p1, bf16x8& pa0, bf16x8& pa1, bf16x8& pa2, bf16x8& pa3) {
#define PK4(P, B_, OUT) do { unsigned a0 = cvtpk(P[B_+0], P[B_+1]), a1 = cvtpk(P[B_+2], P[B_+3]); \
        unsigned b0 = cvtpk(P[B_+4], P[B_+5]), b1 = cvtpk(P[B_+6], P[B_+7]); \
        auto r0 = __builtin_amdgcn_permlane32_swap(a0, b0, false, false); auto r1 = __builtin_amdgcn_permlane32_swap(a1, b1, false, false); \
        u32x4 w = {r0[0], r1[0], r0[1], r1[1]}; OUT = *reinterpret_cast<bf16x8*>(&w); } while (0)
    PK4(p0, 0, pa0); PK4(p0, 8, pa1); PK4(p1, 0, pa2); PK4(p1, 8, pa3);
#undef PK4
}
__device__ __forceinline__ void rescale_o(f32x16* o, float alpha, float* al_l, int r32, int hi) {
    if (__any(alpha < 1.f)) {
        if (hi == 0) al_l[r32] = alpha;
        asm volatile("s_waitcnt lgkmcnt(0)" ::: "memory");
#pragma unroll
        for (int r = 0; r < 16; ++r) { const float a = al_l[crow(r, hi)];
#pragma unroll
            for (int d = 0; d < 4; ++d) o[d][r] *= a; }
    }
}
__device__ __forceinline__ void flush_out(const f32x16* o, float lsum, int br, unsigned char* ws, char* lds, int b, int g, int qb, int wid, int lane_in, bool first) {
    int lane = lane_in; asm volatile("" : "+v"(lane));
    const int r32 = lane & 31, hi = lane >> 5, head = g * 4 + (wid >> 1);
    const size_t tok = (size_t)b * T_ + qb * 64 + (wid & 1) * 32;
    float* li_l = (float*)(lds + L_WS) + wid * 64;
    bf16_t* tb = (bf16_t*)(lds + (first ? wid * 8192 : wid < 4 ? L_IMP + wid * 8192 : wid < 7 ? 104448 + (wid - 4) * 8192 : 131584));
    bf16_t* orow = (bf16_t*)(ws + OFF_PROJ) + tok * LDP + C_NQ + head * 128;
    const float gate = ((const float*)(ws + OFF_GATE))[(tok + r32) * 24 + head * 3 + br];
    uint4 gq[8];
    if (!first) {
#pragma unroll
        for (int i = 0; i < 8; ++i) { const int idx = i * 64 + lane, row = idx >> 4, ch = idx & 15; gq[i] = *(const uint4*)(orow + (size_t)row * LDP + ch * 8); }
    }
    const float f_lane = br == 0 ? gate : (lsum > 0.f ? gate * __builtin_amdgcn_rcpf(lsum) : 0.f);
    if (hi == 0) li_l[r32] = f_lane;
    asm volatile("s_waitcnt lgkmcnt(0)" ::: "memory");
#pragma unroll
    for (int r = 0; r < 16; ++r) {
        const float f = li_l[crow(r, hi)];
        const unsigned u01 = pk_bf16(o[0][r] * f, o[1][r] * f), u23 = pk_bf16(o[2][r] * f, o[3][r] * f);
        bf16_t* tp = tb + crow(r, hi) * 128 + r32;
        tp[0] = (bf16_t)u01; tp[32] = (bf16_t)(u01 >> 16); tp[64] = (bf16_t)u23; tp[96] = (bf16_t)(u23 >> 16);
    }
    asm volatile("s_waitcnt lgkmcnt(0)" ::: "memory");
#pragma unroll
    for (int i = 0; i < 8; ++i) {
        const int idx = i * 64 + lane, row = idx >> 4, ch = idx & 15;
        uint4 w = *(const uint4*)(tb + row * 128 + ch * 8);
        uint4* gp = (uint4*)(orow + (size_t)row * LDP + ch * 8);
        if (!first) {
            const uint4 g = gq[i];
            w.x = cvtpk(__uint_as_float(w.x << 16) + __uint_as_float(g.x << 16), __uint_as_float(w.x & 0xFFFF0000u) + __uint_as_float(g.x & 0xFFFF0000u));
            w.y = cvtpk(__uint_as_float(w.y << 16) + __uint_as_float(g.y << 16), __uint_as_float(w.y & 0xFFFF0000u) + __uint_as_float(g.y & 0xFFFF0000u));
            w.z = cvtpk(__uint_as_float(w.z << 16) + __uint_as_float(g.z << 16), __uint_as_float(w.z & 0xFFFF0000u) + __uint_as_float(g.z & 0xFFFF0000u));
            w.w = cvtpk(__uint_as_float(w.w << 16) + __uint_as_float(g.w << 16), __uint_as_float(w.w & 0xFFFF0000u) + __uint_as_float(g.w & 0xFFFF0000u));
        }
        *gp = w;
    }
}

struct Src { const bf16_t* K; const bf16_t* V; int stride; };
template <bool HASV>
__device__ __forceinline__ void dma_first(const Src s, char* lds, int j, int wid, int lane_in) {
    LAS unsigned char* ldsl = (LAS unsigned char*)lds;
    const bf16_t* kt_ = s.K + (size_t)j * 64 * s.stride; const bf16_t* vt_ = s.V + (size_t)j * 64 * s.stride;
    int ln_ = lane_in; asm volatile("" : "+v"(ln_));
#pragma unroll
    for (int i_ = 0; i_ < 2; ++i_) {
        const int row_ = i_ * 32 + wid * 4 + (ln_ >> 4), srcch_ = (ln_ & 15) ^ (row_ & 7);
        __builtin_amdgcn_global_load_lds((const unsigned*)(kt_ + (row_ * s.stride + srcch_ * 8)), (LAS unsigned*)(ldsl + L_K + i_ * 8192 + wid * 1024), 16, 0, 0);
        if (HASV) { const int kk_ = (i_ * 4 + (wid >> 1)) * 8 + ((ln_ & 31) >> 2), k_ = (kk_ & ~0xC) | ((kk_ & 4) << 1) | ((kk_ & 8) >> 1), cc_ = ((wid & 1) * 2 + (ln_ >> 5)) * 32 + (ln_ & 3) * 8;
            __builtin_amdgcn_global_load_lds((const unsigned*)(vt_ + (k_ * s.stride + cc_)), (LAS unsigned*)(ldsl + L_V + i_ * 8192 + wid * 1024), 16, 0, 0); }
    }
}

template <int MODE, bool PRE = false>
__device__ __forceinline__ void branch(const Src s, char* lds, const bf16x8* qr, f32x16* o, float& m, float& l, int NTL, int jbase, int t, int qb, int wid, int lane, int tid,
                                       const unsigned (&selw)[4], float inv_l) {
    const int r32 = lane & 31, hi = lane >> 5, rh = wid >> 1, iq = (wid & 1) * 32 + r32;
    char* V_lds = lds + L_V; char* K_lds = lds + L_K;
    float* al_l = (float*)(lds + L_WS) + wid * 64 + 32;
    const float* lut = (const float*)(lds + L_LUT) + rh * 128;
    const int* tl = (const int*)(lds + L_TL);
    float* impL = (float*)(lds + L_IMP);
    const int vb0 = (int)(uintptr_t)V_lds + v_rd_base(lane);
    const float cb = lut[127];
    constexpr bool HASV = MODE != 0;
    LAS unsigned char* ldsl = (LAS unsigned char*)lds;
#define TILE_OF(n) (MODE == 2 ? tl[n] : jbase + (n))
#define DMA(j, bf) do { const bf16_t* kt_ = s.K + (size_t)(j) * 64 * s.stride; const bf16_t* vt_ = s.V + (size_t)(j) * 64 * s.stride; \
        int ln_ = lane; asm volatile("" : "+v"(ln_));        \
        _Pragma("unroll") for (int i_ = 0; i_ < 2; ++i_) { \
            const int row_ = i_ * 32 + wid * 4 + (ln_ >> 4), srcch_ = (ln_ & 15) ^ (row_ & 7); \
            __builtin_amdgcn_global_load_lds((const unsigned*)(kt_ + (row_ * s.stride + srcch_ * 8)), (LAS unsigned*)(ldsl + L_K + (bf) * SHM_K + i_ * 8192 + wid * 1024), 16, 0, 0); \
            if (HASV) { const int kk_ = (i_ * 4 + (wid >> 1)) * 8 + ((ln_ & 31) >> 2), k_ = (kk_ & ~0xC) | ((kk_ & 4) << 1) | ((kk_ & 8) >> 1), cc_ = ((wid & 1) * 2 + (ln_ >> 5)) * 32 + (ln_ & 3) * 8; \
                __builtin_amdgcn_global_load_lds((const unsigned*)(vt_ + (k_ * s.stride + cc_)), (LAS unsigned*)(ldsl + L_V + (bf) * SHM_V + i_ * 8192 + wid * 1024), 16, 0, 0); } } } while (0)
#define COMPUTE(n, BF) do { const int j_ = TILE_OF(n); \
        bool act_ = true; bool rowsel_ = true; \
        if (MODE == 2) { const unsigned w_ = j_ < 32 ? selw[0] : j_ < 64 ? selw[1] : j_ < 96 ? selw[2] : selw[3]; rowsel_ = (w_ >> (j_ & 31)) & 1u; act_ = __any(rowsel_); } \
        if (act_) { f32x16 p0, p1; \
            qkt<BF>(p0, p1, K_lds, r32, hi, qr); \
              \
            const bool plain_ = MODE >= 2 && (qb - j_ > 2) && !(MODE == 3 && j_ == qb - 8); \
            float sc_ = C2, cb_ = cb; bool sel_ = rowsel_; \
            if (!plain_) { sc_ = 1.f; cb_ = 0.f; sel_ = true; \
                if (MODE <= 1) { \
                    if (64 * j_ + 63 >= 4 * qb - 10) bias_near<16>(p0, p1, t - 31 - 16 * (64 * j_ + 4 * hi), lut); else bias_const(p0, p1, cb); \
                    if (64 * j_ + 63 > ((64 * qb - 31) >> 4)) mask_tile(p0, p1, ((t - 31) >> 4) - 64 * j_ - 4 * hi, 1u << 30); \
                } else { \
                    bias_near<1>(p0, p1, t - 64 * j_ - 4 * hi, lut); \
                    if (MODE == 2) { if (j_ == qb) mask_tile(p0, p1, t - 64 * j_ - 4 * hi, 1u << 30); \
                        if (!rowsel_) { const float NEG_ = -__builtin_inff(); _Pragma("unroll") for (int r = 0; r < 16; ++r) { p0[r] = NEG_; p1[r] = NEG_; } } } \
                    else { if (j_ == qb || j_ == qb - 8) mask_tile(p0, p1, t - 64 * j_ - 4 * hi, 512u); } \
                } \
            } \
            if (MODE == 1) { \
                _Pragma("unroll") for (int r = 0; r < 16; ++r) { p0[r] = __builtin_amdgcn_exp2f(p0[r] - m) * inv_l; p1[r] = __builtin_amdgcn_exp2f(p1[r] - m) * inv_l; } \
                _Pragma("unroll") for (int a = 0; a < 4; ++a) { \
                    const int jj0 = 16 * j_ + 2 * a + hi, jj1 = jj0 + 8; \
                      \
                      \
                    atomicAdd((unsigned*)&impL[iq * 128 + (jj0 ^ (iq & 31))], (unsigned)((p0[4 * a] + p0[4 * a + 1] + p0[4 * a + 2] + p0[4 * a + 3]) * 536870912.f + 0.5f)); \
                    atomicAdd((unsigned*)&impL[iq * 128 + (jj1 ^ (iq & 31))], (unsigned)((p1[4 * a] + p1[4 * a + 1] + p1[4 * a + 2] + p1[4 * a + 3]) * 536870912.f + 0.5f)); \
                    if (jj0 + 1 < 128) atomicAdd((unsigned*)&impL[iq * 128 + ((jj0 + 1) ^ (iq & 31))], (unsigned)(p0[4 * a + 3] * 536870912.f + 0.5f)); \
                    if (jj1 + 1 < 128) atomicAdd((unsigned*)&impL[iq * 128 + ((jj1 + 1) ^ (iq & 31))], (unsigned)(p1[4 * a + 3] * 536870912.f + 0.5f)); } \
            } else { float alpha_; softmax_online(p0, p1, sc_, cb_, sel_, m, l, alpha_); if (MODE != 0) rescale_o(o, alpha_, al_l, r32, hi); } \
            if (MODE != 0) { bf16x8 pa0, pa1, pa2, pa3; pack_p(p0, p1, pa0, pa1, pa2, pa3); pv_tile<BF>(o, vb0, pa0, pa1, pa2, pa3); } \
        } } while (0)
#define STEP(n, BF) do { \
        if ((n) + 1 < NTL) DMA(TILE_OF((n) + 1), 1 - (BF)); \
        SBAR(); COMPUTE(n, BF); SBAR(); \
        asm volatile("s_waitcnt vmcnt(0)" ::: "memory"); \
        __syncthreads(); } while (0)
    if (NTL > 0) {
        if (!PRE) DMA(TILE_OF(0), 0);
        asm volatile("s_waitcnt vmcnt(0)" ::: "memory");
        __syncthreads();
        for (int n = 0; n < NTL; n += 2) { STEP(n, 0); if (n + 1 < NTL) STEP(n + 1, 1); }
    }
#undef TILE_OF
#undef DMA
#undef COMPUTE
#undef STEP
}

__device__ __forceinline__ void item(unsigned char* ws, int b, int g, int qb, char* lds) {
    const int tid = tid_(), wid = __builtin_amdgcn_readfirstlane(tid >> 6), lane = tid & 63, r32 = lane & 31, hi = lane >> 5, rh = wid >> 1, iq = (wid & 1) * 32 + r32;
    const int t = qb * 64 + iq, head = g * 4 + rh;
    bf16_t* proj = (bf16_t*)(ws + OFF_PROJ);
    const size_t tok0 = (size_t)b * T_;
    float* impL = (float*)(lds + L_IMP); unsigned* selL = (unsigned*)(lds + L_SEL); unsigned* uniL = (unsigned*)(lds + L_UNI); int* tl = (int*)(lds + L_TL);
    const Src scmp{(const bf16_t*)(ws + OFF_KCMP) + (size_t)(b * 2 + g) * 512 * 128, (const bf16_t*)(ws + OFF_VCMP) + (size_t)(b * 2 + g) * 512 * 128, 128};
    dma_first<false>(scmp, lds, 0, wid, lane);
    for (int i = tid; i < 64 * 128; i += 512) impL[i] = 0.f;
    if (tid < 4) uniL[tid] = 0u;
    { const float* lutg = (const float*)(ws + OFF_LUT) + (g * 4) * 128; ((float*)(lds + L_LUT))[tid] = lutg[tid] * LOG2E; }
    bf16x8 qr[8];
    { const bf16_t* qp = proj + (tok0 + t) * LDP + C_NQ + head * 128 + hi * 8;
#pragma unroll
      for (int d0 = 0; d0 < 8; ++d0) qr[d0] = *(const bf16x8*)(qp + d0 * 16); }
    unsigned selw[4] = {0u, 0u, 0u, 0u};
    f32x16 o[4];
    __syncthreads();
    {
        const Src s{(const bf16_t*)(ws + OFF_KCMP) + (size_t)(b * 2 + g) * 512 * 128, (const bf16_t*)(ws + OFF_VCMP) + (size_t)(b * 2 + g) * 512 * 128, 128};
        const int nct = ((4 * qb + 2) >> 6) + 1;
        float m = -1e30f, l = 0.f;
        branch<0, true>(s, lds, qr, o, m, l, nct, 0, t, qb, wid, lane, tid, selw, 0.f);
#pragma unroll
        for (int d = 0; d < 4; ++d) o[d] = f32x16{};
        const float inv_l = l > 0.f ? 1.f / l : 0.f;
        branch<1>(s, lds, qr, o, m, l, nct, 0, t, qb, wid, lane, tid, selw, inv_l);
        flush_out(o, 1.f, 0, ws, lds, b, g, qb, wid, lane, true);
    }
    __syncthreads();
    { const Src ssel{proj + tok0 * LDP + C_KS + g * 128, proj + tok0 * LDP + C_VS + g * 128, LDP}; dma_first<true>(ssel, lds, 0, wid, lane); }
    {
        const int q = wid * 8 + (lane >> 3), sub = lane & 7;
        unsigned m0 = 0u, m1 = 0u, m2 = 0u, m3 = 0u;
        if (qb <= 15) { m0 = qb == 31 ? 0xFFFFFFFFu : ((1u << (qb + 1)) - 1u); }
        else {
            unsigned key[16];
#pragma unroll
            for (int k = 0; k < 16; ++k) { const int j = sub * 16 + k; key[k] = (j >= 1 && j <= qb - 2) ? ((__float_as_uint(impL[q * 128 + (j ^ (q & 31))]) & ~0x7Fu) | (unsigned)(127 - j)) : 0u; }
            for (int it = 0; it < 13; ++it) {
                unsigned lm = key[0];
#pragma unroll
                for (int k = 1; k < 16; ++k) lm = lm > key[k] ? lm : key[k];
                unsigned gm = lm, x;
                x = (unsigned)__builtin_amdgcn_update_dpp(0, (int)gm, 0xB1, 0xF, 0xF, true); gm = gm > x ? gm : x;
                x = (unsigned)__builtin_amdgcn_update_dpp(0, (int)gm, 0x4E, 0xF, 0xF, true); gm = gm > x ? gm : x;
                x = (unsigned)__builtin_amdgcn_update_dpp(0, (int)gm, 0x141, 0xF, 0xF, true); gm = gm > x ? gm : x;
#pragma unroll
                for (int k = 0; k < 16; ++k) key[k] = key[k] == gm ? 0u : key[k];
                const int j = 127 - (int)(gm & 0x7Fu);
                const unsigned bit = 1u << (j & 31);
                m0 |= j < 32 ? bit : 0u; m1 |= (j >= 32 && j < 64) ? bit : 0u; m2 |= (j >= 64 && j < 96) ? bit : 0u; m3 |= j >= 96 ? bit : 0u;
            }
            m0 |= 1u;
            { const int j = qb; const unsigned bit = 1u << (j & 31); m0 |= j < 32 ? bit : 0u; m1 |= (j >= 32 && j < 64) ? bit : 0u; m2 |= (j >= 64 && j < 96) ? bit : 0u; m3 |= j >= 96 ? bit : 0u; }
            { const int j = qb - 1; const unsigned bit = 1u << (j & 31); m0 |= j < 32 ? bit : 0u; m1 |= (j >= 32 && j < 64) ? bit : 0u; m2 |= (j >= 64 && j < 96) ? bit : 0u; m3 |= j >= 96 ? bit : 0u; }
        }
        if (sub == 0) { selL[q * 4 + 0] = m0; selL[q * 4 + 1] = m1; selL[q * 4 + 2] = m2; selL[q * 4 + 3] = m3;
                        atomicOr(&uniL[0], m0); atomicOr(&uniL[1], m1); atomicOr(&uniL[2], m2); atomicOr(&uniL[3], m3); }
    }
    __syncthreads();
    int nsl = 0;
    {
        if (wid == 0) {
            const bool s0 = lane <= qb && ((uniL[lane >> 5] >> (lane & 31)) & 1u), s1 = lane + 64 <= qb && ((uniL[2 + (lane >> 5)] >> (lane & 31)) & 1u);
            const unsigned long long b0 = __ballot(s0), b1 = __ballot(s1), below = (1ull << lane) - 1ull;
            const int n0 = __popcll(b0);
            if (s0) tl[__popcll(b0 & below)] = lane;
            if (s1) tl[n0 + __popcll(b1 & below)] = lane + 64;
            if (lane == 0) tl[128] = n0 + __popcll(b1);
        }
        selw[0] = selL[iq * 4 + 0]; selw[1] = selL[iq * 4 + 1]; selw[2] = selL[iq * 4 + 2]; selw[3] = selL[iq * 4 + 3];
        __syncthreads();
        nsl = tl[128];
    }
    {
        const Src s{proj + tok0 * LDP + C_KS + g * 128, proj + tok0 * LDP + C_VS + g * 128, LDP};
        float m = -1e30f, l = 0.f;
#pragma unroll
        for (int d = 0; d < 4; ++d) o[d] = f32x16{};
        branch<2, true>(s, lds, qr, o, m, l, nsl, 0, t, qb, wid, lane, tid, selw, 0.f);
        { const Src sw{proj + tok0 * LDP + C_KW + g * 128, proj + tok0 * LDP + C_VW + g * 128, LDP}; dma_first<true>(sw, lds, qb >= 8 ? qb - 8 : 0, wid, lane); }
        flush_out(o, l, 1, ws, lds, b, g, qb, wid, lane, false);
    }
    __syncthreads();
    {
        const Src s{proj + tok0 * LDP + C_KW + g * 128, proj + tok0 * LDP + C_VW + g * 128, LDP};
        const int jlo = qb >= 8 ? qb - 8 : 0;
        float m = -1e30f, l = 0.f;
#pragma unroll
        for (int d = 0; d < 4; ++d) o[d] = f32x16{};
        branch<3, true>(s, lds, qr, o, m, l, qb - jlo + 1, jlo, t, qb, wid, lane, tid, selw, 0.f);
        flush_out(o, l, 2, ws, lds, b, g, qb, wid, lane, false);
    }
    __syncthreads();
}
#undef KSWZ
#undef SBAR
}

__device__ void ph_hpre(const Params& p, int u) {
    const int tid = tid_(), b = u >> 8, n = u & 255, c2 = tid * 2;
    char* proj = (char*)(p.ws + OFF_PROJ) + (size_t)(b * T_ + n * 32) * (LDP * 2);
    const unsigned vo = (unsigned)c2 * 2u;
    const float* lb = (const float*)(p.ws + OFF_LB);
    const float kb0 = 1.f - lb[c2], kb1 = 1.f - lb[c2 + 1];
    float b0[32], b1[32];
    unsigned wf[32], wq[32];
#pragma unroll
    for (int i = 0; i < 32; ++i) wf[i] = *(const unsigned*)(proj + ((size_t)i * (LDP * 2) + C_HF * 2) + vo);
#pragma unroll
    for (int i = 0; i < 32; ++i) wq[i] = *(const unsigned*)(proj + ((size_t)i * (LDP * 2) + C_HQ * 2) + vo);
    float s0 = 1.f, s1 = 1.f;
#pragma unroll
    for (int i = 0; i < 32; ++i) {
        const float r0 = __uint_as_float(wf[i] << 16), r1 = __uint_as_float(wf[i] & 0xFFFF0000u);
        const float k0 = kb0 * sigmoidf_(-r0), k1 = kb1 * sigmoidf_(-r1);
        s0 *= 1.f - k0; s1 *= 1.f - k1;
        b0[i] = s0; b1[i] = s1;
        wf[i] = pg8::cvt_pk_bf16(k0, k1);
    }
    const float il0 = __builtin_amdgcn_rcpf(fmaxf(s0, 1e-30f)), il1 = __builtin_amdgcn_rcpf(fmaxf(s1, 1e-30f));
#pragma unroll
    for (int i = 0; i < 32; ++i) {
        const float k0 = __uint_as_float(wf[i] << 16), k1 = __uint_as_float(wf[i] & 0xFFFF0000u);
        const float q0 = __uint_as_float(wq[i] << 16), q1 = __uint_as_float(wq[i] & 0xFFFF0000u);
        const float e0 = s0 * __builtin_amdgcn_rcpf(fmaxf(b0[i], 1e-30f)), e1 = s1 * __builtin_amdgcn_rcpf(fmaxf(b1[i], 1e-30f));
        unsigned long long ro = (unsigned long long)i * (LDP * 2); asm volatile("" : "+s"(ro));
        char* rp = proj + ro + vo;
        *(unsigned*)(rp + C_HQ * 2) = pg8::cvt_pk_bf16(q0 * (b0[i] * il0), q1 * (b1[i] * il1));
        *(unsigned*)(rp + C_HF * 2) = pg8::cvt_pk_bf16(k0 * e0, k1 * e1);
    }
    float* dec = (float*)(p.ws + OFF_DEC) + ((size_t)((b * 8 + (c2 >> 7)) * 256 + n)) * 256 + (c2 & 127);
    dec[0] = s0; dec[1] = s1;
}

namespace hg {
typedef short bf16x8 __attribute__((ext_vector_type(8)));
typedef short s16x4 __attribute__((ext_vector_type(4)));
typedef float f32x4 __attribute__((ext_vector_type(4)));
typedef unsigned u32x4 __attribute__((ext_vector_type(4)));
constexpr int BUF = 25600, L_QA = 0, L_KE = 8192, L_VV = 16384, L_DEC = 24576, L_OB = 51200, OBS = 132;
__device__ __forceinline__ unsigned off_b(unsigned row, unsigned ch) { return 256u * row + 16u * (ch ^ (((row & 3) << 2) | ((row >> 2) & 3))); }
__device__ __forceinline__ unsigned tr_addr16(unsigned lane, unsigned c, unsigned t) {
    const unsigned g = lane >> 4, q = (lane & 15) >> 2, pp = lane & 3;
    return off_b(8 * g + 4 * t + q, 2 * c + (pp >> 1)) + 8 * (pp & 1);
}
__device__ __forceinline__ unsigned cvtpk(float lo, float hi) { unsigned r; asm volatile("v_cvt_pk_bf16_f32 %0, %1, %2" : "=v"(r) : "v"(lo), "v"(hi)); return r; }
__device__ __forceinline__ bf16x8 pack8(f32x4 a, f32x4 b) { u32x4 w = {cvtpk(a[0], a[1]), cvtpk(a[2], a[3]), cvtpk(b[0], b[1]), cvtpk(b[2], b[3])}; return *reinterpret_cast<bf16x8*>(&w); }
__device__ __forceinline__ s16x4 tr_read(unsigned addr) { s16x4 r; asm volatile("ds_read_b64_tr_b16 %0, %1" : "=v"(r) : "v"(addr) : "memory"); return r; }

__device__ __forceinline__ void item(unsigned char* ws, const float* norm_w, int b, int h, char* lds) {
    const int tid = tid_(), wid = __builtin_amdgcn_readfirstlane(tid >> 6), lane = tid & 63, l15 = lane & 15, g = lane >> 4;
    bf16_t* proj = (bf16_t*)(ws + OFF_PROJ) + (size_t)b * T_ * LDP + h * 128;
    const float* decg = (const float*)(ws + OFF_DEC) + (size_t)(b * 8 + h) * 256 * 256;
    LAS unsigned char* ldsl = (LAS unsigned char*)lds;
    const unsigned ldsb = (unsigned)(uintptr_t)lds;
    const int drow = 4 * wid + (lane >> 4);
    const unsigned dsrc = (unsigned)(drow * LDP + (((lane & 15) ^ (((drow & 3) << 2) | ((drow >> 2) & 3))) * 8));
#define HDMA(n, bf) do { const bf16_t* cp_ = proj + (size_t)(n) * 32 * LDP + dsrc; \
        __builtin_amdgcn_global_load_lds((const unsigned*)(cp_ + C_HQ), (LAS unsigned*)(ldsl + (bf) * BUF + L_QA + wid * 1024), 16, 0, 0); \
        __builtin_amdgcn_global_load_lds((const unsigned*)(cp_ + C_HF), (LAS unsigned*)(ldsl + (bf) * BUF + L_KE + wid * 1024), 16, 0, 0); \
        __builtin_amdgcn_global_load_lds((const unsigned*)(cp_ + C_HI), (LAS unsigned*)(ldsl + (bf) * BUF + L_VV + wid * 1024), 16, 0, 0); \
        if (wid == 0) __builtin_amdgcn_global_load_lds((const unsigned*)(decg + (size_t)(n) * 256 + lane * 4), (LAS unsigned*)(ldsl + (bf) * BUF + L_DEC), 16, 0, 0); } while (0)
    unsigned a_ke[2], a_qa[2], a_qp[2], a_vt[2];
#pragma unroll
    for (int x = 0; x < 2; ++x) {
        a_ke[x] = off_b(8 * (l15 >> 2) + 4 * x + (l15 & 3), g);
        a_qa[x] = off_b(16 * x + l15, g);
        a_qp[x] = off_b(16 * x + l15, g >> 1) + 8 * (g & 1);
        a_vt[x] = tr_addr16(lane, wid, x);
    }
    const int ntok = tid >> 4, ndv = (tid & 15) * 8;
    f32x4 S[8];
#pragma unroll
    for (int i = 0; i < 8; ++i) S[i] = (f32x4){0.f, 0.f, 0.f, 0.f};
    float* obuf = (float*)(lds + L_OB);
    const f32x4 n0 = *(const f32x4*)(norm_w + h * 128 + ndv), n1 = *(const f32x4*)(norm_w + h * 128 + ndv + 4);
    HDMA(0, 0); asm volatile("s_waitcnt vmcnt(0)" ::: "memory");
    __syncthreads();
    for (int n = 0; n < 256; ++n) {
        const int bf = n & 1;
        float* ob = obuf + bf * (32 * OBS);
        u32x4 hgw = *(const u32x4*)(proj + (size_t)(n * 32 + ntok) * LDP + C_HG + ndv);
        asm volatile("" ::: "memory");
        if (n + 1 < 256) HDMA(n + 1, bf ^ 1);
        const unsigned B0 = ldsb + bf * BUF;
        s16x4 v0 = tr_read(B0 + L_VV + a_vt[0]), v1 = tr_read(B0 + L_VV + a_vt[1]);
        f32x4 att[2][2];
#pragma unroll
        for (int x = 0; x < 2; ++x)
#pragma unroll
            for (int y = 0; y < 2; ++y) att[x][y] = (f32x4){0.f, 0.f, 0.f, 0.f};
        __builtin_amdgcn_s_setprio(1);
#pragma unroll
        for (int ks = 0; ks < 4; ++ks) {
            bf16x8 ka[2], qb[2];
#pragma unroll
            for (int x = 0; x < 2; ++x) {
                const unsigned rj = 8 * (l15 >> 2) + 4 * x + (l15 & 3), ri = 16 * x + l15;
                ka[x] = *(const LAS bf16x8*)(uintptr_t)(B0 + L_KE + off_b(rj, 4 * ks + g));
                qb[x] = *(const LAS bf16x8*)(uintptr_t)(B0 + L_QA + off_b(ri, 4 * ks + g));
            }
#pragma unroll
            for (int x = 0; x < 2; ++x)
#pragma unroll
                for (int y = 0; y < 2; ++y) att[x][y] = __builtin_amdgcn_mfma_f32_16x16x32_bf16(ka[x], qb[y], att[x][y], 0, 0, 0);
        }
        __builtin_amdgcn_s_setprio(0);
        bf16x8 attf[2];
#pragma unroll
        for (int y = 0; y < 2; ++y) {
            const int i = 16 * y + l15;
            f32x4 a0 = att[0][y], a1 = att[1][y];
#pragma unroll
            for (int r = 0; r < 4; ++r) { if (8 * g + r > i) a0[r] = 0.f; if (8 * g + 4 + r > i) a1[r] = 0.f; }
            attf[y] = pack8(a0, a1);
        }
        bf16x8 vf;
        { asm volatile("s_waitcnt lgkmcnt(0)" : "+v"(v0), "+v"(v1) :: "memory");
          vf = (bf16x8){v0[0], v0[1], v0[2], v0[3], v1[0], v1[1], v1[2], v1[3]}; }
        f32x4 o[2];
#pragma unroll
        for (int y = 0; y < 2; ++y) o[y] = __builtin_amdgcn_mfma_f32_16x16x32_bf16(vf, attf[y], (f32x4){0.f, 0.f, 0.f, 0.f}, 0, 0, 0);
#pragma unroll
        for (int dt = 0; dt < 8; ++dt) { const f32x4 d = *(const LAS f32x4*)(uintptr_t)(B0 + L_DEC + (16 * dt + 4 * g) * 4); S[dt] *= d; }
#pragma unroll
        for (int ks = 0; ks < 4; ++ks) {
            const bf16x8 sa = pack8(S[2 * ks], S[2 * ks + 1]);
#pragma unroll
            for (int y = 0; y < 2; ++y) {
                const unsigned ri = 16 * y + l15;
                const unsigned long long q0 = *(const LAS unsigned long long*)(uintptr_t)(B0 + L_QA + off_b(ri, 4 * ks + (g >> 1)) + 8 * (g & 1));
                const unsigned long long q1 = *(const LAS unsigned long long*)(uintptr_t)(B0 + L_QA + off_b(ri, 4 * ks + 2 + (g >> 1)) + 8 * (g & 1));
                u32x4 w = {(unsigned)q0, (unsigned)(q0 >> 32), (unsigned)q1, (unsigned)(q1 >> 32)};
                o[y] = __builtin_amdgcn_mfma_f32_16x16x32_bf16(sa, *reinterpret_cast<bf16x8*>(&w), o[y], 0, 0, 0);
            }
        }
#pragma unroll
        for (int dh = 0; dh < 2; ++dh) {
            s16x4 k0[4], k1[4];
#pragma unroll
            for (int d = 0; d < 4; ++d) { k0[d] = tr_read(B0 + L_KE + tr_addr16(lane, dh * 4 + d, 0)); k1[d] = tr_read(B0 + L_KE + tr_addr16(lane, dh * 4 + d, 1)); }
            asm volatile("s_waitcnt lgkmcnt(0)" : "+v"(k0[0]), "+v"(k0[1]), "+v"(k0[2]), "+v"(k0[3]), "+v"(k1[0]), "+v"(k1[1]), "+v"(k1[2]), "+v"(k1[3]) :: "memory");
#pragma unroll
            for (int d = 0; d < 4; ++d) {
                const bf16x8 kf = (bf16x8){k0[d][0], k0[d][1], k0[d][2], k0[d][3], k1[d][0], k1[d][1], k1[d][2], k1[d][3]};
                S[dh * 4 + d] = __builtin_amdgcn_mfma_f32_16x16x32_bf16(kf, vf, S[dh * 4 + d], 0, 0, 0);
            }
        }
#pragma unroll
        for (int y = 0; y < 2; ++y) *(f32x4*)(ob + (16 * y + l15) * OBS + 16 * wid + 4 * g) = o[y];
        asm volatile("s_waitcnt vmcnt(0)" ::: "memory");
        __syncthreads();
        asm volatile("" : "+v"(hgw));
        {
            const f32x4 x0 = *(const f32x4*)(ob + ntok * OBS + ndv), x1 = *(const f32x4*)(ob + ntok * OBS + ndv + 4);
            float ss = x0[0] * x0[0] + x0[1] * x0[1] + x0[2] * x0[2] + x0[3] * x0[3] + x1[0] * x1[0] + x1[1] * x1[1] + x1[2] * x1[2] + x1[3] * x1[3];
            ss += dpp_<0xB1>(ss); ss += dpp_<0x4E>(ss); ss += dpp_<0x141>(ss); ss += dpp_<0x140>(ss);
            const float r = rsqrtf(ss * (1.f / 128.f) + 1e-6f);
            const float gv[8] = {__uint_as_float(hgw.x << 16), __uint_as_float(hgw.x & 0xFFFF0000u), __uint_as_float(hgw.y << 16), __uint_as_float(hgw.y & 0xFFFF0000u),
                                 __uint_as_float(hgw.z << 16), __uint_as_float(hgw.z & 0xFFFF0000u), __uint_as_float(hgw.w << 16), __uint_as_float(hgw.w & 0xFFFF0000u)};
            const float xv[8] = {x0[0], x0[1], x0[2], x0[3], x1[0], x1[1], x1[2], x1[3]};
            const float nw[8] = {n0[0], n0[1], n0[2], n0[3], n1[0], n1[1], n1[2], n1[3]};
            float ov[8];
#pragma unroll
            for (int i = 0; i < 8; ++i) ov[i] = xv[i] * r * nw[i] * sigmoidf_(gv[i]);
            u32x4 w = {cvtpk(ov[0], ov[1]), cvtpk(ov[2], ov[3]), cvtpk(ov[4], ov[5]), cvtpk(ov[6], ov[7])};
            *(u32x4*)(proj + (size_t)(n * 32 + ntok) * LDP + C_HI + ndv) = w;
        }
    }
    __syncthreads();
#undef HDMA
    (void)a_ke; (void)a_qa; (void)a_qp;
}
}

__device__ void cvt_tile(float* sm, const float* src, int ldsrc, int k0, int ns0, int nvalid, bf16_t* dst, int lddst, int nd0) {
    (void)sm;
    const int tid = tid_(), n4 = (tid & 15) * 4, kg = tid >> 4;
    float4 v[8];
    const float* sp = src + (size_t)(k0 + kg * 8) * ldsrc + ns0 + n4;
#pragma unroll
    for (int i = 0; i < 8; ++i) v[i] = n4 < nvalid ? *(const float4*)(sp + (size_t)i * ldsrc) : make_float4(0.f, 0.f, 0.f, 0.f);
    bf16_t* dp = dst + (size_t)(nd0 + n4) * lddst + k0 + kg * 8;
    uint4 w;
    w.x = pk_bf16(v[0].x, v[1].x); w.y = pk_bf16(v[2].x, v[3].x); w.z = pk_bf16(v[4].x, v[5].x); w.w = pk_bf16(v[6].x, v[7].x); *(uint4*)dp = w;
    w.x = pk_bf16(v[0].y, v[1].y); w.y = pk_bf16(v[2].y, v[3].y); w.z = pk_bf16(v[4].y, v[5].y); w.w = pk_bf16(v[6].y, v[7].y); *(uint4*)(dp + lddst) = w;
    w.x = pk_bf16(v[0].z, v[1].z); w.y = pk_bf16(v[2].z, v[3].z); w.z = pk_bf16(v[4].z, v[5].z); w.w = pk_bf16(v[6].z, v[7].z); *(uint4*)(dp + 2 * (size_t)lddst) = w;
    w.x = pk_bf16(v[0].w, v[1].w); w.y = pk_bf16(v[2].w, v[3].w); w.z = pk_bf16(v[4].w, v[5].w); w.w = pk_bf16(v[6].w, v[7].w); *(uint4*)(dp + 3 * (size_t)lddst) = w;
}
__device__ __forceinline__ int gemm1_mg_src(int d) { const int tt = d >> 8, cc = d & 255; return 6680 + (cc < 128 ? tt * 128 + cc : 1024 + tt * 128 + (cc - 128)); }
__device__ __forceinline__ int gemm1_src_col(int nd) { return nd < 6656 ? nd : gemm1_mg_src(nd - 6656); }
__device__ void ph_cvt_win(const Params& p, int u, float* sm) {
    if (u < 544) {
        const int nt = u >> 2, kt = u & 3, nd0 = nt * 64;
        const int ns0 = nd0 < 6656 ? nd0 : gemm1_mg_src(nd0 - 6656), nvalid = 64;
        cvt_tile(sm, p.w_in, DIN, kt * 256, ns0, nvalid, (bf16_t*)(p.ws + OFF_WINT), 1024, nd0);
    } else {
        float* b1 = (float*)(p.ws + OFF_BIAS1);
        for (int i = tid_(); i < N1; i += 512) b1[i] = p.b_in[gemm1_src_col(i)];
    }
}
__device__ void ph_cvt_br(const Params& p, int u, float* sm) {
    const int w = u >> 6, t = u & 63, nt = t >> 2, kt = t & 3;
    if (w < 2) cvt_tile(sm, w == 0 ? p.w_br_hg : p.w_br_nsa, 1024, kt * 256, nt * 64, 64, (bf16_t*)(p.ws + OFF_WBRH) + w * 1024, 2048, nt * 64);
    else cvt_tile(sm, p.w_out, 1024, kt * 256, nt * 64, 64, (bf16_t*)(p.ws + OFF_WOUTT), 1024, nt * 64);
}
__device__ void ph_cvt_exp(const Params& p, int u, float* sm) {
    if (u < 2048) {
        const int e = u >> 6, t = u & 63, nt = t >> 2, kt = t & 3, nd0 = nt * 64, pn = nd0 >> 8, half = (nd0 >> 7) & 1, off = nd0 & 127;
        cvt_tile(sm, (half ? p.e_w3 : p.e_w1) + (size_t)e * 1024 * 512, 512, kt * 256, pn * 128 + off, 64, (bf16_t*)(p.ws + OFF_E13) + (size_t)e * 1024 * 1024, 1024, nd0);
    } else {
        const int v = u - 2048, e = v >> 5, t = v & 31, nt = t >> 1, kt = t & 1;
        cvt_tile(sm, p.e_w2 + (size_t)e * 512 * 1024, 1024, kt * 256, nt * 64, 64, (bf16_t*)(p.ws + OFF_E2T) + (size_t)e * 1024 * 512, 512, nt * 64);
    }
}
enum { PH_PRO = 0, PH_LN0, PH_CMP2, PH_FINAL };
__host__ __device__ constexpr int phase_units(int ph) { return ph == PH_PRO ? 99 : ph == PH_LN0 ? NT / 16 : ph == PH_CMP2 ? 256 : ph == PH_FINAL ? NT / 16 : 0; }

__device__ void ph_pro(const Params& p, int u, float* sm) {
    const int tid = tid_();
    float* mod = (float*)(p.ws + OFF_MOD);
    if (u < 192) {
        const int lane = tid & 63, w = tid >> 6, cq = lane & 7, kr = lane >> 3;
        float* ca = sm;
        float* red = sm + 4096;
        for (int i = tid; i < 4096; i += 512) ca[i] = siluf_(p.c[i]);
        __syncthreads();
        const float* wp = p.ada_w + (size_t)(w * 128 + kr) * 6144 + u * 32 + cq * 4;
        float4 wv[16];
#pragma unroll
        for (int i = 0; i < 16; ++i) wv[i] = *(const float4*)(wp + (size_t)(8 * i) * 6144);
        float4 acc[4];
#pragma unroll
        for (int b = 0; b < 4; ++b) acc[b] = make_float4(0.f, 0.f, 0.f, 0.f);
#pragma unroll
        for (int i = 0; i < 16; ++i)
#pragma unroll
            for (int b = 0; b < 4; ++b) { const float cv = ca[b * 1024 + w * 128 + 8 * i + kr]; acc[b].x = fmaf(cv, wv[i].x, acc[b].x); acc[b].y = fmaf(cv, wv[i].y, acc[b].y); acc[b].z = fmaf(cv, wv[i].z, acc[b].z); acc[b].w = fmaf(cv, wv[i].w, acc[b].w); }
#pragma unroll
        for (int b = 0; b < 4; ++b) *(float4*)(red + ((w * 8 + kr) * 4 + b) * 32 + cq * 4) = acc[b];
        __syncthreads();
        if (tid < 128) {
            const int b = tid >> 5, cl = tid & 31;
            float s = p.ada_b[u * 32 + cl];
#pragma unroll 8
            for (int g = 0; g < 64; ++g) s += red[(g * 4 + b) * 32 + cl];
            mod[b * 6144 + u * 32 + cl] = s;
        }
        __syncthreads();
    } else if (u < 256) {
        const int v = u - 192, kv = v >> 5, kc = v & 31;
        const float* pos = kv ? p.pos_v : p.pos_k; const float* w1 = kv ? p.w1_v : p.w1_k;
        const int n = tid & 127, kg = tid >> 7;
        float s = 0.f;
#pragma unroll 8
        for (int k = kc * 128 + kg * 32; k < kc * 128 + kg * 32 + 32; ++k) s = fmaf(pos[k], w1[(size_t)k * 128 + n], s);
        sm[kg * 128 + n] = s;
        __syncthreads();
        if (tid < 128) ((float*)(p.ws + OFF_HID))[(kv * 32 + kc) * 128 + tid] = (sm[tid] + sm[128 + tid]) + (sm[256 + tid] + sm[384 + tid]);
        __syncthreads();
    } else {
        float* lb = (float*)(p.ws + OFF_LB);
        float* lut = (float*)(p.ws + OFF_LUT);
        unsigned* cnt = (unsigned*)(p.ws + OFF_CNT);
        for (int i = tid; i < 1024; i += 512) {
            const float l0 = p.lb_logits[i], l1 = p.lb_logits[1024 + i];
            lb[i] = 1.f / (1.f + __expf(l1 - l0));
            const int h = i >> 7, d = i & 127;
            lut[i] = p.rel_bias[h * 32 + rel_bucket(d)];
        }
        if (tid < 64) cnt[tid] = 0u;
        if (tid < 10) ((unsigned*)(p.ws + OFF_QCTR))[tid * 64] = 0u;
        { bf16_t* kc = (bf16_t*)(p.ws + OFF_KCMP); bf16_t* vc = (bf16_t*)(p.ws + OFF_VCMP);
          for (int i = tid; i < 8 * 128; i += 512) { kc[(size_t)((i >> 7) * 512 + 511) * 128 + (i & 127)] = 0; vc[(size_t)((i >> 7) * 512 + 511) * 128 + (i & 127)] = 0; } }
    }
}

__device__ void ph_ln0_all(const Params& p, float* sm) {
    const int tidx = tid_(), lane = tidx & 63, w = tidx >> 6, c = blockIdx.x, G = gridDim.x, n16 = lane & 15, kq = lane >> 4;
    for (int i = tidx; i < 4096; i += 512) { const int b = i >> 10, cc = i & 1023; const float* mod = (const float*)(p.ws + OFF_MOD) + b * 6144; sm[b * 2048 + cc] = mod[cc]; sm[b * 2048 + 1024 + cc] = 1.f + mod[1024 + cc]; }
    constexpr int LG_A = 32768, LG_AB = 2064, LG_P = (LG_A + 16 * LG_AB) / 4;
    pg8::bf16x8 gw[2][4];
#pragma unroll
    for (int t = 0; t < 2; ++t)
#pragma unroll
        for (int sI = 0; sI < 4; ++sI) {
            pg8::u32x4 hh;
            const int col = 16 * t + n16;
#pragma unroll
            for (int j = 0; j < 4; ++j) { const int k = 128 * w + 32 * sI + 8 * kq + 2 * j;
                const float w0 = col < 24 ? p.w_in[(size_t)k * DIN + 6656 + col] : 0.f, w1 = col < 24 ? p.w_in[(size_t)(k + 1) * DIN + 6656 + col] : 0.f; hh[j] = pk_bf16(w0, w1); }
            gw[t][sI] = __builtin_bit_cast(pg8::bf16x8, hh);
        }
    const float gbias = tidx < 384 ? p.b_in[6656 + tidx % 24] : 0.f;
    __syncthreads();
    pg8::f32x4 ra[2][4], rb[2][4];
#define LN0_LOAD(dst, U_) do { _Pragma("unroll") for (int k = 0; k < 2; ++k) { const float* xr = p.x + (size_t)(((U_) + k * (NT / 16)) * 8 + w) * D_; \
        _Pragma("unroll") for (int i = 0; i < 4; ++i) dst[k][i] = *(const pg8::f32x4*)(xr + (i * 64 + lane) * 4); } asm volatile("" ::: "memory"); } while (0)
    auto norm = [&](pg8::f32x4 (&cur)[2][4], int u) __attribute__((always_inline)) {
#pragma unroll
        for (int k = 0; k < 2; ++k) {
            const int row = (u + k * (NT / 16)) * 8 + w;
            const LAS float* ml = (const LAS float*)sm + (row / T_) * 2048;
            bf16_t* h = (bf16_t*)(p.ws + OFF_H) + (size_t)row * D_;
            float s = 0.f;
#pragma unroll
            for (int i = 0; i < 4; ++i) s += (cur[k][i][0] + cur[k][i][1]) + (cur[k][i][2] + cur[k][i][3]);
            const float mu = wsum(s) * (1.f / 1024.f);
            float q = 0.f;
#pragma unroll
            for (int i = 0; i < 4; ++i) { cur[k][i] -= mu; q += cur[k][i][0] * cur[k][i][0] + cur[k][i][1] * cur[k][i][1] + cur[k][i][2] * cur[k][i][2] + cur[k][i][3] * cur[k][i][3]; }
            const float rs = rsqrtf(wsum(q) * (1.f / 1024.f) + 1e-5f);
#pragma unroll
            for (int i = 0; i < 4; ++i) {
                const int cc = (i * 64 + lane) * 4;
                const pg8::f32x4 sh = *(const LAS pg8::f32x4*)(ml + cc), sc = *(const LAS pg8::f32x4*)(ml + 1024 + cc);
                const pg8::f32x4 o = cur[k][i] * rs * sc + sh;
                const pg8::u32x2 pk = {pk_bf16(o[0], o[1]), pk_bf16(o[2], o[3])};
                *(pg8::u32x2*)(h + cc) = pk;
                *(LAS pg8::u32x2*)((LAS unsigned char*)sm + LG_A + (2 * w + k) * LG_AB + cc * 2) = pk;
            }
        }
        __syncthreads();
        {
            pg8::f32x4 acc[2] = {{0.f, 0.f, 0.f, 0.f}, {0.f, 0.f, 0.f, 0.f}};
            const LAS unsigned char* ar = (const LAS unsigned char*)sm + LG_A + n16 * LG_AB + (128 * w + 8 * kq) * 2;
#pragma unroll
            for (int sI = 0; sI < 4; ++sI) { const pg8::bf16x8 a = *(const LAS pg8::bf16x8*)(ar + sI * 64);
#pragma unroll
                for (int t = 0; t < 2; ++t) acc[t] = __builtin_amdgcn_mfma_f32_16x16x32_bf16(a, gw[t][sI], acc[t], 0, 0, 0); }
            LAS float* pp = (LAS float*)sm + LG_P + (w * 16 + 4 * kq) * 32 + n16;
#pragma unroll
            for (int t = 0; t < 2; ++t)
#pragma unroll
                for (int e = 0; e < 4; ++e) pp[e * 32 + 16 * t] = acc[t][e];
        }
        __syncthreads();
        if (tidx < 384) {
            const int r = tidx / 24, cg = tidx - r * 24;
            const LAS float* pr = (const LAS float*)sm + LG_P + r * 32 + cg;
            float sg = gbias;
#pragma unroll
            for (int ww = 0; ww < 8; ++ww) sg += pr[ww * 16 * 32];
            ((float*)(p.ws + OFF_GATE))[(size_t)((u + (r & 1) * (NT / 16)) * 8 + (r >> 1)) * 24 + cg] = sigmoidf_(sg);
        }
    };
    if (c < NT / 16) {
        LN0_LOAD(ra, c);
        for (int u = c; u < NT / 16; u += 2 * G) {
            const int u1 = u + G < NT / 16 ? u + G : u, u2 = u + 2 * G < NT / 16 ? u + 2 * G : u;
            LN0_LOAD(rb, u1);
            norm(ra, u);
            LN0_LOAD(ra, u2);
            if (u + G < NT / 16) norm(rb, u + G);
        }
    }
#undef LN0_LOAD
    __syncthreads();
}

__device__ void ph_cmp2(const Params& p, int u, float* sm) {
    const int tid = tid_(), kv = u >> 7, m0 = (u & 127) * 32;
    const float* w2 = kv ? p.w2_v : p.w2_k;
    const float* part = (const float*)(p.ws + OFF_PART) + (size_t)kv * 4096 * 256;
    const float* cb = (const float*)(p.ws + OFF_CB) + kv * 128;
    bf16_t* dst = (bf16_t*)(p.ws + (kv ? OFF_VCMP : OFF_KCMP));
    float(*As)[36] = (float(*)[36])sm;
    float(*Bs)[132] = (float(*)[132])(sm + 128 * 36);
    float4 bv[8];
#pragma unroll
    for (int r = 0; r < 8; ++r) { const int idx = tid + r * 512, row = idx >> 5, k4 = (idx & 31) * 4; bv[r] = *(const float4*)(w2 + (size_t)row * 128 + k4); }
    float4 av[2] = {make_float4(0.f, 0.f, 0.f, 0.f), make_float4(0.f, 0.f, 0.f, 0.f)};
#pragma unroll
    for (int kq = 0; kq < 4; ++kq)
#pragma unroll
        for (int r = 0; r < 2; ++r) { const int idx = tid + r * 512, row = idx >> 5, k4 = (idx & 31) * 4, m = m0 + row, m1 = (m & 511) == 511 ? m : m + 1;
            const float4 a0 = *(const float4*)(part + ((size_t)kq * 8192 + m) * 256 + k4), a1 = *(const float4*)(part + ((size_t)kq * 8192 + m1) * 256 + 128 + k4);
            av[r].x += a0.x + a1.x; av[r].y += a0.y + a1.y; av[r].z += a0.z + a1.z; av[r].w += a0.w + a1.w; }
#pragma unroll
    for (int r = 0; r < 2; ++r) { const int idx = tid + r * 512, row = idx >> 5, k4 = (idx & 31) * 4;
        const float4 c4 = *(const float4*)(cb + k4);
        As[k4][row] = siluf_(av[r].x + c4.x); As[k4 + 1][row] = siluf_(av[r].y + c4.y); As[k4 + 2][row] = siluf_(av[r].z + c4.z); As[k4 + 3][row] = siluf_(av[r].w + c4.w); }
#pragma unroll
    for (int r = 0; r < 8; ++r) { const int idx = tid + r * 512, row = idx >> 5, k4 = (idx & 31) * 4; *(float4*)&Bs[row][k4] = bv[r]; }
    __syncthreads();
    const int tx = tid & 31, ty = tid >> 5;
    float acc[2][4];
#pragma unroll
    for (int i = 0; i < 2; ++i)
#pragma unroll
        for (int j = 0; j < 4; ++j) acc[i][j] = 0.f;
#pragma unroll 8
    for (int k = 0; k < 128; ++k) {
        const float2 a0 = *(const float2*)&As[k][ty * 2]; const float4 bb = *(const float4*)&Bs[k][tx * 4];
        const float a_[2] = {a0.x, a0.y};
        const float b_[4] = {bb.x, bb.y, bb.z, bb.w};
#pragma unroll
        for (int i = 0; i < 2; ++i)
#pragma unroll
            for (int j = 0; j < 4; ++j) acc[i][j] = fmaf(a_[i], b_[j], acc[i][j]);
    }
#pragma unroll
    for (int i = 0; i < 2; ++i) {
        const int m = m0 + ty * 2 + i;
        const bool dead = (m & 511) == 511;
        st_bf4(dst + (size_t)m * 128 + tx * 4, dead ? 0.f : acc[i][0], dead ? 0.f : acc[i][1], dead ? 0.f : acc[i][2], dead ? 0.f : acc[i][3]);
    }
    __syncthreads();
}

constexpr int LR_A = 0, LR_AB = 2064, LR_P = 2 * 16 * LR_AB / 4, LR_SLOT = LR_P + 8 * 16 * 48, LR_LC = LR_SLOT + 8 * 80, LR_LNP = LR_LC + 64;
struct Ln1rArgs { unsigned char* ws; const float *ln1_g, *ln1_b, *rg_b, *re_b; float* sm; };
struct Ln1rW { const float *rg_w, *re_w; };
#define GAS __attribute__((address_space(1)))
template <class T> __device__ __forceinline__ GAS T* gptr(T* q) { return (GAS T*)q; }
#define LR_LOADZ(v, U_) do { _Pragma("unroll") for (int k = 0; k < 2; ++k) { const GAS bf16_t* zr_ = (const GAS bf16_t*)(ws + OFF_Z) + (size_t)((U_) * 16 + 2 * w + k) * D_; \
        _Pragma("unroll") for (int i = 0; i < 4; ++i) { const pg8::u32x2 a = *(const GAS pg8::u32x2*)(zr_ + (i * 64 + lane) * 4); v[k][i * 4] = __uint_as_float(a[0] << 16); v[k][i * 4 + 1] = __uint_as_float(a[0] & 0xFFFF0000u); \
            v[k][i * 4 + 2] = __uint_as_float(a[1] << 16); v[k][i * 4 + 3] = __uint_as_float(a[1] & 0xFFFF0000u); } } } while (0)
__device__ __forceinline__ void ph_ln1r_(const Ln1rArgs pa, const Ln1rW pw) {
    const int tidx = tid_(), lane = tidx & 63, w = tidx >> 6, n16 = lane & 15, kq = lane >> 4;
    GAS unsigned char* ws = gptr(pa.ws);
    const GAS float *ln1_g = gptr(pa.ln1_g), *ln1_b = gptr(pa.ln1_b), *rg_b = gptr(pa.rg_b), *re_b = gptr(pa.re_b), *rg_w = gptr(pw.rg_w), *re_w = gptr(pw.re_w);
    const int c = blockIdx.x, G = gridDim.x;
    LAS float* SM = (LAS float*)pa.sm;
    float va[2][16], vb[2][16];
    LR_LOADZ(va, c);
    for (int i = tidx; i < 1024; i += 512) {
        SM[LR_LNP + i] = ln1_g[i]; SM[LR_LNP + 1024 + i] = ln1_b[i];
#pragma unroll
        for (int bb = 0; bb < 4; ++bb) { const GAS float* mod = (const GAS float*)(ws + OFF_MOD) + bb * 6144; SM[LR_LNP + 2048 + bb * 2048 + i] = mod[3072 + i]; SM[LR_LNP + 3072 + bb * 2048 + i] = 1.f + mod[4096 + i]; }
    }
    const int fa_k = lane >= 36 ? 1 : 0, fa_n = lane - 36 * fa_k, fb_n = lane < 8 ? 28 + lane : 35;
    const int fa_c = fa_n < 4 ? 32 + fa_n : fa_n - 4, fb_c = fb_n - 4;
    const float bias_a = fa_n < 4 ? rg_b[fa_n] : re_b[fa_n - 4], bias_b = re_b[fb_n - 4];
    pg8::bf16x8 bwh[3][4], bwl[3][4];
#pragma unroll
    for (int t = 0; t < 3; ++t)
#pragma unroll
        for (int sI = 0; sI < 4; ++sI) {
            float wv[8];
#pragma unroll
            for (int j = 0; j < 8; ++j) { const int k = 128 * w + 32 * sI + 8 * kq + j; wv[j] = t == 0 ? re_w[k * 32 + n16] : t == 1 ? re_w[k * 32 + 16 + n16] : rg_w[k * 4 + (n16 & 3)]; }
            if (t == 2) {
#pragma unroll
                for (int j = 0; j < 8; ++j) wv[j] = n16 < 4 ? wv[j] : 0.f;
            }
            pg8::u32x4 hh, ll;
#pragma unroll
            for (int j = 0; j < 4; ++j) { const unsigned ph = pk_bf16(wv[2 * j], wv[2 * j + 1]); hh[j] = ph; ll[j] = pk_bf16(wv[2 * j] - __uint_as_float(ph << 16), wv[2 * j + 1] - __uint_as_float(ph & 0xFFFF0000u)); }
            bwh[t][sI] = __builtin_bit_cast(pg8::bf16x8, hh); bwl[t][sI] = __builtin_bit_cast(pg8::bf16x8, ll);
        }
    __syncthreads();
    auto unit = [&](float (&v)[2][16], int u, int upre) __attribute__((always_inline)) {
        const int row0 = u * 16 + 2 * w, b = row0 / T_;
        const LAS float* lnp = SM + LR_LNP;
#pragma unroll
        for (int k = 0; k < 2; ++k) {
            GAS bf16_t* zr = (GAS bf16_t*)(ws + OFF_Z) + (size_t)(row0 + k) * D_;
            GAS bf16_t* h2 = (GAS bf16_t*)(ws + OFF_H) + (size_t)(row0 + k) * D_;
            float s1 = 0.f;
#pragma unroll
            for (int i = 0; i < 16; ++i) s1 += v[k][i];
            float mu = wsum(s1) * (1.f / 1024.f), q = 0.f;
#pragma unroll
            for (int i = 0; i < 16; ++i) { v[k][i] -= mu; q = fmaf(v[k][i], v[k][i], q); }
            float rs = rsqrtf(wsum(q) * (1.f / 1024.f) + 1e-5f);
            float s2 = 0.f;
#pragma unroll
            for (int i = 0; i < 4; ++i) {
                const int cc = (i * 64 + lane) * 4;
                const pg8::f32x4 gg = *(const LAS pg8::f32x4*)(lnp + cc), bb = *(const LAS pg8::f32x4*)(lnp + 1024 + cc);
                v[k][i * 4] = v[k][i * 4] * rs * gg[0] + bb[0]; v[k][i * 4 + 1] = v[k][i * 4 + 1] * rs * gg[1] + bb[1]; v[k][i * 4 + 2] = v[k][i * 4 + 2] * rs * gg[2] + bb[2]; v[k][i * 4 + 3] = v[k][i * 4 + 3] * rs * gg[3] + bb[3];
                { pg8::u32x2 pk = {pk_bf16(v[k][i * 4], v[k][i * 4 + 1]), pk_bf16(v[k][i * 4 + 2], v[k][i * 4 + 3])}; *(GAS pg8::u32x2*)(zr + cc) = pk; }
                s2 += v[k][i * 4] + v[k][i * 4 + 1] + v[k][i * 4 + 2] + v[k][i * 4 + 3];
            }
            mu = wsum(s2) * (1.f / 1024.f); q = 0.f;
#pragma unroll
            for (int i = 0; i < 16; ++i) { v[k][i] -= mu; q = fmaf(v[k][i], v[k][i], q); }
            rs = rsqrtf(wsum(q) * (1.f / 1024.f) + 1e-5f);
#pragma unroll
            for (int i = 0; i < 4; ++i) {
                const int cc = (i * 64 + lane) * 4;
                const pg8::f32x4 sh = *(const LAS pg8::f32x4*)(lnp + 2048 + b * 2048 + cc), sc = *(const LAS pg8::f32x4*)(lnp + 3072 + b * 2048 + cc);
                const pg8::f32x4 o = {v[k][i * 4] * rs * sc[0] + sh[0], v[k][i * 4 + 1] * rs * sc[1] + sh[1], v[k][i * 4 + 2] * rs * sc[2] + sh[2], v[k][i * 4 + 3] * rs * sc[3] + sh[3]};
                {
                    const pg8::u32x2 pk = {pk_bf16(o[0], o[1]), pk_bf16(o[2], o[3])};
                    *(GAS pg8::u32x2*)(h2 + cc) = pk;
                    const pg8::u32x2 pl = {pk_bf16(o[0] - __uint_as_float(pk[0] << 16), o[1] - __uint_as_float(pk[0] & 0xFFFF0000u)), pk_bf16(o[2] - __uint_as_float(pk[1] << 16), o[3] - __uint_as_float(pk[1] & 0xFFFF0000u))};
                    LAS unsigned char* ab = (LAS unsigned char*)SM + (2 * w + k) * LR_AB + cc * 2;
                    *(LAS pg8::u32x2*)ab = pk; *(LAS pg8::u32x2*)(ab + 16 * LR_AB) = pl;
                }
            }
        }
        __syncthreads();
        LR_LOADZ(v, upre); asm volatile("" ::: "memory");
        {
            pg8::f32x4 acc[3] = {{0.f, 0.f, 0.f, 0.f}, {0.f, 0.f, 0.f, 0.f}, {0.f, 0.f, 0.f, 0.f}};
            const LAS unsigned char* ar = (const LAS unsigned char*)SM + n16 * LR_AB + (128 * w + 8 * kq) * 2;
            pg8::bf16x8 ah[4], al[4];
#pragma unroll
            for (int sI = 0; sI < 4; ++sI) { ah[sI] = *(const LAS pg8::bf16x8*)(ar + sI * 64); al[sI] = *(const LAS pg8::bf16x8*)(ar + 16 * LR_AB + sI * 64); }
#pragma unroll
            for (int sI = 0; sI < 4; ++sI)
#pragma unroll
                for (int t = 0; t < 3; ++t) {
                    acc[t] = __builtin_amdgcn_mfma_f32_16x16x32_bf16(al[sI], bwh[t][sI], acc[t], 0, 0, 0);
                    acc[t] = __builtin_amdgcn_mfma_f32_16x16x32_bf16(ah[sI], bwl[t][sI], acc[t], 0, 0, 0);
                    acc[t] = __builtin_amdgcn_mfma_f32_16x16x32_bf16(ah[sI], bwh[t][sI], acc[t], 0, 0, 0);
                }
            LAS float* pp = SM + LR_P + (w * 16 + 4 * kq) * 48 + n16;
#pragma unroll
            for (int t = 0; t < 3; ++t)
#pragma unroll
                for (int e = 0; e < 4; ++e) pp[e * 48 + 16 * t] = acc[t][e];
        }
        __syncthreads();
        {
            LAS float* slot = SM + LR_SLOT + w * 80;
            {
                const LAS float* pa_ = SM + LR_P + (2 * w + fa_k) * 48 + fa_c;
                const LAS float* pb_ = SM + LR_P + (2 * w + 1) * 48 + fb_c;
                float ta = bias_a, tb = bias_b;
#pragma unroll
                for (int ww = 0; ww < 8; ++ww) { ta += pa_[ww * 16 * 48]; tb += pb_[ww * 16 * 48]; }
                slot[lane] = ta;
                if (lane < 8) slot[64 + lane] = tb;
            }
            asm volatile("s_waitcnt lgkmcnt(0)" ::: "memory");
            const int kr = lane >> 5, row = row0 + kr;
            float lg[36];
#pragma unroll
            for (int q = 0; q < 9; ++q) { const pg8::f32x4 w4 = *(const LAS pg8::f32x4*)(slot + kr * 36 + q * 4); lg[q * 4] = w4[0]; lg[q * 4 + 1] = w4[1]; lg[q * 4 + 2] = w4[2]; lg[q * 4 + 3] = w4[3]; }
            int gi = 0; float gm = lg[0];
#pragma unroll
            for (int j = 1; j < 4; ++j) if (lg[j] > gm) { gm = lg[j]; gi = j; }
            float gs = 0.f;
#pragma unroll
            for (int j = 0; j < 4; ++j) gs += __expf(lg[j] - gm);
            const float gp = __builtin_amdgcn_rcpf(gs);
            float el[8];
#pragma unroll
            for (int i = 0; i < 8; ++i) el[i] = gi == 0 ? lg[4 + i] : gi == 1 ? lg[12 + i] : gi == 2 ? lg[20 + i] : lg[28 + i];
            int i0 = 0; float l0 = el[0];
#pragma unroll
            for (int i = 1; i < 8; ++i) if (el[i] > l0) { l0 = el[i]; i0 = i; }
            int i1 = -1; float l1 = -3.0e38f;
#pragma unroll
            for (int i = 0; i < 8; ++i) if (i != i0 && el[i] > l1) { l1 = el[i]; i1 = i; }
            const float w0 = __builtin_amdgcn_rcpf(1.f + __expf(l1 - l0));
            if ((lane & 31) == 0) {
                GAS int* ti = (GAS int*)(ws + OFF_TOKI) + (size_t)row * 6;
                const int e0 = gi * 8 + i0, e1 = gi * 8 + i1;
                ti[0] = e0; ti[1] = e1;
                LAS unsigned* lc = (LAS unsigned*)(SM + LR_LC);
                ti[2] = (int)__hip_atomic_fetch_add(lc + e0, 1u, __ATOMIC_RELAXED, __HIP_MEMORY_SCOPE_WORKGROUP); ti[3] = (int)__hip_atomic_fetch_add(lc + e1, 1u, __ATOMIC_RELAXED, __HIP_MEMORY_SCOPE_WORKGROUP);
                ((GAS float*)ti)[4] = gp * w0; ((GAS float*)ti)[5] = gp * (1.f - w0);
            }
        }
    };
    {
        const int last = c + ((NT / 16 - 1 - c) / G) * G;
        LR_LOADZ(vb, c + G <= last ? c + G : last);
        for (int u = c; u <= last; u += 2 * G) {
            unit(va, u, u + 2 * G <= last ? u + 2 * G : last);
            if (u + G <= last) unit(vb, u + G, u + 3 * G <= last ? u + 3 * G : last);
        }
    }
}
#undef LR_LOADZ

__device__ __forceinline__ int wave_offsets(const unsigned* cnt, int lane, int& pc_out, int& tot) {
    const int c = lane < 32 ? (int)cnt[lane] : 0;
    const int pc = ((c + 255) >> 8) << 8;
    int inc = pc;
    for (int o = 1; o < 64; o <<= 1) { const int t = __shfl_up(inc, o); if (lane >= o) inc += t; }
    tot = __shfl(inc, 63);
    pc_out = pc;
    return inc - pc;
}

struct FinTi { int r0[2], r1[2]; float w0[2], w1[2]; };
__device__ void ph_final_all(const Params& p, float* sm) {
    const int tidx = tid_(), lane = tidx & 63, w = tidx >> 6, c = blockIdx.x, G = gridDim.x;
    for (int i = tidx; i < 1024; i += 512) {
        sm[i] = p.ln2_g[i]; sm[1024 + i] = p.ln2_b[i];
#pragma unroll
        for (int b = 0; b < 4; ++b) sm[2048 + b * 1024 + i] = 1.f + ((const float*)(p.ws + OFF_MOD))[b * 6144 + 5120 + i];
    }
    __syncthreads();
    if (c >= NT / 16) return;
    pg8::u32x2 xa[2][4], ya[2][4], za[2][4], xb[2][4], yb[2][4], zb[2][4];
    FinTi ta, tb;
#define FIN_TI(t, U_) do { _Pragma("unroll") for (int k = 0; k < 2; ++k) { const int* ti = (const int*)(p.ws + OFF_TOKI) + (size_t)(((U_) + k * (NT / 16)) * 8 + w) * 6; \
        t.r0[k] = ti[2]; t.r1[k] = ti[3]; t.w0[k] = ((const float*)ti)[4]; t.w1[k] = ((const float*)ti)[5]; } asm volatile("" ::: "memory"); } while (0)
#define FIN_LOAD(X, Y, Z, t, U_) do { _Pragma("unroll") for (int k = 0; k < 2; ++k) { const bf16_t* x1 = (const bf16_t*)(p.ws + OFF_Z) + (size_t)(((U_) + k * (NT / 16)) * 8 + w) * D_; \
        const bf16_t* y0 = (const bf16_t*)(p.ws + OFF_XPAD) + (size_t)t.r0[k] * D_; const bf16_t* y1 = (const bf16_t*)(p.ws + OFF_XPAD) + (size_t)t.r1[k] * D_; \
        _Pragma("unroll") for (int i = 0; i < 4; ++i) { const int cc = (i * 64 + lane) * 4; X[k][i] = *(const pg8::u32x2*)(x1 + cc); Y[k][i] = *(const pg8::u32x2*)(y0 + cc); Z[k][i] = *(const pg8::u32x2*)(y1 + cc); } } \
        asm volatile("" ::: "memory"); } while (0)
    auto fin = [&](pg8::u32x2 (&X)[2][4], pg8::u32x2 (&Y)[2][4], pg8::u32x2 (&Z)[2][4], const FinTi& t, int u) __attribute__((always_inline)) {
#pragma unroll
        for (int k = 0; k < 2; ++k) {
            const int row = (u + k * (NT / 16)) * 8 + w;
            const LAS float* g2 = (const LAS float*)sm + 2048 + (row / T_) * 1024;
            float v[16]; float s = 0.f;
#pragma unroll
            for (int i = 0; i < 4; ++i) {
                const int cc = (i * 64 + lane) * 4;
                const pg8::f32x4 gg = *(const LAS pg8::f32x4*)(g2 + cc);
                const float xv[4] = {__uint_as_float(X[k][i][0] << 16), __uint_as_float(X[k][i][0] & 0xFFFF0000u), __uint_as_float(X[k][i][1] << 16), __uint_as_float(X[k][i][1] & 0xFFFF0000u)};
                const float av[4] = {__uint_as_float(Y[k][i][0] << 16), __uint_as_float(Y[k][i][0] & 0xFFFF0000u), __uint_as_float(Y[k][i][1] << 16), __uint_as_float(Y[k][i][1] & 0xFFFF0000u)};
                const float bv[4] = {__uint_as_float(Z[k][i][0] << 16), __uint_as_float(Z[k][i][0] & 0xFFFF0000u), __uint_as_float(Z[k][i][1] << 16), __uint_as_float(Z[k][i][1] & 0xFFFF0000u)};
#pragma unroll
                for (int j = 0; j < 4; ++j) { v[i * 4 + j] = ALPHA * xv[j] + gg[j] * (t.w0[k] * av[j] + t.w1[k] * bv[j]); s += v[i * 4 + j]; }
            }
            const float mu = wsum(s) * (1.f / 1024.f); float q = 0.f;
#pragma unroll
            for (int i = 0; i < 16; ++i) { v[i] -= mu; q = fmaf(v[i], v[i], q); }
            const float rs = rsqrtf(wsum(q) * (1.f / 1024.f) + 1e-5f);
#pragma unroll
            for (int i = 0; i < 4; ++i) {
                const int cc = (i * 64 + lane) * 4;
                const pg8::f32x4 lg = *(const LAS pg8::f32x4*)((const LAS float*)sm + cc), lb = *(const LAS pg8::f32x4*)((const LAS float*)sm + 1024 + cc);
                const pg8::f32x4 o = {v[i * 4] * rs * lg[0] + lb[0], v[i * 4 + 1] * rs * lg[1] + lb[1], v[i * 4 + 2] * rs * lg[2] + lb[2], v[i * 4 + 3] * rs * lg[3] + lb[3]};
                *(pg8::f32x4*)(p.out + (size_t)row * D_ + cc) = o;
            }
        }
    };
    const int last = c + ((NT / 16 - 1 - c) / G) * G;
    FIN_TI(ta, c);
    FIN_LOAD(xa, ya, za, ta, c);
    FIN_TI(tb, c + G <= last ? c + G : last);
    for (int u = c; u <= last; u += 2 * G) {
        const int u1 = u + G <= last ? u + G : last, u2 = u + 2 * G <= last ? u + 2 * G : last, u3 = u + 3 * G <= last ? u + 3 * G : last;
        FIN_LOAD(xb, yb, zb, tb, u1);
        FinTi tn; FIN_TI(tn, u2);
        fin(xa, ya, za, ta, u);
        ta = tn;
        FIN_LOAD(xa, ya, za, ta, u2);
        FIN_TI(tn, u3);
        if (u + G <= last) fin(xb, yb, zb, tb, u + G);
        tb = tn;
    }
#undef FIN_TI
#undef FIN_LOAD
}

template <int PH> __device__ __forceinline__ void run_unit(const Params& p, int u, float* sm) {
    if constexpr (PH == PH_CMP2) ph_cmp2(p, u, sm);
}

constexpr int MEGA_LDS = 153600 + 16;
enum { Q_PRO = 0, Q_LN0, Q_GEMM1, Q_CMP1, Q_CMP2, Q_MIX, Q_MRG, Q_WOUT, Q_LN1R, Q_PAD, Q_EXP1, Q_EXP2, Q_FINAL };
template <int PH> __device__ __forceinline__ void unit_loop(const Params& p, float* sm) {
    for (int u = blockIdx.x; u < phase_units(PH); u += gridDim.x) run_unit<PH>(p, u, sm);
}
template <int Q> __device__ __forceinline__ void run_phase(const Params& p, float* sm) {
    PG8_LAS unsigned char* lds = (PG8_LAS unsigned char*)sm;
    const int G = gridDim.x, c = blockIdx.x;
    if constexpr (Q == Q_PRO) {
        for (int L = c; L < 192; L += G) ph_pro(p, L, sm);
    }
    else if constexpr (Q == Q_LN0) {
        ph_ln0_all(p, sm);
        for (int L = 192 + c; L < 866; L += G) {
            if (L < 257) ph_pro(p, L, sm);
            else if (L < 321) { const int u = L - 257, kv = u >> 5, t = u & 31, nt = t >> 4, kt = t & 15;
                cvt_tile(sm, kv ? p.w1_v : p.w1_k, 128, kt * 256, nt * 64, 64, (bf16_t*)(p.ws + OFF_CMPW) + (size_t)kv * 128 * 4096, 4096, nt * 64); }
            else ph_cvt_win(p, L - 321, sm);
        }
    }
    else if constexpr (Q == Q_GEMM1) {
        pg8::Gemm g{(const bf16_t*)(p.ws + OFF_H), (const bf16_t*)(p.ws + OFF_WINT), 1024, 1024, 1024};
        pg8::StaticOrder S; S.init(NT, N1, G, c);
        pg8::EpiProj E{(bf16_t*)(p.ws + OFF_PROJ), (bf16_t*)p.out, (float*)(p.ws + OFF_GATE), (const float*)(p.ws + OFF_BIAS1)};
        pg8::gemm_phase(lds, g, S, E);
    }
    else if constexpr (Q == Q_CMP1) {
        {
            pg8::Gemm g{(const bf16_t*)(p.ws + OFF_PROJ), (const bf16_t*)(p.ws + OFF_CMPW), 512, 16 * LDP, 4096, 1, 2};
            pg8::CmpOrder S{G < 128 ? G : 128, c};
            pg8::EpiCmpAcc E{(float*)(p.ws + OFF_PART)};
            if (c < 128) pg8::gemm_phase(lds, g, S, E);
        }
        if (c == G - 1 && threadIdx.x < 256) {
            const int kv = threadIdx.x >> 7, n = threadIdx.x & 127;
            const float* cbp = (const float*)(p.ws + OFF_HID) + (size_t)kv * 32 * 128 + n;
            float sacc = (kv ? p.b1_v : p.b1_k)[n];
            for (int kc = 0; kc < 32; ++kc) sacc += cbp[kc * 128];
            ((float*)(p.ws + OFF_CB))[threadIdx.x] = sacc;
        }
        unsigned* qh = (unsigned*)(p.ws + OFF_QCTR) + 8 * 64;
        volatile int* slot = (volatile int*)((char*)sm + 131072 - 64);
        for (;;) {
            __syncthreads();
            if (threadIdx.x == 0) *slot = (int)__hip_atomic_fetch_add(qh, 1u, __ATOMIC_RELAXED, __HIP_MEMORY_SCOPE_AGENT);
            __syncthreads();
            const int it = *slot;
            if (it >= 1024 + 192) break;
            if (it < 1024) ph_hpre(p, it); else ph_cvt_br(p, it - 1024, sm);
        }
    }
    else if constexpr (Q == Q_CMP2) unit_loop<PH_CMP2>(p, sm);
    else if constexpr (Q == Q_MIX) {
        unsigned* qc = (unsigned*)(p.ws + OFF_QCTR);
        volatile int* slot = (volatile int*)((char*)sm + 131072 - 64);
        int q = c & 7;
        for (;;) {
            __syncthreads();
            if (threadIdx.x == 0) *slot = (int)__hip_atomic_fetch_add(qc + q * 64, 1u, __ATOMIC_RELAXED, __HIP_MEMORY_SCOPE_AGENT);
            __syncthreads();
            const int it = __builtin_amdgcn_readfirstlane(*slot);
            if (it < 4 + 128) {
                if (it < 4) hg::item(p.ws, p.hg_norm_w, q >> 1, (q & 1) * 4 + it, (char*)sm);
                else nsa::item(p.ws, q >> 1, q & 1, 127 - (it - 4), (char*)sm);
                continue;
            }
            __syncthreads();
            if (threadIdx.x < 64) {
                const unsigned hv = threadIdx.x < 8 ? __hip_atomic_load(qc + threadIdx.x * 64, __ATOMIC_RELAXED, __HIP_MEMORY_SCOPE_AGENT) : 0xFFFFFFFFu;
                int nq = -1;
                for (int k = 1; k < 8; ++k) { const int qq = (q + k) & 7; if ((unsigned)__builtin_amdgcn_readlane((int)hv, qq) < 132u) { nq = qq; break; } }
                if (threadIdx.x == 0) *slot = nq;
            }
            __syncthreads();
            q = __builtin_amdgcn_readfirstlane(*slot);
            if (q < 0) break;
        }
    }
    else if constexpr (Q == Q_MRG) {
        pg8::StaticOrder S; S.init(NT, 1024, G, c);
        pg8::Gemm g{(const bf16_t*)(p.ws + OFF_PROJ) + C_HI, (const bf16_t*)(p.ws + OFF_WBRH), 2048, LDP, 2048, 2, 0};
        pg8::EpiMrg E{(const bf16_t*)p.out, (bf16_t*)(p.ws + OFF_H)};
        pg8::gemm_phase(lds, g, S, E);
    }
    else if constexpr (Q == Q_WOUT) {
        pg8::Gemm g{(const bf16_t*)(p.ws + OFF_H), (const bf16_t*)(p.ws + OFF_WOUTT), 1024, 1024, 1024};
        pg8::StaticOrder S; S.init(NT, 1024, G, c);
        pg8::EpiWout E{p.x, (const float*)(p.ws + OFF_MOD), (bf16_t*)(p.ws + OFF_Z)};
        if (c & 1) { for (int u = c; u < 2048; u += G) ph_cvt_exp(p, u, sm); }
        __syncthreads();
        pg8::gemm_phase(lds, g, S, E);
        if (!(c & 1)) { for (int u = c; u < 2048; u += G) ph_cvt_exp(p, u, sm); }
    }
    else if constexpr (Q == Q_LN1R) {
        unsigned* lc = (unsigned*)(sm + LR_LC);
        if (threadIdx.x < 64) lc[threadIdx.x] = 0u;
        __syncthreads();
        ph_ln1r_(Ln1rArgs{p.ws, p.ln1_g, p.ln1_b, p.rg_b, p.re_b, sm}, Ln1rW{p.rg_w, p.re_w});
        __syncthreads();
        if (threadIdx.x < 32) lc[32 + threadIdx.x] = atomicAdd((unsigned*)(p.ws + OFF_CNT) + threadIdx.x, lc[threadIdx.x]);
        __syncthreads();
        for (int u = c; u < NT / 16; u += G) {
            if (threadIdx.x < 32) { int* ti = (int*)(p.ws + OFF_TOKI) + (size_t)(u * 16 + (threadIdx.x >> 1)) * 6; const int k = threadIdx.x & 1; ti[2 + k] += (int)lc[32 + ti[k]]; }
        }
        __syncthreads();
    }
    else if constexpr (Q == Q_PAD) {
        const int tidx = tid_(), lane = tidx & 63;
        const unsigned* cnt = (const unsigned*)(p.ws + OFF_CNT);
        int* inv = (int*)(p.ws + OFF_INV);
        int pc, tot; const int off = wave_offsets(cnt, lane, pc, tot);
        for (int base = c * 512; base < NT; base += G * 512) {
            const int tok = base + tidx;
            int* tw = (int*)(p.ws + OFF_TOKI) + (size_t)tok * 6;
            const int ra = __shfl(off, tw[0]) + tw[2], rb = __shfl(off, tw[1]) + tw[3];
            inv[ra] = tok; inv[rb] = tok; tw[2] = ra; tw[3] = rb;
        }
        for (int e = c; e < 32; e += G) {
            const int oe = __shfl(off, e), ce = (int)cnt[e], pe = __shfl(pc, e);
            for (int r = oe + ce + tidx; r < oe + pe; r += 512) inv[r] = 0;
        }
        if (c == G - 1) {
            int* te = (int*)(p.ws + OFF_TILEE);
            if (tidx < 32) { for (int r = off; r < off + pc; r += 256) te[r >> 8] = tidx; }
            if (tidx == 0) te[511] = tot >> 8;
        }
    }
    else if constexpr (Q == Q_EXP1) {
        const int* te = (const int*)(p.ws + OFF_TILEE);
        pg8::Gemm g{(const bf16_t*)(p.ws + OFF_H), (const bf16_t*)(p.ws + OFF_E13), 1024, 1024, 1024};
        pg8::MoeGatherOrder S{te, (const int*)(p.ws + OFF_INV), te[511] * 4, G, c, (long)1024 * 1024 * 2};
        pg8::EpiExp1 E{(bf16_t*)p.out};
        pg8::gemm_phase(lds, g, S, E);
        unsigned* qh = (unsigned*)(p.ws + OFF_QCTR) + 9 * 64;
        volatile int* slot = (volatile int*)((char*)sm + 131072 - 64);
        for (;;) {
            __syncthreads();
            if (threadIdx.x == 0) *slot = (int)__hip_atomic_fetch_add(qh, 1u, __ATOMIC_RELAXED, __HIP_MEMORY_SCOPE_AGENT);
            __syncthreads();
            const int it = *slot;
            if (it >= 1024) break;
            ph_cvt_exp(p, 2048 + it, sm);
        }
    }
    else if constexpr (Q == Q_EXP2) {
        const int* te = (const int*)(p.ws + OFF_TILEE);
        pg8::Gemm g{(const bf16_t*)p.out, (const bf16_t*)(p.ws + OFF_E2T), 512, 512, 512};
        pg8::MoeOrder S{te, te[511] * 4, G, c, (long)1024 * 512 * 2};
        pg8::EpiBf E{(bf16_t*)(p.ws + OFF_XPAD), 1024};
        pg8::gemm_phase(lds, g, S, E);
    }
    else if constexpr (Q == Q_FINAL) ph_final_all(p, sm);
}
__global__ void __launch_bounds__(512, 2) k_mega(Params p) {
    extern __shared__ __attribute__((aligned(16))) float smem[];
    volatile LAS unsigned* st = (volatile LAS unsigned*)(smem + 153600 / 4);
    if (threadIdx.x == 0) { st[0] = 0u; st[1] = 0u; st[2] = 0u; st[3] = 0u; }
    __syncthreads();
    XcdBarrier bar = xcd_barrier_post((unsigned*)(p.ws + OFF_BAR), st);
    run_phase<Q_PRO>(p, smem);   xcd_barrier(bar);
    run_phase<Q_LN0>(p, smem);   xcd_barrier(bar);
    run_phase<Q_GEMM1>(p, smem); xcd_barrier(bar);
    run_phase<Q_CMP1>(p, smem);  xcd_barrier(bar);
    run_phase<Q_CMP2>(p, smem);  xcd_barrier(bar);
    run_phase<Q_MIX>(p, smem);   xcd_barrier(bar);
    run_phase<Q_MRG>(p, smem);   xcd_barrier(bar);
    run_phase<Q_WOUT>(p, smem);  xcd_barrier(bar);
    run_phase<Q_LN1R>(p, smem);  xcd_barrier(bar);
    run_phase<Q_PAD>(p, smem);   xcd_barrier(bar);
    run_phase<Q_EXP1>(p, smem);  xcd_barrier(bar);
    run_phase<Q_EXP2>(p, smem);  xcd_barrier(bar);
    run_phase<Q_FINAL>(p, smem);
}

extern "C" void kernel_launch(void* const* d_in, const int* in_sizes, int n_in, void* d_out, int out_size, void* d_ws, size_t ws_size, hipStream_t stream) {
    Params p{};
    const float** fp = (const float**)&p;
    for (int i = 0; i < 31; ++i) fp[i] = (const float*)d_in[i];
    p.out = (float*)d_out; p.ws = (unsigned char*)d_ws;
    static int grid = 0;
    if (!grid) {
        int dev = 0, cus = 0, per_cu = 0;
        (void)hipGetDevice(&dev);
        (void)hipDeviceGetAttribute(&cus, hipDeviceAttributeMultiprocessorCount, dev);
        (void)hipFuncSetAttribute((const void*)k_mega, hipFuncAttributeMaxDynamicSharedMemorySize, MEGA_LDS);
        (void)hipOccupancyMaxActiveBlocksPerMultiprocessor(&per_cu, (const void*)k_mega, 512, MEGA_LDS);
        grid = cus * (per_cu < 1 ? per_cu : 1);
    }
    (void)hipMemsetAsync(p.ws + OFF_BAR, 0, OFF_CNT, stream);
    hipLaunchKernelGGL(k_mega, dim3(grid), dim3(512), MEGA_LDS, stream, p);
}
```
